# Optimizing an MI355X kernel written in HIP

```python
import math
import jax, jax.numpy as jnp
from jax import lax
import numpy as np

D_MODEL = 1024
BATCH = 8
SEQ = 4096
DEPTH = 2

D_MIX = D_MODEL
N_GROUPS = 4
GROUP = D_MIX // N_GROUPS
HEAD_DIM = 64
LRU_BLOCKS = GROUP // HEAD_DIM
LRU_BLOCK_DIM = GROUP // LRU_BLOCKS
LRU_CONV = 4
LRU_C = 8.0
SC_CONV = 3
FOX_HEADS = GROUP // HEAD_DIM
NSA_HEADS = GROUP // HEAD_DIM
CMP_LEN = 32
CMP_STRIDE = 16
CMP_HIDDEN = 128
SLC_BLOCK = 64
SLC_TOPK = 16
WINDOW = 512
Q_BLOCK = 128
REL_BUCKETS = 32
REL_MAX_DIST = 128
D_FF = ((8 * D_MODEL // 3 + 255) // 256) * 256
NEG_INF = -1e30
BIG = 1e30
RMS_EPS = 1e-6

C_LRU_X = 0
C_LRU_G = C_LRU_X + GROUP
C_SC_B = C_LRU_G + GROUP
C_SC_C = C_SC_B + GROUP
C_SC_X = C_SC_C + GROUP
C_FOX_Q = C_SC_X + GROUP
C_FOX_K = C_FOX_Q + GROUP
C_FOX_V = C_FOX_K + GROUP
C_FOX_F = C_FOX_V + GROUP
C_NSA_Q = C_FOX_F + FOX_HEADS
C_NSA_KV = C_NSA_Q + GROUP
C_NSA_G = C_NSA_KV + 6 * HEAD_DIM
N_IN = C_NSA_G + 3 * NSA_HEADS

kernel_name = "hymba_style_hybrid_lru_conv_fox_nsa"


def rms_norm(x, g):
    xf = x.astype(jnp.float32)
    y = xf * lax.rsqrt(jnp.mean(xf * xf, axis=-1, keepdims=True) + RMS_EPS)
    return (y * g.astype(jnp.float32)).astype(x.dtype)


def cols(z, start, width):
    return z[..., start:start + width]


def causal_dwconv(x, w):
    k_len, ch = w.shape
    return lax.conv_general_dilated(x, w[:, None, :], window_strides=(1,), padding=[(k_len - 1, 0)],
                                    dimension_numbers=('NWC', 'WIO', 'NWC'), feature_group_count=ch)


def masked_softmax(s, mask):
    p = jax.nn.softmax(jnp.where(mask, s, NEG_INF), axis=-1)
    return jnp.where(mask, p, 0.0)


def rel_bucket(dist):
    max_exact = REL_BUCKETS // 2
    d = jnp.maximum(dist, 0)
    large = max_exact + (jnp.log(jnp.maximum(d, 1).astype(jnp.float32) / max_exact)
                         / math.log(REL_MAX_DIST / max_exact) * (REL_BUCKETS - max_exact)).astype(jnp.int32)
    large = jnp.minimum(large, REL_BUCKETS - 1)
    return jnp.where(d < max_exact, d, large)


def rg_lru_mixer(xr, gate, conv_w, conv_b, w_gates, b_gates, lam):
    bsz, s_len, _ = xr.shape
    xc = causal_dwconv(xr, conv_w) + conv_b
    xb = xc.reshape(bsz, s_len, LRU_BLOCKS, LRU_BLOCK_DIM)
    r = jax.nn.sigmoid(jnp.einsum('bshi,hij->bshj', xb, w_gates[0]).reshape(bsz, s_len, GROUP) + b_gates[0])
    i = jax.nn.sigmoid(jnp.einsum('bshi,hij->bshj', xb, w_gates[1]).reshape(bsz, s_len, GROUP) + b_gates[1])
    log_a = (-LRU_C * jax.nn.softplus(-lam.astype(jnp.float32))) * r.astype(jnp.float32)
    a = jnp.exp(log_a)
    b = jnp.sqrt(-jnp.expm1(2.0 * log_a)) * (i * xc).astype(jnp.float32)

    def combine(left, right):
        a1, b1 = left
        a2, b2 = right
        return a1 * a2, a2 * b1 + b2

    _, h = lax.associative_scan(combine, (a, b), axis=1)
    return h.astype(xr.dtype) * jax.nn.gelu(gate)


def short_conv_mixer(bg, cg, xs, conv_w):
    return bg * causal_dwconv(cg * xs, conv_w)


def fox_mixer(q, k, v, f_logit, f_bias, qk_gain):
    bsz, s_len, _ = q.shape
    h, d = FOX_HEADS, HEAD_DIM
    q = rms_norm(q.reshape(bsz, s_len, h, d), qk_gain[0])
    k = rms_norm(k.reshape(bsz, s_len, h, d), qk_gain[1])
    v = v.reshape(bsz, s_len, h, d)
    logf = jax.nn.log_sigmoid((f_logit + f_bias).astype(jnp.float32))
    c = lax.cumsum(logf, axis=1).transpose(0, 2, 1)
    nb = s_len // Q_BLOCK
    qb = q.reshape(bsz, nb, Q_BLOCK, h, d).swapaxes(0, 1)
    cb = c.reshape(bsz, h, nb, Q_BLOCK).transpose(2, 0, 1, 3)
    kpos = jnp.arange(s_len)
    scale = HEAD_DIM ** -0.5

    def block(args):
        qi, ci, bi = args
        t = bi * Q_BLOCK + jnp.arange(Q_BLOCK)
        s = jnp.einsum('bqhd,bkhd->bhqk', qi, k).astype(jnp.float32) * scale + (ci[..., :, None] - c[..., None, :])
        p = masked_softmax(s, kpos[None, :] <= t[:, None])
        return jnp.einsum('bhqk,bkhd->bqhd', p.astype(v.dtype), v)

    o = lax.map(block, (qb, cb, jnp.arange(nb)))
    return o.swapaxes(0, 1).reshape(bsz, s_len, GROUP)


def compress(kx, pos, w1, w2):
    s_len = kx.shape[1]
    n_cmp = (s_len - CMP_LEN) // CMP_STRIDE + 1
    idx = jnp.arange(n_cmp)[:, None] * CMP_STRIDE + jnp.arange(CMP_LEN)[None, :]
    blocks = kx[:, idx] + pos
    hid = jax.nn.gelu(jnp.einsum('bnld,ldm->bnm', blocks, w1))
    return hid @ w2


def nsa_mixer(q, kc_in, vc_in, ks_in, vs_in, kw_in, vw_in, g_logit, g_bias, qk_gain, cmp_pos, cmp_w1, cmp_w2, rel_bias):
    bsz, s_len, _ = q.shape
    h, d = NSA_HEADS, HEAD_DIM
    f32 = jnp.float32
    q = rms_norm(q.reshape(bsz, s_len, h, d), qk_gain[0])
    kc = rms_norm(compress(kc_in, cmp_pos[0], cmp_w1[0], cmp_w2[0]), qk_gain[1])
    vc = compress(vc_in, cmp_pos[1], cmp_w1[1], cmp_w2[1])
    ks_ = rms_norm(ks_in, qk_gain[2])
    kw = rms_norm(kw_in, qk_gain[3])
    gates = jax.nn.sigmoid(g_logit + g_bias).reshape(bsz, s_len, 3, h)
    n_cmp = kc.shape[1]
    n_slc = s_len // SLC_BLOCK
    top = min(SLC_TOPK, n_slc)
    cmp_start = jnp.arange(n_cmp) * CMP_STRIDE
    cmp_end = cmp_start + CMP_LEN - 1
    slc_start = jnp.arange(n_slc) * SLC_BLOCK
    overlap = jnp.clip(jnp.minimum(cmp_start[:, None] + CMP_LEN, slc_start[None, :] + SLC_BLOCK)
                       - jnp.maximum(cmp_start[:, None], slc_start[None, :]), 0, CMP_LEN).astype(f32)
    ks_blk = ks_.reshape(bsz, n_slc, SLC_BLOCK, d)
    vs_blk = vs_in.reshape(bsz, n_slc, SLC_BLOCK, d)
    kw_pad = jnp.pad(kw, ((0, 0), (WINDOW, 0), (0, 0)))
    vw_pad = jnp.pad(vw_in, ((0, 0), (WINDOW, 0), (0, 0)))
    nb = s_len // Q_BLOCK
    qb = q.reshape(bsz, nb, Q_BLOCK, h, d).swapaxes(0, 1)
    gb = gates.reshape(bsz, nb, Q_BLOCK, 3, h).swapaxes(0, 1)
    bidx = jnp.arange(bsz)[:, None, None]
    jblk = jnp.arange(n_slc)
    scale = HEAD_DIM ** -0.5

    def block(args):
        qi, gi, bi = args
        t = bi * Q_BLOCK + jnp.arange(Q_BLOCK)
        dist_c = t[:, None] - cmp_end[None, :]
        s_c = (jnp.einsum('bqhd,bnd->bhqn', qi, kc).astype(f32) * scale
               + rel_bias[rel_bucket(dist_c)].transpose(2, 0, 1))
        p_c = masked_softmax(s_c, dist_c >= 0)
        o_c = jnp.einsum('bhqn,bnd->bqhd', p_c.astype(vc.dtype), vc)
        imp = jnp.einsum('bhqn,nm->bqm', p_c, overlap)
        cur = t // SLC_BLOCK
        forced = (jblk[None, :] == 0) | (jblk[None, :] == cur[:, None]) | (jblk[None, :] == cur[:, None] - 1)
        imp = jnp.where(forced, BIG, imp)
        imp = jnp.where(jblk[None, :] <= cur[:, None], imp, -jnp.inf)
        _, sel = lax.top_k(imp, top)
        k_sel = ks_blk[bidx, sel].reshape(bsz, Q_BLOCK, top * SLC_BLOCK, d)
        v_sel = vs_blk[bidx, sel].reshape(bsz, Q_BLOCK, top * SLC_BLOCK, d)
        pos_sel = (sel[..., None] * SLC_BLOCK + jnp.arange(SLC_BLOCK)).reshape(bsz, Q_BLOCK, top * SLC_BLOCK)
        dist_s = t[None, :, None] - pos_sel
        s_s = (jnp.einsum('bqhd,bqnd->bhqn', qi, k_sel).astype(f32) * scale
               + rel_bias[rel_bucket(dist_s)].transpose(0, 3, 1, 2))
        p_s = masked_softmax(s_s, (dist_s >= 0)[:, None])
        o_s = jnp.einsum('bhqn,bqnd->bqhd', p_s.astype(v_sel.dtype), v_sel)
        k_win = lax.dynamic_slice_in_dim(kw_pad, bi * Q_BLOCK, WINDOW + Q_BLOCK, axis=1)
        v_win = lax.dynamic_slice_in_dim(vw_pad, bi * Q_BLOCK, WINDOW + Q_BLOCK, axis=1)
        pos_w = bi * Q_BLOCK - WINDOW + jnp.arange(WINDOW + Q_BLOCK)
        dist_w = t[:, None] - pos_w[None, :]
        mask_w = (dist_w >= 0) & (dist_w < WINDOW) & (pos_w[None, :] >= 0)
        s_w = (jnp.einsum('bqhd,bnd->bhqn', qi, k_win).astype(f32) * scale
               + rel_bias[rel_bucket(dist_w)].transpose(2, 0, 1))
        p_w = masked_softmax(s_w, mask_w)
        o_w = jnp.einsum('bhqn,bnd->bqhd', p_w.astype(v_win.dtype), v_win)
        return gi[:, :, 0, :, None] * o_c + gi[:, :, 1, :, None] * o_s + gi[:, :, 2, :, None] * o_w

    o = lax.map(block, (qb, gb, jnp.arange(nb)))
    return o.swapaxes(0, 1).reshape(bsz, s_len, GROUP)


def setup_inputs(seed: int = 0) -> dict:
    key = jax.random.key(seed)
    ks = jax.random.split(key, 24)
    f32 = jnp.float32
    nl = DEPTH

    def nrm(k, shape, scale):
        return jax.random.normal(k, shape, f32) * scale

    u = jax.random.uniform(ks[7], (nl, GROUP), f32, 0.9, 0.999)
    return {
        'x': jax.random.normal(ks[0], (BATCH, SEQ, D_MODEL), f32),
        'norm_mix': 1.0 + nrm(ks[1], (nl, D_MODEL), 0.02),
        'w_in': nrm(ks[2], (nl, D_MODEL, N_IN), D_MODEL ** -0.5),
        'lru_conv_w': nrm(ks[3], (nl, LRU_CONV, GROUP), LRU_CONV ** -0.5),
        'lru_conv_b': nrm(ks[4], (nl, GROUP), 0.02),
        'lru_w_gates': nrm(ks[5], (nl, 2, LRU_BLOCKS, LRU_BLOCK_DIM, LRU_BLOCK_DIM), LRU_BLOCK_DIM ** -0.5),
        'lru_b_gates': nrm(ks[6], (nl, 2, GROUP), 0.02),
        'lru_lambda': jnp.log(u) - jnp.log1p(-u),
        'sc_conv_w': nrm(ks[8], (nl, SC_CONV, GROUP), SC_CONV ** -0.5),
        'fox_f_bias': 3.0 + nrm(ks[9], (nl, FOX_HEADS), 0.1),
        'fox_qk_norm': 1.0 + nrm(ks[10], (nl, 2, HEAD_DIM), 0.02),
        'nsa_qk_norm': 1.0 + nrm(ks[11], (nl, 4, HEAD_DIM), 0.02),
        'nsa_cmp_pos': nrm(ks[12], (nl, 2, CMP_LEN, HEAD_DIM), 0.1),
        'nsa_cmp_w1': nrm(ks[13], (nl, 2, CMP_LEN, HEAD_DIM, CMP_HIDDEN), (CMP_LEN * HEAD_DIM) ** -0.5),
        'nsa_cmp_w2': nrm(ks[14], (nl, 2, CMP_HIDDEN, HEAD_DIM), CMP_HIDDEN ** -0.5),
        'nsa_gate_bias': nrm(ks[15], (nl, 3 * NSA_HEADS), 0.02),
        'rel_bias': nrm(ks[16], (REL_BUCKETS, NSA_HEADS), 0.2),
        'out_norm': 1.0 + nrm(ks[17], (nl, N_GROUPS, GROUP), 0.02),
        'w_out': nrm(ks[18], (nl, D_MIX, D_MODEL), D_MIX ** -0.5),
        'norm_ffn': 1.0 + nrm(ks[19], (nl, D_MODEL), 0.02),
        'w_gate_up': nrm(ks[20], (nl, D_MODEL, 2 * D_FF), D_MODEL ** -0.5),
        'w_down': nrm(ks[21], (nl, D_FF, D_MODEL), D_FF ** -0.5),
    }


def reference(x, norm_mix, w_in, lru_conv_w, lru_conv_b, lru_w_gates, lru_b_gates, lru_lambda, sc_conv_w,
              fox_f_bias, fox_qk_norm, nsa_qk_norm, nsa_cmp_pos, nsa_cmp_w1, nsa_cmp_w2, nsa_gate_bias,
              rel_bias, out_norm, w_out, norm_ffn, w_gate_up, w_down):
    for l in range(DEPTH):
        z = rms_norm(x, norm_mix[l]) @ w_in[l]
        y_a = rg_lru_mixer(cols(z, C_LRU_X, GROUP), cols(z, C_LRU_G, GROUP), lru_conv_w[l], lru_conv_b[l],
                           lru_w_gates[l], lru_b_gates[l], lru_lambda[l])
        y_b = short_conv_mixer(cols(z, C_SC_B, GROUP), cols(z, C_SC_C, GROUP), cols(z, C_SC_X, GROUP), sc_conv_w[l])
        y_c = fox_mixer(cols(z, C_FOX_Q, GROUP), cols(z, C_FOX_K, GROUP), cols(z, C_FOX_V, GROUP),
                        cols(z, C_FOX_F, FOX_HEADS), fox_f_bias[l], fox_qk_norm[l])
        kv = [cols(z, C_NSA_KV + j * HEAD_DIM, HEAD_DIM) for j in range(6)]
        y_d = nsa_mixer(cols(z, C_NSA_Q, GROUP), kv[0], kv[1], kv[2], kv[3], kv[4], kv[5],
                        cols(z, C_NSA_G, 3 * NSA_HEADS), nsa_gate_bias[l], nsa_qk_norm[l],
                        nsa_cmp_pos[l], nsa_cmp_w1[l], nsa_cmp_w2[l], rel_bias)
        mixed = jnp.concatenate([rms_norm(y_a, out_norm[l, 0]), rms_norm(y_b, out_norm[l, 1]),
                                 rms_norm(y_c, out_norm[l, 2]), rms_norm(y_d, out_norm[l, 3])], axis=-1)
        x = x + mixed @ w_out[l]
        gu = rms_norm(x, norm_ffn[l]) @ w_gate_up[l]
        x = x + (jax.nn.silu(gu[..., :D_FF]) * gu[..., D_FF:]) @ w_down[l]
    return x
```

```cpp
#include <hip/hip_runtime.h>
#include <stdint.h>
#include <stdio.h>

#define LAS __attribute__((address_space(3)))
typedef _Float16 half_t;
typedef _Float16 h8 __attribute__((ext_vector_type(8)));
typedef _Float16 h4 __attribute__((ext_vector_type(4)));
typedef _Float16 h2 __attribute__((ext_vector_type(2)));
typedef float f32x4 __attribute__((ext_vector_type(4)));
typedef unsigned u32x4 __attribute__((ext_vector_type(4)));
typedef unsigned u32x2 __attribute__((ext_vector_type(2)));

constexpr int BATCH = 8, SEQ = 4096, T = BATCH * SEQ, D = 1024, NZP = 2816, DFF = 2816, NCMP = 255;
constexpr int NIN_SRC = 2704;
constexpr int ZC_LRU_X = 0, ZC_LRU_G = 256, ZC_SC_B = 512, ZC_SC_C = 768, ZC_SC_X = 1024, ZC_FOX_Q = 1280, ZC_FOX_K = 1536, ZC_FOX_V = 1792,
              ZC_NSA_Q = 2048, ZC_KC = 2304, ZC_VC = 2368, ZC_KS = 2432, ZC_VS = 2496, ZC_KW = 2560, ZC_VW = 2624, ZC_FOX_F = 2688, ZC_NSA_G = 2692;
constexpr float EPS = 1e-6f;
constexpr int NWAVES = 8, NTHR = 512;

constexpr size_t MiB = 1u << 20;
constexpr size_t WS_CTL = 0, CTL_ZERO_BYTES = 64 * 1024;
constexpr size_t WS_SSQA = 2 * MiB, WS_SSQB = 4 * MiB, WS_CFOX = 6 * MiB, WS_KVC = 7 * MiB, WS_LRUAGG = 9 * MiB, WS_CB = 11 * MiB;
constexpr size_t WS_WIN = 12 * MiB, WS_WOUT = 24 * MiB, WS_WGU = 28 * MiB, WS_WDN = 50 * MiB;
constexpr size_t WS_XH = 62 * MiB, WS_MIXED = 126 * MiB, WS_Z = 190 * MiB, WS_YD = 366 * MiB, WS_END = 398 * MiB;
static_assert(WS_WIN + 2 * (size_t)NZP * D * 2 <= WS_WOUT && WS_WOUT + 2 * (size_t)D * D * 2 <= WS_WGU && WS_WGU + 2 * (size_t)2 * DFF * D * 2 <= WS_WDN &&
              WS_WDN + 2 * (size_t)D * DFF * 2 <= WS_XH && WS_XH + (size_t)T * D * 2 <= WS_MIXED && WS_MIXED + (size_t)T * D * 2 <= WS_Z &&
              WS_Z + (size_t)T * NZP * 2 <= WS_YD && WS_YD + (size_t)T * 256 * 4 <= WS_END, "ws map");
constexpr int CW_BAR = 1024;

constexpr int RING_BYTES = 131072, MISC_OFF = RING_BYTES, LDS_BYTES = 147456;

__device__ __constant__ unsigned char c_bucket[128] = {
 0,1,2,3,4,5,6,7,8,9,10,11,12,13,14,15,
 16,16,16,17,17,18,18,18,19,19,19,20,20,20,20,21,
 21,21,21,22,22,22,22,22,23,23,23,23,23,23,24,24,
 24,24,24,24,25,25,25,25,25,25,25,26,26,26,26,26,
 26,26,26,27,27,27,27,27,27,27,27,27,27,28,28,28,
 28,28,28,28,28,28,28,29,29,29,29,29,29,29,29,29,
 29,29,29,30,30,30,30,30,30,30,30,30,30,30,30,30,
 30,31,31,31,31,31,31,31,31,31,31,31,31,31,31,31};
__device__ __forceinline__ int rel_bucket(int d) { return d >= 128 ? 31 : (int)c_bucket[d < 0 ? 0 : d]; }

__device__ __forceinline__ float sigmoidf_(float x) { return 1.f / (1.f + __expf(-x)); }
__device__ __forceinline__ float gelu_tanh(float x) { const float c = 0.7978845608028654f; return 0.5f * x * (1.f + tanhf(c * (x + 0.044715f * x * x * x))); }
__device__ __forceinline__ float log_sigmoid(float x) { return x >= 0.f ? -log1pf(expf(-x)) : x - log1pf(expf(x)); }
__device__ __forceinline__ u32x4 pack_h8(f32x4 a, f32x4 b) {
    h8 h; h[0] = (half_t)a.x; h[1] = (half_t)a.y; h[2] = (half_t)a.z; h[3] = (half_t)a.w; h[4] = (half_t)b.x; h[5] = (half_t)b.y; h[6] = (half_t)b.z; h[7] = (half_t)b.w;
    return __builtin_bit_cast(u32x4, h);
}
__device__ __forceinline__ unsigned pack_h2(float a, float b) { h2 h; h[0] = (half_t)a; h[1] = (half_t)b; return __builtin_bit_cast(unsigned, h); }
#define LDS_WAIT() asm volatile("s_waitcnt lgkmcnt(0)" ::: "memory")

#define XB_TMO      128
#define XB_XCNT(j)  (256  + 64 * (j))
#define XB_XSUB(j)  (1280 + 64 * (j))
#define XB_XGEN(j)  (2304 + 64 * (j))
#define XB_TOP      3328
#define XB_TOPGEN   3392
#define XCD_BAR_WORDS 3456
#define XB_SPIN_CAP (1u << 20)
__device__ __forceinline__ unsigned xb_ld(unsigned* p)              { return __hip_atomic_load(p, __ATOMIC_RELAXED, __HIP_MEMORY_SCOPE_AGENT); }
__device__ __forceinline__ unsigned xb_add(unsigned* p, unsigned v) { return __hip_atomic_fetch_add(p, v, __ATOMIC_RELAXED, __HIP_MEMORY_SCOPE_AGENT); }
__device__ __forceinline__ unsigned xb_xcc_id() { return (unsigned)__builtin_amdgcn_s_getreg((3 << 11) | 20) & 0xFu; }
#define XB_SPIN(cond, bar) do { unsigned _sp = 0; while (cond) { __builtin_amdgcn_s_sleep(1); \
    if ((++_sp & 255u) == 0u) { if (xb_ld(&(bar)[XB_TMO])) break; if (_sp > XB_SPIN_CAP) { atomicAdd(&(bar)[XB_TMO], 1u); break; } } } } while (0)
struct XcdBarrier { unsigned* bar; unsigned x; volatile LAS unsigned* st; };
__device__ __forceinline__ XcdBarrier xcd_barrier_post(unsigned* bar, volatile LAS unsigned* st) {
    XcdBarrier b; b.bar = bar; b.x = xb_xcc_id(); b.st = st;
    if (threadIdx.x == 0) (void)xb_add(&bar[XB_XCNT(b.x)], 1u);
    return b;
}
__device__ __forceinline__ void xcd_barrier_complete(unsigned* bar, unsigned x, unsigned& nloc, unsigned& nx) {
    const unsigned G = gridDim.x * gridDim.y * gridDim.z;
    unsigned sum, cnt, mine, sp = 0u;
    for (;;) {
        sum = 0u; cnt = 0u; mine = 0u;
#pragma unroll
        for (unsigned j = 0; j < 16; ++j) { const unsigned c = xb_ld(&bar[XB_XCNT(j)]); sum += c; cnt += (c > 0u) ? 1u : 0u; mine = (j == x) ? c : mine; }
        if (sum == G) break;
        __builtin_amdgcn_s_sleep(1);
        if ((++sp & 255u) == 0u) { if (xb_ld(&bar[XB_TMO])) break; if (sp > XB_SPIN_CAP) { atomicAdd(&bar[XB_TMO], 1u); break; } }
    }
    nloc = mine > 0u ? mine : 1u; nx = cnt > 0u ? cnt : 1u;
}
__device__ __forceinline__ void xcd_barrier(const XcdBarrier& b) {
    asm volatile("s_waitcnt vmcnt(0)" ::: "memory");
    __syncthreads();
    if (threadIdx.x == 0) {
        unsigned* bar = b.bar;
        __builtin_amdgcn_s_waitcnt(0);
        unsigned nloc = b.st[0], nx = b.st[1];
        if (nloc == 0u) { xcd_barrier_complete(bar, b.x, nloc, nx); b.st[0] = nloc; b.st[1] = nx; }
        const unsigned old = xb_add(&bar[XB_XSUB(b.x)], 1u);
        const unsigned gen = old / nloc;
        if (old + 1u == (gen + 1u) * nloc) {
            __builtin_amdgcn_fence(__ATOMIC_RELEASE, "agent");
            asm volatile("s_waitcnt vmcnt(0)" ::: "memory");
            const unsigned og = xb_add(&bar[XB_TOP], 1u);
            const unsigned tg = og / nx;
            if (og + 1u == (tg + 1u) * nx) xb_add(&bar[XB_TOPGEN], 1u);
            else XB_SPIN(xb_ld(&bar[XB_TOPGEN]) == tg, bar);
            __builtin_amdgcn_fence(__ATOMIC_ACQUIRE, "agent");
            xb_add(&bar[XB_XGEN(b.x)], 1u);
            asm volatile("s_waitcnt vmcnt(0)" ::: "memory");
        } else {
            XB_SPIN(xb_ld(&bar[XB_XGEN(b.x)]) == gen, bar);
            __builtin_amdgcn_fence(__ATOMIC_ACQUIRE, "agent");
            asm volatile("s_waitcnt vmcnt(0)" ::: "memory");
        }
    }
    __syncthreads();
}

namespace pg8 {
constexpr int BM = 256, BK = 64, HALF = 128, HTB = HALF * BK * 2, STAGE_BYTES = 8 * HTB, NXCD = 8, WGM = 8;
__host__ __device__ __forceinline__ int lds_byte(int r, int c) { const int st = (r >> 4) * 2 + (c >> 5), rr = r & 15, cc = c & 31, ob = rr * 64 + cc * 2; return st * 1024 + (ob ^ (((ob >> 9) & 1) << 5)); }
__host__ __device__ __forceinline__ void stage_rc(int b, int& R, int& C) { const int st = b / 1024, sb = b % 1024, swz = sb ^ (((sb >> 9) & 1) << 5); R = (st >> 1) * 16 + swz / 64; C = (st & 1) * 32 + (swz % 64) / 2; }
__host__ __device__ __forceinline__ int perm32(int rho) { const int n = rho >> 4, i = rho & 15; return 8 * (i >> 2) + 4 * n + (i & 3); }
struct Unit { int pm, pn; };
struct Gemm { const half_t* A; const half_t* Bt; int M, N, K; };
struct StaticOrder {
    int nM, nN, nwg, G, c;
    __host__ __device__ void init(int M, int N, int G_, int c_) { nM = M / BM; nN = N / BM; nwg = nM * nN; G = G_; c = c_; }
    __host__ __device__ bool next(int i, Unit& u) const {
        const long L = (long)i * G + c; if (L >= nwg) return false;
        int wgid = (int)L; { const int q = nwg / NXCD, r = nwg % NXCD, xcd = wgid % NXCD, off = wgid / NXCD; wgid = (xcd < r ? xcd * (q + 1) : r * (q + 1) + (xcd - r) * q) + off; }
        const int nig = WGM * nN, gid = wgid / nig, fm = gid * WGM, gsz = (nM - fm) < WGM ? (nM - fm) : WGM;
        u.pm = fm + ((wgid % nig) % gsz); u.pn = (wgid % nig) / gsz; return true;
    }
    __device__ __forceinline__ void a_ready(const Unit&) const {}
    __device__ __forceinline__ void done(const Unit&) const {}
};

template <class Epi, class Sched>
__device__ __forceinline__ void gemm_phase(LAS unsigned char* lds, const Gemm g, const Sched& S, const Epi& E) {
    int tid = threadIdx.x; asm volatile("" : "+v"(tid));
    const int wid = __builtin_amdgcn_readfirstlane(tid >> 6), lane = tid & 63, wr = wid >> 2, wc = wid & 3, fr = lane & 15, fq = lane >> 4;
    const int K = g.K, nt = K / BK;
    unsigned voffA[2], voffB[2];
#pragma unroll
    for (int i = 0; i < 2; ++i) { int R, C; stage_rc(tid * 16 + i * 8192, R, C); const int Rb = Epi::PERM ? ((R & ~31) + perm32(R & 31)) : R;
        voffA[i] = (unsigned)(R * K + C) * 2u; voffB[i] = (unsigned)(Rb * K + C) * 2u; }
    const size_t kstep = (size_t)(BK * 2);
    const size_t hstep = (size_t)HALF * K * 2;
    const size_t tstep = 2 * hstep;
    const unsigned ldsw = (unsigned)wid * 1024u;
    const int aoff = lds_byte(wr * 64 + fr, fq * 8), boff = lds_byte(wc * 32 + fr, fq * 8);
#define PG8_SA(b, h) (((b) * 2 + (h)) * HTB)
#define PG8_SB(b, h) ((4 + (b) * 2 + (h)) * HTB)
#define PG8_STAGE(bufoff, gbase, voff) do { _Pragma("unroll") for (int _i = 0; _i < 2; ++_i) \
        __builtin_amdgcn_global_load_lds((const unsigned*)((const char*)(gbase) + (voff)[_i]), (LAS unsigned*)(lds + (bufoff) + ldsw + _i * 8192), 16, 0, 0); } while (0)
#define PG8_LDA(dst, b, h) do { _Pragma("unroll") for (int m = 0; m < 4; ++m) _Pragma("unroll") for (int k = 0; k < 2; ++k) dst[m][k] = *(const LAS h8*)(lds + PG8_SA(b, h) + aoff + m * 2048 + k * 1024); } while (0)
#define PG8_LDB(dst, b, h) do { _Pragma("unroll") for (int n = 0; n < 2; ++n) _Pragma("unroll") for (int k = 0; k < 2; ++k) dst[n][k] = *(const LAS h8*)(lds + PG8_SB(b, h) + boff + n * 2048 + k * 1024); } while (0)
#define PG8_MMA(ai, bj, At, Bt) do { __builtin_amdgcn_s_setprio(1); _Pragma("unroll") for (int m = 0; m < 4; ++m) _Pragma("unroll") for (int n = 0; n < 2; ++n) _Pragma("unroll") for (int k = 0; k < 2; ++k) \
        acc[ai][bj][m][n] = __builtin_amdgcn_mfma_f32_16x16x32_f16(Bt[n][k], At[m][k], acc[ai][bj][m][n], 0, 0, 0); __builtin_amdgcn_s_setprio(0); } while (0)
#define PG8_WAIT_V(n) asm volatile("s_waitcnt vmcnt(" #n ")" ::: "memory")
#define PG8_WAIT_L(n) asm volatile("s_waitcnt lgkmcnt(" #n ")" ::: "memory")
#define PG8_BAR __builtin_amdgcn_s_barrier()
#define PG8_SCHED __builtin_amdgcn_sched_barrier(0)
    Unit cur, nxt; int ui = 0;
    if (!S.next(0, cur)) return;
    f32x4 acc[2][2][4][2];
#pragma unroll
    for (int a = 0; a < 2; ++a)
#pragma unroll
        for (int b = 0; b < 2; ++b)
#pragma unroll
            for (int m = 0; m < 4; ++m)
#pragma unroll
                for (int n = 0; n < 2; ++n) acc[a][b][m][n] = (f32x4){0.f, 0.f, 0.f, 0.f};
    h8 At[4][2], B0[2][2], B1[2][2];
    const char* cA = (const char*)g.A + (size_t)cur.pm * tstep; const char* cB = (const char*)g.Bt + (size_t)cur.pn * tstep;
    S.a_ready(cur);
    PG8_STAGE(PG8_SB(0, 0), cB, voffB); PG8_STAGE(PG8_SA(0, 0), cA, voffA); PG8_STAGE(PG8_SB(0, 1), cB + hstep, voffB); PG8_STAGE(PG8_SA(0, 1), cA + hstep, voffA);
    if (wr == 1) PG8_BAR;
    PG8_WAIT_V(4); PG8_BAR;
    PG8_STAGE(PG8_SB(1, 0), cB + kstep, voffB); PG8_STAGE(PG8_SA(1, 0), cA + kstep, voffA); PG8_STAGE(PG8_SB(1, 1), cB + hstep + kstep, voffB);
    PG8_WAIT_V(6); PG8_BAR;
    for (;;) {
        const bool has_next = S.next(ui + 1, nxt);
        const char* nA = has_next ? (const char*)g.A + (size_t)nxt.pm * tstep : cA; const char* nB = has_next ? (const char*)g.Bt + (size_t)nxt.pn * tstep : cB;
        for (int t = 0; t < nt; t += 2) {
            const bool last = (t == nt - 2);
            const char* a1 = cA + (size_t)(t + 1) * kstep;
            const char* a2 = last ? nA : cA + (size_t)(t + 2) * kstep; const char* b2 = last ? nB : cB + (size_t)(t + 2) * kstep;
            const char* a3 = a2 + kstep; const char* b3 = b2 + kstep;
            if (last && has_next) S.a_ready(nxt);
            PG8_LDB(B0, 0, 0); PG8_SCHED; PG8_LDA(At, 0, 0); PG8_STAGE(PG8_SA(1, 1), a1 + hstep, voffA);
            PG8_WAIT_L(8); PG8_BAR; PG8_WAIT_L(0); PG8_MMA(0, 0, At, B0); PG8_BAR; PG8_SCHED;
            PG8_LDB(B1, 0, 1); PG8_STAGE(PG8_SB(0, 0), b2, voffB);
            PG8_BAR; PG8_WAIT_L(0); PG8_MMA(0, 1, At, B1); PG8_BAR;
            PG8_LDA(At, 0, 1); PG8_STAGE(PG8_SA(0, 0), a2, voffA);
            PG8_BAR; PG8_WAIT_L(0); PG8_MMA(1, 0, At, B0); PG8_BAR; PG8_SCHED;
            PG8_STAGE(PG8_SB(0, 1), b2 + hstep, voffB);
            PG8_WAIT_V(6); PG8_BAR; PG8_MMA(1, 1, At, B1); PG8_BAR;
            PG8_LDB(B0, 1, 0); PG8_SCHED; PG8_LDA(At, 1, 0); PG8_STAGE(PG8_SA(0, 1), a2 + hstep, voffA);
            PG8_WAIT_L(8); PG8_BAR; PG8_WAIT_L(0); PG8_MMA(0, 0, At, B0); PG8_BAR; PG8_SCHED;
            PG8_LDB(B1, 1, 1); PG8_STAGE(PG8_SB(1, 0), b3, voffB);
            PG8_BAR; PG8_WAIT_L(0); PG8_MMA(0, 1, At, B1); PG8_BAR;
            PG8_LDA(At, 1, 1); PG8_STAGE(PG8_SA(1, 0), a3, voffA);
            PG8_BAR; PG8_WAIT_L(0); PG8_MMA(1, 0, At, B0); PG8_BAR; PG8_SCHED;
            PG8_STAGE(PG8_SB(1, 1), b3 + hstep, voffB);
            PG8_WAIT_V(6); PG8_BAR; PG8_MMA(1, 1, At, B1); PG8_BAR;
        }
        E(acc, cur, wr, wc, fr, fq); S.done(cur);
        if (!has_next) break;
#pragma unroll
        for (int a = 0; a < 2; ++a)
#pragma unroll
            for (int b = 0; b < 2; ++b)
#pragma unroll
                for (int m = 0; m < 4; ++m)
#pragma unroll
                    for (int n = 0; n < 2; ++n) acc[a][b][m][n] = (f32x4){0.f, 0.f, 0.f, 0.f};
        cur = nxt; cA = nA; cB = nB; ++ui;
    }
    PG8_WAIT_V(0);
    if (wr == 0) PG8_BAR;
    PG8_BAR;
#undef PG8_SA
#undef PG8_SB
#undef PG8_STAGE
#undef PG8_LDA
#undef PG8_LDB
#undef PG8_MMA
#undef PG8_WAIT_V
#undef PG8_WAIT_L
#undef PG8_BAR
#undef PG8_SCHED
}
}

__device__ __forceinline__ float row_rstd(const float* ssq, int row) {
    const f32x4* p = (const f32x4*)(ssq + (size_t)row * 16);
    const f32x4 a = p[0], b = p[1], c = p[2], d = p[3];
    const float s = (((a.x + a.y) + (a.z + a.w)) + ((b.x + b.y) + (b.z + b.w))) + (((c.x + c.y) + (c.z + c.w)) + ((d.x + d.y) + (d.z + d.w)));
    return rsqrtf(s * (1.f / 1024.f) + EPS);
}
struct EpiZ {
    static constexpr bool PERM = true;
    half_t* Z; const float* ssq;
    __device__ __forceinline__ void operator()(const f32x4 (&acc)[2][2][4][2], const pg8::Unit& u, int wr, int wc, int fr, int fq) const {
        const int row0 = u.pm * 256 + wr * 64 + fr, col0 = u.pn * 256 + wc * 32 + 8 * fq;
#pragma unroll
        for (int ai = 0; ai < 2; ++ai)
#pragma unroll
            for (int m = 0; m < 4; ++m) { const int row = row0 + ai * 128 + m * 16; const float r = row_rstd(ssq, row); half_t* rp = Z + (size_t)row * NZP + col0;
#pragma unroll
                for (int bj = 0; bj < 2; ++bj) *(u32x4*)(rp + bj * 128) = pack_h8(acc[ai][bj][m][0] * r, acc[ai][bj][m][1] * r); }
    }
};
struct EpiRes {
    static constexpr bool PERM = true;
    const float* xold; float* out; half_t* XH; float* ssq;
    __device__ __forceinline__ void operator()(const f32x4 (&acc)[2][2][4][2], const pg8::Unit& u, int wr, int wc, int fr, int fq) const {
        const int row0 = u.pm * 256 + wr * 64 + fr, col0 = u.pn * 256 + wc * 32 + 8 * fq;
#pragma unroll
        for (int ai = 0; ai < 2; ++ai)
#pragma unroll
            for (int m = 0; m < 4; ++m) { const int row = row0 + ai * 128 + m * 16; float s = 0.f;
#pragma unroll
                for (int bj = 0; bj < 2; ++bj) { const size_t o = (size_t)row * D + col0 + bj * 128;
                    f32x4 v0 = *(const f32x4*)(xold + o) + acc[ai][bj][m][0], v1 = *(const f32x4*)(xold + o + 4) + acc[ai][bj][m][1];
                    *(f32x4*)(out + o) = v0; *(f32x4*)(out + o + 4) = v1;
                    if (XH) *(u32x4*)(XH + o) = pack_h8(v0, v1);
                    s += (v0.x * v0.x + v0.y * v0.y) + (v0.z * v0.z + v0.w * v0.w) + (v1.x * v1.x + v1.y * v1.y) + (v1.z * v1.z + v1.w * v1.w); }
                s += __shfl_xor(s, 16); s += __shfl_xor(s, 32);
                if (fq == 0 && ssq) ssq[(size_t)row * 16 + u.pn * 4 + wc] = s; }
    }
};
struct EpiSwiglu {
    static constexpr bool PERM = true;
    half_t* H; const float* ssq;
    __device__ __forceinline__ void operator()(const f32x4 (&acc)[2][2][4][2], const pg8::Unit& u, int wr, int wc, int fr, int fq) const {
        const int row0 = u.pm * 256 + wr * 64 + fr, col0 = u.pn * 128 + wc * 32 + 8 * fq;
#pragma unroll
        for (int ai = 0; ai < 2; ++ai)
#pragma unroll
            for (int m = 0; m < 4; ++m) { const int row = row0 + ai * 128 + m * 16; const float r = row_rstd(ssq, row);
                f32x4 o[2];
#pragma unroll
                for (int n = 0; n < 2; ++n) { const f32x4 g = acc[ai][0][m][n] * r, uu = acc[ai][1][m][n] * r;
                    o[n].x = g.x * sigmoidf_(g.x) * uu.x; o[n].y = g.y * sigmoidf_(g.y) * uu.y; o[n].z = g.z * sigmoidf_(g.z) * uu.z; o[n].w = g.w * sigmoidf_(g.w) * uu.w; }
                *(u32x4*)(H + (size_t)row * DFF + col0) = pack_h8(o[0], o[1]); }
    }
};

struct Params {
    const float* x; const float* norm_mix; const float* w_in; const float* lru_conv_w; const float* lru_conv_b; const float* lru_w_gates; const float* lru_b_gates;
    const float* lru_lambda; const float* sc_conv_w; const float* fox_f_bias; const float* fox_qk_norm; const float* nsa_qk_norm; const float* nsa_cmp_pos;
    const float* nsa_cmp_w1; const float* nsa_cmp_w2; const float* nsa_gate_bias; const float* rel_bias; const float* out_norm; const float* w_out;
    const float* norm_ffn; const float* w_gate_up; const float* w_down; float* out; unsigned char* ws;
};

template <int MODE> __device__ __forceinline__ int src_col(int n) {
    if (MODE == 1) { if (n < 2048) return n; if (n < 2688) return n + 4; if (n < 2692) return 2048 + (n - 2688); if (n < 2704) return n; return -1; }
    if (MODE == 2) { const int pn = n >> 8, w = n & 255; return w < 128 ? pn * 128 + w : DFF + pn * 128 + (w - 128); }
    return n;
}
template <int MODE> __device__ __forceinline__ void p0_item(const float* W, int K, int Nsrc, const float* gain, half_t* WT, int item, int nbn, LAS unsigned* scr, int lane) {
    const int kb = item / nbn, nb = item % nbn, k0 = 64 * kb, n0 = 64 * nb;
    const int sc = src_col<MODE>(n0 + lane);
#pragma unroll 8
    for (int kk = 0; kk < 64; kk += 2) {
        float v0 = 0.f, v1 = 0.f;
        if (sc >= 0) { v0 = W[(size_t)(k0 + kk) * Nsrc + sc]; v1 = W[(size_t)(k0 + kk + 1) * Nsrc + sc]; }
        if (gain) { v0 *= gain[k0 + kk]; v1 *= gain[k0 + kk + 1]; }
        scr[lane * 33 + (kk >> 1)] = pack_h2(v0, v1);
    }
    LDS_WAIT(); asm volatile("" ::: "memory");
    const int c = lane & 7;
#pragma unroll
    for (int j = 0; j < 8; ++j) { const int nn = (lane >> 3) + 8 * j; const LAS unsigned* s = scr + nn * 33 + 4 * c;
        u32x4 o; o.x = s[0]; o.y = s[1]; o.z = s[2]; o.w = s[3];
        *(u32x4*)(WT + (size_t)(n0 + nn) * K + k0 + 8 * c) = o; }
    LDS_WAIT(); asm volatile("" ::: "memory");
}
__device__ __forceinline__ float wave_sum(float v) {
#pragma unroll
    for (int o = 1; o < 64; o <<= 1) v += __shfl_xor(v, o);
    return v;
}

__device__ __forceinline__ void attn_step_h(const float (&q)[64], float (&acc)[64], float& m, float& l, const half_t* kp, const half_t* vp, float bias, bool valid) {
    float sc = 0.f;
#pragma unroll
    for (int hh = 0; hh < 2; ++hh) {
#pragma unroll
        for (int j = 4 * hh; j < 4 * hh + 4; ++j) { const h8 kv = *(const h8*)(kp + 8 * j);
#pragma unroll
            for (int e = 0; e < 8; ++e) sc = fmaf(q[8 * j + e], (float)kv[e], sc); }
        __builtin_amdgcn_sched_barrier(0);
    }
    sc += bias;
    const float mn = valid ? fmaxf(m, sc) : m;
    const float alpha = __expf(m - mn), p = valid ? __expf(sc - mn) : 0.f;
    m = mn; l = l * alpha + p;
#pragma unroll
    for (int hh = 0; hh < 2; ++hh) {
#pragma unroll
        for (int j = 4 * hh; j < 4 * hh + 4; ++j) { const h8 vv = *(const h8*)(vp + 8 * j);
#pragma unroll
            for (int e = 0; e < 8; ++e) acc[8 * j + e] = fmaf(acc[8 * j + e], alpha, p * (float)vv[e]); }
        __builtin_amdgcn_sched_barrier(0);
    }
}
__device__ __forceinline__ float dot_f32(const float (&q)[64], const float* kp) {
    float sc = 0.f;
#pragma unroll
    for (int j = 0; j < 16; ++j) { const f32x4 kv = *(const f32x4*)(kp + 4 * j); sc = fmaf(q[4 * j], kv.x, sc); sc = fmaf(q[4 * j + 1], kv.y, sc); sc = fmaf(q[4 * j + 2], kv.z, sc); sc = fmaf(q[4 * j + 3], kv.w, sc); }
    return sc;
}
__device__ __forceinline__ void load_q(float (&q)[64], const half_t* qp, float scale) {
#pragma unroll
    for (int j = 0; j < 8; ++j) { const h8 v = *(const h8*)(qp + 8 * j);
#pragma unroll
        for (int e = 0; e < 8; ++e) q[8 * j + e] = (float)v[e] * scale; }
}

__device__ __forceinline__ void lru_gate_r(const float* wcol, float bias, const LAS float* xrow, LAS float* yout) {
    float w[64];
#pragma unroll
    for (int k = 0; k < 64; ++k) w[k] = wcol[(size_t)k * 64];
    for (int i = 0; i < 32; ++i) {
        const LAS float* xr = xrow + i * 256; float r = bias;
#pragma unroll
        for (int k = 0; k < 64; k += 4) { const f32x4 xv = *(const LAS f32x4*)(xr + k);
            r = fmaf(xv.x, w[k], r); r = fmaf(xv.y, w[k + 1], r); r = fmaf(xv.z, w[k + 2], r); r = fmaf(xv.w, w[k + 3], r); }
        yout[i * 256] = 1.f / (1.f + expf(-r));
    }
}

__global__ void __launch_bounds__(NTHR, 2) hymba_fwd(Params P) {
    extern __shared__ __attribute__((aligned(16))) unsigned char lds_raw[];
    LAS unsigned char* lds = (LAS unsigned char*)lds_raw;
    volatile LAS unsigned* MISC = (volatile LAS unsigned*)(lds + MISC_OFF);
    const int tid = threadIdx.x, lane = tid & 63, wave = __builtin_amdgcn_readfirstlane(tid >> 6);
    const int G = gridDim.x, bid = blockIdx.x;
    unsigned char* ws = P.ws;
    unsigned* ctl = (unsigned*)(ws + WS_CTL);
    float* SSQA = (float*)(ws + WS_SSQA); float* SSQB = (float*)(ws + WS_SSQB); float* CFOX = (float*)(ws + WS_CFOX); float* KVC = (float*)(ws + WS_KVC);
    float* LRUAGG = (float*)(ws + WS_LRUAGG); float* CB = (float*)(ws + WS_CB); float* YD = (float*)(ws + WS_YD);
    half_t* WIN_T = (half_t*)(ws + WS_WIN); half_t* WOUT_T = (half_t*)(ws + WS_WOUT); half_t* WGU_T = (half_t*)(ws + WS_WGU); half_t* WDN_T = (half_t*)(ws + WS_WDN);
    half_t* XH = (half_t*)(ws + WS_XH); half_t* MIXED = (half_t*)(ws + WS_MIXED); half_t* Z = (half_t*)(ws + WS_Z); half_t* HB = (half_t*)(ws + WS_Z);

    for (int u = tid; u < 64; u += NTHR) MISC[u] = 0u;
    __syncthreads();
    XcdBarrier bar = xcd_barrier_post(ctl + CW_BAR, MISC + 8);

    const int gw = bid * NWAVES + wave, NGW = G * NWAVES;

#ifndef SKIP_P0
    {
        LAS unsigned* scr = (LAS unsigned*)(lds + wave * 8448);
        constexpr int I_IN = 16 * 44, I_OUT = 16 * 16, I_GU = 16 * 88, I_DN = 44 * 16, PER_L = I_IN + I_OUT + I_GU + I_DN;
        for (int it = gw; it < 2 * PER_L; it += NGW) {
            const int L = it / PER_L; int r = it % PER_L;
            if (r < I_IN) { p0_item<1>(P.w_in + (size_t)L * D * NIN_SRC, D, NIN_SRC, P.norm_mix + L * D, WIN_T + (size_t)L * NZP * D, r, 44, scr, lane); continue; } r -= I_IN;
            if (r < I_OUT) { p0_item<0>(P.w_out + (size_t)L * D * D, D, D, nullptr, WOUT_T + (size_t)L * D * D, r, 16, scr, lane); continue; } r -= I_OUT;
            if (r < I_GU) { p0_item<2>(P.w_gate_up + (size_t)L * D * 2 * DFF, D, 2 * DFF, P.norm_ffn + L * D, WGU_T + (size_t)L * 2 * DFF * D, r, 88, scr, lane); continue; } r -= I_GU;
            p0_item<0>(P.w_down + (size_t)L * DFF * D, DFF, D, nullptr, WDN_T + (size_t)L * D * DFF, r, 16, scr, lane);
        }
        for (int o = gw; o < 2 * 2 * 128; o += NGW) {
            const int m = o & 127, ln = o >> 7;
            const float* pp = P.nsa_cmp_pos + (size_t)ln * 2048; const float* wp = P.nsa_cmp_w1 + (size_t)ln * 2048 * 128 + m;
            float s = 0.f;
            for (int i = lane; i < 2048; i += 64) s = fmaf(pp[i], wp[(size_t)i * 128], s);
            s = wave_sum(s);
            if (lane == 0) CB[o] = s;
        }
        for (int row = gw; row < T; row += NGW) {
            const f32x4* xr = (const f32x4*)(P.x + (size_t)row * D) + lane;
            float s = 0.f;
#pragma unroll
            for (int j = 0; j < 4; ++j) { const f32x4 v = xr[64 * j]; s += (v.x * v.x + v.y * v.y) + (v.z * v.z + v.w * v.w);
                u32x2 o; o.x = pack_h2(v.x, v.y); o.y = pack_h2(v.z, v.w); *(u32x2*)(XH + (size_t)row * D + 4 * (lane + 64 * j)) = o; }
            s = wave_sum(s);
            if (lane < 16) SSQB[(size_t)row * 16 + lane] = lane == 0 ? s : 0.f;
        }
    }
#endif
    xcd_barrier(bar);

    for (int L = 0; L < 2; ++L) {
#ifndef SKIP_G1
        {
            pg8::Gemm g{XH, WIN_T + (size_t)L * NZP * D, T, NZP, D}; pg8::StaticOrder S; S.init(T, NZP, G, bid);
            EpiZ E{Z, SSQB};
            pg8::gemm_phase<EpiZ, pg8::StaticOrder>(lds, g, S, E);
        }
#endif
        xcd_barrier(bar);

        {
#ifndef SKIP_P2AB
            {
                int tid = threadIdx.x; asm volatile("" : "+v"(tid)); const int lane = tid & 63;
                const int g8 = lane >> 3, sub = lane & 7;
                for (int tok = gw; tok < T; tok += NGW) {
#pragma unroll
                    for (int rr = 0; rr < 2; ++rr) {
                        const int r = g8 + 8 * rr;
                        if (r < 14) {
                            int col; const float* gain;
                            if (r < 4) { col = ZC_FOX_Q + 64 * r; gain = P.fox_qk_norm + (L * 2 + 0) * 64; }
                            else if (r < 8) { col = ZC_FOX_K + 64 * (r - 4); gain = P.fox_qk_norm + (L * 2 + 1) * 64; }
                            else if (r < 12) { col = ZC_NSA_Q + 64 * (r - 8); gain = P.nsa_qk_norm + (L * 4 + 0) * 64; }
                            else if (r == 12) { col = ZC_KS; gain = P.nsa_qk_norm + (L * 4 + 2) * 64; }
                            else { col = ZC_KW; gain = P.nsa_qk_norm + (L * 4 + 3) * 64; }
                            half_t* p = Z + (size_t)tok * NZP + col + 8 * sub;
                            const h8 v = *(const h8*)p; float f[8]; float s = 0.f;
#pragma unroll
                            for (int e = 0; e < 8; ++e) { f[e] = (float)v[e]; s += f[e] * f[e]; }
                            s += __shfl_xor(s, 1); s += __shfl_xor(s, 2); s += __shfl_xor(s, 4);
                            const float rs = rsqrtf(s * (1.f / 64.f) + EPS);
                            const f32x4 g0 = *(const f32x4*)(gain + 8 * sub), g1 = *(const f32x4*)(gain + 8 * sub + 4);
                            *(u32x4*)p = pack_h8((f32x4){f[0] * rs * g0.x, f[1] * rs * g0.y, f[2] * rs * g0.z, f[3] * rs * g0.w}, (f32x4){f[4] * rs * g1.x, f[5] * rs * g1.y, f[6] * rs * g1.z, f[7] * rs * g1.w});
                        }
                    }
                }
            }
            if (wave == 1 && (bid & 7) == 0 && (bid >> 3) < 32) {
                int tid = threadIdx.x; asm volatile("" : "+v"(tid)); const int lane = tid & 63;
                const int task = bid >> 3, b = task >> 2, h = task & 3;
                const float fb = P.fox_f_bias[L * 4 + h];
                float carry = 0.f;
                for (int it = 0; it < SEQ / 64; ++it) {
                    const size_t tok = (size_t)b * SEQ + it * 64 + lane;
                    float v = log_sigmoid((float)Z[tok * NZP + ZC_FOX_F + h] + fb);
#pragma unroll
                    for (int o = 1; o < 64; o <<= 1) { const float n = __shfl_up(v, o); if (lane >= o) v += n; }
                    v += carry;
                    CFOX[tok * 4 + h] = v;
                    carry = __shfl(v, 63);
                }
            }
#endif
#ifndef SKIP_P2LRU
            for (int ui = bid; ui < 512; ui += G) {
                {
                    int tid = threadIdx.x; asm volatile("" : "+v"(tid)); const int lane = tid & 63; (void)lane;

                    const int b = ui >> 6, chunk = ui & 63, c = tid & 255, hf = tid >> 8;
                    LAS float* bufX = (LAS float*)lds;
                    const int t0 = chunk * 64 + hf * 32; const size_t tokb = (size_t)b * SEQ;
                    {
                        const float w0 = P.lru_conv_w[(L * 4 + 0) * 256 + c], w1 = P.lru_conv_w[(L * 4 + 1) * 256 + c], w2 = P.lru_conv_w[(L * 4 + 2) * 256 + c], w3 = P.lru_conv_w[(L * 4 + 3) * 256 + c], cb = P.lru_conv_b[L * 256 + c];
                        float x0 = t0 >= 3 ? (float)Z[(tokb + t0 - 3) * NZP + ZC_LRU_X + c] : 0.f, x1 = t0 >= 2 ? (float)Z[(tokb + t0 - 2) * NZP + ZC_LRU_X + c] : 0.f, x2 = t0 >= 1 ? (float)Z[(tokb + t0 - 1) * NZP + ZC_LRU_X + c] : 0.f;
                        for (int i = 0; i < 32; ++i) { const float x3 = (float)Z[(tokb + t0 + i) * NZP + ZC_LRU_X + c];
                            bufX[(hf * 32 + i) * 256 + c] = cb + w0 * x0 + w1 * x1 + w2 * x2 + w3 * x3; x0 = x1; x1 = x2; x2 = x3; }
                    }
                    __syncthreads();
                    {
                        const int blk = c >> 6, j = c & 63;
                        LAS float* bufY = (LAS float*)(lds + 65536);
                        lru_gate_r(P.lru_w_gates + ((size_t)((L * 2 + 0) * 4 + blk) * 64) * 64 + j, P.lru_b_gates[(L * 2 + 0) * 256 + c], bufX + hf * 32 * 256 + blk * 64, bufY + hf * 32 * 256 + c);
                        float wi_[64];
#pragma unroll
                        for (int k = 0; k < 64; ++k) wi_[k] = P.lru_w_gates[((size_t)((L * 2 + 1) * 4 + blk) * 64 + k) * 64 + j];
                        const float bi = P.lru_b_gates[(L * 2 + 1) * 256 + c];
                        const float lsp = -8.0f * log1pf(expf(-P.lru_lambda[L * 256 + c]));
                        float h = 0.f, Ap = 1.f;
                        for (int i = 0; i < 32; ++i) {
                            const LAS float* xr = bufX + (hf * 32 + i) * 256 + blk * 64;
                            float ii = bi;
#pragma unroll
                            for (int k = 0; k < 64; k += 4) { const f32x4 xv = *(const LAS f32x4*)(xr + k);
                                ii = fmaf(xv.x, wi_[k], ii); ii = fmaf(xv.y, wi_[k + 1], ii); ii = fmaf(xv.z, wi_[k + 2], ii); ii = fmaf(xv.w, wi_[k + 3], ii); }
                            ii = 1.f / (1.f + expf(-ii));
                            const float r = bufY[(hf * 32 + i) * 256 + c];
                            const float xc = xr[j];
                            const float log_a = lsp * r, a = expf(log_a), bb = sqrtf(-expm1f(2.0f * log_a)) * (ii * xc);
                            h = fmaf(a, h, bb); Ap *= a;
                        }
                        float* ag = LRUAGG + (((size_t)b * 128 + chunk * 2 + hf) * 256 + c) * 2;
                        ag[0] = Ap; ag[1] = h;
                    }
                    __syncthreads();
                }
            }
#endif
#ifndef SKIP_P2CMP
            for (int ui = bid; ui < 256; ui += G) {
                {
                    int tid = threadIdx.x; asm volatile("" : "+v"(tid)); const int lane = tid & 63; (void)lane;
                const int cu = ui, net = cu >> 7, b = (cu >> 4) & 7, ng = cu & 15, n0 = ng * 16;
                    LAS float* zs = (LAS float*)lds;
                    LAS float* hid = (LAS float*)(lds + 272 * 64 * 4);
                    const int zcol = net == 0 ? ZC_KC : ZC_VC;
                    for (int e = tid; e < 272 * 8; e += NTHR) { const int tl = e >> 3, c8 = e & 7; int t = n0 * 16 + tl; if (t > SEQ - 1) t = SEQ - 1;
                        const h8 v = *(const h8*)(Z + ((size_t)b * SEQ + t) * NZP + zcol + 8 * c8);
#pragma unroll
                        for (int k = 0; k < 8; ++k) zs[tl * 64 + 8 * c8 + k] = (float)v[k]; }
                    __syncthreads();
                    {
                        const int m = tid & 127, q4 = tid >> 7;
                        const float* wp = P.nsa_cmp_w1 + (size_t)(L * 2 + net) * 2048 * 128 + m;
                        float a0 = 0.f, a1 = 0.f, a2 = 0.f, a3 = 0.f;
                        for (int l = 0; l < 32; ++l) {
                            const LAS float* z0 = zs + ((4 * q4 + 0) * 16 + l) * 64;
#pragma unroll 8
                            for (int d = 0; d < 64; ++d) { const float w = wp[(size_t)(l * 64 + d) * 128];
                                a0 = fmaf(z0[d], w, a0); a1 = fmaf(z0[16 * 64 + d], w, a1); a2 = fmaf(z0[32 * 64 + d], w, a2); a3 = fmaf(z0[48 * 64 + d], w, a3); }
                        }
                        const float cb = CB[(L * 2 + net) * 128 + m];
                        hid[(4 * q4 + 0) * 128 + m] = gelu_tanh(a0 + cb); hid[(4 * q4 + 1) * 128 + m] = gelu_tanh(a1 + cb);
                        hid[(4 * q4 + 2) * 128 + m] = gelu_tanh(a2 + cb); hid[(4 * q4 + 3) * 128 + m] = gelu_tanh(a3 + cb);
                    }
                    __syncthreads();
                    {
                        const int d = tid & 63;
                        const float* w2 = P.nsa_cmp_w2 + (size_t)(L * 2 + net) * 128 * 64 + d;
#pragma unroll
                        for (int rep = 0; rep < 2; ++rep) {
                            const int nl = (tid >> 6) + 8 * rep;
                            float o = 0.f;
                            for (int m = 0; m < 128; ++m) o = fmaf(hid[nl * 128 + m], w2[m * 64], o);
                            if (net == 0) { const float ss = wave_sum(o * o); o = o * rsqrtf(ss * (1.f / 64.f) + EPS) * P.nsa_qk_norm[(L * 4 + 1) * 64 + d]; }
                            const int n = n0 + nl;
                            if (n < NCMP) KVC[(((size_t)net * BATCH + b) * NCMP + n) * 64 + d] = o;
                        }
                    }
                    __syncthreads();
                }
            }
#endif
        }
        xcd_barrier(bar);

#ifndef SKIP_FOX
        for (int ui = bid; ui < 256; ui += G) {
            {
                int tid = threadIdx.x; asm volatile("" : "+v"(tid)); const int lane = tid & 63; (void)lane;
                const int b = ui >> 5, pi = ui & 31, tile = wave < 4 ? pi : 63 - pi, h = wave & 3, t = tile * 64 + lane;
                const size_t tokb = (size_t)b * SEQ, tok = tokb + t;
                LAS float* ex = (LAS float*)lds;
                float q[64], acc[64];
                load_q(q, Z + tok * NZP + ZC_FOX_Q + h * 64, 0.125f);
#pragma unroll
                for (int d = 0; d < 64; ++d) acc[d] = 0.f;
                const float ct = CFOX[tok * 4 + h];
                float m = -1e30f, l = 0.f;
                const int smax = tile * 64 + 63;
                for (int s = 0; s <= smax; ++s) {
                    const half_t* kp = Z + (tokb + s) * NZP + ZC_FOX_K + h * 64;
                    attn_step_h(q, acc, m, l, kp, kp + (ZC_FOX_V - ZC_FOX_K), ct - CFOX[(tokb + s) * 4 + h], s <= t);
                }
                const float inv = 1.f / l; float ss = 0.f;
#pragma unroll
                for (int d = 0; d < 64; ++d) { acc[d] *= inv; ss += acc[d] * acc[d]; }
                const int ridx = (wave >> 2) * 64 + lane;
                ex[ridx * 4 + h] = ss;
                __syncthreads();
                const float rs = rsqrtf((ex[ridx * 4] + ex[ridx * 4 + 1] + ex[ridx * 4 + 2] + ex[ridx * 4 + 3]) * (1.f / 256.f) + EPS);
                const float* gn = P.out_norm + (L * 4 + 2) * 256 + h * 64;
#pragma unroll
                for (int j = 0; j < 8; ++j) { f32x4 a, c2;
                    a.x = acc[8 * j] * rs * gn[8 * j]; a.y = acc[8 * j + 1] * rs * gn[8 * j + 1]; a.z = acc[8 * j + 2] * rs * gn[8 * j + 2]; a.w = acc[8 * j + 3] * rs * gn[8 * j + 3];
                    c2.x = acc[8 * j + 4] * rs * gn[8 * j + 4]; c2.y = acc[8 * j + 5] * rs * gn[8 * j + 5]; c2.z = acc[8 * j + 6] * rs * gn[8 * j + 6]; c2.w = acc[8 * j + 7] * rs * gn[8 * j + 7];
                    *(u32x4*)(MIXED + tok * D + 512 + h * 64 + 8 * j) = pack_h8(a, c2); }
                __syncthreads();
            }
        }
#endif
#ifndef SKIP_NSA
        for (int ui = bid; ui < 256; ui += G) {
            {
                int tid = threadIdx.x; asm volatile("" : "+v"(tid)); const int lane = tid & 63; (void)lane;
                const int uu = ui, b = uu >> 5, pi = uu & 31, tile = wave < 4 ? pi : 63 - pi, h = wave & 3, t = tile * 64 + lane;
                const size_t tokb = (size_t)b * SEQ, tok = tokb + t;
                const int ridx = (wave >> 2) * 64 + lane;
                LAS float* imp = (LAS float*)lds;
                LAS float* stm = (LAS float*)(lds + 128 * 65 * 4);
                LAS float* stl = stm + 512;
                LAS float* ex = stl + 512;
                LAS unsigned* selm = (LAS unsigned*)(ex + 512);
                const float* relb = P.rel_bias; const float* gb = P.nsa_gate_bias + L * 12;
                float q[64], acc[64];
                load_q(q, Z + tok * NZP + ZC_NSA_Q + h * 64, 0.125f);
                const float* kc = KVC + ((size_t)0 * BATCH + b) * NCMP * 64; const float* vc = KVC + ((size_t)1 * BATCH + b) * NCMP * 64;
                int nvalid = t >= 31 ? (t - 31) / 16 + 1 : 0; if (nvalid > NCMP) nvalid = NCMP;
                int nmax = (tile * 64 + 63 - 31) / 16 + 1; if (nmax > NCMP) nmax = NCMP;
                float* yd = YD + tok * 256 + h * 64;
                for (int e = tid; e < 128 * 65; e += NTHR) imp[e] = 0.f;
                {
#pragma unroll
                    for (int d = 0; d < 64; ++d) acc[d] = 0.f;
                    float m = -1e30f, l = 0.f;
                    for (int n = 0; n < nmax; ++n) {
                        float sc = dot_f32(q, kc + n * 64) + relb[rel_bucket(t - (16 * n + 31)) * 4 + h];
                        const bool valid = n < nvalid;
                        const float mn = valid ? fmaxf(m, sc) : m;
                        const float alpha = __expf(m - mn), p = valid ? __expf(sc - mn) : 0.f;
                        m = mn; l = l * alpha + p;
                        const float* vp = vc + n * 64;
#pragma unroll
                        for (int j = 0; j < 16; ++j) { const f32x4 vv = *(const f32x4*)(vp + 4 * j);
                            acc[4 * j] = fmaf(acc[4 * j], alpha, p * vv.x); acc[4 * j + 1] = fmaf(acc[4 * j + 1], alpha, p * vv.y); acc[4 * j + 2] = fmaf(acc[4 * j + 2], alpha, p * vv.z); acc[4 * j + 3] = fmaf(acc[4 * j + 3], alpha, p * vv.w); }
                    }
                    const float g0 = sigmoidf_((float)Z[tok * NZP + ZC_NSA_G + 0 * 4 + h] + gb[0 * 4 + h]);
                    const float il = nvalid > 0 ? 1.f / l : 0.f, sc0 = g0 * il;
#pragma unroll
                    for (int j = 0; j < 16; ++j) *(f32x4*)(yd + 4 * j) = (f32x4){acc[4 * j] * sc0, acc[4 * j + 1] * sc0, acc[4 * j + 2] * sc0, acc[4 * j + 3] * sc0};
                    stm[ridx * 4 + h] = m; stl[ridx * 4 + h] = il;
                }
                __syncthreads();
                for (int hh = 0; hh < 4; ++hh) {
                    if (h == hh && nvalid > 0) {
                        const float mh = stm[ridx * 4 + h], il = stl[ridx * 4 + h];
                        float pprev = 0.f;
                        const int mbmax = (nvalid + 3) / 4;
                        for (int mb = 0; mb <= mbmax && mb < 64; ++mb) {
                            float v = 16.f * pprev, plast = 0.f;
#pragma unroll
                            for (int e = 0; e < 4; ++e) { const int n = 4 * mb + e; float p = 0.f;
                                if (n < nvalid) { const float sc = dot_f32(q, kc + n * 64) + relb[rel_bucket(t - (16 * n + 31)) * 4 + h]; p = __expf(sc - mh) * il; }
                                v += (e == 3 ? 16.f : 32.f) * p; plast = p; }
                            pprev = plast;
                            imp[ridx * 65 + mb] += v;
                        }
                    }
                    __syncthreads();
                }
                for (int rr = 0; rr < 16; ++rr) {
                    const int row = wave * 16 + rr, rtile = row < 64 ? pi : 63 - pi, cur = rtile;
                    float v = imp[row * 65 + lane];
                    if (lane > cur) v = -INFINITY; else if (lane == 0 || lane == cur || lane == cur - 1) v = 1e30f;
                    int rank = 0;
                    for (int o = 0; o < 64; ++o) { const float w = __shfl(v, o); rank += (w > v || (w == v && o < lane)) ? 1 : 0; }
                    const unsigned long long msk = __ballot(rank < 16);
                    if (lane == 0) { selm[row * 2] = (unsigned)msk; selm[row * 2 + 1] = (unsigned)(msk >> 32); }
                }
                __syncthreads();
                {
                    const unsigned long long msk = (unsigned long long)selm[ridx * 2] | ((unsigned long long)selm[ridx * 2 + 1] << 32);
#pragma unroll
                    for (int d = 0; d < 64; ++d) acc[d] = 0.f;
                    float m = -1e30f, l = 0.f;
                    for (int mb = 0; mb <= tile; ++mb) {
                        const bool sel = (msk >> mb) & 1ull;
                        if (!__any(sel)) continue;
                        for (int j = 0; j < 64; ++j) { const int pos = mb * 64 + j;
                            const half_t* kp = Z + (tokb + pos) * NZP + ZC_KS;
                            attn_step_h(q, acc, m, l, kp, kp + 64, relb[rel_bucket(t - pos) * 4 + h], sel && pos <= t); }
                    }
                    const float g1 = sigmoidf_((float)Z[tok * NZP + ZC_NSA_G + 1 * 4 + h] + gb[1 * 4 + h]);
                    const float sc1 = g1 / l;
#pragma unroll
                    for (int j = 0; j < 16; ++j) { f32x4 o = *(const f32x4*)(yd + 4 * j); o.x += acc[4 * j] * sc1; o.y += acc[4 * j + 1] * sc1; o.z += acc[4 * j + 2] * sc1; o.w += acc[4 * j + 3] * sc1; *(f32x4*)(yd + 4 * j) = o; }
                }
                {
#pragma unroll
                    for (int d = 0; d < 64; ++d) acc[d] = 0.f;
                    float m = -1e30f, l = 0.f;
                    int p0 = tile * 64 - 511; if (p0 < 0) p0 = 0;
                    const int p1 = tile * 64 + 63;
                    for (int pos = p0; pos <= p1; ++pos) { const int dist = t - pos;
                        const half_t* kp = Z + (tokb + pos) * NZP + ZC_KW;
                        attn_step_h(q, acc, m, l, kp, kp + 64, relb[rel_bucket(dist) * 4 + h], dist >= 0 && dist < 512); }
                    const float g2 = sigmoidf_((float)Z[tok * NZP + ZC_NSA_G + 2 * 4 + h] + gb[2 * 4 + h]);
                    const float sc2 = g2 / l; float ss = 0.f;
#pragma unroll
                    for (int j = 0; j < 16; ++j) { const f32x4 o = *(const f32x4*)(yd + 4 * j);
                        acc[4 * j] = o.x + acc[4 * j] * sc2; acc[4 * j + 1] = o.y + acc[4 * j + 1] * sc2; acc[4 * j + 2] = o.z + acc[4 * j + 2] * sc2; acc[4 * j + 3] = o.w + acc[4 * j + 3] * sc2;
                        ss += (acc[4 * j] * acc[4 * j] + acc[4 * j + 1] * acc[4 * j + 1]) + (acc[4 * j + 2] * acc[4 * j + 2] + acc[4 * j + 3] * acc[4 * j + 3]); }
                    ex[ridx * 4 + h] = ss;
                    __syncthreads();
                    const float rs = rsqrtf((ex[ridx * 4] + ex[ridx * 4 + 1] + ex[ridx * 4 + 2] + ex[ridx * 4 + 3]) * (1.f / 256.f) + EPS);
                    const float* gn = P.out_norm + (L * 4 + 3) * 256 + h * 64;
#pragma unroll
                    for (int j = 0; j < 8; ++j) { f32x4 a, c2;
                        a.x = acc[8 * j] * rs * gn[8 * j]; a.y = acc[8 * j + 1] * rs * gn[8 * j + 1]; a.z = acc[8 * j + 2] * rs * gn[8 * j + 2]; a.w = acc[8 * j + 3] * rs * gn[8 * j + 3];
                        c2.x = acc[8 * j + 4] * rs * gn[8 * j + 4]; c2.y = acc[8 * j + 5] * rs * gn[8 * j + 5]; c2.z = acc[8 * j + 6] * rs * gn[8 * j + 6]; c2.w = acc[8 * j + 7] * rs * gn[8 * j + 7];
                        *(u32x4*)(MIXED + tok * D + 768 + h * 64 + 8 * j) = pack_h8(a, c2); }
                }
                __syncthreads();
            }
        }
#endif
#ifndef SKIP_LRU
        for (int ui = bid; ui < 512; ui += G) {
            {
                int tid = threadIdx.x; asm volatile("" : "+v"(tid)); const int lane = tid & 63; (void)lane;
                const int uu = ui, b = uu >> 6, chunk = uu & 63, c = tid & 255, hf = tid >> 8;
                LAS float* bufX = (LAS float*)lds;
                LAS float* bufY = (LAS float*)(lds + 65536);
                const int t0 = chunk * 64 + hf * 32; const size_t tokb = (size_t)b * SEQ;
                {
                    const float w0 = P.lru_conv_w[(L * 4 + 0) * 256 + c], w1 = P.lru_conv_w[(L * 4 + 1) * 256 + c], w2 = P.lru_conv_w[(L * 4 + 2) * 256 + c], w3 = P.lru_conv_w[(L * 4 + 3) * 256 + c], cb = P.lru_conv_b[L * 256 + c];
                    float x0 = t0 >= 3 ? (float)Z[(tokb + t0 - 3) * NZP + ZC_LRU_X + c] : 0.f, x1 = t0 >= 2 ? (float)Z[(tokb + t0 - 2) * NZP + ZC_LRU_X + c] : 0.f, x2 = t0 >= 1 ? (float)Z[(tokb + t0 - 1) * NZP + ZC_LRU_X + c] : 0.f;
                    for (int i = 0; i < 32; ++i) { const float x3 = (float)Z[(tokb + t0 + i) * NZP + ZC_LRU_X + c];
                        bufX[(hf * 32 + i) * 256 + c] = cb + w0 * x0 + w1 * x1 + w2 * x2 + w3 * x3; x0 = x1; x1 = x2; x2 = x3; }
                }
                __syncthreads();
                {
                    const int blk = c >> 6, j = c & 63;
                    lru_gate_r(P.lru_w_gates + ((size_t)((L * 2 + 0) * 4 + blk) * 64) * 64 + j, P.lru_b_gates[(L * 2 + 0) * 256 + c], bufX + hf * 32 * 256 + blk * 64, bufY + hf * 32 * 256 + c);
                    float wi_[64];
#pragma unroll
                    for (int k = 0; k < 64; ++k) wi_[k] = P.lru_w_gates[((size_t)((L * 2 + 1) * 4 + blk) * 64 + k) * 64 + j];
                    const float bi = P.lru_b_gates[(L * 2 + 1) * 256 + c];
                    const float lsp = -8.0f * log1pf(expf(-P.lru_lambda[L * 256 + c]));
                    float h = 0.f;
                    {
                        const int nsub = chunk * 2 + hf; const float* ag = LRUAGG + ((size_t)b * 128 * 256 + c) * 2;
                        for (int s = 0; s < nsub; ++s) { const float A = ag[(size_t)s * 512], hh = ag[(size_t)s * 512 + 1]; h = fmaf(A, h, hh); }
                    }
                    for (int i = 0; i < 32; ++i) {
                        const LAS float* xr = bufX + (hf * 32 + i) * 256 + blk * 64;
                        float ii = bi;
#pragma unroll
                        for (int k = 0; k < 64; k += 4) { const f32x4 xv = *(const LAS f32x4*)(xr + k);
                            ii = fmaf(xv.x, wi_[k], ii); ii = fmaf(xv.y, wi_[k + 1], ii); ii = fmaf(xv.z, wi_[k + 2], ii); ii = fmaf(xv.w, wi_[k + 3], ii); }
                        ii = 1.f / (1.f + expf(-ii));
                        const float r = bufY[(hf * 32 + i) * 256 + c];
                        const float xc = xr[j];
                        const float log_a = lsp * r, a = expf(log_a), bb = sqrtf(-expm1f(2.0f * log_a)) * (ii * xc);
                        h = fmaf(a, h, bb);
                        const float gt = (float)Z[(tokb + t0 + i) * NZP + ZC_LRU_G + c];
                        bufY[(hf * 32 + i) * 256 + c] = h * gelu_tanh(gt);
                    }
                }
                __syncthreads();
                {
                    const float* gn = P.out_norm + (L * 4 + 0) * 256 + 4 * lane; const f32x4 g4 = *(const f32x4*)gn;
                    for (int i = 0; i < 8; ++i) { const int tl = wave * 8 + i; const f32x4 v = *(const LAS f32x4*)(bufY + tl * 256 + 4 * lane);
                        const float ss = wave_sum((v.x * v.x + v.y * v.y) + (v.z * v.z + v.w * v.w)); const float rs = rsqrtf(ss * (1.f / 256.f) + EPS);
                        u32x2 o; o.x = pack_h2(v.x * rs * g4.x, v.y * rs * g4.y); o.y = pack_h2(v.z * rs * g4.z, v.w * rs * g4.w);
                        *(u32x2*)(MIXED + (tokb + chunk * 64 + tl) * D + 0 + 4 * lane) = o; }
                }
                {
                    const float w0 = P.sc_conv_w[(L * 3 + 0) * 256 + c], w1 = P.sc_conv_w[(L * 3 + 1) * 256 + c], w2 = P.sc_conv_w[(L * 3 + 2) * 256 + c];
                    float u0 = 0.f, u1 = 0.f;
                    if (t0 >= 2) { const size_t tk = tokb + t0 - 2; u0 = (float)Z[tk * NZP + ZC_SC_C + c] * (float)Z[tk * NZP + ZC_SC_X + c]; }
                    if (t0 >= 1) { const size_t tk = tokb + t0 - 1; u1 = (float)Z[tk * NZP + ZC_SC_C + c] * (float)Z[tk * NZP + ZC_SC_X + c]; }
                    for (int i = 0; i < 32; ++i) { const size_t tk = tokb + t0 + i;
                        const float u2 = (float)Z[tk * NZP + ZC_SC_C + c] * (float)Z[tk * NZP + ZC_SC_X + c];
                        bufX[(hf * 32 + i) * 256 + c] = (float)Z[tk * NZP + ZC_SC_B + c] * (w0 * u0 + w1 * u1 + w2 * u2); u0 = u1; u1 = u2; }
                }
                __syncthreads();
                {
                    const float* gn = P.out_norm + (L * 4 + 1) * 256 + 4 * lane; const f32x4 g4 = *(const f32x4*)gn;
                    for (int i = 0; i < 8; ++i) { const int tl = wave * 8 + i; const f32x4 v = *(const LAS f32x4*)(bufX + tl * 256 + 4 * lane);
                        const float ss = wave_sum((v.x * v.x + v.y * v.y) + (v.z * v.z + v.w * v.w)); const float rs = rsqrtf(ss * (1.f / 256.f) + EPS);
                        u32x2 o; o.x = pack_h2(v.x * rs * g4.x, v.y * rs * g4.y); o.y = pack_h2(v.z * rs * g4.z, v.w * rs * g4.w);
                        *(u32x2*)(MIXED + (tokb + chunk * 64 + tl) * D + 256 + 4 * lane) = o; }
                }
                __syncthreads();
            }
        }
#endif
        xcd_barrier(bar);

#ifndef SKIP_G4
        {
            pg8::Gemm g{MIXED, WOUT_T + (size_t)L * D * D, T, D, D}; pg8::StaticOrder S; S.init(T, D, G, bid);
            EpiRes E{L == 0 ? P.x : P.out, P.out, XH, SSQA};
            pg8::gemm_phase<EpiRes, pg8::StaticOrder>(lds, g, S, E);
        }
#endif
        xcd_barrier(bar);
#ifndef SKIP_G5
        {
            pg8::Gemm g{XH, WGU_T + (size_t)L * 2 * DFF * D, T, 2 * DFF, D}; pg8::StaticOrder S; S.init(T, 2 * DFF, G, bid);
            EpiSwiglu E{HB, SSQA};
            pg8::gemm_phase<EpiSwiglu, pg8::StaticOrder>(lds, g, S, E);
        }
#endif
        xcd_barrier(bar);
#ifndef SKIP_G6
        {
            pg8::Gemm g{HB, WDN_T + (size_t)L * D * DFF, T, D, DFF}; pg8::StaticOrder S; S.init(T, D, G, bid);
            EpiRes E{P.out, P.out, L == 0 ? XH : nullptr, L == 0 ? SSQB : nullptr};
            pg8::gemm_phase<EpiRes, pg8::StaticOrder>(lds, g, S, E);
        }
#endif
        if (L == 0) xcd_barrier(bar);
    }
}

extern "C" void kernel_launch(void* const* d_in, const int* in_sizes, int n_in, void* d_out, int out_size, void* d_ws, size_t ws_size, hipStream_t stream) {
    static int grid = 0;
    if (grid == 0) {
        if (n_in != 22 || ws_size < WS_END) { fprintf(stderr, "kernel_launch: unexpected n_in %d or ws_size %zu (< %zu)\n", n_in, ws_size, (size_t)WS_END); grid = -1; return; }
        int dev = 0, cus = 0, per_cu = 0;
        if (hipGetDevice(&dev) != hipSuccess || hipDeviceGetAttribute(&cus, hipDeviceAttributeMultiprocessorCount, dev) != hipSuccess) { grid = -1; return; }
        if (hipFuncSetAttribute((const void*)hymba_fwd, hipFuncAttributeMaxDynamicSharedMemorySize, LDS_BYTES) != hipSuccess) { fprintf(stderr, "kernel_launch: hipFuncSetAttribute failed\n"); grid = -1; return; }
        if (hipOccupancyMaxActiveBlocksPerMultiprocessor(&per_cu, (const void*)hymba_fwd, NTHR, LDS_BYTES) != hipSuccess || per_cu < 1) { fprintf(stderr, "kernel_launch: occupancy query says %d\n", per_cu); }
        (void)hipGetLastError();
        grid = cus;
    }
    if (grid < 0) return;
    (void)hipMemsetAsync((char*)d_ws + WS_CTL, 0, CTL_ZERO_BYTES, stream);
    Params p{};
    p.x = (const float*)d_in[0]; p.norm_mix = (const float*)d_in[1]; p.w_in = (const float*)d_in[2]; p.lru_conv_w = (const float*)d_in[3]; p.lru_conv_b = (const float*)d_in[4];
    p.lru_w_gates = (const float*)d_in[5]; p.lru_b_gates = (const float*)d_in[6]; p.lru_lambda = (const float*)d_in[7]; p.sc_conv_w = (const float*)d_in[8];
    p.fox_f_bias = (const float*)d_in[9]; p.fox_qk_norm = (const float*)d_in[10]; p.nsa_qk_norm = (const float*)d_in[11]; p.nsa_cmp_pos = (const float*)d_in[12];
    p.nsa_cmp_w1 = (const float*)d_in[13]; p.nsa_cmp_w2 = (const float*)d_in[14]; p.nsa_gate_bias = (const float*)d_in[15]; p.rel_bias = (const float*)d_in[16];
    p.out_norm = (const float*)d_in[17]; p.w_out = (const float*)d_in[18]; p.norm_ffn = (const float*)d_in[19]; p.w_gate_up = (const float*)d_in[20]; p.w_down = (const float*)d_in[21];
    p.out = (float*)d_out; p.ws = (unsigned char*)d_ws;
    hipLaunchKernelGGL(hymba_fwd, dim3(grid), dim3(NTHR), LDS_BYTES, stream, p);
}
```

```cpp
#include <hip/hip_runtime.h>
#include <stdint.h>
#include <stdio.h>

#define LAS __attribute__((address_space(3)))
typedef _Float16 half_t;
typedef _Float16 h8 __attribute__((ext_vector_type(8)));
typedef _Float16 h4 __attribute__((ext_vector_type(4)));
typedef _Float16 h2 __attribute__((ext_vector_type(2)));
typedef float f32x4 __attribute__((ext_vector_type(4)));
typedef unsigned u32x4 __attribute__((ext_vector_type(4)));
typedef unsigned u32x2 __attribute__((ext_vector_type(2)));
typedef float f32x16 __attribute__((ext_vector_type(16)));
#define MFMA32(a, b, c) __builtin_amdgcn_mfma_f32_32x32x16_f16(a, b, c, 0, 0, 0)
constexpr float LOG2E = 1.4426950408889634f, QSCALE = 0.125f * 1.4426950408889634f;
__device__ __forceinline__ int pi16(int r) { return (r & ~0xC) | ((r & 4) << 1) | ((r & 8) >> 1); }

constexpr int BATCH = 8, SEQ = 4096, T = BATCH * SEQ, D = 1024, NZP = 2816, DFF = 2816, NCMP = 255;
constexpr int NIN_SRC = 2704;
constexpr int ZC_LRU_X = 0, ZC_LRU_G = 256, ZC_SC_B = 512, ZC_SC_C = 768, ZC_SC_X = 1024, ZC_FOX_Q = 1280, ZC_FOX_K = 1536, ZC_FOX_V = 1792,
              ZC_NSA_Q = 2048, ZC_KC = 2304, ZC_VC = 2368, ZC_KS = 2432, ZC_VS = 2496, ZC_KW = 2560, ZC_VW = 2624, ZC_FOX_F = 2688, ZC_NSA_G = 2692;
constexpr float EPS = 1e-6f;
constexpr int NWAVES = 8, NTHR = 512;

constexpr size_t MiB = 1u << 20;
constexpr size_t WS_CTL = 0, CTL_ZERO_BYTES = 64 * 1024;
constexpr size_t WS_SSQA = 2 * MiB, WS_SSQB = 4 * MiB, WS_CFOX = 6 * MiB, WS_KVC = 7 * MiB, WS_LRUAGG = 9 * MiB, WS_CB = 11 * MiB;
constexpr size_t WS_WIN = 12 * MiB, WS_WOUT = 24 * MiB, WS_WGU = 28 * MiB, WS_WDN = 50 * MiB;
constexpr size_t WS_XH = 62 * MiB, WS_MIXED = 126 * MiB, WS_Z = 190 * MiB, WS_YD = 366 * MiB, WS_FOXVT = 398 * MiB, WS_VST = 414 * MiB, WS_VWT = 418 * MiB, WS_KCH = 422 * MiB, WS_VCT = 423 * MiB, WS_END = 424 * MiB;
static_assert(WS_WIN + 2 * (size_t)NZP * D * 2 <= WS_WOUT && WS_WOUT + 2 * (size_t)D * D * 2 <= WS_WGU && WS_WGU + 2 * (size_t)2 * DFF * D * 2 <= WS_WDN &&
              WS_WDN + 2 * (size_t)D * DFF * 2 <= WS_XH && WS_XH + (size_t)T * D * 2 <= WS_MIXED && WS_MIXED + (size_t)T * D * 2 <= WS_Z &&
              WS_Z + (size_t)T * NZP * 2 <= WS_YD && WS_YD + (size_t)T * 256 * 4 <= WS_FOXVT && WS_FOXVT + (size_t)T * 256 * 2 <= WS_VST, "ws map");
constexpr int CW_BAR = 1024;

constexpr int RING_BYTES = 131072, MISC_OFF = RING_BYTES, LDS_BYTES = 147456;

__device__ __constant__ unsigned char c_bucket[128] = {
 0,1,2,3,4,5,6,7,8,9,10,11,12,13,14,15,
 16,16,16,17,17,18,18,18,19,19,19,20,20,20,20,21,
 21,21,21,22,22,22,22,22,23,23,23,23,23,23,24,24,
 24,24,24,24,25,25,25,25,25,25,25,26,26,26,26,26,
 26,26,26,27,27,27,27,27,27,27,27,27,27,28,28,28,
 28,28,28,28,28,28,28,29,29,29,29,29,29,29,29,29,
 29,29,29,30,30,30,30,30,30,30,30,30,30,30,30,30,
 30,31,31,31,31,31,31,31,31,31,31,31,31,31,31,31};
__device__ __forceinline__ int rel_bucket(int d) { return d >= 128 ? 31 : (int)c_bucket[d < 0 ? 0 : d]; }

__device__ __forceinline__ float sigmoidf_(float x) { return 1.f / (1.f + __expf(-x)); }
__device__ __forceinline__ float gelu_tanh(float x) { const float c = 0.7978845608028654f; return 0.5f * x * (1.f + tanhf(c * (x + 0.044715f * x * x * x))); }
__device__ __forceinline__ float log_sigmoid(float x) { return x >= 0.f ? -log1pf(expf(-x)) : x - log1pf(expf(x)); }
__device__ __forceinline__ u32x4 pack_h8(f32x4 a, f32x4 b) {
    h8 h; h[0] = (half_t)a.x; h[1] = (half_t)a.y; h[2] = (half_t)a.z; h[3] = (half_t)a.w; h[4] = (half_t)b.x; h[5] = (half_t)b.y; h[6] = (half_t)b.z; h[7] = (half_t)b.w;
    return __builtin_bit_cast(u32x4, h);
}
__device__ __forceinline__ unsigned pack_h2(float a, float b) { h2 h; h[0] = (half_t)a; h[1] = (half_t)b; return __builtin_bit_cast(unsigned, h); }
#define LDS_WAIT() asm volatile("s_waitcnt lgkmcnt(0)" ::: "memory")

#define XB_TMO      128
#define XB_XCNT(j)  (256  + 64 * (j))
#define XB_XSUB(j)  (1280 + 64 * (j))
#define XB_XGEN(j)  (2304 + 64 * (j))
#define XB_TOP      3328
#define XB_TOPGEN   3392
#define XCD_BAR_WORDS 3456
#define XB_SPIN_CAP (1u << 20)
__device__ __forceinline__ unsigned xb_ld(unsigned* p)              { return __hip_atomic_load(p, __ATOMIC_RELAXED, __HIP_MEMORY_SCOPE_AGENT); }
__device__ __forceinline__ unsigned xb_add(unsigned* p, unsigned v) { return __hip_atomic_fetch_add(p, v, __ATOMIC_RELAXED, __HIP_MEMORY_SCOPE_AGENT); }
__device__ __forceinline__ unsigned xb_xcc_id() { return (unsigned)__builtin_amdgcn_s_getreg((3 << 11) | 20) & 0xFu; }
#define XB_SPIN(cond, bar) do { unsigned _sp = 0; while (cond) { __builtin_amdgcn_s_sleep(1); \
    if ((++_sp & 255u) == 0u) { if (xb_ld(&(bar)[XB_TMO])) break; if (_sp > XB_SPIN_CAP) { atomicAdd(&(bar)[XB_TMO], 1u); break; } } } } while (0)
struct XcdBarrier { unsigned* bar; unsigned x; volatile LAS unsigned* st; };
__device__ __forceinline__ XcdBarrier xcd_barrier_post(unsigned* bar, volatile LAS unsigned* st) {
    XcdBarrier b; b.bar = bar; b.x = xb_xcc_id(); b.st = st;
    if (threadIdx.x == 0) (void)xb_add(&bar[XB_XCNT(b.x)], 1u);
    return b;
}
__device__ __forceinline__ void xcd_barrier_complete(unsigned* bar, unsigned x, unsigned& nloc, unsigned& nx) {
    const unsigned G = gridDim.x * gridDim.y * gridDim.z;
    unsigned sum, cnt, mine, sp = 0u;
    for (;;) {
        sum = 0u; cnt = 0u; mine = 0u;
#pragma unroll
        for (unsigned j = 0; j < 16; ++j) { const unsigned c = xb_ld(&bar[XB_XCNT(j)]); sum += c; cnt += (c > 0u) ? 1u : 0u; mine = (j == x) ? c : mine; }
        if (sum == G) break;
        __builtin_amdgcn_s_sleep(1);
        if ((++sp & 255u) == 0u) { if (xb_ld(&bar[XB_TMO])) break; if (sp > XB_SPIN_CAP) { atomicAdd(&bar[XB_TMO], 1u); break; } }
    }
    nloc = mine > 0u ? mine : 1u; nx = cnt > 0u ? cnt : 1u;
}
__device__ __forceinline__ void xcd_barrier(const XcdBarrier& b) {
    asm volatile("s_waitcnt vmcnt(0)" ::: "memory");
    __syncthreads();
    if (threadIdx.x == 0) {
        unsigned* bar = b.bar;
        __builtin_amdgcn_s_waitcnt(0);
        unsigned nloc = b.st[0], nx = b.st[1];
        if (nloc == 0u) { xcd_barrier_complete(bar, b.x, nloc, nx); b.st[0] = nloc; b.st[1] = nx; }
        const unsigned old = xb_add(&bar[XB_XSUB(b.x)], 1u);
        const unsigned gen = old / nloc;
        if (old + 1u == (gen + 1u) * nloc) {
            __builtin_amdgcn_fence(__ATOMIC_RELEASE, "agent");
            asm volatile("s_waitcnt vmcnt(0)" ::: "memory");
            const unsigned og = xb_add(&bar[XB_TOP], 1u);
            const unsigned tg = og / nx;
            if (og + 1u == (tg + 1u) * nx) xb_add(&bar[XB_TOPGEN], 1u);
            else XB_SPIN(xb_ld(&bar[XB_TOPGEN]) == tg, bar);
            __builtin_amdgcn_fence(__ATOMIC_ACQUIRE, "agent");
            xb_add(&bar[XB_XGEN(b.x)], 1u);
            asm volatile("s_waitcnt vmcnt(0)" ::: "memory");
        } else {
            XB_SPIN(xb_ld(&bar[XB_XGEN(b.x)]) == gen, bar);
            __builtin_amdgcn_fence(__ATOMIC_ACQUIRE, "agent");
            asm volatile("s_waitcnt vmcnt(0)" ::: "memory");
        }
    }
    __syncthreads();
}

namespace pg8 {
constexpr int BM = 256, BK = 64, HALF = 128, HTB = HALF * BK * 2, STAGE_BYTES = 8 * HTB, NXCD = 8, WGM = 8;
__host__ __device__ __forceinline__ int lds_byte(int r, int c) { const int st = (r >> 4) * 2 + (c >> 5), rr = r & 15, cc = c & 31, ob = rr * 64 + cc * 2; return st * 1024 + (ob ^ (((ob >> 9) & 1) << 5)); }
__host__ __device__ __forceinline__ void stage_rc(int b, int& R, int& C) { const int st = b / 1024, sb = b % 1024, swz = sb ^ (((sb >> 9) & 1) << 5); R = (st >> 1) * 16 + swz / 64; C = (st & 1) * 32 + (swz % 64) / 2; }
__host__ __device__ __forceinline__ int perm32(int rho) { const int n = rho >> 4, i = rho & 15; return 8 * (i >> 2) + 4 * n + (i & 3); }
struct Unit { int pm, pn; };
struct Gemm { const half_t* A; const half_t* Bt; int M, N, K; };
struct StaticOrder {
    int nM, nN, nwg, G, c;
    __host__ __device__ void init(int M, int N, int G_, int c_) { nM = M / BM; nN = N / BM; nwg = nM * nN; G = G_; c = c_; }
    __host__ __device__ bool next(int i, Unit& u) const {
        const long L = (long)i * G + c; if (L >= nwg) return false;
        int wgid = (int)L; { const int q = nwg / NXCD, r = nwg % NXCD, xcd = wgid % NXCD, off = wgid / NXCD; wgid = (xcd < r ? xcd * (q + 1) : r * (q + 1) + (xcd - r) * q) + off; }
        const int nig = WGM * nN, gid = wgid / nig, fm = gid * WGM, gsz = (nM - fm) < WGM ? (nM - fm) : WGM;
        u.pm = fm + ((wgid % nig) % gsz); u.pn = (wgid % nig) / gsz; return true;
    }
    __device__ __forceinline__ void a_ready(const Unit&) const {}
    __device__ __forceinline__ void done(const Unit&) const {}
};

template <class Epi, class Sched>
__device__ __forceinline__ void gemm_phase(LAS unsigned char* lds, const Gemm g, const Sched& S, const Epi& E) {
    int tid = threadIdx.x; asm volatile("" : "+v"(tid));
    const int wid = __builtin_amdgcn_readfirstlane(tid >> 6), lane = tid & 63, wr = wid >> 2, wc = wid & 3, fr = lane & 15, fq = lane >> 4;
    const int K = g.K, nt = K / BK;
    unsigned voffA[2], voffB[2];
#pragma unroll
    for (int i = 0; i < 2; ++i) { int R, C; stage_rc(tid * 16 + i * 8192, R, C); const int Rb = Epi::PERM ? ((R & ~31) + perm32(R & 31)) : R;
        voffA[i] = (unsigned)(R * K + C) * 2u; voffB[i] = (unsigned)(Rb * K + C) * 2u; }
    const size_t kstep = (size_t)(BK * 2);
    const size_t hstep = (size_t)HALF * K * 2;
    const size_t tstep = 2 * hstep;
    const unsigned ldsw = (unsigned)wid * 1024u;
    const int aoff = lds_byte(wr * 64 + fr, fq * 8), boff = lds_byte(wc * 32 + fr, fq * 8);
#define PG8_SA(b, h) (((b) * 2 + (h)) * HTB)
#define PG8_SB(b, h) ((4 + (b) * 2 + (h)) * HTB)
#define PG8_STAGE(bufoff, gbase, voff) do { _Pragma("unroll") for (int _i = 0; _i < 2; ++_i) \
        __builtin_amdgcn_global_load_lds((const unsigned*)((const char*)(gbase) + (voff)[_i]), (LAS unsigned*)(lds + (bufoff) + ldsw + _i * 8192), 16, 0, 0); } while (0)
#define PG8_LDA(dst, b, h) do { _Pragma("unroll") for (int m = 0; m < 4; ++m) _Pragma("unroll") for (int k = 0; k < 2; ++k) dst[m][k] = *(const LAS h8*)(lds + PG8_SA(b, h) + aoff + m * 2048 + k * 1024); } while (0)
#define PG8_LDB(dst, b, h) do { _Pragma("unroll") for (int n = 0; n < 2; ++n) _Pragma("unroll") for (int k = 0; k < 2; ++k) dst[n][k] = *(const LAS h8*)(lds + PG8_SB(b, h) + boff + n * 2048 + k * 1024); } while (0)
#define PG8_MMA(ai, bj, At, Bt) do { __builtin_amdgcn_s_setprio(1); _Pragma("unroll") for (int m = 0; m < 4; ++m) _Pragma("unroll") for (int n = 0; n < 2; ++n) _Pragma("unroll") for (int k = 0; k < 2; ++k) \
        acc[ai][bj][m][n] = __builtin_amdgcn_mfma_f32_16x16x32_f16(Bt[n][k], At[m][k], acc[ai][bj][m][n], 0, 0, 0); __builtin_amdgcn_s_setprio(0); } while (0)
#define PG8_WAIT_V(n) asm volatile("s_waitcnt vmcnt(" #n ")" ::: "memory")
#define PG8_WAIT_L(n) asm volatile("s_waitcnt lgkmcnt(" #n ")" ::: "memory")
#define PG8_BAR __builtin_amdgcn_s_barrier()
#define PG8_SCHED __builtin_amdgcn_sched_barrier(0)
    Unit cur, nxt; int ui = 0;
    if (!S.next(0, cur)) return;
    f32x4 acc[2][2][4][2];
#pragma unroll
    for (int a = 0; a < 2; ++a)
#pragma unroll
        for (int b = 0; b < 2; ++b)
#pragma unroll
            for (int m = 0; m < 4; ++m)
#pragma unroll
                for (int n = 0; n < 2; ++n) acc[a][b][m][n] = (f32x4){0.f, 0.f, 0.f, 0.f};
    h8 At[4][2], B0[2][2], B1[2][2];
    const char* cA = (const char*)g.A + (size_t)cur.pm * tstep; const char* cB = (const char*)g.Bt + (size_t)cur.pn * tstep;
    S.a_ready(cur);
    PG8_STAGE(PG8_SB(0, 0), cB, voffB); PG8_STAGE(PG8_SA(0, 0), cA, voffA); PG8_STAGE(PG8_SB(0, 1), cB + hstep, voffB); PG8_STAGE(PG8_SA(0, 1), cA + hstep, voffA);
    if (wr == 1) PG8_BAR;
    PG8_WAIT_V(4); PG8_BAR;
    PG8_STAGE(PG8_SB(1, 0), cB + kstep, voffB); PG8_STAGE(PG8_SA(1, 0), cA + kstep, voffA); PG8_STAGE(PG8_SB(1, 1), cB + hstep + kstep, voffB);
    PG8_WAIT_V(6); PG8_BAR;
    for (;;) {
        const bool has_next = S.next(ui + 1, nxt);
        const char* nA = has_next ? (const char*)g.A + (size_t)nxt.pm * tstep : cA; const char* nB = has_next ? (const char*)g.Bt + (size_t)nxt.pn * tstep : cB;
        for (int t = 0; t < nt; t += 2) {
            const bool last = (t == nt - 2);
            const char* a1 = cA + (size_t)(t + 1) * kstep;
            const char* a2 = last ? nA : cA + (size_t)(t + 2) * kstep; const char* b2 = last ? nB : cB + (size_t)(t + 2) * kstep;
            const char* a3 = a2 + kstep; const char* b3 = b2 + kstep;
            if (last && has_next) S.a_ready(nxt);
            PG8_LDB(B0, 0, 0); PG8_SCHED; PG8_LDA(At, 0, 0); PG8_STAGE(PG8_SA(1, 1), a1 + hstep, voffA);
            PG8_WAIT_L(8); PG8_BAR; PG8_WAIT_L(0); PG8_MMA(0, 0, At, B0); PG8_BAR; PG8_SCHED;
            PG8_LDB(B1, 0, 1); PG8_STAGE(PG8_SB(0, 0), b2, voffB);
            PG8_BAR; PG8_WAIT_L(0); PG8_MMA(0, 1, At, B1); PG8_BAR;
            PG8_LDA(At, 0, 1); PG8_STAGE(PG8_SA(0, 0), a2, voffA);
            PG8_BAR; PG8_WAIT_L(0); PG8_MMA(1, 0, At, B0); PG8_BAR; PG8_SCHED;
            PG8_STAGE(PG8_SB(0, 1), b2 + hstep, voffB);
            PG8_WAIT_V(6); PG8_BAR; PG8_MMA(1, 1, At, B1); PG8_BAR;
            PG8_LDB(B0, 1, 0); PG8_SCHED; PG8_LDA(At, 1, 0); PG8_STAGE(PG8_SA(0, 1), a2 + hstep, voffA);
            PG8_WAIT_L(8); PG8_BAR; PG8_WAIT_L(0); PG8_MMA(0, 0, At, B0); PG8_BAR; PG8_SCHED;
            PG8_LDB(B1, 1, 1); PG8_STAGE(PG8_SB(1, 0), b3, voffB);
            PG8_BAR; PG8_WAIT_L(0); PG8_MMA(0, 1, At, B1); PG8_BAR;
            PG8_LDA(At, 1, 1); PG8_STAGE(PG8_SA(1, 0), a3, voffA);
            PG8_BAR; PG8_WAIT_L(0); PG8_MMA(1, 0, At, B0); PG8_BAR; PG8_SCHED;
            PG8_STAGE(PG8_SB(1, 1), b3 + hstep, voffB);
            PG8_WAIT_V(6); PG8_BAR; PG8_MMA(1, 1, At, B1); PG8_BAR;
        }
        E(acc, cur, wr, wc, fr, fq); S.done(cur);
        if (!has_next) break;
#pragma unroll
        for (int a = 0; a < 2; ++a)
#pragma unroll
            for (int b = 0; b < 2; ++b)
#pragma unroll
                for (int m = 0; m < 4; ++m)
#pragma unroll
                    for (int n = 0; n < 2; ++n) acc[a][b][m][n] = (f32x4){0.f, 0.f, 0.f, 0.f};
        cur = nxt; cA = nA; cB = nB; ++ui;
    }
    PG8_WAIT_V(0);
    if (wr == 0) PG8_BAR;
    PG8_BAR;
#undef PG8_SA
#undef PG8_SB
#undef PG8_STAGE
#undef PG8_LDA
#undef PG8_LDB
#undef PG8_MMA
#undef PG8_WAIT_V
#undef PG8_WAIT_L
#undef PG8_BAR
#undef PG8_SCHED
}
}

__device__ __forceinline__ float row_rstd(const float* ssq, int row) {
    const f32x4* p = (const f32x4*)(ssq + (size_t)row * 16);
    const f32x4 a = p[0], b = p[1], c = p[2], d = p[3];
    const float s = (((a.x + a.y) + (a.z + a.w)) + ((b.x + b.y) + (b.z + b.w))) + (((c.x + c.y) + (c.z + c.w)) + ((d.x + d.y) + (d.z + d.w)));
    return rsqrtf(s * (1.f / 1024.f) + EPS);
}
struct EpiZ {
    static constexpr bool PERM = true;
    half_t* Z; const float* ssq;
    __device__ __forceinline__ void operator()(const f32x4 (&acc)[2][2][4][2], const pg8::Unit& u, int wr, int wc, int fr, int fq) const {
        const int row0 = u.pm * 256 + wr * 64 + fr, col0 = u.pn * 256 + wc * 32 + 8 * fq;
#pragma unroll
        for (int ai = 0; ai < 2; ++ai)
#pragma unroll
            for (int m = 0; m < 4; ++m) { const int row = row0 + ai * 128 + m * 16; const float r = row_rstd(ssq, row); half_t* rp = Z + (size_t)row * NZP + col0;
#pragma unroll
                for (int bj = 0; bj < 2; ++bj) *(u32x4*)(rp + bj * 128) = pack_h8(acc[ai][bj][m][0] * r, acc[ai][bj][m][1] * r); }
    }
};
struct EpiRes {
    static constexpr bool PERM = true;
    const float* xold; float* out; half_t* XH; float* ssq;
    __device__ __forceinline__ void operator()(const f32x4 (&acc)[2][2][4][2], const pg8::Unit& u, int wr, int wc, int fr, int fq) const {
        const int row0 = u.pm * 256 + wr * 64 + fr, col0 = u.pn * 256 + wc * 32 + 8 * fq;
#pragma unroll
        for (int ai = 0; ai < 2; ++ai)
#pragma unroll
            for (int m = 0; m < 4; ++m) { const int row = row0 + ai * 128 + m * 16; float s = 0.f;
#pragma unroll
                for (int bj = 0; bj < 2; ++bj) { const size_t o = (size_t)row * D + col0 + bj * 128;
                    f32x4 v0 = *(const f32x4*)(xold + o) + acc[ai][bj][m][0], v1 = *(const f32x4*)(xold + o + 4) + acc[ai][bj][m][1];
                    *(f32x4*)(out + o) = v0; *(f32x4*)(out + o + 4) = v1;
                    if (XH) *(u32x4*)(XH + o) = pack_h8(v0, v1);
                    s += (v0.x * v0.x + v0.y * v0.y) + (v0.z * v0.z + v0.w * v0.w) + (v1.x * v1.x + v1.y * v1.y) + (v1.z * v1.z + v1.w * v1.w); }
                s += __shfl_xor(s, 16); s += __shfl_xor(s, 32);
                if (fq == 0 && ssq) ssq[(size_t)row * 16 + u.pn * 4 + wc] = s; }
    }
};
struct EpiSwiglu {
    static constexpr bool PERM = true;
    half_t* H; const float* ssq;
    __device__ __forceinline__ void operator()(const f32x4 (&acc)[2][2][4][2], const pg8::Unit& u, int wr, int wc, int fr, int fq) const {
        const int row0 = u.pm * 256 + wr * 64 + fr, col0 = u.pn * 128 + wc * 32 + 8 * fq;
#pragma unroll
        for (int ai = 0; ai < 2; ++ai)
#pragma unroll
            for (int m = 0; m < 4; ++m) { const int row = row0 + ai * 128 + m * 16; const float r = row_rstd(ssq, row);
                f32x4 o[2];
#pragma unroll
                for (int n = 0; n < 2; ++n) { const f32x4 g = acc[ai][0][m][n] * r, uu = acc[ai][1][m][n] * r;
                    o[n].x = g.x * sigmoidf_(g.x) * uu.x; o[n].y = g.y * sigmoidf_(g.y) * uu.y; o[n].z = g.z * sigmoidf_(g.z) * uu.z; o[n].w = g.w * sigmoidf_(g.w) * uu.w; }
                *(u32x4*)(H + (size_t)row * DFF + col0) = pack_h8(o[0], o[1]); }
    }
};

struct Params {
    const float* x; const float* norm_mix; const float* w_in; const float* lru_conv_w; const float* lru_conv_b; const float* lru_w_gates; const float* lru_b_gates;
    const float* lru_lambda; const float* sc_conv_w; const float* fox_f_bias; const float* fox_qk_norm; const float* nsa_qk_norm; const float* nsa_cmp_pos;
    const float* nsa_cmp_w1; const float* nsa_cmp_w2; const float* nsa_gate_bias; const float* rel_bias; const float* out_norm; const float* w_out;
    const float* norm_ffn; const float* w_gate_up; const float* w_down; float* out; unsigned char* ws;
};

template <int MODE> __device__ __forceinline__ int src_col(int n) {
    if (MODE == 1) { if (n < 2048) return n; if (n < 2688) return n + 4; if (n < 2692) return 2048 + (n - 2688); if (n < 2704) return n; return -1; }
    if (MODE == 2) { const int pn = n >> 8, w = n & 255; return w < 128 ? pn * 128 + w : DFF + pn * 128 + (w - 128); }
    return n;
}
template <int MODE> __device__ __forceinline__ void p0_item(const float* W, int K, int Nsrc, const float* gain, half_t* WT, int item, int nbn, LAS unsigned* scr, int lane) {
    const int kb = item / nbn, nb = item % nbn, k0 = 64 * kb, n0 = 64 * nb;
    const int sc = src_col<MODE>(n0 + lane);
#pragma unroll 8
    for (int kk = 0; kk < 64; kk += 2) {
        float v0 = 0.f, v1 = 0.f;
        if (sc >= 0) { v0 = W[(size_t)(k0 + kk) * Nsrc + sc]; v1 = W[(size_t)(k0 + kk + 1) * Nsrc + sc]; }
        if (gain) { v0 *= gain[k0 + kk]; v1 *= gain[k0 + kk + 1]; }
        scr[lane * 33 + (kk >> 1)] = pack_h2(v0, v1);
    }
    LDS_WAIT(); asm volatile("" ::: "memory");
    const int c = lane & 7;
#pragma unroll
    for (int j = 0; j < 8; ++j) { const int nn = (lane >> 3) + 8 * j; const LAS unsigned* s = scr + nn * 33 + 4 * c;
        u32x4 o; o.x = s[0]; o.y = s[1]; o.z = s[2]; o.w = s[3];
        *(u32x4*)(WT + (size_t)(n0 + nn) * K + k0 + 8 * c) = o; }
    LDS_WAIT(); asm volatile("" ::: "memory");
}
__device__ __forceinline__ float wave_sum(float v) {
#pragma unroll
    for (int o = 1; o < 64; o <<= 1) v += __shfl_xor(v, o);
    return v;
}

__device__ __forceinline__ void attn_step_h(const float (&q)[64], float (&acc)[64], float& m, float& l, const half_t* kp, const half_t* vp, float bias, bool valid) {
    float sc = 0.f;
#pragma unroll
    for (int hh = 0; hh < 2; ++hh) {
#pragma unroll
        for (int j = 4 * hh; j < 4 * hh + 4; ++j) { const h8 kv = *(const h8*)(kp + 8 * j);
#pragma unroll
            for (int e = 0; e < 8; ++e) sc = fmaf(q[8 * j + e], (float)kv[e], sc); }
        __builtin_amdgcn_sched_barrier(0);
    }
    sc += bias;
    const float mn = valid ? fmaxf(m, sc) : m;
    const float alpha = __expf(m - mn), p = valid ? __expf(sc - mn) : 0.f;
    m = mn; l = l * alpha + p;
#pragma unroll
    for (int hh = 0; hh < 2; ++hh) {
#pragma unroll
        for (int j = 4 * hh; j < 4 * hh + 4; ++j) { const h8 vv = *(const h8*)(vp + 8 * j);
#pragma unroll
            for (int e = 0; e < 8; ++e) acc[8 * j + e] = fmaf(acc[8 * j + e], alpha, p * (float)vv[e]); }
        __builtin_amdgcn_sched_barrier(0);
    }
}
__device__ __forceinline__ float dot_f32(const float (&q)[64], const float* kp) {
    float sc = 0.f;
#pragma unroll
    for (int j = 0; j < 16; ++j) { const f32x4 kv = *(const f32x4*)(kp + 4 * j); sc = fmaf(q[4 * j], kv.x, sc); sc = fmaf(q[4 * j + 1], kv.y, sc); sc = fmaf(q[4 * j + 2], kv.z, sc); sc = fmaf(q[4 * j + 3], kv.w, sc); }
    return sc;
}
__device__ __forceinline__ void load_q(float (&q)[64], const half_t* qp, float scale) {
#pragma unroll
    for (int j = 0; j < 8; ++j) { const h8 v = *(const h8*)(qp + 8 * j);
#pragma unroll
        for (int e = 0; e < 8; ++e) q[8 * j + e] = (float)v[e] * scale; }
}

__device__ __forceinline__ void lru_gate_r(const float* wcol, float bias, const LAS float* xrow, LAS float* yout) {
    float w[64];
#pragma unroll
    for (int k = 0; k < 64; ++k) w[k] = wcol[(size_t)k * 64];
    for (int i = 0; i < 32; ++i) {
        const LAS float* xr = xrow + i * 256; float r = bias;
#pragma unroll
        for (int k = 0; k < 64; k += 4) { const f32x4 xv = *(const LAS f32x4*)(xr + k);
            r = fmaf(xv.x, w[k], r); r = fmaf(xv.y, w[k + 1], r); r = fmaf(xv.z, w[k + 2], r); r = fmaf(xv.w, w[k + 3], r); }
        yout[i * 256] = 1.f / (1.f + expf(-r));
    }
}

__device__ __forceinline__ void qk64(f32x16& S0, f32x16& S1, const h8 (&q)[4], const LAS unsigned char* Ks, int qi, int hb) {
    const LAS unsigned char* r0 = Ks + pi16(qi) * 144 + 16 * hb;
#pragma unroll
    for (int kk = 0; kk < 4; ++kk) { const h8 a0 = *(const LAS h8*)(r0 + 32 * kk); S0 = MFMA32(a0, q[kk], S0);
        const h8 a1 = *(const LAS h8*)(r0 + 32 * 144 + 32 * kk); S1 = MFMA32(a1, q[kk], S1); }
}
__device__ __forceinline__ void pv64(const f32x16& P0, const f32x16& P1, const LAS unsigned char* Vs, f32x16& O0, f32x16& O1, int qi, int hb) {
    h8 pf[4];
#pragma unroll
    for (int e = 0; e < 8; ++e) { pf[0][e] = (half_t)P0[e]; pf[1][e] = (half_t)P0[8 + e]; pf[2][e] = (half_t)P1[e]; pf[3][e] = (half_t)P1[8 + e]; }
    const LAS unsigned char* v0 = Vs + qi * 144 + 16 * hb;
#pragma unroll
    for (int s = 0; s < 4; ++s) { const h8 a0 = *(const LAS h8*)(v0 + 32 * s); O0 = MFMA32(a0, pf[s], O0);
        const h8 a1 = *(const LAS h8*)(v0 + 32 * 144 + 32 * s); O1 = MFMA32(a1, pf[s], O1); }
}
__device__ __forceinline__ float rowmax64(const f32x16& S0, const f32x16& S1) {
    float mx = fmaxf(S0[0], S1[0]);
#pragma unroll
    for (int r = 1; r < 16; ++r) mx = fmaxf(mx, fmaxf(S0[r], S1[r]));
    return fmaxf(mx, __shfl_xor(mx, 32));
}
__device__ __forceinline__ void softmax64(f32x16& S0, f32x16& S1, float& m, float& l, f32x16& O0, f32x16& O1) {
    const float mn = fmaxf(m, rowmax64(S0, S1)), alpha = __builtin_amdgcn_exp2f(m - mn);
    m = mn; float ps = 0.f;
#pragma unroll
    for (int r = 0; r < 16; ++r) { S0[r] = __builtin_amdgcn_exp2f(S0[r] - mn); S1[r] = __builtin_amdgcn_exp2f(S1[r] - mn); ps += S0[r] + S1[r]; }
    l = l * alpha + ps;
#pragma unroll
    for (int r = 0; r < 16; ++r) { O0[r] *= alpha; O1[r] *= alpha; }
}
__device__ __forceinline__ void init_near(f32x16& S0, f32x16& S1, const LAS float* TRh, int dq, int hb, int step, int wlim) {
#pragma unroll
    for (int r = 0; r < 16; ++r) {
        const int k0 = 16 * (r >> 3) + 8 * hb + 4 * ((r >> 2) & 1) + (r & 3);
        const int d0 = dq - step * k0, d1 = dq - step * (k0 + 32);
        const float b0 = TRh[d0 < 0 ? 0 : (d0 > 128 ? 128 : d0)], b1 = TRh[d1 < 0 ? 0 : (d1 > 128 ? 128 : d1)];
        S0[r] = (d0 >= 0 && d0 < wlim) ? b0 : -INFINITY; S1[r] = (d1 >= 0 && d1 < wlim) ? b1 : -INFINITY;
    }
}
__device__ __forceinline__ void init_const(f32x16& S0, f32x16& S1, float c) {
#pragma unroll
    for (int r = 0; r < 16; ++r) { S0[r] = c; S1[r] = c; }
}

__global__ void __launch_bounds__(NTHR, 2) hymba_fwd(Params P) {
    extern __shared__ __attribute__((aligned(16))) unsigned char lds_raw[];
    LAS unsigned char* lds = (LAS unsigned char*)lds_raw;
    volatile LAS unsigned* MISC = (volatile LAS unsigned*)(lds + MISC_OFF);
    const int tid = threadIdx.x, lane = tid & 63, wave = __builtin_amdgcn_readfirstlane(tid >> 6);
    const int G = gridDim.x, bid = blockIdx.x;
    unsigned char* ws = P.ws;
    unsigned* ctl = (unsigned*)(ws + WS_CTL);
    float* SSQA = (float*)(ws + WS_SSQA); float* SSQB = (float*)(ws + WS_SSQB); float* CFOX = (float*)(ws + WS_CFOX); float* KVC = (float*)(ws + WS_KVC);
    float* LRUAGG = (float*)(ws + WS_LRUAGG); float* CB = (float*)(ws + WS_CB); float* YD = (float*)(ws + WS_YD);
    half_t* WIN_T = (half_t*)(ws + WS_WIN); half_t* WOUT_T = (half_t*)(ws + WS_WOUT); half_t* WGU_T = (half_t*)(ws + WS_WGU); half_t* WDN_T = (half_t*)(ws + WS_WDN);
    half_t* FOXVT = (half_t*)(ws + WS_FOXVT); half_t* VST = (half_t*)(ws + WS_VST); half_t* VWT = (half_t*)(ws + WS_VWT); half_t* KCH = (half_t*)(ws + WS_KCH); half_t* VCT = (half_t*)(ws + WS_VCT); half_t* XH = (half_t*)(ws + WS_XH); half_t* MIXED = (half_t*)(ws + WS_MIXED); half_t* Z = (half_t*)(ws + WS_Z); half_t* HB = (half_t*)(ws + WS_Z);

    for (int u = tid; u < 64; u += NTHR) MISC[u] = 0u;
    __syncthreads();
    XcdBarrier bar = xcd_barrier_post(ctl + CW_BAR, MISC + 8);

    const int gw = bid * NWAVES + wave, NGW = G * NWAVES;

#ifndef SKIP_P0
    {
        LAS unsigned* scr = (LAS unsigned*)(lds + wave * 8448);
        constexpr int I_IN = 16 * 44, I_OUT = 16 * 16, I_GU = 16 * 88, I_DN = 44 * 16, PER_L = I_IN + I_OUT + I_GU + I_DN;
        for (int it = gw; it < 2 * PER_L; it += NGW) {
            const int L = it / PER_L; int r = it % PER_L;
            if (r < I_IN) { p0_item<1>(P.w_in + (size_t)L * D * NIN_SRC, D, NIN_SRC, P.norm_mix + L * D, WIN_T + (size_t)L * NZP * D, r, 44, scr, lane); continue; } r -= I_IN;
            if (r < I_OUT) { p0_item<0>(P.w_out + (size_t)L * D * D, D, D, nullptr, WOUT_T + (size_t)L * D * D, r, 16, scr, lane); continue; } r -= I_OUT;
            if (r < I_GU) { p0_item<2>(P.w_gate_up + (size_t)L * D * 2 * DFF, D, 2 * DFF, P.norm_ffn + L * D, WGU_T + (size_t)L * 2 * DFF * D, r, 88, scr, lane); continue; } r -= I_GU;
            p0_item<0>(P.w_down + (size_t)L * DFF * D, DFF, D, nullptr, WDN_T + (size_t)L * D * DFF, r, 16, scr, lane);
        }
        for (int o = gw; o < 2 * 2 * 128; o += NGW) {
            const int m = o & 127, ln = o >> 7;
            const float* pp = P.nsa_cmp_pos + (size_t)ln * 2048; const float* wp = P.nsa_cmp_w1 + (size_t)ln * 2048 * 128 + m;
            float s = 0.f;
            for (int i = lane; i < 2048; i += 64) s = fmaf(pp[i], wp[(size_t)i * 128], s);
            s = wave_sum(s);
            if (lane == 0) CB[o] = s;
        }
        for (int row = gw; row < T; row += NGW) {
            const f32x4* xr = (const f32x4*)(P.x + (size_t)row * D) + lane;
            float s = 0.f;
#pragma unroll
            for (int j = 0; j < 4; ++j) { const f32x4 v = xr[64 * j]; s += (v.x * v.x + v.y * v.y) + (v.z * v.z + v.w * v.w);
                u32x2 o; o.x = pack_h2(v.x, v.y); o.y = pack_h2(v.z, v.w); *(u32x2*)(XH + (size_t)row * D + 4 * (lane + 64 * j)) = o; }
            s = wave_sum(s);
            if (lane < 16) SSQB[(size_t)row * 16 + lane] = lane == 0 ? s : 0.f;
        }
    }
#endif
    xcd_barrier(bar);

    for (int L = 0; L < 2; ++L) {
#ifndef SKIP_G1
        {
            pg8::Gemm g{XH, WIN_T + (size_t)L * NZP * D, T, NZP, D}; pg8::StaticOrder S; S.init(T, NZP, G, bid);
            EpiZ E{Z, SSQB};
            pg8::gemm_phase<EpiZ, pg8::StaticOrder>(lds, g, S, E);
        }
#endif
        xcd_barrier(bar);

        {
#ifndef SKIP_P2AB
            {
                int tid = threadIdx.x; asm volatile("" : "+v"(tid)); const int lane = tid & 63;
                const int g8 = lane >> 3, sub = lane & 7;
                for (int tok = gw; tok < T; tok += NGW) {
#pragma unroll
                    for (int rr = 0; rr < 2; ++rr) {
                        const int r = g8 + 8 * rr;
                        if (r < 14) {
                            int col; const float* gain;
                            if (r < 4) { col = ZC_FOX_Q + 64 * r; gain = P.fox_qk_norm + (L * 2 + 0) * 64; }
                            else if (r < 8) { col = ZC_FOX_K + 64 * (r - 4); gain = P.fox_qk_norm + (L * 2 + 1) * 64; }
                            else if (r < 12) { col = ZC_NSA_Q + 64 * (r - 8); gain = P.nsa_qk_norm + (L * 4 + 0) * 64; }
                            else if (r == 12) { col = ZC_KS; gain = P.nsa_qk_norm + (L * 4 + 2) * 64; }
                            else { col = ZC_KW; gain = P.nsa_qk_norm + (L * 4 + 3) * 64; }
                            half_t* p = Z + (size_t)tok * NZP + col + 8 * sub;
                            const h8 v = *(const h8*)p; float f[8]; float s = 0.f;
#pragma unroll
                            for (int e = 0; e < 8; ++e) { f[e] = (float)v[e]; s += f[e] * f[e]; }
                            s += __shfl_xor(s, 1); s += __shfl_xor(s, 2); s += __shfl_xor(s, 4);
                            const float rs = rsqrtf(s * (1.f / 64.f) + EPS) * ((r < 4 || (r >= 8 && r < 12)) ? QSCALE : 1.f);
                            const f32x4 g0 = *(const f32x4*)(gain + 8 * sub), g1 = *(const f32x4*)(gain + 8 * sub + 4);
                            *(u32x4*)p = pack_h8((f32x4){f[0] * rs * g0.x, f[1] * rs * g0.y, f[2] * rs * g0.z, f[3] * rs * g0.w}, (f32x4){f[4] * rs * g1.x, f[5] * rs * g1.y, f[6] * rs * g1.z, f[7] * rs * g1.w});
                        }
                    }
                }
            }
            if (wave == 1 && (bid & 7) == 0 && (bid >> 3) < 32) {
                int tid = threadIdx.x; asm volatile("" : "+v"(tid)); const int lane = tid & 63;
                const int task = bid >> 3, b = task >> 2, h = task & 3;
                const float fb = P.fox_f_bias[L * 4 + h];
                float carry = 0.f;
                for (int it = 0; it < SEQ / 64; ++it) {
                    const size_t tok = (size_t)b * SEQ + it * 64 + lane;
                    float v = log_sigmoid((float)Z[tok * NZP + ZC_FOX_F + h] + fb);
#pragma unroll
                    for (int o = 1; o < 64; o <<= 1) { const float n = __shfl_up(v, o); if (lane >= o) v += n; }
                    v += carry;
                    CFOX[((size_t)b * 4 + h) * SEQ + it * 64 + lane] = v;
                    carry = __shfl(v, 63);
                }
            }
#endif
            for (int ui = bid; ui < 512; ui += G) {
                int tid = threadIdx.x; asm volatile("" : "+v"(tid));
                const int b = ui >> 6, chunk = ui & 63; const size_t tokb = (size_t)b * SEQ + chunk * 64;
                LAS half_t* tb = (LAS half_t*)lds;
#pragma unroll
                for (int i = 0; i < 4; ++i) { const int p = tid + 512 * i, tk = p >> 5, c8 = p & 31;
                    *(LAS h8*)(tb + tk * 264 + 8 * c8) = *(const h8*)(Z + (tokb + tk) * NZP + ZC_FOX_V + 8 * c8); }
                LAS half_t* tb2 = tb + 64 * 264;
#pragma unroll
                for (int i = 0; i < 2; ++i) { const int p = tid + 512 * i, tk = p >> 4, c8 = p & 15;
                    *(LAS h8*)(tb2 + tk * 136 + 8 * c8) = *(const h8*)(Z + (tokb + tk) * NZP + (c8 < 8 ? ZC_VS + 8 * c8 : ZC_VW + 8 * (c8 - 8))); }
                __syncthreads();
                {
                    const int col = tid & 255, ktl = tid >> 8;
                    half_t* dst = FOXVT + ((size_t)(b * 128 + chunk * 2 + ktl) * 256 + col) * 32;
#pragma unroll
                    for (int j4 = 0; j4 < 4; ++j4) { h8 o;
#pragma unroll
                        for (int e = 0; e < 8; ++e) o[e] = tb[(32 * ktl + 8 * j4 + e) * 264 + col];
                        *(h8*)(dst + 8 * j4) = o; }
#pragma unroll
                    for (int i = 0; i < 2; ++i) { const int p = tid + 512 * i, which = p >> 9, d = (p >> 3) & 63, ch = p & 7; h8 o;
#pragma unroll
                        for (int e = 0; e < 8; ++e) o[e] = tb2[(8 * ch + e) * 136 + 64 * which + d];
                        *(h8*)((which ? VWT : VST) + ((size_t)(b * 64 + chunk) * 64 + d) * 64 + 8 * ch) = o; }
                }
                __syncthreads();
            }
#ifndef SKIP_P2LRU
            for (int ui = bid; ui < 512; ui += G) {
                {
                    int tid = threadIdx.x; asm volatile("" : "+v"(tid)); const int lane = tid & 63; (void)lane;

                    const int b = ui >> 6, chunk = ui & 63, c = tid & 255, hf = tid >> 8;
                    LAS float* bufX = (LAS float*)lds;
                    const int t0 = chunk * 64 + hf * 32; const size_t tokb = (size_t)b * SEQ;
                    {
                        const float w0 = P.lru_conv_w[(L * 4 + 0) * 256 + c], w1 = P.lru_conv_w[(L * 4 + 1) * 256 + c], w2 = P.lru_conv_w[(L * 4 + 2) * 256 + c], w3 = P.lru_conv_w[(L * 4 + 3) * 256 + c], cb = P.lru_conv_b[L * 256 + c];
                        float x0 = t0 >= 3 ? (float)Z[(tokb + t0 - 3) * NZP + ZC_LRU_X + c] : 0.f, x1 = t0 >= 2 ? (float)Z[(tokb + t0 - 2) * NZP + ZC_LRU_X + c] : 0.f, x2 = t0 >= 1 ? (float)Z[(tokb + t0 - 1) * NZP + ZC_LRU_X + c] : 0.f;
                        for (int i = 0; i < 32; ++i) { const float x3 = (float)Z[(tokb + t0 + i) * NZP + ZC_LRU_X + c];
                            bufX[(hf * 32 + i) * 256 + c] = cb + w0 * x0 + w1 * x1 + w2 * x2 + w3 * x3; x0 = x1; x1 = x2; x2 = x3; }
                    }
                    __syncthreads();
                    {
                        const int blk = c >> 6, j = c & 63;
                        LAS float* bufY = (LAS float*)(lds + 65536);
                        lru_gate_r(P.lru_w_gates + ((size_t)((L * 2 + 0) * 4 + blk) * 64) * 64 + j, P.lru_b_gates[(L * 2 + 0) * 256 + c], bufX + hf * 32 * 256 + blk * 64, bufY + hf * 32 * 256 + c);
                        float wi_[64];
#pragma unroll
                        for (int k = 0; k < 64; ++k) wi_[k] = P.lru_w_gates[((size_t)((L * 2 + 1) * 4 + blk) * 64 + k) * 64 + j];
                        const float bi = P.lru_b_gates[(L * 2 + 1) * 256 + c];
                        const float lsp = -8.0f * log1pf(expf(-P.lru_lambda[L * 256 + c]));
                        float h = 0.f, Ap = 1.f;
                        for (int i = 0; i < 32; ++i) {
                            const LAS float* xr = bufX + (hf * 32 + i) * 256 + blk * 64;
                            float ii = bi;
#pragma unroll
                            for (int k = 0; k < 64; k += 4) { const f32x4 xv = *(const LAS f32x4*)(xr + k);
                                ii = fmaf(xv.x, wi_[k], ii); ii = fmaf(xv.y, wi_[k + 1], ii); ii = fmaf(xv.z, wi_[k + 2], ii); ii = fmaf(xv.w, wi_[k + 3], ii); }
                            ii = 1.f / (1.f + expf(-ii));
                            const float r = bufY[(hf * 32 + i) * 256 + c];
                            const float xc = xr[j];
                            const float log_a = lsp * r, a = expf(log_a), bb = sqrtf(-expm1f(2.0f * log_a)) * (ii * xc);
                            h = fmaf(a, h, bb); Ap *= a;
                        }
                        float* ag = LRUAGG + (((size_t)b * 128 + chunk * 2 + hf) * 256 + c) * 2;
                        ag[0] = Ap; ag[1] = h;
                    }
                    __syncthreads();
                }
            }
#endif
#ifndef SKIP_P2CMP
            for (int ui = bid; ui < 256; ui += G) {
                {
                    int tid = threadIdx.x; asm volatile("" : "+v"(tid)); const int lane = tid & 63; (void)lane;
                const int cu = ui, net = cu >> 7, b = (cu >> 4) & 7, ng = cu & 15, n0 = ng * 16;
                    LAS float* zs = (LAS float*)lds;
                    LAS float* hid = (LAS float*)(lds + 272 * 64 * 4);
                    const int zcol = net == 0 ? ZC_KC : ZC_VC;
                    for (int e = tid; e < 272 * 8; e += NTHR) { const int tl = e >> 3, c8 = e & 7; int t = n0 * 16 + tl; if (t > SEQ - 1) t = SEQ - 1;
                        const h8 v = *(const h8*)(Z + ((size_t)b * SEQ + t) * NZP + zcol + 8 * c8);
#pragma unroll
                        for (int k = 0; k < 8; ++k) zs[tl * 64 + 8 * c8 + k] = (float)v[k]; }
                    __syncthreads();
                    {
                        const int m = tid & 127, q4 = tid >> 7;
                        const float* wp = P.nsa_cmp_w1 + (size_t)(L * 2 + net) * 2048 * 128 + m;
                        float a0 = 0.f, a1 = 0.f, a2 = 0.f, a3 = 0.f;
                        for (int l = 0; l < 32; ++l) {
                            const LAS float* z0 = zs + ((4 * q4 + 0) * 16 + l) * 64;
#pragma unroll 8
                            for (int d = 0; d < 64; ++d) { const float w = wp[(size_t)(l * 64 + d) * 128];
                                a0 = fmaf(z0[d], w, a0); a1 = fmaf(z0[16 * 64 + d], w, a1); a2 = fmaf(z0[32 * 64 + d], w, a2); a3 = fmaf(z0[48 * 64 + d], w, a3); }
                        }
                        const float cb = CB[(L * 2 + net) * 128 + m];
                        hid[(4 * q4 + 0) * 128 + m] = gelu_tanh(a0 + cb); hid[(4 * q4 + 1) * 128 + m] = gelu_tanh(a1 + cb);
                        hid[(4 * q4 + 2) * 128 + m] = gelu_tanh(a2 + cb); hid[(4 * q4 + 3) * 128 + m] = gelu_tanh(a3 + cb);
                    }
                    __syncthreads();
                    {
                        const int d = tid & 63;
                        const float* w2 = P.nsa_cmp_w2 + (size_t)(L * 2 + net) * 128 * 64 + d;
#pragma unroll
                        for (int rep = 0; rep < 2; ++rep) {
                            const int nl = (tid >> 6) + 8 * rep;
                            float o = 0.f;
                            for (int m = 0; m < 128; ++m) o = fmaf(hid[nl * 128 + m], w2[m * 64], o);
                            if (net == 0) { const float ss = wave_sum(o * o); o = o * rsqrtf(ss * (1.f / 64.f) + EPS) * P.nsa_qk_norm[(L * 4 + 1) * 64 + d]; }
                            const int n = n0 + nl;
                            if (n >= NCMP) o = 0.f;
                            if (net == 0) KCH[((size_t)b * 256 + n) * 64 + d] = (half_t)o; else VCT[((size_t)b * 64 + d) * 256 + n] = (half_t)o;
                        }
                    }
                    __syncthreads();
                }
            }
#endif
        }
        xcd_barrier(bar);

#ifndef SKIP_FOX
        for (int ui = bid; ui < 512; ui += G) {
            int tid = threadIdx.x; asm volatile("" : "+v"(tid)); const int lane = tid & 63, hb = lane >> 5, qi = lane & 31;
            const int h = wave & 3, rh = wave >> 2;
            const int b = ui & 7, qt = 63 - (ui >> 3), t0 = qt * 64, t = t0 + 32 * rh + qi;
            const size_t tokb = (size_t)b * SEQ;
            const float* cf = CFOX + (size_t)b * 4 * SEQ;
            constexpr int FX_VT = 18432, FX_CB = 38912, FX_STAGE = 39424, FX_EX = 2 * FX_STAGE, FX_MISC = FX_EX + 1024;
            LAS unsigned* misc = (LAS unsigned*)(lds + FX_MISC);
            if (wave == 0) {
                float gq = fabsf(P.fox_qk_norm[(L * 2 + 0) * 64 + lane]), gk = fabsf(P.fox_qk_norm[(L * 2 + 1) * 64 + lane]);
#pragma unroll
                for (int o = 1; o < 64; o <<= 1) { gq = fmaxf(gq, __shfl_xor(gq, o)); gk = fmaxf(gk, __shfl_xor(gk, o)); }
                const float bound = -(30.f + 16.f * gq * gk);
                bool c0 = false, c1 = false;
#pragma unroll
                for (int hh = 0; hh < 4; ++hh) { const float cref = cf[hh * SEQ + t0];
                    const int e0 = 32 * lane + 31, e1 = 32 * (lane + 64) + 31;
                    c0 = c0 || (e0 >= t0) || (cref - cf[hh * SEQ + (e0 < SEQ ? e0 : SEQ - 1)] > bound);
                    c1 = c1 || (e1 >= t0) || (cref - cf[hh * SEQ + (e1 < SEQ ? e1 : SEQ - 1)] > bound); }
                const unsigned long long b0 = __ballot(c0), b1 = __ballot(c1);
                if (lane == 0) misc[0] = b0 ? (unsigned)__builtin_ctzll(b0) : 64u + (unsigned)__builtin_ctzll(b1);
            }
            __syncthreads();
            const int kt_lo = __builtin_amdgcn_readfirstlane((int)misc[0]), kt_hi = 2 * qt + 1;
            h8 q[4];
#pragma unroll
            for (int kk = 0; kk < 4; ++kk) q[kk] = *(const h8*)(Z + (tokb + t) * NZP + ZC_FOX_Q + 64 * h + 16 * kk + 8 * hb);
            f32x16 O0, O1;
#pragma unroll
            for (int r = 0; r < 16; ++r) { O0[r] = 0.f; O1[r] = 0.f; }
            float m = -1e30f, l = 0.f;
            u32x4 kr[2], vr[2]; float cbv = 0.f;
#define FX_ISSUE(kt_) do { _Pragma("unroll") for (int i_ = 0; i_ < 2; ++i_) { const int p_ = tid + 512 * i_; \
                kr[i_] = *(const u32x4*)(Z + (tokb + 32 * (kt_) + (p_ >> 5)) * NZP + ZC_FOX_K + 8 * (p_ & 31)); \
                vr[i_] = *(const u32x4*)(FOXVT + ((size_t)(b * 128 + (kt_)) * 256 + (p_ >> 2)) * 32 + 8 * (p_ & 3)); } \
                if (tid < 128) cbv = (cf[(tid >> 5) * SEQ + t0] - cf[(tid >> 5) * SEQ + 32 * (kt_) + (tid & 31)]) * LOG2E; } while (0)
#define FX_WRITE(sb_) do { _Pragma("unroll") for (int i_ = 0; i_ < 2; ++i_) { const int p_ = tid + 512 * i_; \
                *(LAS u32x4*)(lds + (sb_) + ((p_ & 31) >> 3) * 4608 + (p_ >> 5) * 144 + (p_ & 7) * 16) = kr[i_]; \
                *(LAS u32x4*)(lds + (sb_) + FX_VT + ((p_ >> 2) >> 6) * 5120 + ((p_ >> 2) & 63) * 80 + (p_ & 3) * 16) = vr[i_]; } \
                if (tid < 128) *(LAS float*)(lds + (sb_) + FX_CB + tid * 4) = cbv; } while (0)
            FX_ISSUE(kt_lo); FX_WRITE((kt_lo & 1) * FX_STAGE);
            __syncthreads();
            for (int kt = kt_lo; kt <= kt_hi; ++kt) {
                const int sb = (kt & 1) * FX_STAGE;
                if (kt < kt_hi) FX_ISSUE(kt + 1);
                if (32 * kt <= t0 + 32 * rh + 31) {
                    const LAS unsigned char* Kh = lds + sb + h * 4608; const LAS unsigned char* Vh = lds + sb + FX_VT + h * 5120;
                    const LAS float* cbh = (const LAS float*)(lds + sb + FX_CB) + h * 32;
                    f32x16 S;
#pragma unroll
                    for (int g = 0; g < 4; ++g) { const f32x4 c4 = *(const LAS f32x4*)(cbh + 16 * (g >> 1) + 8 * hb + 4 * (g & 1)); S[4 * g] = c4.x; S[4 * g + 1] = c4.y; S[4 * g + 2] = c4.z; S[4 * g + 3] = c4.w; }
#pragma unroll
                    for (int kk = 0; kk < 4; ++kk) { const h8 a = *(const LAS h8*)(Kh + pi16(qi) * 144 + (16 * kk + 8 * hb) * 2); S = MFMA32(a, q[kk], S); }
                    if (32 * kt + 31 > t0 + 32 * rh) {
#pragma unroll
                        for (int r = 0; r < 16; ++r) { const int key = 32 * kt + 16 * (r >> 3) + 8 * hb + 4 * ((r >> 2) & 1) + (r & 3); if (key > t) S[r] = -INFINITY; }
                    }
                    float mx = S[0];
#pragma unroll
                    for (int r = 1; r < 16; ++r) mx = fmaxf(mx, S[r]);
                    mx = fmaxf(mx, __shfl_xor(mx, 32));
                    const float mn = fmaxf(m, mx), alpha = __builtin_amdgcn_exp2f(m - mn);
                    m = mn;
                    float ps = 0.f;
#pragma unroll
                    for (int r = 0; r < 16; ++r) { S[r] = __builtin_amdgcn_exp2f(S[r] - mn); ps += S[r]; }
                    l = l * alpha + ps;
#pragma unroll
                    for (int r = 0; r < 16; ++r) { O0[r] *= alpha; O1[r] *= alpha; }
                    h8 pf0, pf1;
#pragma unroll
                    for (int e = 0; e < 8; ++e) { pf0[e] = (half_t)S[e]; pf1[e] = (half_t)S[8 + e]; }
                    { const h8 a = *(const LAS h8*)(Vh + qi * 80 + (8 * hb) * 2); O0 = MFMA32(a, pf0, O0); }
                    { const h8 a = *(const LAS h8*)(Vh + qi * 80 + (16 + 8 * hb) * 2); O0 = MFMA32(a, pf1, O0); }
                    { const h8 a = *(const LAS h8*)(Vh + (32 + qi) * 80 + (8 * hb) * 2); O1 = MFMA32(a, pf0, O1); }
                    { const h8 a = *(const LAS h8*)(Vh + (32 + qi) * 80 + (16 + 8 * hb) * 2); O1 = MFMA32(a, pf1, O1); }
                }
                if (kt < kt_hi) FX_WRITE(((kt + 1) & 1) * FX_STAGE);
                __syncthreads();
            }
#undef FX_ISSUE
#undef FX_WRITE
            {
                l += __shfl_xor(l, 32);
                const float inv = 1.f / l; float ss = 0.f;
#pragma unroll
                for (int r = 0; r < 16; ++r) { O0[r] *= inv; O1[r] *= inv; ss += O0[r] * O0[r] + O1[r] * O1[r]; }
                ss += __shfl_xor(ss, 32);
                LAS float* ex = (LAS float*)(lds + FX_EX);
                const int ridx = 32 * rh + qi;
                if (hb == 0) ex[ridx * 4 + h] = ss;
                __syncthreads();
                const float rs = rsqrtf((ex[ridx * 4] + ex[ridx * 4 + 1] + ex[ridx * 4 + 2] + ex[ridx * 4 + 3]) * (1.f / 256.f) + EPS);
                const float* gn = P.out_norm + (L * 4 + 2) * 256 + h * 64;
                half_t* op = MIXED + (tokb + t) * D + 512 + h * 64;
#pragma unroll
                for (int g = 0; g < 4; ++g) {
                    const int d0 = 8 * g + 4 * hb; const f32x4 g0 = *(const f32x4*)(gn + d0), g1 = *(const f32x4*)(gn + 32 + d0);
                    u32x2 o0, o1;
                    o0.x = pack_h2(O0[4 * g] * rs * g0.x, O0[4 * g + 1] * rs * g0.y); o0.y = pack_h2(O0[4 * g + 2] * rs * g0.z, O0[4 * g + 3] * rs * g0.w);
                    o1.x = pack_h2(O1[4 * g] * rs * g1.x, O1[4 * g + 1] * rs * g1.y); o1.y = pack_h2(O1[4 * g + 2] * rs * g1.z, O1[4 * g + 3] * rs * g1.w);
                    *(u32x2*)(op + d0) = o0; *(u32x2*)(op + 32 + d0) = o1;
                }
            }
            __syncthreads();
        }
#endif
#ifndef SKIP_NSA
        for (int ui = bid; ui < 512; ui += G) {
            int tid = threadIdx.x; asm volatile("" : "+v"(tid)); const int lane = tid & 63, hb = lane >> 5, qi = lane & 31;
            const int h = wave & 3, rh = wave >> 2;
            const int b = ui & 7, qt = 63 - (ui >> 3), t0 = qt * 64, t = t0 + 32 * rh + qi, cur = qt, row = 32 * rh + qi;
            const size_t tokb = (size_t)b * SEQ;
            constexpr int NS_VT = 9216, NS_STAGE = 18432, NS_TR = 36864, NS_IMP = 38976, NS_SELM = NS_IMP + 4 * 64 * 65 * 4, NS_EX = NS_SELM + 512, NS_MISC = NS_EX + 1024;
            static_assert(NS_MISC + 256 <= RING_BYTES, "NSA LDS map");
            LAS float* TR = (LAS float*)(lds + NS_TR); LAS float* impH = (LAS float*)(lds + NS_IMP); LAS unsigned* selm = (LAS unsigned*)(lds + NS_SELM);
            LAS float* ex = (LAS float*)(lds + NS_EX); LAS unsigned* misc = (LAS unsigned*)(lds + NS_MISC);
            for (int e = tid; e < 4 * 129; e += NTHR) { const int hh = e / 129, d = e % 129; TR[hh * 132 + d] = P.rel_bias[(d < 128 ? (int)c_bucket[d] : 31) * 4 + hh] * LOG2E; }
            for (int e = tid; e < 4 * 64 * 65; e += NTHR) impH[e] = 0.f;
            const LAS float* TRh = TR + h * 132;
            h8 q[4];
#pragma unroll
            for (int kk = 0; kk < 4; ++kk) q[kk] = *(const h8*)(Z + (tokb + t) * NZP + ZC_NSA_Q + 64 * h + 16 * kk + 8 * hb);
            const float* gb = P.nsa_gate_bias + L * 12;
            const half_t* gz = Z + (tokb + t) * NZP + ZC_NSA_G;
            f32x16 T0, T1;
            u32x4 kr, vr;
#define NS_ISSUE(kbase_, kstride_, vbase_, vstride_) do { kr = *(const u32x4*)((const char*)(kbase_) + (size_t)(tid >> 3) * (kstride_) + (tid & 7) * 16); \
                vr = *(const u32x4*)((const char*)(vbase_) + (size_t)(tid >> 3) * (vstride_) + (tid & 7) * 16); } while (0)
#define NS_WRITE(sb_) do { *(LAS u32x4*)(lds + (sb_) + (tid >> 3) * 144 + (tid & 7) * 16) = kr; *(LAS u32x4*)(lds + (sb_) + NS_VT + (tid >> 3) * 144 + (tid & 7) * 16) = vr; } while (0)
            {
                int cnt = (t0 + 63 - 31) / 16 + 1; if (cnt > NCMP) cnt = NCMP;
                const int ntc = (cnt + 63) >> 6;
                const half_t* kcb = KCH + (size_t)b * 256 * 64; const half_t* vcb = VCT + (size_t)b * 64 * 256;
                float m = -1e30f, l = 0.f;
                for (int c = 0; c < ntc; ++c) {
                    __syncthreads();
                    NS_ISSUE(kcb + (size_t)c * 64 * 64, 128, vcb + c * 64, 512); NS_WRITE(0);
                    __syncthreads();
                    f32x16 S0, S1; init_near(S0, S1, TRh, t - 31 - 1024 * c, hb, 16, 1 << 30);
                    qk64(S0, S1, q, lds, qi, hb);
                    const float mn = fmaxf(m, rowmax64(S0, S1)), alpha = __builtin_amdgcn_exp2f(m - mn);
                    m = mn; float ps = 0.f;
#pragma unroll
                    for (int r = 0; r < 16; ++r) ps += __builtin_amdgcn_exp2f(S0[r] - mn) + __builtin_amdgcn_exp2f(S1[r] - mn);
                    l = l * alpha + ps;
                }
                l += __shfl_xor(l, 32);
                const float il = l > 0.f ? 1.f / l : 0.f;
#pragma unroll
                for (int r = 0; r < 16; ++r) { T0[r] = 0.f; T1[r] = 0.f; }
                for (int c = 0; c < ntc; ++c) {
                    __syncthreads();
                    NS_ISSUE(kcb + (size_t)c * 64 * 64, 128, vcb + c * 64, 512); NS_WRITE(0);
                    __syncthreads();
                    f32x16 S0, S1; init_near(S0, S1, TRh, t - 31 - 1024 * c, hb, 16, 1 << 30);
                    qk64(S0, S1, q, lds, qi, hb);
#pragma unroll
                    for (int r = 0; r < 16; ++r) { S0[r] = __builtin_amdgcn_exp2f(S0[r] - m) * il; S1[r] = __builtin_amdgcn_exp2f(S1[r] - m) * il; }
                    LAS float* ip = impH + (h * 64 + row) * 65 + 16 * c + 2 * hb;
#pragma unroll
                    for (int g = 0; g < 4; ++g) {
                        const int mo = 4 * (g >> 1) + (g & 1);
                        { const float v1 = 16.f * S0[4 * g + 3], v0 = 32.f * ((S0[4 * g] + S0[4 * g + 1]) + S0[4 * g + 2]) + v1;
                          __hip_atomic_fetch_add(ip + mo, v0, __ATOMIC_RELAXED, __HIP_MEMORY_SCOPE_WORKGROUP); if (16 * c + 2 * hb + mo + 1 < 64) __hip_atomic_fetch_add(ip + mo + 1, v1, __ATOMIC_RELAXED, __HIP_MEMORY_SCOPE_WORKGROUP); }
                        { const float v1 = 16.f * S1[4 * g + 3], v0 = 32.f * ((S1[4 * g] + S1[4 * g + 1]) + S1[4 * g + 2]) + v1;
                          __hip_atomic_fetch_add(ip + 8 + mo, v0, __ATOMIC_RELAXED, __HIP_MEMORY_SCOPE_WORKGROUP); if (16 * c + 2 * hb + 8 + mo + 1 < 64) __hip_atomic_fetch_add(ip + 8 + mo + 1, v1, __ATOMIC_RELAXED, __HIP_MEMORY_SCOPE_WORKGROUP); }
                    }
                    pv64(S0, S1, lds + NS_VT, T0, T1, qi, hb);
                }
                const float g0 = sigmoidf_((float)gz[0 * 4 + h] + gb[0 * 4 + h]);
#pragma unroll
                for (int r = 0; r < 16; ++r) { T0[r] *= g0; T1[r] *= g0; }
            }
            __syncthreads();
            for (int rr = 0; rr < 8; ++rr) {
                const int rw = wave * 8 + rr;
                float v = ((impH[(0 * 64 + rw) * 65 + lane] + impH[(1 * 64 + rw) * 65 + lane]) + impH[(2 * 64 + rw) * 65 + lane]) + impH[(3 * 64 + rw) * 65 + lane];
                if (lane > cur) v = -INFINITY; else if (lane == 0 || lane == cur || lane == cur - 1) v = 1e30f;
                int rank = 0;
                for (int o = 0; o < 64; ++o) { const float w = __shfl(v, o); rank += (w > v || (w == v && o < lane)) ? 1 : 0; }
                const unsigned long long msk = __ballot(rank < 16);
                if (lane == 0) { selm[rw * 2] = (unsigned)msk; selm[rw * 2 + 1] = (unsigned)(msk >> 32); }
            }
            __syncthreads();
            if (wave == 0) {
                unsigned lo = selm[lane * 2], hi = selm[lane * 2 + 1];
#pragma unroll
                for (int o = 1; o < 64; o <<= 1) { lo |= __shfl_xor(lo, o); hi |= __shfl_xor(hi, o); }
                if (lane == 0) { misc[0] = lo; misc[1] = hi; }
            }
            __syncthreads();
            const unsigned long long mymask = (unsigned long long)selm[row * 2] | ((unsigned long long)selm[row * 2 + 1] << 32);
            unsigned long long um = (unsigned long long)__builtin_amdgcn_readfirstlane((int)misc[0]) | ((unsigned long long)(unsigned)__builtin_amdgcn_readfirstlane((int)misc[1]) << 32);
            um &= (cur >= 63) ? ~0ull : ((1ull << (cur + 1)) - 1ull);
            const float cfar = TRh[128];
            {
                f32x16 O0, O1;
#pragma unroll
                for (int r = 0; r < 16; ++r) { O0[r] = 0.f; O1[r] = 0.f; }
                float m = -1e30f, l = 0.f;
                int j = __builtin_ctzll(um); um &= um - 1; int it = 0;
                NS_ISSUE(Z + (tokb + 64 * j) * NZP + ZC_KS, NZP * 2, VST + (size_t)(b * 64 + j) * 64 * 64, 128); NS_WRITE(0);
                __syncthreads();
                for (;;) {
                    const int sb = (it & 1) * NS_STAGE; const bool more = um != 0ull; int jn = 0;
                    if (more) { jn = __builtin_ctzll(um); um &= um - 1; NS_ISSUE(Z + (tokb + 64 * jn) * NZP + ZC_KS, NZP * 2, VST + (size_t)(b * 64 + jn) * 64 * 64, 128); }
                    const bool sel = (mymask >> j) & 1ull;
                    f32x16 S0, S1;
                    if (j >= cur - 2) init_near(S0, S1, TRh, t - 64 * j, hb, 1, sel ? (1 << 30) : 0); else init_const(S0, S1, sel ? cfar : -INFINITY);
                    qk64(S0, S1, q, lds + sb, qi, hb);
                    softmax64(S0, S1, m, l, O0, O1);
                    pv64(S0, S1, lds + sb + NS_VT, O0, O1, qi, hb);
                    if (!more) break;
                    NS_WRITE(((it + 1) & 1) * NS_STAGE);
                    __syncthreads();
                    j = jn; ++it;
                }
                l += __shfl_xor(l, 32);
                const float g1 = sigmoidf_((float)gz[1 * 4 + h] + gb[1 * 4 + h]) / l;
#pragma unroll
                for (int r = 0; r < 16; ++r) { T0[r] += g1 * O0[r]; T1[r] += g1 * O1[r]; }
            }
            __syncthreads();
            {
                f32x16 O0, O1;
#pragma unroll
                for (int r = 0; r < 16; ++r) { O0[r] = 0.f; O1[r] = 0.f; }
                float m = -1e30f, l = 0.f;
                const int jlo = cur >= 8 ? cur - 8 : 0;
                NS_ISSUE(Z + (tokb + 64 * jlo) * NZP + ZC_KW, NZP * 2, VWT + (size_t)(b * 64 + jlo) * 64 * 64, 128); NS_WRITE(0);
                __syncthreads();
                for (int j = jlo; j <= cur; ++j) {
                    const int sb = ((j - jlo) & 1) * NS_STAGE;
                    if (j < cur) NS_ISSUE(Z + (tokb + 64 * (j + 1)) * NZP + ZC_KW, NZP * 2, VWT + (size_t)(b * 64 + j + 1) * 64 * 64, 128);
                    f32x16 S0, S1;
                    if (j >= cur - 2 || j == cur - 8) init_near(S0, S1, TRh, t - 64 * j, hb, 1, 512); else init_const(S0, S1, cfar);
                    qk64(S0, S1, q, lds + sb, qi, hb);
                    softmax64(S0, S1, m, l, O0, O1);
                    pv64(S0, S1, lds + sb + NS_VT, O0, O1, qi, hb);
                    if (j < cur) NS_WRITE((((j - jlo) + 1) & 1) * NS_STAGE);
                    __syncthreads();
                }
                l += __shfl_xor(l, 32);
                const float g2 = sigmoidf_((float)gz[2 * 4 + h] + gb[2 * 4 + h]) / l;
#pragma unroll
                for (int r = 0; r < 16; ++r) { T0[r] += g2 * O0[r]; T1[r] += g2 * O1[r]; }
            }
#undef NS_ISSUE
#undef NS_WRITE
            {
                float ss = 0.f;
#pragma unroll
                for (int r = 0; r < 16; ++r) ss += T0[r] * T0[r] + T1[r] * T1[r];
                ss += __shfl_xor(ss, 32);
                if (hb == 0) ex[row * 4 + h] = ss;
                __syncthreads();
                const float rs = rsqrtf((ex[row * 4] + ex[row * 4 + 1] + ex[row * 4 + 2] + ex[row * 4 + 3]) * (1.f / 256.f) + EPS);
                const float* gn = P.out_norm + (L * 4 + 3) * 256 + h * 64;
                half_t* op = MIXED + (tokb + t) * D + 768 + h * 64;
#pragma unroll
                for (int g = 0; g < 4; ++g) {
                    const int d0 = 8 * g + 4 * hb; const f32x4 g0 = *(const f32x4*)(gn + d0), g1 = *(const f32x4*)(gn + 32 + d0);
                    u32x2 o0, o1;
                    o0.x = pack_h2(T0[4 * g] * rs * g0.x, T0[4 * g + 1] * rs * g0.y); o0.y = pack_h2(T0[4 * g + 2] * rs * g0.z, T0[4 * g + 3] * rs * g0.w);
                    o1.x = pack_h2(T1[4 * g] * rs * g1.x, T1[4 * g + 1] * rs * g1.y); o1.y = pack_h2(T1[4 * g + 2] * rs * g1.z, T1[4 * g + 3] * rs * g1.w);
                    *(u32x2*)(op + d0) = o0; *(u32x2*)(op + 32 + d0) = o1;
                }
            }
            __syncthreads();
        }
#endif
#ifndef SKIP_LRU
        for (int ui = bid; ui < 512; ui += G) {
            {
                int tid = threadIdx.x; asm volatile("" : "+v"(tid)); const int lane = tid & 63; (void)lane;
                const int uu = ui, b = uu >> 6, chunk = uu & 63, c = tid & 255, hf = tid >> 8;
                LAS float* bufX = (LAS float*)lds;
                LAS float* bufY = (LAS float*)(lds + 65536);
                const int t0 = chunk * 64 + hf * 32; const size_t tokb = (size_t)b * SEQ;
                {
                    const float w0 = P.lru_conv_w[(L * 4 + 0) * 256 + c], w1 = P.lru_conv_w[(L * 4 + 1) * 256 + c], w2 = P.lru_conv_w[(L * 4 + 2) * 256 + c], w3 = P.lru_conv_w[(L * 4 + 3) * 256 + c], cb = P.lru_conv_b[L * 256 + c];
                    float x0 = t0 >= 3 ? (float)Z[(tokb + t0 - 3) * NZP + ZC_LRU_X + c] : 0.f, x1 = t0 >= 2 ? (float)Z[(tokb + t0 - 2) * NZP + ZC_LRU_X + c] : 0.f, x2 = t0 >= 1 ? (float)Z[(tokb + t0 - 1) * NZP + ZC_LRU_X + c] : 0.f;
                    for (int i = 0; i < 32; ++i) { const float x3 = (float)Z[(tokb + t0 + i) * NZP + ZC_LRU_X + c];
                        bufX[(hf * 32 + i) * 256 + c] = cb + w0 * x0 + w1 * x1 + w2 * x2 + w3 * x3; x0 = x1; x1 = x2; x2 = x3; }
                }
                __syncthreads();
                {
                    const int blk = c >> 6, j = c & 63;
                    lru_gate_r(P.lru_w_gates + ((size_t)((L * 2 + 0) * 4 + blk) * 64) * 64 + j, P.lru_b_gates[(L * 2 + 0) * 256 + c], bufX + hf * 32 * 256 + blk * 64, bufY + hf * 32 * 256 + c);
                    float wi_[64];
#pragma unroll
                    for (int k = 0; k < 64; ++k) wi_[k] = P.lru_w_gates[((size_t)((L * 2 + 1) * 4 + blk) * 64 + k) * 64 + j];
                    const float bi = P.lru_b_gates[(L * 2 + 1) * 256 + c];
                    const float lsp = -8.0f * log1pf(expf(-P.lru_lambda[L * 256 + c]));
                    float h = 0.f;
                    {
                        const int nsub = chunk * 2 + hf; const float* ag = LRUAGG + ((size_t)b * 128 * 256 + c) * 2;
                        for (int s = 0; s < nsub; ++s) { const float A = ag[(size_t)s * 512], hh = ag[(size_t)s * 512 + 1]; h = fmaf(A, h, hh); }
                    }
                    for (int i = 0; i < 32; ++i) {
                        const LAS float* xr = bufX + (hf * 32 + i) * 256 + blk * 64;
                        float ii = bi;
#pragma unroll
                        for (int k = 0; k < 64; k += 4) { const f32x4 xv = *(const LAS f32x4*)(xr + k);
                            ii = fmaf(xv.x, wi_[k], ii); ii = fmaf(xv.y, wi_[k + 1], ii); ii = fmaf(xv.z, wi_[k + 2], ii); ii = fmaf(xv.w, wi_[k + 3], ii); }
                        ii = 1.f / (1.f + expf(-ii));
                        const float r = bufY[(hf * 32 + i) * 256 + c];
                        const float xc = xr[j];
                        const float log_a = lsp * r, a = expf(log_a), bb = sqrtf(-expm1f(2.0f * log_a)) * (ii * xc);
                        h = fmaf(a, h, bb);
                        const float gt = (float)Z[(tokb + t0 + i) * NZP + ZC_LRU_G + c];
                        bufY[(hf * 32 + i) * 256 + c] = h * gelu_tanh(gt);
                    }
                }
                __syncthreads();
                {
                    const float* gn = P.out_norm + (L * 4 + 0) * 256 + 4 * lane; const f32x4 g4 = *(const f32x4*)gn;
                    for (int i = 0; i < 8; ++i) { const int tl = wave * 8 + i; const f32x4 v = *(const LAS f32x4*)(bufY + tl * 256 + 4 * lane);
                        const float ss = wave_sum((v.x * v.x + v.y * v.y) + (v.z * v.z + v.w * v.w)); const float rs = rsqrtf(ss * (1.f / 256.f) + EPS);
                        u32x2 o; o.x = pack_h2(v.x * rs * g4.x, v.y * rs * g4.y); o.y = pack_h2(v.z * rs * g4.z, v.w * rs * g4.w);
                        *(u32x2*)(MIXED + (tokb + chunk * 64 + tl) * D + 0 + 4 * lane) = o; }
                }
                {
                    const float w0 = P.sc_conv_w[(L * 3 + 0) * 256 + c], w1 = P.sc_conv_w[(L * 3 + 1) * 256 + c], w2 = P.sc_conv_w[(L * 3 + 2) * 256 + c];
                    float u0 = 0.f, u1 = 0.f;
                    if (t0 >= 2) { const size_t tk = tokb + t0 - 2; u0 = (float)Z[tk * NZP + ZC_SC_C + c] * (float)Z[tk * NZP + ZC_SC_X + c]; }
                    if (t0 >= 1) { const size_t tk = tokb + t0 - 1; u1 = (float)Z[tk * NZP + ZC_SC_C + c] * (float)Z[tk * NZP + ZC_SC_X + c]; }
                    for (int i = 0; i < 32; ++i) { const size_t tk = tokb + t0 + i;
                        const float u2 = (float)Z[tk * NZP + ZC_SC_C + c] * (float)Z[tk * NZP + ZC_SC_X + c];
                        bufX[(hf * 32 + i) * 256 + c] = (float)Z[tk * NZP + ZC_SC_B + c] * (w0 * u0 + w1 * u1 + w2 * u2); u0 = u1; u1 = u2; }
                }
                __syncthreads();
                {
                    const float* gn = P.out_norm + (L * 4 + 1) * 256 + 4 * lane; const f32x4 g4 = *(const f32x4*)gn;
                    for (int i = 0; i < 8; ++i) { const int tl = wave * 8 + i; const f32x4 v = *(const LAS f32x4*)(bufX + tl * 256 + 4 * lane);
                        const float ss = wave_sum((v.x * v.x + v.y * v.y) + (v.z * v.z + v.w * v.w)); const float rs = rsqrtf(ss * (1.f / 256.f) + EPS);
                        u32x2 o; o.x = pack_h2(v.x * rs * g4.x, v.y * rs * g4.y); o.y = pack_h2(v.z * rs * g4.z, v.w * rs * g4.w);
                        *(u32x2*)(MIXED + (tokb + chunk * 64 + tl) * D + 256 + 4 * lane) = o; }
                }
                __syncthreads();
            }
        }
#endif
        xcd_barrier(bar);

#ifndef SKIP_G4
        {
            pg8::Gemm g{MIXED, WOUT_T + (size_t)L * D * D, T, D, D}; pg8::StaticOrder S; S.init(T, D, G, bid);
            EpiRes E{L == 0 ? P.x : P.out, P.out, XH, SSQA};
            pg8::gemm_phase<EpiRes, pg8::StaticOrder>(lds, g, S, E);
        }
#endif
        xcd_barrier(bar);
#ifndef SKIP_G5
        {
            pg8::Gemm g{XH, WGU_T + (size_t)L * 2 * DFF * D, T, 2 * DFF, D}; pg8::StaticOrder S; S.init(T, 2 * DFF, G, bid);
            EpiSwiglu E{HB, SSQA};
            pg8::gemm_phase<EpiSwiglu, pg8::StaticOrder>(lds, g, S, E);
        }
#endif
        xcd_barrier(bar);
#ifndef SKIP_G6
        {
            pg8::Gemm g{HB, WDN_T + (size_t)L * D * DFF, T, D, DFF}; pg8::StaticOrder S; S.init(T, D, G, bid);
            EpiRes E{P.out, P.out, L == 0 ? XH : nullptr, L == 0 ? SSQB : nullptr};
            pg8::gemm_phase<EpiRes, pg8::StaticOrder>(lds, g, S, E);
        }
#endif
        if (L == 0) xcd_barrier(bar);
    }
}

extern "C" void kernel_launch(void* const* d_in, const int* in_sizes, int n_in, void* d_out, int out_size, void* d_ws, size_t ws_size, hipStream_t stream) {
    static int grid = 0;
    if (grid == 0) {
        if (n_in != 22 || ws_size < WS_END) { fprintf(stderr, "kernel_launch: unexpected n_in %d or ws_size %zu (< %zu)\n", n_in, ws_size, (size_t)WS_END); grid = -1; return; }
        int dev = 0, cus = 0, per_cu = 0;
        if (hipGetDevice(&dev) != hipSuccess || hipDeviceGetAttribute(&cus, hipDeviceAttributeMultiprocessorCount, dev) != hipSuccess) { grid = -1; return; }
        if (hipFuncSetAttribute((const void*)hymba_fwd, hipFuncAttributeMaxDynamicSharedMemorySize, LDS_BYTES) != hipSuccess) { fprintf(stderr, "kernel_launch: hipFuncSetAttribute failed\n"); grid = -1; return; }
        if (hipOccupancyMaxActiveBlocksPerMultiprocessor(&per_cu, (const void*)hymba_fwd, NTHR, LDS_BYTES) != hipSuccess || per_cu < 1) { fprintf(stderr, "kernel_launch: occupancy query says %d\n", per_cu); }
        (void)hipGetLastError();
        grid = cus;
    }
    if (grid < 0) return;
    (void)hipMemsetAsync((char*)d_ws + WS_CTL, 0, CTL_ZERO_BYTES, stream);
    Params p{};
    p.x = (const float*)d_in[0]; p.norm_mix = (const float*)d_in[1]; p.w_in = (const float*)d_in[2]; p.lru_conv_w = (const float*)d_in[3]; p.lru_conv_b = (const float*)d_in[4];
    p.lru_w_gates = (const float*)d_in[5]; p.lru_b_gates = (const float*)d_in[6]; p.lru_lambda = (const float*)d_in[7]; p.sc_conv_w = (const float*)d_in[8];
    p.fox_f_bias = (const float*)d_in[9]; p.fox_qk_norm = (const float*)d_in[10]; p.nsa_qk_norm = (const float*)d_in[11]; p.nsa_cmp_pos = (const float*)d_in[12];
    p.nsa_cmp_w1 = (const float*)d_in[13]; p.nsa_cmp_w2 = (const float*)d_in[14]; p.nsa_gate_bias = (const float*)d_in[15]; p.rel_bias = (const float*)d_in[16];
    p.out_norm = (const float*)d_in[17]; p.w_out = (const float*)d_in[18]; p.norm_ffn = (const float*)d_in[19]; p.w_gate_up = (const float*)d_in[20]; p.w_down = (const float*)d_in[21];
    p.out = (float*)d_out; p.ws = (unsigned char*)d_ws;
    hipLaunchKernelGGL(hymba_fwd, dim3(grid), dim3(NTHR), LDS_BYTES, stream, p);
}
```

```cpp
#define REP_FOX 1
#define REP_LRU 3
#define REP_P2CMP 2
#define REP_VT 2
#include <hip/hip_runtime.h>
#include <stdint.h>
#include <stdio.h>

#define LAS __attribute__((address_space(3)))
typedef _Float16 half_t;
typedef _Float16 h8 __attribute__((ext_vector_type(8)));
typedef _Float16 h4 __attribute__((ext_vector_type(4)));
typedef _Float16 h2 __attribute__((ext_vector_type(2)));
typedef float f32x4 __attribute__((ext_vector_type(4)));
typedef unsigned u32x4 __attribute__((ext_vector_type(4)));
typedef unsigned u32x2 __attribute__((ext_vector_type(2)));
typedef float f32x16 __attribute__((ext_vector_type(16)));
#define MFMA32(a, b, c) __builtin_amdgcn_mfma_f32_32x32x16_f16(a, b, c, 0, 0, 0)
constexpr float LOG2E = 1.4426950408889634f, QSCALE = 0.125f * 1.4426950408889634f;
__device__ __forceinline__ int pi16(int r) { return (r & ~0xC) | ((r & 4) << 1) | ((r & 8) >> 1); }

constexpr int BATCH = 8, SEQ = 4096, T = BATCH * SEQ, D = 1024, NZP = 2816, DFF = 2816, NCMP = 255;
constexpr int NIN_SRC = 2704;
constexpr int ZC_LRU_X = 0, ZC_LRU_G = 256, ZC_SC_B = 512, ZC_SC_C = 768, ZC_SC_X = 1024, ZC_FOX_Q = 1280, ZC_FOX_K = 1536, ZC_FOX_V = 1792,
              ZC_NSA_Q = 2048, ZC_KC = 2304, ZC_VC = 2368, ZC_KS = 2432, ZC_VS = 2496, ZC_KW = 2560, ZC_VW = 2624, ZC_FOX_F = 2688, ZC_NSA_G = 2692;
constexpr float EPS = 1e-6f;
constexpr int NWAVES = 8, NTHR = 512;
#ifndef REP_G1
#define REP_G1 1
#endif
#ifndef REP_P0
#define REP_P0 1
#endif
#ifndef REP_G4N
#define REP_G4N 0
#endif
#ifndef REP_G6N
#define REP_G6N 0
#endif
#ifndef NORM_DRY
#define NORM_DRY 0
#endif
#ifndef REP_G5
#define REP_G5 1
#endif
#ifndef REP_CUM
#define REP_CUM 1
#endif
#ifndef REP_VT
#define REP_VT 1
#endif
#ifndef REP_P2LRU
#define REP_P2LRU 1
#endif
#ifndef REP_P2CMP
#define REP_P2CMP 1
#endif
#ifndef REP_FOX
#define REP_FOX 1
#endif
#ifndef REP_NSA
#define REP_NSA 1
#endif
#ifndef REP_LRU
#define REP_LRU 1
#endif

constexpr size_t MiB = 1u << 20;
constexpr size_t WS_CTL = 0, CTL_ZERO_BYTES = 64 * 1024;
constexpr size_t WS_SSQA = 2 * MiB, WS_SSQB = 4 * MiB, WS_CFOX = 6 * MiB, WS_KVC = 7 * MiB, WS_LRUAGG = 9 * MiB, WS_CB = 11 * MiB;
constexpr size_t WS_WIN = 12 * MiB, WS_WOUT = 24 * MiB, WS_WGU = 28 * MiB, WS_WDN = 50 * MiB;
constexpr size_t WS_XH = 62 * MiB, WS_MIXED = 126 * MiB, WS_Z = 190 * MiB, WS_YD = 366 * MiB, WS_FOXVT = 398 * MiB, WS_VST = 414 * MiB, WS_VWT = 418 * MiB, WS_KCH = 422 * MiB, WS_VCT = 423 * MiB, WS_W1T = 424 * MiB, WS_WGT = 426 * MiB, WS_END = 427 * MiB;
static_assert(WS_WIN + 2 * (size_t)NZP * D * 2 <= WS_WOUT && WS_WOUT + 2 * (size_t)D * D * 2 <= WS_WGU && WS_WGU + 2 * (size_t)2 * DFF * D * 2 <= WS_WDN &&
              WS_WDN + 2 * (size_t)D * DFF * 2 <= WS_XH && WS_XH + (size_t)T * D * 2 <= WS_MIXED && WS_MIXED + (size_t)T * D * 2 <= WS_Z &&
              WS_Z + (size_t)T * NZP * 2 <= WS_YD && WS_YD + (size_t)T * 256 * 4 <= WS_FOXVT && WS_FOXVT + (size_t)T * 256 * 2 <= WS_VST, "ws map");
constexpr int CW_BAR = 1024;

constexpr int RING_BYTES = 131072, MISC_OFF = RING_BYTES, LDS_BYTES = 147456;

__device__ __constant__ unsigned char c_bucket[128] = {
 0,1,2,3,4,5,6,7,8,9,10,11,12,13,14,15,
 16,16,16,17,17,18,18,18,19,19,19,20,20,20,20,21,
 21,21,21,22,22,22,22,22,23,23,23,23,23,23,24,24,
 24,24,24,24,25,25,25,25,25,25,25,26,26,26,26,26,
 26,26,26,27,27,27,27,27,27,27,27,27,27,28,28,28,
 28,28,28,28,28,28,28,29,29,29,29,29,29,29,29,29,
 29,29,29,30,30,30,30,30,30,30,30,30,30,30,30,30,
 30,31,31,31,31,31,31,31,31,31,31,31,31,31,31,31};
__device__ __forceinline__ int rel_bucket(int d) { return d >= 128 ? 31 : (int)c_bucket[d < 0 ? 0 : d]; }

__device__ __forceinline__ float sigmoidf_(float x) { return __builtin_amdgcn_rcpf(1.f + __builtin_amdgcn_exp2f(-1.4426950408889634f * x)); }
__device__ __forceinline__ float gelu_tanh(float x) { return x * __builtin_amdgcn_rcpf(1.f + __builtin_amdgcn_exp2f(-2.f * 1.4426950408889634f * 0.7978845608028654f * (x + 0.044715f * x * x * x))); }
__device__ __forceinline__ float log_sigmoid(float x) { const float e = __builtin_amdgcn_exp2f(-1.4426950408889634f * fabsf(x)); return fminf(x, 0.f) - 0.6931471805599453f * __builtin_amdgcn_logf(1.f + e); }
__device__ __forceinline__ u32x4 pack_h8(f32x4 a, f32x4 b) {
    h8 h; h[0] = (half_t)a.x; h[1] = (half_t)a.y; h[2] = (half_t)a.z; h[3] = (half_t)a.w; h[4] = (half_t)b.x; h[5] = (half_t)b.y; h[6] = (half_t)b.z; h[7] = (half_t)b.w;
    return __builtin_bit_cast(u32x4, h);
}
__device__ __forceinline__ unsigned pack_h2(float a, float b) { h2 h; h[0] = (half_t)a; h[1] = (half_t)b; return __builtin_bit_cast(unsigned, h); }
#define LDS_WAIT() asm volatile("s_waitcnt lgkmcnt(0)" ::: "memory")

#define XB_TMO      128
#define XB_XCNT(j)  (256  + 64 * (j))
#define XB_XSUB(j)  (1280 + 64 * (j))
#define XB_XGEN(j)  (2304 + 64 * (j))
#define XB_TOP      3328
#define XB_TOPGEN   3392
#define XCD_BAR_WORDS 3456
#define XB_SPIN_CAP (1u << 20)
__device__ __forceinline__ unsigned xb_ld(unsigned* p)              { return __hip_atomic_load(p, __ATOMIC_RELAXED, __HIP_MEMORY_SCOPE_AGENT); }
__device__ __forceinline__ unsigned xb_add(unsigned* p, unsigned v) { return __hip_atomic_fetch_add(p, v, __ATOMIC_RELAXED, __HIP_MEMORY_SCOPE_AGENT); }
__device__ __forceinline__ unsigned xb_xcc_id() { return (unsigned)__builtin_amdgcn_s_getreg((3 << 11) | 20) & 0xFu; }
#define XB_SPIN(cond, bar) do { unsigned _sp = 0; while (cond) { __builtin_amdgcn_s_sleep(1); \
    if ((++_sp & 255u) == 0u) { if (xb_ld(&(bar)[XB_TMO])) break; if (_sp > XB_SPIN_CAP) { atomicAdd(&(bar)[XB_TMO], 1u); break; } } } } while (0)
struct XcdBarrier { unsigned* bar; unsigned x; volatile LAS unsigned* st; };
__device__ __forceinline__ XcdBarrier xcd_barrier_post(unsigned* bar, volatile LAS unsigned* st) {
    XcdBarrier b; b.bar = bar; b.x = xb_xcc_id(); b.st = st;
    if (threadIdx.x == 0) (void)xb_add(&bar[XB_XCNT(b.x)], 1u);
    return b;
}
__device__ __forceinline__ void xcd_barrier_complete(unsigned* bar, unsigned x, unsigned& nloc, unsigned& nx) {
    const unsigned G = gridDim.x * gridDim.y * gridDim.z;
    unsigned sum, cnt, mine, sp = 0u;
    for (;;) {
        sum = 0u; cnt = 0u; mine = 0u;
#pragma unroll
        for (unsigned j = 0; j < 16; ++j) { const unsigned c = xb_ld(&bar[XB_XCNT(j)]); sum += c; cnt += (c > 0u) ? 1u : 0u; mine = (j == x) ? c : mine; }
        if (sum == G) break;
        __builtin_amdgcn_s_sleep(1);
        if ((++sp & 255u) == 0u) { if (xb_ld(&bar[XB_TMO])) break; if (sp > XB_SPIN_CAP) { atomicAdd(&bar[XB_TMO], 1u); break; } }
    }
    nloc = mine > 0u ? mine : 1u; nx = cnt > 0u ? cnt : 1u;
}
__device__ __forceinline__ void xcd_barrier(const XcdBarrier& b) {
    asm volatile("s_waitcnt vmcnt(0)" ::: "memory");
    __syncthreads();
    if (threadIdx.x == 0) {
        unsigned* bar = b.bar;
        unsigned bx = b.x; asm volatile("" : "+s"(bx));
        __builtin_amdgcn_s_waitcnt(0);
        unsigned nloc = b.st[0], nx = b.st[1];
        if (nloc == 0u) { xcd_barrier_complete(bar, bx, nloc, nx); b.st[0] = nloc; b.st[1] = nx; }
        const unsigned old = xb_add(&bar[XB_XSUB(bx)], 1u);
        const unsigned gen = old / nloc;
        if (old + 1u == (gen + 1u) * nloc) {
            __builtin_amdgcn_fence(__ATOMIC_RELEASE, "agent");
            asm volatile("s_waitcnt vmcnt(0)" ::: "memory");
            const unsigned og = xb_add(&bar[XB_TOP], 1u);
            const unsigned tg = og / nx;
            if (og + 1u == (tg + 1u) * nx) xb_add(&bar[XB_TOPGEN], 1u);
            else XB_SPIN(xb_ld(&bar[XB_TOPGEN]) == tg, bar);
            __builtin_amdgcn_fence(__ATOMIC_ACQUIRE, "agent");
            xb_add(&bar[XB_XGEN(bx)], 1u);
            asm volatile("s_waitcnt vmcnt(0)" ::: "memory");
        } else {
            XB_SPIN(xb_ld(&bar[XB_XGEN(bx)]) == gen, bar);
            __builtin_amdgcn_fence(__ATOMIC_ACQUIRE, "agent");
            asm volatile("s_waitcnt vmcnt(0)" ::: "memory");
        }
    }
    __syncthreads();
}

namespace pg8 {
constexpr int BM = 256, BK = 64, HALF = 128, HTB = HALF * BK * 2, STAGE_BYTES = 8 * HTB, NXCD = 8, WGM = 8;
__host__ __device__ __forceinline__ int lds_byte(int r, int c) { const int st = (r >> 4) * 2 + (c >> 5), rr = r & 15, cc = c & 31, ob = rr * 64 + cc * 2; return st * 1024 + (ob ^ (((ob >> 9) & 1) << 5)); }
__host__ __device__ __forceinline__ void stage_rc(int b, int& R, int& C) { const int st = b / 1024, sb = b % 1024, swz = sb ^ (((sb >> 9) & 1) << 5); R = (st >> 1) * 16 + swz / 64; C = (st & 1) * 32 + (swz % 64) / 2; }
__host__ __device__ __forceinline__ int perm32(int rho) { const int n = rho >> 4, i = rho & 15; return 8 * (i >> 2) + 4 * n + (i & 3); }
struct Unit { int pm, pn; };
struct Gemm { const half_t* A; const half_t* Bt; int M, N, K; };
struct StaticOrder {
    int nM, nN, nwg, G, c;
    __host__ __device__ void init(int M, int N, int G_, int c_) { nM = M / BM; nN = N / BM; nwg = nM * nN; G = G_; c = c_; }
    __host__ __device__ bool next(int i, Unit& u) const {
        const long L = (long)i * G + c; if (L >= nwg) return false;
        int wgid = (int)L; { const int q = nwg / NXCD, r = nwg % NXCD, xcd = wgid % NXCD, off = wgid / NXCD; wgid = (xcd < r ? xcd * (q + 1) : r * (q + 1) + (xcd - r) * q) + off; }
        const int nig = WGM * nN, gid = wgid / nig, fm = gid * WGM, gsz = (nM - fm) < WGM ? (nM - fm) : WGM;
        u.pm = fm + ((wgid % nig) % gsz); u.pn = (wgid % nig) / gsz; return true;
    }
    __device__ __forceinline__ void a_ready(const Unit&) const {}
    __device__ __forceinline__ void done(const Unit&) const {}
};

template <class Epi, class Sched>
__device__ __forceinline__ void gemm_phase(LAS unsigned char* lds, const Gemm g, const Sched& S, const Epi& E) {
    int tid = threadIdx.x; asm volatile("" : "+v"(tid));
    const int wid = __builtin_amdgcn_readfirstlane(tid >> 6), lane = tid & 63, wr = wid >> 2, wc = wid & 3, fr = lane & 15, fq = lane >> 4;
    const int K = g.K, nt = K / BK;
    unsigned voffA[2], voffB[2];
#pragma unroll
    for (int i = 0; i < 2; ++i) { int R, C; stage_rc(tid * 16 + i * 8192, R, C); const int Rb = Epi::PERM ? ((R & ~31) + perm32(R & 31)) : R;
        voffA[i] = (unsigned)(R * K + C) * 2u; voffB[i] = (unsigned)(Rb * K + C) * 2u; }
    const size_t kstep = (size_t)(BK * 2);
    const size_t hstep = (size_t)HALF * K * 2;
    const size_t tstep = 2 * hstep;
    const unsigned ldsw = (unsigned)wid * 1024u;
    const int aoff = lds_byte(wr * 64 + fr, fq * 8), boff = lds_byte(wc * 32 + fr, fq * 8);
#define PG8_SA(b, h) (((b) * 2 + (h)) * HTB)
#define PG8_SB(b, h) ((4 + (b) * 2 + (h)) * HTB)
#define PG8_STAGE(bufoff, gbase, voff) do { _Pragma("unroll") for (int _i = 0; _i < 2; ++_i) \
        __builtin_amdgcn_global_load_lds((const unsigned*)((const char*)(gbase) + (voff)[_i]), (LAS unsigned*)(lds + (bufoff) + ldsw + _i * 8192), 16, 0, 0); } while (0)
#define PG8_LDA(dst, b, h) do { _Pragma("unroll") for (int m = 0; m < 4; ++m) _Pragma("unroll") for (int k = 0; k < 2; ++k) dst[m][k] = *(const LAS h8*)(lds + PG8_SA(b, h) + aoff + m * 2048 + k * 1024); } while (0)
#define PG8_LDB(dst, b, h) do { _Pragma("unroll") for (int n = 0; n < 2; ++n) _Pragma("unroll") for (int k = 0; k < 2; ++k) dst[n][k] = *(const LAS h8*)(lds + PG8_SB(b, h) + boff + n * 2048 + k * 1024); } while (0)
#define PG8_MMA(ai, bj, At, Bt) do { __builtin_amdgcn_s_setprio(1); _Pragma("unroll") for (int m = 0; m < 4; ++m) _Pragma("unroll") for (int n = 0; n < 2; ++n) _Pragma("unroll") for (int k = 0; k < 2; ++k) \
        acc[ai][bj][m][n] = __builtin_amdgcn_mfma_f32_16x16x32_f16(Bt[n][k], At[m][k], acc[ai][bj][m][n], 0, 0, 0); __builtin_amdgcn_s_setprio(0); } while (0)
#define PG8_WAIT_V(n) asm volatile("s_waitcnt vmcnt(" #n ")" ::: "memory")
#define PG8_WAIT_L(n) asm volatile("s_waitcnt lgkmcnt(" #n ")" ::: "memory")
#define PG8_BAR __builtin_amdgcn_s_barrier()
#define PG8_SCHED __builtin_amdgcn_sched_barrier(0)
    Unit cur, nxt; int ui = 0;
    if (!S.next(0, cur)) return;
    f32x4 acc[2][2][4][2];
#pragma unroll
    for (int a = 0; a < 2; ++a)
#pragma unroll
        for (int b = 0; b < 2; ++b)
#pragma unroll
            for (int m = 0; m < 4; ++m)
#pragma unroll
                for (int n = 0; n < 2; ++n) acc[a][b][m][n] = (f32x4){0.f, 0.f, 0.f, 0.f};
    h8 At[4][2], B0[2][2], B1[2][2];
    const char* cA = (const char*)g.A + (size_t)cur.pm * tstep; const char* cB = (const char*)g.Bt + (size_t)cur.pn * tstep;
    S.a_ready(cur);
    PG8_STAGE(PG8_SB(0, 0), cB, voffB); PG8_STAGE(PG8_SA(0, 0), cA, voffA); PG8_STAGE(PG8_SB(0, 1), cB + hstep, voffB); PG8_STAGE(PG8_SA(0, 1), cA + hstep, voffA);
    if (wr == 1) PG8_BAR;
    PG8_WAIT_V(4); PG8_BAR;
    PG8_STAGE(PG8_SB(1, 0), cB + kstep, voffB); PG8_STAGE(PG8_SA(1, 0), cA + kstep, voffA); PG8_STAGE(PG8_SB(1, 1), cB + hstep + kstep, voffB);
    PG8_WAIT_V(6); PG8_BAR;
    for (;;) {
        const bool has_next = S.next(ui + 1, nxt);
        const char* nA = has_next ? (const char*)g.A + (size_t)nxt.pm * tstep : cA; const char* nB = has_next ? (const char*)g.Bt + (size_t)nxt.pn * tstep : cB;
        for (int t = 0; t < nt; t += 2) {
            const bool last = (t == nt - 2);
            const char* a1 = cA + (size_t)(t + 1) * kstep;
            const char* a2 = last ? nA : cA + (size_t)(t + 2) * kstep; const char* b2 = last ? nB : cB + (size_t)(t + 2) * kstep;
            const char* a3 = a2 + kstep; const char* b3 = b2 + kstep;
            if (last && has_next) S.a_ready(nxt);
            PG8_LDB(B0, 0, 0); PG8_SCHED; PG8_LDA(At, 0, 0); PG8_STAGE(PG8_SA(1, 1), a1 + hstep, voffA);
            PG8_WAIT_L(8); PG8_BAR; PG8_WAIT_L(0); PG8_MMA(0, 0, At, B0); PG8_BAR; PG8_SCHED;
            PG8_LDB(B1, 0, 1); PG8_STAGE(PG8_SB(0, 0), b2, voffB);
            PG8_BAR; PG8_WAIT_L(0); PG8_MMA(0, 1, At, B1); PG8_BAR;
            PG8_LDA(At, 0, 1); PG8_STAGE(PG8_SA(0, 0), a2, voffA);
            PG8_BAR; PG8_WAIT_L(0); PG8_MMA(1, 0, At, B0); PG8_BAR; PG8_SCHED;
            PG8_STAGE(PG8_SB(0, 1), b2 + hstep, voffB);
            PG8_WAIT_V(6); PG8_BAR; PG8_MMA(1, 1, At, B1); PG8_BAR;
            PG8_LDB(B0, 1, 0); PG8_SCHED; PG8_LDA(At, 1, 0); PG8_STAGE(PG8_SA(0, 1), a2 + hstep, voffA);
            PG8_WAIT_L(8); PG8_BAR; PG8_WAIT_L(0); PG8_MMA(0, 0, At, B0); PG8_BAR; PG8_SCHED;
            PG8_LDB(B1, 1, 1); PG8_STAGE(PG8_SB(1, 0), b3, voffB);
            PG8_BAR; PG8_WAIT_L(0); PG8_MMA(0, 1, At, B1); PG8_BAR;
            PG8_LDA(At, 1, 1); PG8_STAGE(PG8_SA(1, 0), a3, voffA);
            PG8_BAR; PG8_WAIT_L(0); PG8_MMA(1, 0, At, B0); PG8_BAR; PG8_SCHED;
            PG8_STAGE(PG8_SB(1, 1), b3 + hstep, voffB);
            PG8_WAIT_V(6); PG8_BAR; PG8_MMA(1, 1, At, B1); PG8_BAR;
        }
        E(acc, cur, wr, wc, fr, fq); S.done(cur);
        if (!has_next) break;
#pragma unroll
        for (int a = 0; a < 2; ++a)
#pragma unroll
            for (int b = 0; b < 2; ++b)
#pragma unroll
                for (int m = 0; m < 4; ++m)
#pragma unroll
                    for (int n = 0; n < 2; ++n) acc[a][b][m][n] = (f32x4){0.f, 0.f, 0.f, 0.f};
        cur = nxt; cA = nA; cB = nB; ++ui;
    }
    PG8_WAIT_V(0);
    if (wr == 0) PG8_BAR;
    PG8_BAR;
#undef PG8_SA
#undef PG8_SB
#undef PG8_STAGE
#undef PG8_LDA
#undef PG8_LDB
#undef PG8_MMA
#undef PG8_WAIT_V
#undef PG8_WAIT_L
#undef PG8_BAR
#undef PG8_SCHED
}
}

__device__ __forceinline__ float row_rstd(const float* ssq, int row) {
    const f32x4* p = (const f32x4*)(ssq + (size_t)row * 16);
    const f32x4 a = p[0], b = p[1], c = p[2], d = p[3];
    const float s = (((a.x + a.y) + (a.z + a.w)) + ((b.x + b.y) + (b.z + b.w))) + (((c.x + c.y) + (c.z + c.w)) + ((d.x + d.y) + (d.z + d.w)));
    return rsqrtf(s * (1.f / 1024.f) + EPS);
}
struct EpiZ {
    static constexpr bool PERM = true;
    half_t* Z; const float* ssq;
    __device__ __forceinline__ void operator()(const f32x4 (&acc)[2][2][4][2], const pg8::Unit& u, int wr, int wc, int fr, int fq) const {
        const int row0 = u.pm * 256 + wr * 64 + fr, col0 = u.pn * 256 + wc * 32 + 8 * fq;
#pragma unroll
        for (int ai = 0; ai < 2; ++ai)
#pragma unroll
            for (int m = 0; m < 4; ++m) { const int row = row0 + ai * 128 + m * 16; const float r = row_rstd(ssq, row); half_t* rp = Z + (size_t)row * NZP + col0;
#pragma unroll
                for (int bj = 0; bj < 2; ++bj) *(u32x4*)(rp + bj * 128) = pack_h8(acc[ai][bj][m][0] * r, acc[ai][bj][m][1] * r); }
    }
};
struct EpiRes {
    static constexpr bool PERM = true;
    const float* xold; float* out; half_t* XH; float* ssq;
    __device__ __forceinline__ void operator()(const f32x4 (&acc)[2][2][4][2], const pg8::Unit& u, int wr, int wc, int fr, int fq) const {
        const int row0 = u.pm * 256 + wr * 64 + fr, col0 = u.pn * 256 + wc * 32 + 8 * fq;
#pragma unroll
        for (int ai = 0; ai < 2; ++ai)
#pragma unroll
            for (int m = 0; m < 4; ++m) { const int row = row0 + ai * 128 + m * 16; float s = 0.f;
#pragma unroll
                for (int bj = 0; bj < 2; ++bj) { const size_t o = (size_t)row * D + col0 + bj * 128;
                    f32x4 v0 = *(const f32x4*)(xold + o) + acc[ai][bj][m][0], v1 = *(const f32x4*)(xold + o + 4) + acc[ai][bj][m][1];
                    *(f32x4*)(out + o) = v0; *(f32x4*)(out + o + 4) = v1;
                    if (XH) *(u32x4*)(XH + o) = pack_h8(v0, v1);
                    s += (v0.x * v0.x + v0.y * v0.y) + (v0.z * v0.z + v0.w * v0.w) + (v1.x * v1.x + v1.y * v1.y) + (v1.z * v1.z + v1.w * v1.w); }
                s += __shfl_xor(s, 16); s += __shfl_xor(s, 32);
                if (fq == 0 && ssq) ssq[(size_t)row * 16 + u.pn * 4 + wc] = s; }
    }
};
struct EpiSwiglu {
    static constexpr bool PERM = true;
    half_t* H; const float* ssq;
    __device__ __forceinline__ void operator()(const f32x4 (&acc)[2][2][4][2], const pg8::Unit& u, int wr, int wc, int fr, int fq) const {
        const int row0 = u.pm * 256 + wr * 64 + fr, col0 = u.pn * 128 + wc * 32 + 8 * fq;
#pragma unroll
        for (int ai = 0; ai < 2; ++ai)
#pragma unroll
            for (int m = 0; m < 4; ++m) { const int row = row0 + ai * 128 + m * 16; const float r = row_rstd(ssq, row);
                f32x4 o[2];
#pragma unroll
                for (int n = 0; n < 2; ++n) { const f32x4 g = acc[ai][0][m][n] * r, uu = acc[ai][1][m][n] * r;
                    o[n].x = g.x * sigmoidf_(g.x) * uu.x; o[n].y = g.y * sigmoidf_(g.y) * uu.y; o[n].z = g.z * sigmoidf_(g.z) * uu.z; o[n].w = g.w * sigmoidf_(g.w) * uu.w; }
                *(u32x4*)(H + (size_t)row * DFF + col0) = pack_h8(o[0], o[1]); }
    }
};

struct EpiNull {
    static constexpr bool PERM = true;
    __device__ __forceinline__ void operator()(const f32x4 (&acc)[2][2][4][2], const pg8::Unit&, int, int, int, int) const {
#pragma unroll
        for (int ai = 0; ai < 2; ++ai)
#pragma unroll
            for (int bj = 0; bj < 2; ++bj)
#pragma unroll
                for (int m = 0; m < 4; ++m)
#pragma unroll
                    for (int n = 0; n < 2; ++n) asm volatile("" :: "v"(acc[ai][bj][m][n]));
    }
};
struct Params {
    const float* x; const float* norm_mix; const float* w_in; const float* lru_conv_w; const float* lru_conv_b; const float* lru_w_gates; const float* lru_b_gates;
    const float* lru_lambda; const float* sc_conv_w; const float* fox_f_bias; const float* fox_qk_norm; const float* nsa_qk_norm; const float* nsa_cmp_pos;
    const float* nsa_cmp_w1; const float* nsa_cmp_w2; const float* nsa_gate_bias; const float* rel_bias; const float* out_norm; const float* w_out;
    const float* norm_ffn; const float* w_gate_up; const float* w_down; float* out; unsigned char* ws;
};

template <int MODE> __device__ __forceinline__ int src_col(int n) {
    if (MODE == 1) { if (n < 2048) return n; if (n < 2688) return n + 4; if (n < 2692) return 2048 + (n - 2688); if (n < 2704) return n; return -1; }
    if (MODE == 2) { const int pn = n >> 8, w = n & 255; return w < 128 ? pn * 128 + w : DFF + pn * 128 + (w - 128); }
    return n;
}
template <int MODE> __device__ __forceinline__ void p0_item(const float* W, int K, int Nsrc, const float* gain, half_t* WT, int item, int nbn, LAS unsigned* scr, int lane) {
    const int kb = item / nbn, nb = item % nbn, k0 = 64 * kb, n0 = 64 * nb;
    const int sc = src_col<MODE>(n0 + lane);
#pragma unroll 8
    for (int kk = 0; kk < 64; kk += 2) {
        float v0 = 0.f, v1 = 0.f;
        if (sc >= 0) { v0 = W[(size_t)(k0 + kk) * Nsrc + sc]; v1 = W[(size_t)(k0 + kk + 1) * Nsrc + sc]; }
        if (gain) { v0 *= gain[k0 + kk]; v1 *= gain[k0 + kk + 1]; }
        scr[lane * 33 + (kk >> 1)] = pack_h2(v0, v1);
    }
    LDS_WAIT(); asm volatile("" ::: "memory");
    const int c = lane & 7;
#pragma unroll
    for (int j = 0; j < 8; ++j) { const int nn = (lane >> 3) + 8 * j; const LAS unsigned* s = scr + nn * 33 + 4 * c;
        u32x4 o; o.x = s[0]; o.y = s[1]; o.z = s[2]; o.w = s[3];
        *(u32x4*)(WT + (size_t)(n0 + nn) * K + k0 + 8 * c) = o; }
    LDS_WAIT(); asm volatile("" ::: "memory");
}
__device__ __forceinline__ float wave_sum(float v) {
#pragma unroll
    for (int o = 1; o < 64; o <<= 1) v += __shfl_xor(v, o);
    return v;
}

__device__ __forceinline__ void attn_step_h(const float (&q)[64], float (&acc)[64], float& m, float& l, const half_t* kp, const half_t* vp, float bias, bool valid) {
    float sc = 0.f;
#pragma unroll
    for (int hh = 0; hh < 2; ++hh) {
#pragma unroll
        for (int j = 4 * hh; j < 4 * hh + 4; ++j) { const h8 kv = *(const h8*)(kp + 8 * j);
#pragma unroll
            for (int e = 0; e < 8; ++e) sc = fmaf(q[8 * j + e], (float)kv[e], sc); }
        __builtin_amdgcn_sched_barrier(0);
    }
    sc += bias;
    const float mn = valid ? fmaxf(m, sc) : m;
    const float alpha = __expf(m - mn), p = valid ? __expf(sc - mn) : 0.f;
    m = mn; l = l * alpha + p;
#pragma unroll
    for (int hh = 0; hh < 2; ++hh) {
#pragma unroll
        for (int j = 4 * hh; j < 4 * hh + 4; ++j) { const h8 vv = *(const h8*)(vp + 8 * j);
#pragma unroll
            for (int e = 0; e < 8; ++e) acc[8 * j + e] = fmaf(acc[8 * j + e], alpha, p * (float)vv[e]); }
        __builtin_amdgcn_sched_barrier(0);
    }
}
__device__ __forceinline__ float dot_f32(const float (&q)[64], const float* kp) {
    float sc = 0.f;
#pragma unroll
    for (int j = 0; j < 16; ++j) { const f32x4 kv = *(const f32x4*)(kp + 4 * j); sc = fmaf(q[4 * j], kv.x, sc); sc = fmaf(q[4 * j + 1], kv.y, sc); sc = fmaf(q[4 * j + 2], kv.z, sc); sc = fmaf(q[4 * j + 3], kv.w, sc); }
    return sc;
}
__device__ __forceinline__ void load_q(float (&q)[64], const half_t* qp, float scale) {
#pragma unroll
    for (int j = 0; j < 8; ++j) { const h8 v = *(const h8*)(qp + 8 * j);
#pragma unroll
        for (int e = 0; e < 8; ++e) q[8 * j + e] = (float)v[e] * scale; }
}

__device__ __forceinline__ void lru_gate_r(const float* wcol, float bias, const LAS float* xrow, LAS float* yout) {
    float w[64];
#pragma unroll
    for (int k = 0; k < 64; ++k) w[k] = wcol[(size_t)k * 64];
    for (int i = 0; i < 32; ++i) {
        const LAS float* xr = xrow + i * 256; float r = bias;
#pragma unroll
        for (int k = 0; k < 64; k += 4) { const f32x4 xv = *(const LAS f32x4*)(xr + k);
            r = fmaf(xv.x, w[k], r); r = fmaf(xv.y, w[k + 1], r); r = fmaf(xv.z, w[k + 2], r); r = fmaf(xv.w, w[k + 3], r); }
        yout[i * 256] = 1.f / (1.f + expf(-r));
    }
}

__device__ __forceinline__ void qk64(f32x16& S0, f32x16& S1, const h8 (&q)[4], const LAS unsigned char* Ks, int qi, int hb) {
    const LAS unsigned char* r0 = Ks + pi16(qi) * 144 + 16 * hb;
#pragma unroll
    for (int kk = 0; kk < 4; ++kk) { const h8 a0 = *(const LAS h8*)(r0 + 32 * kk); S0 = MFMA32(a0, q[kk], S0);
        const h8 a1 = *(const LAS h8*)(r0 + 32 * 144 + 32 * kk); S1 = MFMA32(a1, q[kk], S1); }
}
__device__ __forceinline__ void pv64(const f32x16& P0, const f32x16& P1, const LAS unsigned char* Vs, f32x16& O0, f32x16& O1, int qi, int hb) {
    h8 pf[4];
#pragma unroll
    for (int e = 0; e < 8; ++e) { pf[0][e] = (half_t)P0[e]; pf[1][e] = (half_t)P0[8 + e]; pf[2][e] = (half_t)P1[e]; pf[3][e] = (half_t)P1[8 + e]; }
    const LAS unsigned char* v0 = Vs + qi * 144 + 16 * hb;
#pragma unroll
    for (int s = 0; s < 4; ++s) { const h8 a0 = *(const LAS h8*)(v0 + 32 * s); O0 = MFMA32(a0, pf[s], O0);
        const h8 a1 = *(const LAS h8*)(v0 + 32 * 144 + 32 * s); O1 = MFMA32(a1, pf[s], O1); }
}
__device__ __forceinline__ float rowmax64(const f32x16& S0, const f32x16& S1) {
    float mx = fmaxf(S0[0], S1[0]);
#pragma unroll
    for (int r = 1; r < 16; ++r) mx = fmaxf(mx, fmaxf(S0[r], S1[r]));
    return fmaxf(mx, __shfl_xor(mx, 32));
}
__device__ __forceinline__ void softmax64(f32x16& S0, f32x16& S1, float& m, float& l, f32x16& O0, f32x16& O1) {
    const float mn = fmaxf(m, rowmax64(S0, S1)), alpha = __builtin_amdgcn_exp2f(m - mn);
    m = mn; float ps = 0.f;
#pragma unroll
    for (int r = 0; r < 16; ++r) { S0[r] = __builtin_amdgcn_exp2f(S0[r] - mn); S1[r] = __builtin_amdgcn_exp2f(S1[r] - mn); ps += S0[r] + S1[r]; }
    l = l * alpha + ps;
    if (__any(alpha != 1.f)) {
#pragma unroll
        for (int r = 0; r < 16; ++r) { O0[r] *= alpha; O1[r] *= alpha; }
    }
}
__device__ __forceinline__ void init_near(f32x16& S0, f32x16& S1, const LAS float* TRh, int dq, int hb, int step, int wlim) {
#pragma unroll
    for (int r = 0; r < 16; ++r) {
        const int k0 = 16 * (r >> 3) + 8 * hb + 4 * ((r >> 2) & 1) + (r & 3);
        const int d0 = dq - step * k0, d1 = dq - step * (k0 + 32);
        const float b0 = TRh[d0 < 0 ? 0 : (d0 > 128 ? 128 : d0)], b1 = TRh[d1 < 0 ? 0 : (d1 > 128 ? 128 : d1)];
        S0[r] = (d0 >= 0 && d0 < wlim) ? b0 : -INFINITY; S1[r] = (d1 >= 0 && d1 < wlim) ? b1 : -INFINITY;
    }
}
__device__ __forceinline__ void init_const(f32x16& S0, f32x16& S1, float c) {
#pragma unroll
    for (int r = 0; r < 16; ++r) { S0[r] = c; S1[r] = c; }
}

__device__ __forceinline__ void fox_tile(const LAS unsigned char* sbp, int h, const h8 (&q)[4], int qi, int hb, bool diag, int kbase, int t, float& m, float& l, f32x16& O0, f32x16& O1) {
    const LAS unsigned char* Kh = sbp + h * 4608; const LAS unsigned char* Vh = sbp + 18432 + h * 5120;
    const LAS float* cbh = (const LAS float*)(sbp + 38912) + h * 32;
    f32x16 S;
#pragma unroll
    for (int g = 0; g < 4; ++g) { const f32x4 c4 = *(const LAS f32x4*)(cbh + 16 * (g >> 1) + 8 * hb + 4 * (g & 1)); S[4 * g] = c4.x; S[4 * g + 1] = c4.y; S[4 * g + 2] = c4.z; S[4 * g + 3] = c4.w; }
#pragma unroll
    for (int kk = 0; kk < 4; ++kk) { const h8 a = *(const LAS h8*)(Kh + pi16(qi) * 144 + (16 * kk + 8 * hb) * 2); S = MFMA32(a, q[kk], S); }
    if (diag) {
#pragma unroll
        for (int r = 0; r < 16; ++r) { const int key = kbase + 16 * (r >> 3) + 8 * hb + 4 * ((r >> 2) & 1) + (r & 3); if (key > t) S[r] = -INFINITY; }
    }
    float mx = S[0];
#pragma unroll
    for (int r = 1; r < 16; ++r) mx = fmaxf(mx, S[r]);
    mx = fmaxf(mx, __shfl_xor(mx, 32));
    const float mn = fmaxf(m, mx), alpha = __builtin_amdgcn_exp2f(m - mn);
    m = mn;
    float ps = 0.f;
#pragma unroll
    for (int r = 0; r < 16; ++r) { S[r] = __builtin_amdgcn_exp2f(S[r] - mn); ps += S[r]; }
    l = l * alpha + ps;
    if (__any(alpha != 1.f)) {
#pragma unroll
        for (int r = 0; r < 16; ++r) { O0[r] *= alpha; O1[r] *= alpha; }
    }
    h8 pf0, pf1;
#pragma unroll
    for (int e = 0; e < 8; ++e) { pf0[e] = (half_t)S[e]; pf1[e] = (half_t)S[8 + e]; }
    { const h8 a = *(const LAS h8*)(Vh + qi * 80 + (8 * hb) * 2); O0 = MFMA32(a, pf0, O0); }
    { const h8 a = *(const LAS h8*)(Vh + qi * 80 + (16 + 8 * hb) * 2); O0 = MFMA32(a, pf1, O0); }
    { const h8 a = *(const LAS h8*)(Vh + (32 + qi) * 80 + (8 * hb) * 2); O1 = MFMA32(a, pf0, O1); }
    { const h8 a = *(const LAS h8*)(Vh + (32 + qi) * 80 + (16 + 8 * hb) * 2); O1 = MFMA32(a, pf1, O1); }
}
__device__ __forceinline__ void nsa_tile(bool near, int dq, int wlim, float cinit, const LAS float* TRh, const h8 (&q)[4], const LAS unsigned char* stage, float& m, float& l, f32x16& O0, f32x16& O1, int qi, int hb) {
    f32x16 S0, S1;
    if (near) init_near(S0, S1, TRh, dq, hb, 1, wlim); else init_const(S0, S1, cinit);
    qk64(S0, S1, q, stage, qi, hb);
    softmax64(S0, S1, m, l, O0, O1);
    pv64(S0, S1, stage + 9216, O0, O1, qi, hb);
}

#define MFMA16(a, b, c) __builtin_amdgcn_mfma_f32_16x16x32_f16(a, b, c, 0, 0, 0)
template <bool FINAL>
__device__ __forceinline__ void lru_unit(const Params& P, int L, int ui, LAS unsigned char* lds, const half_t* Z, const half_t* WGT, const float* LSPp, float* LRUAGG, half_t* MIXED, int wave, float& hcarry, bool first) {
    int tid = threadIdx.x; asm volatile("" : "+v"(tid)); const int lane = tid & 63;
    const int b = ui >> 7, sub = ui & 127, t0 = sub * 32; const size_t tokb = (size_t)b * SEQ;
    LAS float* xcF = (LAS float*)lds;
    LAS float* Aa = (LAS float*)(lds + 32768);
    LAS half_t* xcH = (LAS half_t*)(lds + 65536);
    LAS float* Sc = (LAS float*)(lds + 82944);
    {
        const int c = tid & 255, q2 = tid >> 8, ta = t0 + 16 * q2;
        const float w0 = P.lru_conv_w[(L * 4 + 0) * 256 + c], w1 = P.lru_conv_w[(L * 4 + 1) * 256 + c], w2 = P.lru_conv_w[(L * 4 + 2) * 256 + c], w3 = P.lru_conv_w[(L * 4 + 3) * 256 + c], cb = P.lru_conv_b[L * 256 + c];
        const half_t* zp = Z + (tokb + ta) * NZP + ZC_LRU_X + c;
        float x0 = ta >= 3 ? (float)zp[-3 * NZP] : 0.f, x1 = ta >= 2 ? (float)zp[-2 * NZP] : 0.f, x2 = ta >= 1 ? (float)zp[-1 * NZP] : 0.f;
#pragma unroll
        for (int i = 0; i < 16; ++i) { const float x3 = (float)zp[(size_t)i * NZP]; const float v = cb + w0 * x0 + w1 * x1 + w2 * x2 + w3 * x3;
            xcF[(16 * q2 + i) * 256 + c] = v; xcH[(16 * q2 + i) * 264 + c] = (half_t)v; x0 = x1; x1 = x2; x2 = x3; }
    }
    __syncthreads();
    {
        const int blk = wave & 3, th = wave >> 2, r16 = lane & 15, kq = lane >> 4;
        const h8 a0 = *(const LAS h8*)(xcH + (16 * th + r16) * 264 + blk * 64 + 8 * kq), a1 = *(const LAS h8*)(xcH + (16 * th + r16) * 264 + blk * 64 + 32 + 8 * kq);
#pragma unroll
        for (int cbk = 0; cbk < 4; ++cbk) {
            const half_t* wr = WGT + ((size_t)((L * 2 + 0) * 4 + blk) * 64 + 16 * cbk + r16) * 64 + 8 * kq; const half_t* wi = wr + 4 * 64 * 64;
            f32x4 ar = {0.f, 0.f, 0.f, 0.f}, ai = {0.f, 0.f, 0.f, 0.f};
            ar = MFMA16(a0, *(const h8*)wr, ar); ar = MFMA16(a1, *(const h8*)(wr + 32), ar);
            ai = MFMA16(a0, *(const h8*)wi, ai); ai = MFMA16(a1, *(const h8*)(wi + 32), ai);
            const int c = blk * 64 + 16 * cbk + r16;
            const float br = P.lru_b_gates[(L * 2 + 0) * 256 + c], bi = P.lru_b_gates[(L * 2 + 1) * 256 + c];
            const float lsp = LSPp[L * 256 + c];
#pragma unroll
            for (int rg = 0; rg < 4; ++rg) { const int tl = 16 * th + 4 * kq + rg;
                const float r = __builtin_amdgcn_rcpf(1.f + __builtin_amdgcn_exp2f(-LOG2E * (ar[rg] + br))), ii = __builtin_amdgcn_rcpf(1.f + __builtin_amdgcn_exp2f(-LOG2E * (ai[rg] + bi)));
                const float xc = xcF[tl * 256 + c];
                const float a = __builtin_amdgcn_exp2f(lsp * r), bb = __builtin_amdgcn_sqrtf(fmaxf(1.f - a * a, 0.f)) * (ii * xc);
                Aa[tl * 256 + c] = a; xcF[tl * 256 + c] = bb; }
        }
    }
    __syncthreads();
    if (tid < 256) {
        const int c = tid;
        if (!FINAL) {
            float h = 0.f, Ap = 1.f;
#pragma unroll 8
            for (int i = 0; i < 32; ++i) { const float a = Aa[i * 256 + c], bb = xcF[i * 256 + c]; h = fmaf(a, h, bb); Ap *= a; }
            float* ag = LRUAGG + (((size_t)b * 128 + sub) * 256 + c) * 2; ag[0] = Ap; ag[1] = h;
        } else {
            float h = hcarry;
            if (first) { h = 0.f; const float* ag = LRUAGG + ((size_t)b * 128 * 256 + c) * 2;
              for (int s0 = 0; s0 < sub; s0 += 16) {
                  typedef float f32x2 __attribute__((ext_vector_type(2)));
                  f32x2 pr[16];
#pragma unroll
                  for (int k = 0; k < 16; ++k) pr[k] = (s0 + k < sub) ? *(const f32x2*)(ag + (size_t)(s0 + k) * 512) : (f32x2){1.f, 0.f};
#pragma unroll
                  for (int k = 0; k < 16; ++k) h = fmaf(pr[k].x, h, pr[k].y); } }
            const half_t* gp = Z + (tokb + t0) * NZP + ZC_LRU_G + c;
#pragma unroll 8
            for (int i = 0; i < 32; ++i) { const float a = Aa[i * 256 + c], bb = xcF[i * 256 + c]; h = fmaf(a, h, bb);
                const float gx = (float)gp[(size_t)i * NZP];
                Aa[i * 256 + c] = h * gx * __builtin_amdgcn_rcpf(1.f + __builtin_amdgcn_exp2f(-2.f * LOG2E * 0.7978845608028654f * (gx + 0.044715f * gx * gx * gx))); }
            hcarry = h;
        }
    } else if (FINAL) {
        const int c = tid - 256;
        const float w0 = P.sc_conv_w[(L * 3 + 0) * 256 + c], w1 = P.sc_conv_w[(L * 3 + 1) * 256 + c], w2 = P.sc_conv_w[(L * 3 + 2) * 256 + c];
        const half_t* zp = Z + (tokb + t0) * NZP + c;
        float u0 = t0 >= 2 ? (float)zp[-2 * NZP + ZC_SC_C] * (float)zp[-2 * NZP + ZC_SC_X] : 0.f, u1 = t0 >= 1 ? (float)zp[-1 * NZP + ZC_SC_C] * (float)zp[-1 * NZP + ZC_SC_X] : 0.f;
#pragma unroll 8
        for (int i = 0; i < 32; ++i) { const half_t* zr = zp + (size_t)i * NZP; const float u2 = (float)zr[ZC_SC_C] * (float)zr[ZC_SC_X];
            Sc[i * 256 + c] = (float)zr[ZC_SC_B] * (w0 * u0 + w1 * u1 + w2 * u2); u0 = u1; u1 = u2; }
    }
    __syncthreads();
    if (FINAL) {
        const f32x4 ga = *(const f32x4*)(P.out_norm + (L * 4 + 0) * 256 + 4 * lane), gbv = *(const f32x4*)(P.out_norm + (L * 4 + 1) * 256 + 4 * lane);
#pragma unroll
        for (int i = 0; i < 4; ++i) { const int tl = wave * 4 + i; half_t* op = MIXED + (tokb + t0 + tl) * D + 4 * lane;
            { const f32x4 v = *(const LAS f32x4*)(Aa + tl * 256 + 4 * lane); const float rs = rsqrtf(wave_sum((v.x * v.x + v.y * v.y) + (v.z * v.z + v.w * v.w)) * (1.f / 256.f) + EPS);
              u32x2 o; o.x = pack_h2(v.x * rs * ga.x, v.y * rs * ga.y); o.y = pack_h2(v.z * rs * ga.z, v.w * rs * ga.w); *(u32x2*)op = o; }
            { const f32x4 v = *(const LAS f32x4*)(Sc + tl * 256 + 4 * lane); const float rs = rsqrtf(wave_sum((v.x * v.x + v.y * v.y) + (v.z * v.z + v.w * v.w)) * (1.f / 256.f) + EPS);
              u32x2 o; o.x = pack_h2(v.x * rs * gbv.x, v.y * rs * gbv.y); o.y = pack_h2(v.z * rs * gbv.z, v.w * rs * gbv.w); *(u32x2*)(op + 256) = o; }
        }
        __syncthreads();
    }
}

__global__ void __launch_bounds__(NTHR, 2) hymba_fwd(Params P) {
    extern __shared__ __attribute__((aligned(16))) unsigned char lds_raw[];
    LAS unsigned char* lds = (LAS unsigned char*)lds_raw;
    volatile LAS unsigned* MISC = (volatile LAS unsigned*)(lds + MISC_OFF);
    const int tid = threadIdx.x, lane = tid & 63, wave = __builtin_amdgcn_readfirstlane(tid >> 6);
    const int G = gridDim.x, bid = blockIdx.x;
    unsigned char* ws = P.ws;
    unsigned* ctl = (unsigned*)(ws + WS_CTL);
    float* SSQA = (float*)(ws + WS_SSQA); float* SSQB = (float*)(ws + WS_SSQB); float* CFOX = (float*)(ws + WS_CFOX); float* KVC = (float*)(ws + WS_KVC);
    float* LRUAGG = (float*)(ws + WS_LRUAGG); float* CB = (float*)(ws + WS_CB); float* YD = (float*)(ws + WS_YD);
    half_t* WIN_T = (half_t*)(ws + WS_WIN); half_t* WOUT_T = (half_t*)(ws + WS_WOUT); half_t* WGU_T = (half_t*)(ws + WS_WGU); half_t* WDN_T = (half_t*)(ws + WS_WDN);
    half_t* FOXVT = (half_t*)(ws + WS_FOXVT); half_t* VST = (half_t*)(ws + WS_VST); half_t* VWT = (half_t*)(ws + WS_VWT); half_t* KCH = (half_t*)(ws + WS_KCH); half_t* VCT = (half_t*)(ws + WS_VCT); half_t* W1T = (half_t*)(ws + WS_W1T); half_t* WGT = (half_t*)(ws + WS_WGT); half_t* XH = (half_t*)(ws + WS_XH); half_t* MIXED = (half_t*)(ws + WS_MIXED); half_t* Z = (half_t*)(ws + WS_Z); half_t* HB = (half_t*)(ws + WS_Z);

    for (int u = tid; u < 64; u += NTHR) MISC[u] = 0u;
    __syncthreads();
    XcdBarrier bar = xcd_barrier_post(ctl + CW_BAR, MISC + 8);

    const int gw = bid * NWAVES + wave, NGW = G * NWAVES;

#ifndef SKIP_P0
    for (int rp0 = 0; rp0 < REP_P0; ++rp0) {
        LAS unsigned* scr = (LAS unsigned*)(lds + wave * 8448);
        constexpr int I_IN = 16 * 44, I_OUT = 16 * 16, I_GU = 16 * 88, I_DN = 44 * 16, PER_L = I_IN + I_OUT + I_GU + I_DN;
        for (int it = gw; it < 2 * PER_L; it += NGW) {
            const int L = it / PER_L; int r = it % PER_L;
            if (r < I_IN) { p0_item<1>(P.w_in + (size_t)L * D * NIN_SRC, D, NIN_SRC, P.norm_mix + L * D, WIN_T + (size_t)L * NZP * D, r, 44, scr, lane); continue; } r -= I_IN;
            if (r < I_OUT) { p0_item<0>(P.w_out + (size_t)L * D * D, D, D, nullptr, WOUT_T + (size_t)L * D * D, r, 16, scr, lane); continue; } r -= I_OUT;
            if (r < I_GU) { p0_item<2>(P.w_gate_up + (size_t)L * D * 2 * DFF, D, 2 * DFF, P.norm_ffn + L * D, WGU_T + (size_t)L * 2 * DFF * D, r, 88, scr, lane); continue; } r -= I_GU;
            p0_item<0>(P.w_down + (size_t)L * DFF * D, DFF, D, nullptr, WDN_T + (size_t)L * D * DFF, r, 16, scr, lane);
        }
        for (int it = gw; it < 4 * 64 + 16; it += NGW) {
            if (it < 256) { const int ln = it >> 6; p0_item<0>(P.nsa_cmp_w1 + (size_t)ln * 2048 * 128, 2048, 128, nullptr, W1T + (size_t)ln * 128 * 2048, it & 63, 2, scr, lane); }
            else { const int gi = it - 256; p0_item<0>(P.lru_w_gates + (size_t)gi * 64 * 64, 64, 64, nullptr, WGT + (size_t)gi * 64 * 64, 0, 1, scr, lane); }
        }
        for (int o = gw; o < 2 * 2 * 128; o += NGW) {
            const int m = o & 127, ln = o >> 7;
            const float* pp = P.nsa_cmp_pos + (size_t)ln * 2048; const float* wp = P.nsa_cmp_w1 + (size_t)ln * 2048 * 128 + m;
            float s = 0.f;
            for (int i = lane; i < 2048; i += 64) s = fmaf(pp[i], wp[(size_t)i * 128], s);
            s = wave_sum(s);
            if (lane == 0) CB[o] = s;
        }
        for (int o = bid * NTHR + tid; o < 512; o += G * NTHR) CB[1024 + o] = -8.0f * LOG2E * log1pf(expf(-P.lru_lambda[o]));
        for (int row = gw; row < T; row += NGW) {
            const f32x4* xr = (const f32x4*)(P.x + (size_t)row * D) + lane;
            float s = 0.f;
#pragma unroll
            for (int j = 0; j < 4; ++j) { const f32x4 v = xr[64 * j]; s += (v.x * v.x + v.y * v.y) + (v.z * v.z + v.w * v.w);
                u32x2 o; o.x = pack_h2(v.x, v.y); o.y = pack_h2(v.z, v.w); *(u32x2*)(XH + (size_t)row * D + 4 * (lane + 64 * j)) = o; }
            s = wave_sum(s);
            if (lane < 16) SSQB[(size_t)row * 16 + lane] = lane == 0 ? s : 0.f;
        }
    }
#endif
    xcd_barrier(bar);

    for (int L = 0; L < 2; ++L) {
#ifndef SKIP_G1
        {
            pg8::Gemm g{XH, WIN_T + (size_t)L * NZP * D, T, NZP, D}; pg8::StaticOrder S; S.init(T, NZP, G, bid);
            EpiZ E{Z, SSQB};
            for (int rp = 0; rp < REP_G1; ++rp) pg8::gemm_phase<EpiZ, pg8::StaticOrder>(lds, g, S, E);
        }
#endif
        xcd_barrier(bar);

        {
#ifndef SKIP_P2AB
            {
                int tid = threadIdx.x; asm volatile("" : "+v"(tid)); const int lane = tid & 63;
                const int g8 = lane >> 3, sub = lane & 7;
                for (int dry = NORM_DRY; dry >= 0; --dry)
                for (int tok = gw; tok < T; tok += NGW) {
#pragma unroll
                    for (int rr = 0; rr < 2; ++rr) {
                        const int r = g8 + 8 * rr;
                        if (r < 14) {
                            int col; const float* gain;
                            if (r < 4) { col = ZC_FOX_Q + 64 * r; gain = P.fox_qk_norm + (L * 2 + 0) * 64; }
                            else if (r < 8) { col = ZC_FOX_K + 64 * (r - 4); gain = P.fox_qk_norm + (L * 2 + 1) * 64; }
                            else if (r < 12) { col = ZC_NSA_Q + 64 * (r - 8); gain = P.nsa_qk_norm + (L * 4 + 0) * 64; }
                            else if (r == 12) { col = ZC_KS; gain = P.nsa_qk_norm + (L * 4 + 2) * 64; }
                            else { col = ZC_KW; gain = P.nsa_qk_norm + (L * 4 + 3) * 64; }
                            half_t* p = Z + (size_t)tok * NZP + col + 8 * sub;
                            const h8 v = *(const h8*)p; float f[8]; float s = 0.f;
#pragma unroll
                            for (int e = 0; e < 8; ++e) { f[e] = (float)v[e]; s += f[e] * f[e]; }
                            s += __shfl_xor(s, 1); s += __shfl_xor(s, 2); s += __shfl_xor(s, 4);
                            const float rs = rsqrtf(s * (1.f / 64.f) + EPS) * ((r < 4 || (r >= 8 && r < 12)) ? QSCALE : 1.f);
                            const f32x4 g0 = *(const f32x4*)(gain + 8 * sub), g1 = *(const f32x4*)(gain + 8 * sub + 4);
                            if (dry) *(h8*)p = v; else
                            *(u32x4*)p = pack_h8((f32x4){f[0] * rs * g0.x, f[1] * rs * g0.y, f[2] * rs * g0.z, f[3] * rs * g0.w}, (f32x4){f[4] * rs * g1.x, f[5] * rs * g1.y, f[6] * rs * g1.z, f[7] * rs * g1.w});
                        }
                    }
                }
            }
            for (int rp = 0; rp < REP_CUM; ++rp)
            if (wave == 1 && (bid & 7) == 0 && (bid >> 3) < 32) {
                int tid = threadIdx.x; asm volatile("" : "+v"(tid)); const int lane = tid & 63;
                const int task = bid >> 3, b = task >> 2, h = task & 3;
                const float fb = P.fox_f_bias[L * 4 + h];
                float carry = 0.f;
                for (int it = 0; it < SEQ / 64; ++it) {
                    const size_t tok = (size_t)b * SEQ + it * 64 + lane;
                    float v = log_sigmoid((float)Z[tok * NZP + ZC_FOX_F + h] + fb);
#pragma unroll
                    for (int o = 1; o < 64; o <<= 1) { const float n = __shfl_up(v, o); if (lane >= o) v += n; }
                    v += carry;
                    CFOX[((size_t)b * 4 + h) * SEQ + it * 64 + lane] = v;
                    carry = __shfl(v, 63);
                }
            }
#endif
            for (int rp = 0; rp < REP_VT; ++rp)
            for (int ui = bid; ui < 512; ui += G) {
                int tid = threadIdx.x; asm volatile("" : "+v"(tid));
                const int b = ui >> 6, chunk = ui & 63; const size_t tokb = (size_t)b * SEQ + chunk * 64;
                LAS half_t* tb = (LAS half_t*)lds;
#pragma unroll
                for (int i = 0; i < 4; ++i) { const int p = tid + 512 * i, tk = p >> 5, c8 = p & 31;
                    *(LAS h8*)(tb + tk * 264 + 8 * c8) = *(const h8*)(Z + (tokb + tk) * NZP + ZC_FOX_V + 8 * c8); }
                LAS half_t* tb2 = tb + 64 * 264;
#pragma unroll
                for (int i = 0; i < 2; ++i) { const int p = tid + 512 * i, tk = p >> 4, c8 = p & 15;
                    *(LAS h8*)(tb2 + tk * 136 + 8 * c8) = *(const h8*)(Z + (tokb + tk) * NZP + (c8 < 8 ? ZC_VS + 8 * c8 : ZC_VW + 8 * (c8 - 8))); }
                __syncthreads();
                {
                    const int col = tid & 255, ktl = tid >> 8;
                    half_t* dst = FOXVT + ((size_t)(b * 128 + chunk * 2 + ktl) * 256 + col) * 32;
#pragma unroll
                    for (int j4 = 0; j4 < 4; ++j4) { h8 o;
#pragma unroll
                        for (int e = 0; e < 8; ++e) o[e] = tb[(32 * ktl + 8 * j4 + e) * 264 + col];
                        *(h8*)(dst + 8 * j4) = o; }
#pragma unroll
                    for (int i = 0; i < 2; ++i) { const int p = tid + 512 * i, which = p >> 9, d = (p >> 3) & 63, ch = p & 7; h8 o;
#pragma unroll
                        for (int e = 0; e < 8; ++e) o[e] = tb2[(8 * ch + e) * 136 + 64 * which + d];
                        *(h8*)((which ? VWT : VST) + ((size_t)(b * 64 + chunk) * 64 + d) * 64 + 8 * ch) = o; }
                }
                __syncthreads();
            }
#ifndef SKIP_P2LRU
            for (int rp = 0; rp < REP_P2LRU; ++rp)
            for (int ui = bid; ui < 1024; ui += G) { float hc = 0.f; lru_unit<false>(P, L, ui, lds, Z, WGT, CB + 1024, LRUAGG, MIXED, wave, hc, true); }
#endif
#ifndef SKIP_P2CMP
            for (int rp = 0; rp < REP_P2CMP; ++rp)
            for (int ui = bid; ui < 256; ui += G) {
                int tid = threadIdx.x; asm volatile("" : "+v"(tid)); const int lane = tid & 63, r16 = lane & 15, kq = lane >> 4;
                const int net = ui >> 7, b = (ui >> 4) & 7, n0 = (ui & 15) * 16;
                const size_t tokb = (size_t)b * SEQ;
                LAS float* hidb = (LAS float*)lds;
                {
                    const half_t* w1t = W1T + ((size_t)((L * 2 + net) * 128 + 16 * wave + r16)) * 2048 + 8 * kq;
                    int na = n0 + r16; if (na > 254) na = 254;
                    const half_t* za = Z + (tokb + 16 * na) * NZP + (net ? ZC_VC : ZC_KC) + 8 * kq;
                    f32x4 c0 = {0.f, 0.f, 0.f, 0.f}, c1 = {0.f, 0.f, 0.f, 0.f};
#pragma unroll 8
                    for (int s = 0; s < 64; s += 2) {
                        c0 = MFMA16(*(const h8*)(za + (size_t)(s >> 1) * NZP), *(const h8*)(w1t + 32 * s), c0);
                        c1 = MFMA16(*(const h8*)(za + (size_t)(s >> 1) * NZP + 32), *(const h8*)(w1t + 32 * s + 32), c1); }
                    const int m = 16 * wave + r16; const float cbm = CB[(L * 2 + net) * 128 + m];
#pragma unroll
                    for (int rg = 0; rg < 4; ++rg) hidb[(4 * kq + rg) * 132 + m] = gelu_tanh((c0[rg] + c1[rg]) + cbm);
                }
                __syncthreads();
                {
                    const int d = lane; const float* w2 = P.nsa_cmp_w2 + (size_t)(L * 2 + net) * 128 * 64 + d;
                    float o0 = 0.f, o1 = 0.f; const LAS float* hp = hidb + (2 * wave) * 132;
#pragma unroll 16
                    for (int m = 0; m < 128; ++m) { const float w = w2[m * 64]; o0 = fmaf(hp[m], w, o0); o1 = fmaf(hp[132 + m], w, o1); }
                    float ov[2] = {o0, o1};
#pragma unroll
                    for (int i = 0; i < 2; ++i) { float o = ov[i]; const int n = n0 + 2 * wave + i;
                        if (net == 0) { const float ss = wave_sum(o * o); o = o * rsqrtf(ss * (1.f / 64.f) + EPS) * P.nsa_qk_norm[(L * 4 + 1) * 64 + d]; }
                        if (n >= NCMP) o = 0.f;
                        if (net == 0) KCH[((size_t)b * 256 + n) * 64 + d] = (half_t)o; else VCT[((size_t)b * 64 + d) * 256 + n] = (half_t)o; }
                }
                __syncthreads();
            }
#endif
        }
        xcd_barrier(bar);

#ifndef SKIP_FOX
        for (int rp = 0; rp < REP_FOX; ++rp)
        for (int ui = bid; ui < 512; ui += G) {
            int tid = threadIdx.x; asm volatile("" : "+v"(tid)); const int lane = tid & 63, hb = lane >> 5, qi = lane & 31;
            const int h = wave & 3, rh = wave >> 2;
            const int b = ui & 7, qt = (ui >> 8) ? ((ui & 255) >> 3) : 63 - (ui >> 3), t0 = qt * 64, t = t0 + 32 * rh + qi;
            const size_t tokb = (size_t)b * SEQ;
            const float* cf = CFOX + (size_t)b * 4 * SEQ;
            constexpr int FX_VT = 18432, FX_CB = 38912, FX_STAGE = 39424, FX_EX = 2 * FX_STAGE, FX_MISC = FX_EX + 1024;
            LAS unsigned* misc = (LAS unsigned*)(lds + FX_MISC);
            if (wave == 0) {
                float gq = fabsf(P.fox_qk_norm[(L * 2 + 0) * 64 + lane]), gk = fabsf(P.fox_qk_norm[(L * 2 + 1) * 64 + lane]);
#pragma unroll
                for (int o = 1; o < 64; o <<= 1) { gq = fmaxf(gq, __shfl_xor(gq, o)); gk = fmaxf(gk, __shfl_xor(gk, o)); }
                const float bound = -(30.f + 16.f * gq * gk);
                bool c0 = false, c1 = false;
#pragma unroll
                for (int hh = 0; hh < 4; ++hh) { const float cref = cf[hh * SEQ + t0];
                    const int e0 = 32 * lane + 31, e1 = 32 * (lane + 64) + 31;
                    c0 = c0 || (e0 >= t0) || (cref - cf[hh * SEQ + (e0 < SEQ ? e0 : SEQ - 1)] > bound);
                    c1 = c1 || (e1 >= t0) || (cref - cf[hh * SEQ + (e1 < SEQ ? e1 : SEQ - 1)] > bound); }
                const unsigned long long b0 = __ballot(c0), b1 = __ballot(c1);
                if (lane == 0) misc[0] = b0 ? (unsigned)__builtin_ctzll(b0) : 64u + (unsigned)__builtin_ctzll(b1);
            }
            __syncthreads();
            const int kt_lo = __builtin_amdgcn_readfirstlane((int)misc[0]), kt_hi = 2 * qt + 1;
            h8 q[4];
#pragma unroll
            for (int kk = 0; kk < 4; ++kk) q[kk] = *(const h8*)(Z + (tokb + t) * NZP + ZC_FOX_Q + 64 * h + 16 * kk + 8 * hb);
            f32x16 O0, O1;
#pragma unroll
            for (int r = 0; r < 16; ++r) { O0[r] = 0.f; O1[r] = 0.f; }
            float m = -1e30f, l = 0.f;
            u32x4 krA[2], vrA[2], krB[2], vrB[2]; float cbA = 0.f, cbB = 0.f;
#define FX_ISSUE(KR, VR, CB, kt_) do { _Pragma("unroll") for (int i_ = 0; i_ < 2; ++i_) { const int p_ = tid + 512 * i_; \
                KR[i_] = *(const u32x4*)(Z + (tokb + 32 * (kt_) + (p_ >> 5)) * NZP + ZC_FOX_K + 8 * (p_ & 31)); \
                VR[i_] = *(const u32x4*)(FOXVT + ((size_t)(b * 128 + (kt_)) * 256 + (p_ >> 2)) * 32 + 8 * (p_ & 3)); } \
                if (tid < 128) CB = (cf[(tid >> 5) * SEQ + t0] - cf[(tid >> 5) * SEQ + 32 * (kt_) + (tid & 31)]) * LOG2E; } while (0)
#define FX_WRITE(KR, VR, CB, sb_) do { _Pragma("unroll") for (int i_ = 0; i_ < 2; ++i_) { const int p_ = tid + 512 * i_; \
                *(LAS u32x4*)(lds + (sb_) + ((p_ & 31) >> 3) * 4608 + (p_ >> 5) * 144 + (p_ & 7) * 16) = KR[i_]; \
                *(LAS u32x4*)(lds + (sb_) + FX_VT + ((p_ >> 2) >> 6) * 5120 + ((p_ >> 2) & 63) * 80 + (p_ & 3) * 16) = VR[i_]; } \
                if (tid < 128) *(LAS float*)(lds + (sb_) + FX_CB + tid * 4) = CB; } while (0)
            FX_ISSUE(krA, vrA, cbA, kt_lo); FX_WRITE(krA, vrA, cbA, (kt_lo & 1) * FX_STAGE);
            if (kt_lo + 1 <= kt_hi) FX_ISSUE(krA, vrA, cbA, kt_lo + 1);
            __syncthreads();
            int kt = kt_lo;
#define FX_BODY(KX, VX, CX, KY, VY, CY) do { \
                if (kt + 2 <= kt_hi) FX_ISSUE(KY, VY, CY, kt + 2); \
                if (32 * kt <= t0 + 32 * rh + 31) fox_tile(lds + (kt & 1) * FX_STAGE, h, q, qi, hb, 32 * kt + 31 > t0 + 32 * rh, 32 * kt, t, m, l, O0, O1); \
                if (kt + 1 <= kt_hi) FX_WRITE(KX, VX, CX, ((kt + 1) & 1) * FX_STAGE); \
                __syncthreads(); ++kt; } while (0)
            for (;;) { FX_BODY(krA, vrA, cbA, krB, vrB, cbB); if (kt > kt_hi) break; FX_BODY(krB, vrB, cbB, krA, vrA, cbA); if (kt > kt_hi) break; }
#undef FX_BODY
#undef FX_ISSUE
#undef FX_WRITE
            {
                l += __shfl_xor(l, 32);
                const float inv = __builtin_amdgcn_rcpf(l); float ss = 0.f;
#pragma unroll
                for (int r = 0; r < 16; ++r) { O0[r] *= inv; O1[r] *= inv; ss += O0[r] * O0[r] + O1[r] * O1[r]; }
                ss += __shfl_xor(ss, 32);
                LAS float* ex = (LAS float*)(lds + FX_EX);
                const int ridx = 32 * rh + qi;
                if (hb == 0) ex[ridx * 4 + h] = ss;
                __syncthreads();
                const float rs = rsqrtf((ex[ridx * 4] + ex[ridx * 4 + 1] + ex[ridx * 4 + 2] + ex[ridx * 4 + 3]) * (1.f / 256.f) + EPS);
                const float* gn = P.out_norm + (L * 4 + 2) * 256 + h * 64;
                half_t* op = MIXED + (tokb + t) * D + 512 + h * 64;
#pragma unroll
                for (int g = 0; g < 4; ++g) {
                    const int d0 = 8 * g + 4 * hb; const f32x4 g0 = *(const f32x4*)(gn + d0), g1 = *(const f32x4*)(gn + 32 + d0);
                    u32x2 o0, o1;
                    o0.x = pack_h2(O0[4 * g] * rs * g0.x, O0[4 * g + 1] * rs * g0.y); o0.y = pack_h2(O0[4 * g + 2] * rs * g0.z, O0[4 * g + 3] * rs * g0.w);
                    o1.x = pack_h2(O1[4 * g] * rs * g1.x, O1[4 * g + 1] * rs * g1.y); o1.y = pack_h2(O1[4 * g + 2] * rs * g1.z, O1[4 * g + 3] * rs * g1.w);
                    *(u32x2*)(op + d0) = o0; *(u32x2*)(op + 32 + d0) = o1;
                }
            }
            __syncthreads();
        }
#endif
#ifndef SKIP_NSA
        for (int rp = 0; rp < REP_NSA; ++rp)
        for (int ui = bid; ui < 512; ui += G) {
            int tid = threadIdx.x; asm volatile("" : "+v"(tid)); const int lane = tid & 63, hb = lane >> 5, qi = lane & 31;
            const int h = wave & 3, rh = wave >> 2;
            const int b = ui & 7, qt = (ui >> 8) ? ((ui & 255) >> 3) : 63 - (ui >> 3), t0 = qt * 64, t = t0 + 32 * rh + qi, cur = qt, row = 32 * rh + qi;
            const size_t tokb = (size_t)b * SEQ;
            constexpr int NS_VT = 9216, NS_STAGE = 18432, NS_TR = 36864, NS_IMP = 38976, NS_SELM = NS_IMP + 4 * 64 * 65 * 4, NS_EX = NS_SELM + 512, NS_MISC = NS_EX + 1024;
            static_assert(NS_MISC + 256 <= RING_BYTES, "NSA LDS map");
            LAS float* TR = (LAS float*)(lds + NS_TR); LAS float* impH = (LAS float*)(lds + NS_IMP); LAS unsigned* selm = (LAS unsigned*)(lds + NS_SELM);
            LAS float* ex = (LAS float*)(lds + NS_EX); LAS unsigned* misc = (LAS unsigned*)(lds + NS_MISC);
            for (int e = tid; e < 4 * 129; e += NTHR) { const int hh = e / 129, d = e % 129; TR[hh * 132 + d] = P.rel_bias[(d < 128 ? (int)c_bucket[d] : 31) * 4 + hh] * LOG2E; }
            for (int e = tid; e < 4 * 64 * 65; e += NTHR) impH[e] = 0.f;
            const LAS float* TRh = TR + h * 132;
            h8 q[4];
#pragma unroll
            for (int kk = 0; kk < 4; ++kk) q[kk] = *(const h8*)(Z + (tokb + t) * NZP + ZC_NSA_Q + 64 * h + 16 * kk + 8 * hb);
            const float* gb = P.nsa_gate_bias + L * 12;
            const half_t* gz = Z + (tokb + t) * NZP + ZC_NSA_G;
            f32x16 T0, T1;
            u32x4 kr, vr, krB, vrB;
#define NS_ISSUE_R(KR, VR, kbase_, kstride_, vbase_, vstride_) do { KR = *(const u32x4*)((const char*)(kbase_) + (size_t)(tid >> 3) * (kstride_) + (tid & 7) * 16); \
                VR = *(const u32x4*)((const char*)(vbase_) + (size_t)(tid >> 3) * (vstride_) + (tid & 7) * 16); } while (0)
#define NS_WRITE_R(KR, VR, sb_) do { *(LAS u32x4*)(lds + (sb_) + (tid >> 3) * 144 + (tid & 7) * 16) = KR; *(LAS u32x4*)(lds + (sb_) + NS_VT + (tid >> 3) * 144 + (tid & 7) * 16) = VR; } while (0)
#define NS_ISSUE(kbase_, kstride_, vbase_, vstride_) do { kr = *(const u32x4*)((const char*)(kbase_) + (size_t)(tid >> 3) * (kstride_) + (tid & 7) * 16); \
                vr = *(const u32x4*)((const char*)(vbase_) + (size_t)(tid >> 3) * (vstride_) + (tid & 7) * 16); } while (0)
#define NS_WRITE(sb_) do { *(LAS u32x4*)(lds + (sb_) + (tid >> 3) * 144 + (tid & 7) * 16) = kr; *(LAS u32x4*)(lds + (sb_) + NS_VT + (tid >> 3) * 144 + (tid & 7) * 16) = vr; } while (0)
            {
                int cnt = (t0 + 63 - 31) / 16 + 1; if (cnt > NCMP) cnt = NCMP;
                const int ntc = (cnt + 63) >> 6;
                const half_t* kcb = KCH + (size_t)b * 256 * 64; const half_t* vcb = VCT + (size_t)b * 64 * 256;
                float m = -1e30f, l = 0.f;
                for (int c = 0; c < ntc; ++c) {
                    __syncthreads();
                    NS_ISSUE(kcb + (size_t)c * 64 * 64, 128, vcb + c * 64, 512); NS_WRITE(0);
                    __syncthreads();
                    f32x16 S0, S1; init_near(S0, S1, TRh, t - 31 - 1024 * c, hb, 16, 1 << 30);
                    qk64(S0, S1, q, lds, qi, hb);
                    const float mn = fmaxf(m, rowmax64(S0, S1)), alpha = __builtin_amdgcn_exp2f(m - mn);
                    m = mn; float ps = 0.f;
#pragma unroll
                    for (int r = 0; r < 16; ++r) ps += __builtin_amdgcn_exp2f(S0[r] - mn) + __builtin_amdgcn_exp2f(S1[r] - mn);
                    l = l * alpha + ps;
                }
                l += __shfl_xor(l, 32);
                const float il = l > 0.f ? __builtin_amdgcn_rcpf(l) : 0.f;
#pragma unroll
                for (int r = 0; r < 16; ++r) { T0[r] = 0.f; T1[r] = 0.f; }
                for (int c = 0; c < ntc; ++c) {
                    __syncthreads();
                    NS_ISSUE(kcb + (size_t)c * 64 * 64, 128, vcb + c * 64, 512); NS_WRITE(0);
                    __syncthreads();
                    f32x16 S0, S1; init_near(S0, S1, TRh, t - 31 - 1024 * c, hb, 16, 1 << 30);
                    qk64(S0, S1, q, lds, qi, hb);
#pragma unroll
                    for (int r = 0; r < 16; ++r) { S0[r] = __builtin_amdgcn_exp2f(S0[r] - m) * il; S1[r] = __builtin_amdgcn_exp2f(S1[r] - m) * il; }
                    LAS float* ip = impH + (h * 64 + row) * 65 + 16 * c + 2 * hb;
#pragma unroll
                    for (int g = 0; g < 4; ++g) {
                        const int mo = 4 * (g >> 1) + (g & 1);
                        { const float v1 = 16.f * S0[4 * g + 3], v0 = 32.f * ((S0[4 * g] + S0[4 * g + 1]) + S0[4 * g + 2]) + v1;
                          __hip_atomic_fetch_add(ip + mo, v0, __ATOMIC_RELAXED, __HIP_MEMORY_SCOPE_WORKGROUP); if (16 * c + 2 * hb + mo + 1 < 64) __hip_atomic_fetch_add(ip + mo + 1, v1, __ATOMIC_RELAXED, __HIP_MEMORY_SCOPE_WORKGROUP); }
                        { const float v1 = 16.f * S1[4 * g + 3], v0 = 32.f * ((S1[4 * g] + S1[4 * g + 1]) + S1[4 * g + 2]) + v1;
                          __hip_atomic_fetch_add(ip + 8 + mo, v0, __ATOMIC_RELAXED, __HIP_MEMORY_SCOPE_WORKGROUP); if (16 * c + 2 * hb + 8 + mo + 1 < 64) __hip_atomic_fetch_add(ip + 8 + mo + 1, v1, __ATOMIC_RELAXED, __HIP_MEMORY_SCOPE_WORKGROUP); }
                    }
                    pv64(S0, S1, lds + NS_VT, T0, T1, qi, hb);
                }
                const float g0 = sigmoidf_((float)gz[0 * 4 + h] + gb[0 * 4 + h]);
#pragma unroll
                for (int r = 0; r < 16; ++r) { T0[r] *= g0; T1[r] *= g0; }
            }
            __syncthreads();
            for (int rr = 0; rr < 8; ++rr) {
                const int rw = wave * 8 + rr;
                float v = ((impH[(0 * 64 + rw) * 65 + lane] + impH[(1 * 64 + rw) * 65 + lane]) + impH[(2 * 64 + rw) * 65 + lane]) + impH[(3 * 64 + rw) * 65 + lane];
                if (lane > cur) v = -INFINITY; else if (lane == 0 || lane == cur || lane == cur - 1) v = 1e30f;
                int rank = 0;
                for (int o = 0; o < 64; ++o) { const float w = __shfl(v, o); rank += (w > v || (w == v && o < lane)) ? 1 : 0; }
                const unsigned long long msk = __ballot(rank < 16);
                if (lane == 0) { selm[rw * 2] = (unsigned)msk; selm[rw * 2 + 1] = (unsigned)(msk >> 32); }
            }
            __syncthreads();
            if (wave == 0) {
                unsigned lo = selm[lane * 2], hi = selm[lane * 2 + 1];
#pragma unroll
                for (int o = 1; o < 64; o <<= 1) { lo |= __shfl_xor(lo, o); hi |= __shfl_xor(hi, o); }
                if (lane == 0) { misc[0] = lo; misc[1] = hi; }
            }
            __syncthreads();
            const unsigned long long mymask = (unsigned long long)selm[row * 2] | ((unsigned long long)selm[row * 2 + 1] << 32);
            unsigned long long um = (unsigned long long)__builtin_amdgcn_readfirstlane((int)misc[0]) | ((unsigned long long)(unsigned)__builtin_amdgcn_readfirstlane((int)misc[1]) << 32);
            um &= (cur >= 63) ? ~0ull : ((1ull << (cur + 1)) - 1ull);
            const float cfar = TRh[128];
            {
                f32x16 O0, O1;
#pragma unroll
                for (int r = 0; r < 16; ++r) { O0[r] = 0.f; O1[r] = 0.f; }
                float m = -1e30f, l = 0.f;
                int jc = __builtin_ctzll(um); um &= um - 1;
                int jn = -1; if (um) { jn = __builtin_ctzll(um); um &= um - 1; }
                int it = 0;
#define SEL_K(j_) (Z + (tokb + 64 * (j_)) * NZP + ZC_KS)
#define SEL_V(j_) (VST + (size_t)(b * 64 + (j_)) * 64 * 64)
                NS_ISSUE_R(kr, vr, SEL_K(jc), NZP * 2, SEL_V(jc), 128); NS_WRITE_R(kr, vr, 0);
                if (jn >= 0) NS_ISSUE_R(kr, vr, SEL_K(jn), NZP * 2, SEL_V(jn), 128);
                __syncthreads();
#define SEL_BODY(KX, VX, KY, VY) do { \
                    int jnn = -1; if (um) { jnn = __builtin_ctzll(um); um &= um - 1; NS_ISSUE_R(KY, VY, SEL_K(jnn), NZP * 2, SEL_V(jnn), 128); } \
                    { const bool sel = (mymask >> jc) & 1ull; \
                      if (__any(sel)) nsa_tile(jc >= cur - 2, t - 64 * jc, sel ? (1 << 30) : 0, sel ? cfar : -INFINITY, TRh, q, lds + (it & 1) * NS_STAGE, m, l, O0, O1, qi, hb); } \
                    if (jn >= 0) NS_WRITE_R(KX, VX, ((it + 1) & 1) * NS_STAGE); \
                    __syncthreads(); jc = jn; jn = jnn; ++it; } while (0)
                for (;;) { SEL_BODY(kr, vr, krB, vrB); if (jc < 0) break; SEL_BODY(krB, vrB, kr, vr); if (jc < 0) break; }
#undef SEL_BODY
#undef SEL_K
#undef SEL_V
                l += __shfl_xor(l, 32);
                const float g1 = sigmoidf_((float)gz[1 * 4 + h] + gb[1 * 4 + h]) * __builtin_amdgcn_rcpf(l);
#pragma unroll
                for (int r = 0; r < 16; ++r) { T0[r] += g1 * O0[r]; T1[r] += g1 * O1[r]; }
            }
            __syncthreads();
            {
                f32x16 O0, O1;
#pragma unroll
                for (int r = 0; r < 16; ++r) { O0[r] = 0.f; O1[r] = 0.f; }
                float m = -1e30f, l = 0.f;
                const int jlo = cur >= 8 ? cur - 8 : 0;
#define WIN_K(j_) (Z + (tokb + 64 * (j_)) * NZP + ZC_KW)
#define WIN_V(j_) (VWT + (size_t)(b * 64 + (j_)) * 64 * 64)
                NS_ISSUE_R(kr, vr, WIN_K(jlo), NZP * 2, WIN_V(jlo), 128); NS_WRITE_R(kr, vr, 0);
                if (jlo + 1 <= cur) NS_ISSUE_R(kr, vr, WIN_K(jlo + 1), NZP * 2, WIN_V(jlo + 1), 128);
                __syncthreads();
                int j = jlo;
#define WIN_BODY(KX, VX, KY, VY) do { \
                    if (j + 2 <= cur) NS_ISSUE_R(KY, VY, WIN_K(j + 2), NZP * 2, WIN_V(j + 2), 128); \
                    nsa_tile(j >= cur - 2 || j == cur - 8, t - 64 * j, 512, cfar, TRh, q, lds + ((j - jlo) & 1) * NS_STAGE, m, l, O0, O1, qi, hb); \
                    if (j + 1 <= cur) NS_WRITE_R(KX, VX, (((j - jlo) + 1) & 1) * NS_STAGE); \
                    __syncthreads(); ++j; } while (0)
                for (;;) { WIN_BODY(kr, vr, krB, vrB); if (j > cur) break; WIN_BODY(krB, vrB, kr, vr); if (j > cur) break; }
#undef WIN_BODY
#undef WIN_K
#undef WIN_V
                l += __shfl_xor(l, 32);
                const float g2 = sigmoidf_((float)gz[2 * 4 + h] + gb[2 * 4 + h]) * __builtin_amdgcn_rcpf(l);
#pragma unroll
                for (int r = 0; r < 16; ++r) { T0[r] += g2 * O0[r]; T1[r] += g2 * O1[r]; }
            }
#undef NS_ISSUE
#undef NS_WRITE
#undef NS_ISSUE_R
#undef NS_WRITE_R
            {
                float ss = 0.f;
#pragma unroll
                for (int r = 0; r < 16; ++r) ss += T0[r] * T0[r] + T1[r] * T1[r];
                ss += __shfl_xor(ss, 32);
                if (hb == 0) ex[row * 4 + h] = ss;
                __syncthreads();
                const float rs = rsqrtf((ex[row * 4] + ex[row * 4 + 1] + ex[row * 4 + 2] + ex[row * 4 + 3]) * (1.f / 256.f) + EPS);
                const float* gn = P.out_norm + (L * 4 + 3) * 256 + h * 64;
                half_t* op = MIXED + (tokb + t) * D + 768 + h * 64;
#pragma unroll
                for (int g = 0; g < 4; ++g) {
                    const int d0 = 8 * g + 4 * hb; const f32x4 g0 = *(const f32x4*)(gn + d0), g1 = *(const f32x4*)(gn + 32 + d0);
                    u32x2 o0, o1;
                    o0.x = pack_h2(T0[4 * g] * rs * g0.x, T0[4 * g + 1] * rs * g0.y); o0.y = pack_h2(T0[4 * g + 2] * rs * g0.z, T0[4 * g + 3] * rs * g0.w);
                    o1.x = pack_h2(T1[4 * g] * rs * g1.x, T1[4 * g + 1] * rs * g1.y); o1.y = pack_h2(T1[4 * g + 2] * rs * g1.z, T1[4 * g + 3] * rs * g1.w);
                    *(u32x2*)(op + d0) = o0; *(u32x2*)(op + 32 + d0) = o1;
                }
            }
            __syncthreads();
        }
#endif
#ifndef SKIP_LRU
        for (int rp = 0; rp < REP_LRU; ++rp)
        for (int gI = bid; gI < 256; gI += G) {
            float hc = 0.f;
            for (int k = 0; k < 4; ++k) lru_unit<true>(P, L, ((gI >> 5) << 7) + 4 * (gI & 31) + k, lds, Z, WGT, CB + 1024, LRUAGG, MIXED, wave, hc, k == 0);
        }
#endif
        xcd_barrier(bar);

#ifndef SKIP_G4
        {
            pg8::Gemm g{MIXED, WOUT_T + (size_t)L * D * D, T, D, D}; pg8::StaticOrder S; S.init(T, D, G, bid);
            EpiRes E{L == 0 ? P.x : P.out, P.out, XH, SSQA};
            for (int rp = 0; rp < REP_G4N; ++rp) { EpiNull EN; pg8::gemm_phase<EpiNull, pg8::StaticOrder>(lds, g, S, EN); }
            pg8::gemm_phase<EpiRes, pg8::StaticOrder>(lds, g, S, E);
        }
#endif
        xcd_barrier(bar);
#ifndef SKIP_G5
        {
            pg8::Gemm g{XH, WGU_T + (size_t)L * 2 * DFF * D, T, 2 * DFF, D}; pg8::StaticOrder S; S.init(T, 2 * DFF, G, bid);
            EpiSwiglu E{HB, SSQA};
            for (int rp = 0; rp < REP_G5; ++rp) pg8::gemm_phase<EpiSwiglu, pg8::StaticOrder>(lds, g, S, E);
        }
#endif
        xcd_barrier(bar);
#ifndef SKIP_G6
        {
            pg8::Gemm g{HB, WDN_T + (size_t)L * D * DFF, T, D, DFF}; pg8::StaticOrder S; S.init(T, D, G, bid);
            EpiRes E{P.out, P.out, L == 0 ? XH : nullptr, L == 0 ? SSQB : nullptr};
            for (int rp = 0; rp < REP_G6N; ++rp) { EpiNull EN; pg8::gemm_phase<EpiNull, pg8::StaticOrder>(lds, g, S, EN); }
            pg8::gemm_phase<EpiRes, pg8::StaticOrder>(lds, g, S, E);
        }
#endif
        if (L == 0) xcd_barrier(bar);
    }
}

extern "C" void kernel_launch(void* const* d_in, const int* in_sizes, int n_in, void* d_out, int out_size, void* d_ws, size_t ws_size, hipStream_t stream) {
    static int grid = 0;
    if (grid == 0) {
        if (n_in != 22 || ws_size < WS_END) { fprintf(stderr, "kernel_launch: unexpected n_in %d or ws_size %zu (< %zu)\n", n_in, ws_size, (size_t)WS_END); grid = -1; return; }
        int dev = 0, cus = 0, per_cu = 0;
        if (hipGetDevice(&dev) != hipSuccess || hipDeviceGetAttribute(&cus, hipDeviceAttributeMultiprocessorCount, dev) != hipSuccess) { grid = -1; return; }
        if (hipFuncSetAttribute((const void*)hymba_fwd, hipFuncAttributeMaxDynamicSharedMemorySize, LDS_BYTES) != hipSuccess) { fprintf(stderr, "kernel_launch: hipFuncSetAttribute failed\n"); grid = -1; return; }
        if (hipOccupancyMaxActiveBlocksPerMultiprocessor(&per_cu, (const void*)hymba_fwd, NTHR, LDS_BYTES) != hipSuccess || per_cu < 1) { fprintf(stderr, "kernel_launch: occupancy query says %d\n", per_cu); }
        (void)hipGetLastError();
        grid = cus;
    }
    if (grid < 0) return;
    (void)hipMemsetAsync((char*)d_ws + WS_CTL, 0, CTL_ZERO_BYTES, stream);
    Params p{};
    p.x = (const float*)d_in[0]; p.norm_mix = (const float*)d_in[1]; p.w_in = (const float*)d_in[2]; p.lru_conv_w = (const float*)d_in[3]; p.lru_conv_b = (const float*)d_in[4];
    p.lru_w_gates = (const float*)d_in[5]; p.lru_b_gates = (const float*)d_in[6]; p.lru_lambda = (const float*)d_in[7]; p.sc_conv_w = (const float*)d_in[8];
    p.fox_f_bias = (const float*)d_in[9]; p.fox_qk_norm = (const float*)d_in[10]; p.nsa_qk_norm = (const float*)d_in[11]; p.nsa_cmp_pos = (const float*)d_in[12];
    p.nsa_cmp_w1 = (const float*)d_in[13]; p.nsa_cmp_w2 = (const float*)d_in[14]; p.nsa_gate_bias = (const float*)d_in[15]; p.rel_bias = (const float*)d_in[16];
    p.out_norm = (const float*)d_in[17]; p.w_out = (const float*)d_in[18]; p.norm_ffn = (const float*)d_in[19]; p.w_gate_up = (const float*)d_in[20]; p.w_down = (const float*)d_in[21];
    p.out = (float*)d_out; p.ws = (unsigned char*)d_ws;
    hipLaunchKernelGGL(hymba_fwd, dim3(grid), dim3(NTHR), LDS_BYTES, stream, p);
}
```

```cpp
#include <hip/hip_runtime.h>
#include <stdint.h>
#include <stdio.h>

#define LAS __attribute__((address_space(3)))
typedef _Float16 half_t;
typedef _Float16 h8 __attribute__((ext_vector_type(8)));
typedef _Float16 h4 __attribute__((ext_vector_type(4)));
typedef _Float16 h2 __attribute__((ext_vector_type(2)));
typedef float f32x4 __attribute__((ext_vector_type(4)));
typedef unsigned u32x4 __attribute__((ext_vector_type(4)));
typedef unsigned u32x2 __attribute__((ext_vector_type(2)));
typedef float f32x16 __attribute__((ext_vector_type(16)));
#define MFMA32(a, b, c) __builtin_amdgcn_mfma_f32_32x32x16_f16(a, b, c, 0, 0, 0)
constexpr float LOG2E = 1.4426950408889634f, QSCALE = 0.125f * 1.4426950408889634f;
__device__ __forceinline__ int pi16(int r) { return (r & ~0xC) | ((r & 4) << 1) | ((r & 8) >> 1); }

constexpr int BATCH = 8, SEQ = 4096, T = BATCH * SEQ, D = 1024, NZP = 2816, DFF = 2816, NCMP = 255;
constexpr int NIN_SRC = 2704;
constexpr int ZC_LRU_X = 0, ZC_LRU_G = 256, ZC_SC_B = 512, ZC_SC_C = 768, ZC_SC_X = 1024, ZC_FOX_Q = 1280, ZC_FOX_K = 1536, ZC_FOX_V = 1792,
              ZC_NSA_Q = 2048, ZC_KC = 2304, ZC_VC = 2368, ZC_KS = 2432, ZC_VS = 2496, ZC_KW = 2560, ZC_VW = 2624, ZC_FOX_F = 2688, ZC_NSA_G = 2692;
constexpr float EPS = 1e-6f;
constexpr int NWAVES = 8, NTHR = 512;
#ifndef REP_G1
#define REP_G1 1
#endif
#ifndef REP_P0
#define REP_P0 1
#endif
#ifndef REP_G4N
#define REP_G4N 0
#endif
#ifndef REP_G6N
#define REP_G6N 0
#endif
#ifndef NORM_DRY
#define NORM_DRY 0
#endif
#ifndef REP_NSEL
#define REP_NSEL 1
#endif
#ifndef REP_NWIN
#define REP_NWIN 1
#endif
#ifndef REP_NSELECT
#define REP_NSELECT 1
#endif
#ifndef REP_G5
#define REP_G5 1
#endif
#ifndef REP_CUM
#define REP_CUM 1
#endif
#ifndef REP_VT
#define REP_VT 1
#endif
#ifndef REP_P2LRU
#define REP_P2LRU 1
#endif
#ifndef REP_P2CMP
#define REP_P2CMP 1
#endif
#ifndef REP_FOX
#define REP_FOX 1
#endif
#ifndef REP_NSA
#define REP_NSA 1
#endif
#ifndef REP_LRU
#define REP_LRU 1
#endif

constexpr size_t MiB = 1u << 20;
constexpr size_t WS_CTL = 0, CTL_ZERO_BYTES = 64 * 1024;
constexpr size_t WS_SSQA = 2 * MiB, WS_SSQB = 4 * MiB, WS_CFOX = 6 * MiB, WS_KVC = 7 * MiB, WS_LRUAGG = 9 * MiB, WS_CB = 11 * MiB;
constexpr size_t WS_WIN = 12 * MiB, WS_WOUT = 24 * MiB, WS_WGU = 28 * MiB, WS_WDN = 50 * MiB;
constexpr size_t WS_XH = 62 * MiB, WS_MIXED = 126 * MiB, WS_Z = 190 * MiB, WS_YD = 366 * MiB, WS_FOXVT = 398 * MiB, WS_VST = 414 * MiB, WS_VWT = 418 * MiB, WS_KCH = 422 * MiB, WS_VCT = 423 * MiB, WS_W1T = 424 * MiB, WS_WGT = 426 * MiB, WS_END = 427 * MiB;
static_assert(WS_WIN + 2 * (size_t)NZP * D * 2 <= WS_WOUT && WS_WOUT + 2 * (size_t)D * D * 2 <= WS_WGU && WS_WGU + 2 * (size_t)2 * DFF * D * 2 <= WS_WDN &&
              WS_WDN + 2 * (size_t)D * DFF * 2 <= WS_XH && WS_XH + (size_t)T * D * 2 <= WS_MIXED && WS_MIXED + (size_t)T * D * 2 <= WS_Z &&
              WS_Z + (size_t)T * NZP * 2 <= WS_YD && WS_YD + (size_t)T * 256 * 4 <= WS_FOXVT && WS_FOXVT + (size_t)T * 256 * 2 <= WS_VST, "ws map");
constexpr int CW_BAR = 1024;

constexpr int RING_BYTES = 131072, MISC_OFF = RING_BYTES, LDS_BYTES = 147456;

__device__ __constant__ unsigned char c_bucket[128] = {
 0,1,2,3,4,5,6,7,8,9,10,11,12,13,14,15,
 16,16,16,17,17,18,18,18,19,19,19,20,20,20,20,21,
 21,21,21,22,22,22,22,22,23,23,23,23,23,23,24,24,
 24,24,24,24,25,25,25,25,25,25,25,26,26,26,26,26,
 26,26,26,27,27,27,27,27,27,27,27,27,27,28,28,28,
 28,28,28,28,28,28,28,29,29,29,29,29,29,29,29,29,
 29,29,29,30,30,30,30,30,30,30,30,30,30,30,30,30,
 30,31,31,31,31,31,31,31,31,31,31,31,31,31,31,31};
__device__ __forceinline__ int rel_bucket(int d) { return d >= 128 ? 31 : (int)c_bucket[d < 0 ? 0 : d]; }

__device__ __forceinline__ float sigmoidf_(float x) { return __builtin_amdgcn_rcpf(1.f + __builtin_amdgcn_exp2f(-1.4426950408889634f * x)); }
__device__ __forceinline__ float gelu_tanh(float x) { return x * __builtin_amdgcn_rcpf(1.f + __builtin_amdgcn_exp2f(-2.f * 1.4426950408889634f * 0.7978845608028654f * (x + 0.044715f * x * x * x))); }
__device__ __forceinline__ float log_sigmoid(float x) { const float e = __builtin_amdgcn_exp2f(-1.4426950408889634f * fabsf(x)); return fminf(x, 0.f) - 0.6931471805599453f * __builtin_amdgcn_logf(1.f + e); }
__device__ __forceinline__ u32x4 pack_h8(f32x4 a, f32x4 b) {
    h8 h; h[0] = (half_t)a.x; h[1] = (half_t)a.y; h[2] = (half_t)a.z; h[3] = (half_t)a.w; h[4] = (half_t)b.x; h[5] = (half_t)b.y; h[6] = (half_t)b.z; h[7] = (half_t)b.w;
    return __builtin_bit_cast(u32x4, h);
}
__device__ __forceinline__ unsigned pack_h2(float a, float b) { h2 h; h[0] = (half_t)a; h[1] = (half_t)b; return __builtin_bit_cast(unsigned, h); }
#define LDS_WAIT() asm volatile("s_waitcnt lgkmcnt(0)" ::: "memory")

#define XB_TMO      128
#define XB_XCNT(j)  (256  + 64 * (j))
#define XB_XSUB(j)  (1280 + 64 * (j))
#define XB_XGEN(j)  (2304 + 64 * (j))
#define XB_TOP      3328
#define XB_TOPGEN   3392
#define XCD_BAR_WORDS 3456
#define XB_SPIN_CAP (1u << 20)
__device__ __forceinline__ unsigned xb_ld(unsigned* p)              { return __hip_atomic_load(p, __ATOMIC_RELAXED, __HIP_MEMORY_SCOPE_AGENT); }
__device__ __forceinline__ unsigned xb_add(unsigned* p, unsigned v) { return __hip_atomic_fetch_add(p, v, __ATOMIC_RELAXED, __HIP_MEMORY_SCOPE_AGENT); }
__device__ __forceinline__ unsigned xb_xcc_id() { return (unsigned)__builtin_amdgcn_s_getreg((3 << 11) | 20) & 0xFu; }
#define XB_SPIN(cond, bar) do { unsigned _sp = 0; while (cond) { __builtin_amdgcn_s_sleep(1); \
    if ((++_sp & 255u) == 0u) { if (xb_ld(&(bar)[XB_TMO])) break; if (_sp > XB_SPIN_CAP) { atomicAdd(&(bar)[XB_TMO], 1u); break; } } } } while (0)
struct XcdBarrier { unsigned* bar; unsigned x; volatile LAS unsigned* st; };
__device__ __forceinline__ XcdBarrier xcd_barrier_post(unsigned* bar, volatile LAS unsigned* st) {
    XcdBarrier b; b.bar = bar; b.x = xb_xcc_id(); b.st = st;
    if (threadIdx.x == 0) (void)xb_add(&bar[XB_XCNT(b.x)], 1u);
    return b;
}
__device__ __forceinline__ void xcd_barrier_complete(unsigned* bar, unsigned x, unsigned& nloc, unsigned& nx) {
    const unsigned G = gridDim.x * gridDim.y * gridDim.z;
    unsigned sum, cnt, mine, sp = 0u;
    for (;;) {
        sum = 0u; cnt = 0u; mine = 0u;
#pragma unroll
        for (unsigned j = 0; j < 16; ++j) { const unsigned c = xb_ld(&bar[XB_XCNT(j)]); sum += c; cnt += (c > 0u) ? 1u : 0u; mine = (j == x) ? c : mine; }
        if (sum == G) break;
        __builtin_amdgcn_s_sleep(1);
        if ((++sp & 255u) == 0u) { if (xb_ld(&bar[XB_TMO])) break; if (sp > XB_SPIN_CAP) { atomicAdd(&bar[XB_TMO], 1u); break; } }
    }
    nloc = mine > 0u ? mine : 1u; nx = cnt > 0u ? cnt : 1u;
}
__device__ __forceinline__ void xcd_barrier(const XcdBarrier& b) {
    asm volatile("s_waitcnt vmcnt(0)" ::: "memory");
    __syncthreads();
    if (threadIdx.x == 0) {
        unsigned* bar = b.bar;
        unsigned bx = b.x; asm volatile("" : "+s"(bx));
        __builtin_amdgcn_s_waitcnt(0);
        unsigned nloc = b.st[0], nx = b.st[1];
        if (nloc == 0u) { xcd_barrier_complete(bar, bx, nloc, nx); b.st[0] = nloc; b.st[1] = nx; }
        const unsigned old = xb_add(&bar[XB_XSUB(bx)], 1u);
        const unsigned gen = old / nloc;
        if (old + 1u == (gen + 1u) * nloc) {
            __builtin_amdgcn_fence(__ATOMIC_RELEASE, "agent");
            asm volatile("s_waitcnt vmcnt(0)" ::: "memory");
            const unsigned og = xb_add(&bar[XB_TOP], 1u);
            const unsigned tg = og / nx;
            if (og + 1u == (tg + 1u) * nx) xb_add(&bar[XB_TOPGEN], 1u);
            else XB_SPIN(xb_ld(&bar[XB_TOPGEN]) == tg, bar);
            __builtin_amdgcn_fence(__ATOMIC_ACQUIRE, "agent");
            xb_add(&bar[XB_XGEN(bx)], 1u);
            asm volatile("s_waitcnt vmcnt(0)" ::: "memory");
        } else {
            XB_SPIN(xb_ld(&bar[XB_XGEN(bx)]) == gen, bar);
            __builtin_amdgcn_fence(__ATOMIC_ACQUIRE, "agent");
            asm volatile("s_waitcnt vmcnt(0)" ::: "memory");
        }
    }
    __syncthreads();
}

namespace pg8 {
constexpr int BM = 256, BK = 64, HALF = 128, HTB = HALF * BK * 2, STAGE_BYTES = 8 * HTB, NXCD = 8, WGM = 8;
__host__ __device__ __forceinline__ int lds_byte(int r, int c) { const int st = (r >> 4) * 2 + (c >> 5), rr = r & 15, cc = c & 31, ob = rr * 64 + cc * 2; return st * 1024 + (ob ^ (((ob >> 9) & 1) << 5)); }
__host__ __device__ __forceinline__ void stage_rc(int b, int& R, int& C) { const int st = b / 1024, sb = b % 1024, swz = sb ^ (((sb >> 9) & 1) << 5); R = (st >> 1) * 16 + swz / 64; C = (st & 1) * 32 + (swz % 64) / 2; }
__host__ __device__ __forceinline__ int perm32(int rho) { const int n = rho >> 4, i = rho & 15; return 8 * (i >> 2) + 4 * n + (i & 3); }
struct Unit { int pm, pn; };
struct Gemm { const half_t* A; const half_t* Bt; int M, N, K; };
struct StaticOrder {
    int nM, nN, nwg, G, c;
    __host__ __device__ void init(int M, int N, int G_, int c_) { nM = M / BM; nN = N / BM; nwg = nM * nN; G = G_; c = c_; }
    __host__ __device__ bool next(int i, Unit& u) const {
        const long L = (long)i * G + c; if (L >= nwg) return false;
        int wgid = (int)L; { const int q = nwg / NXCD, r = nwg % NXCD, xcd = wgid % NXCD, off = wgid / NXCD; wgid = (xcd < r ? xcd * (q + 1) : r * (q + 1) + (xcd - r) * q) + off; }
        const int nig = WGM * nN, gid = wgid / nig, fm = gid * WGM, gsz = (nM - fm) < WGM ? (nM - fm) : WGM;
        u.pm = fm + ((wgid % nig) % gsz); u.pn = (wgid % nig) / gsz; return true;
    }
    __device__ __forceinline__ void a_ready(const Unit&) const {}
    __device__ __forceinline__ void done(const Unit&) const {}
};

template <class Epi, class Sched>
__device__ __forceinline__ void gemm_phase(LAS unsigned char* lds, const Gemm g, const Sched& S, const Epi& E) {
    int tid = threadIdx.x; asm volatile("" : "+v"(tid));
    const int wid = __builtin_amdgcn_readfirstlane(tid >> 6), lane = tid & 63, wr = wid >> 2, wc = wid & 3, fr = lane & 15, fq = lane >> 4;
    const int K = g.K, nt = K / BK;
    unsigned voffA[2], voffB[2];
#pragma unroll
    for (int i = 0; i < 2; ++i) { int R, C; stage_rc(tid * 16 + i * 8192, R, C); const int Rb = Epi::PERM ? ((R & ~31) + perm32(R & 31)) : R;
        voffA[i] = (unsigned)(R * K + C) * 2u; voffB[i] = (unsigned)(Rb * K + C) * 2u; }
    const size_t kstep = (size_t)(BK * 2);
    const size_t hstep = (size_t)HALF * K * 2;
    const size_t tstep = 2 * hstep;
    const unsigned ldsw = (unsigned)wid * 1024u;
    const int aoff = lds_byte(wr * 64 + fr, fq * 8), boff = lds_byte(wc * 32 + fr, fq * 8);
#define PG8_SA(b, h) (((b) * 2 + (h)) * HTB)
#define PG8_SB(b, h) ((4 + (b) * 2 + (h)) * HTB)
#define PG8_STAGE(bufoff, gbase, voff) do { _Pragma("unroll") for (int _i = 0; _i < 2; ++_i) \
        __builtin_amdgcn_global_load_lds((const unsigned*)((const char*)(gbase) + (voff)[_i]), (LAS unsigned*)(lds + (bufoff) + ldsw + _i * 8192), 16, 0, 0); } while (0)
#define PG8_LDA(dst, b, h) do { _Pragma("unroll") for (int m = 0; m < 4; ++m) _Pragma("unroll") for (int k = 0; k < 2; ++k) dst[m][k] = *(const LAS h8*)(lds + PG8_SA(b, h) + aoff + m * 2048 + k * 1024); } while (0)
#define PG8_LDB(dst, b, h) do { _Pragma("unroll") for (int n = 0; n < 2; ++n) _Pragma("unroll") for (int k = 0; k < 2; ++k) dst[n][k] = *(const LAS h8*)(lds + PG8_SB(b, h) + boff + n * 2048 + k * 1024); } while (0)
#define PG8_MMA(ai, bj, At, Bt) do { __builtin_amdgcn_s_setprio(1); _Pragma("unroll") for (int m = 0; m < 4; ++m) _Pragma("unroll") for (int n = 0; n < 2; ++n) _Pragma("unroll") for (int k = 0; k < 2; ++k) \
        acc[ai][bj][m][n] = __builtin_amdgcn_mfma_f32_16x16x32_f16(Bt[n][k], At[m][k], acc[ai][bj][m][n], 0, 0, 0); __builtin_amdgcn_s_setprio(0); } while (0)
#define PG8_WAIT_V(n) asm volatile("s_waitcnt vmcnt(" #n ")" ::: "memory")
#define PG8_WAIT_L(n) asm volatile("s_waitcnt lgkmcnt(" #n ")" ::: "memory")
#define PG8_BAR __builtin_amdgcn_s_barrier()
#define PG8_SCHED __builtin_amdgcn_sched_barrier(0)
    Unit cur, nxt; int ui = 0;
    if (!S.next(0, cur)) return;
    f32x4 acc[2][2][4][2];
#pragma unroll
    for (int a = 0; a < 2; ++a)
#pragma unroll
        for (int b = 0; b < 2; ++b)
#pragma unroll
            for (int m = 0; m < 4; ++m)
#pragma unroll
                for (int n = 0; n < 2; ++n) acc[a][b][m][n] = (f32x4){0.f, 0.f, 0.f, 0.f};
    h8 At[4][2], B0[2][2], B1[2][2];
    const char* cA = (const char*)g.A + (size_t)cur.pm * tstep; const char* cB = (const char*)g.Bt + (size_t)cur.pn * tstep;
    S.a_ready(cur);
    PG8_STAGE(PG8_SB(0, 0), cB, voffB); PG8_STAGE(PG8_SA(0, 0), cA, voffA); PG8_STAGE(PG8_SB(0, 1), cB + hstep, voffB); PG8_STAGE(PG8_SA(0, 1), cA + hstep, voffA);
    if (wr == 1) PG8_BAR;
    PG8_WAIT_V(4); PG8_BAR;
    PG8_STAGE(PG8_SB(1, 0), cB + kstep, voffB); PG8_STAGE(PG8_SA(1, 0), cA + kstep, voffA); PG8_STAGE(PG8_SB(1, 1), cB + hstep + kstep, voffB);
    PG8_WAIT_V(6); PG8_BAR;
    for (;;) {
        const bool has_next = S.next(ui + 1, nxt);
        const char* nA = has_next ? (const char*)g.A + (size_t)nxt.pm * tstep : cA; const char* nB = has_next ? (const char*)g.Bt + (size_t)nxt.pn * tstep : cB;
        for (int t = 0; t < nt; t += 2) {
            const bool last = (t == nt - 2);
            const char* a1 = cA + (size_t)(t + 1) * kstep;
            const char* a2 = last ? nA : cA + (size_t)(t + 2) * kstep; const char* b2 = last ? nB : cB + (size_t)(t + 2) * kstep;
            const char* a3 = a2 + kstep; const char* b3 = b2 + kstep;
            if (last && has_next) S.a_ready(nxt);
            PG8_LDB(B0, 0, 0); PG8_SCHED; PG8_LDA(At, 0, 0); PG8_STAGE(PG8_SA(1, 1), a1 + hstep, voffA);
            PG8_WAIT_L(8); PG8_BAR; PG8_WAIT_L(0); PG8_MMA(0, 0, At, B0); PG8_BAR; PG8_SCHED;
            PG8_LDB(B1, 0, 1); PG8_STAGE(PG8_SB(0, 0), b2, voffB);
            PG8_BAR; PG8_WAIT_L(0); PG8_MMA(0, 1, At, B1); PG8_BAR;
            PG8_LDA(At, 0, 1); PG8_STAGE(PG8_SA(0, 0), a2, voffA);
            PG8_BAR; PG8_WAIT_L(0); PG8_MMA(1, 0, At, B0); PG8_BAR; PG8_SCHED;
            PG8_STAGE(PG8_SB(0, 1), b2 + hstep, voffB);
            PG8_WAIT_V(6); PG8_BAR; PG8_MMA(1, 1, At, B1); PG8_BAR;
            PG8_LDB(B0, 1, 0); PG8_SCHED; PG8_LDA(At, 1, 0); PG8_STAGE(PG8_SA(0, 1), a2 + hstep, voffA);
            PG8_WAIT_L(8); PG8_BAR; PG8_WAIT_L(0); PG8_MMA(0, 0, At, B0); PG8_BAR; PG8_SCHED;
            PG8_LDB(B1, 1, 1); PG8_STAGE(PG8_SB(1, 0), b3, voffB);
            PG8_BAR; PG8_WAIT_L(0); PG8_MMA(0, 1, At, B1); PG8_BAR;
            PG8_LDA(At, 1, 1); PG8_STAGE(PG8_SA(1, 0), a3, voffA);
            PG8_BAR; PG8_WAIT_L(0); PG8_MMA(1, 0, At, B0); PG8_BAR; PG8_SCHED;
            PG8_STAGE(PG8_SB(1, 1), b3 + hstep, voffB);
            PG8_WAIT_V(6); PG8_BAR; PG8_MMA(1, 1, At, B1); PG8_BAR;
        }
        E(acc, cur, wr, wc, fr, fq); S.done(cur);
        if (!has_next) break;
#pragma unroll
        for (int a = 0; a < 2; ++a)
#pragma unroll
            for (int b = 0; b < 2; ++b)
#pragma unroll
                for (int m = 0; m < 4; ++m)
#pragma unroll
                    for (int n = 0; n < 2; ++n) acc[a][b][m][n] = (f32x4){0.f, 0.f, 0.f, 0.f};
        cur = nxt; cA = nA; cB = nB; ++ui;
    }
    PG8_WAIT_V(0);
    if (wr == 0) PG8_BAR;
    PG8_BAR;
#undef PG8_SA
#undef PG8_SB
#undef PG8_STAGE
#undef PG8_LDA
#undef PG8_LDB
#undef PG8_MMA
#undef PG8_WAIT_V
#undef PG8_WAIT_L
#undef PG8_BAR
#undef PG8_SCHED
}
}

__device__ __forceinline__ float row_rstd(const float* ssq, int row) {
    const f32x4* p = (const f32x4*)(ssq + (size_t)row * 16);
    const f32x4 a = p[0], b = p[1], c = p[2], d = p[3];
    const float s = (((a.x + a.y) + (a.z + a.w)) + ((b.x + b.y) + (b.z + b.w))) + (((c.x + c.y) + (c.z + c.w)) + ((d.x + d.y) + (d.z + d.w)));
    return rsqrtf(s * (1.f / 1024.f) + EPS);
}
struct EpiZ {
    static constexpr bool PERM = true;
    half_t* Z; const float* ssq;
    __device__ __forceinline__ void operator()(const f32x4 (&acc)[2][2][4][2], const pg8::Unit& u, int wr, int wc, int fr, int fq) const {
        const int row0 = u.pm * 256 + wr * 64 + fr, col0 = u.pn * 256 + wc * 32 + 8 * fq;
#pragma unroll
        for (int ai = 0; ai < 2; ++ai)
#pragma unroll
            for (int m = 0; m < 4; ++m) { const int row = row0 + ai * 128 + m * 16; const float r = row_rstd(ssq, row); half_t* rp = Z + (size_t)row * NZP + col0;
#pragma unroll
                for (int bj = 0; bj < 2; ++bj) *(u32x4*)(rp + bj * 128) = pack_h8(acc[ai][bj][m][0] * r, acc[ai][bj][m][1] * r); }
    }
};
struct EpiRes {
    static constexpr bool PERM = true;
    const float* xold; float* out; half_t* XH; float* ssq;
    __device__ __forceinline__ void operator()(const f32x4 (&acc)[2][2][4][2], const pg8::Unit& u, int wr, int wc, int fr, int fq) const {
        const int row0 = u.pm * 256 + wr * 64 + fr, col0 = u.pn * 256 + wc * 32 + 8 * fq;
#pragma unroll
        for (int ai = 0; ai < 2; ++ai)
#pragma unroll
            for (int m = 0; m < 4; ++m) { const int row = row0 + ai * 128 + m * 16; float s = 0.f;
#pragma unroll
                for (int bj = 0; bj < 2; ++bj) { const size_t o = (size_t)row * D + col0 + bj * 128;
                    f32x4 v0 = *(const f32x4*)(xold + o) + acc[ai][bj][m][0], v1 = *(const f32x4*)(xold + o + 4) + acc[ai][bj][m][1];
                    *(f32x4*)(out + o) = v0; *(f32x4*)(out + o + 4) = v1;
                    if (XH) *(u32x4*)(XH + o) = pack_h8(v0, v1);
                    s += (v0.x * v0.x + v0.y * v0.y) + (v0.z * v0.z + v0.w * v0.w) + (v1.x * v1.x + v1.y * v1.y) + (v1.z * v1.z + v1.w * v1.w); }
                s += __shfl_xor(s, 16); s += __shfl_xor(s, 32);
                if (fq == 0 && ssq) ssq[(size_t)row * 16 + u.pn * 4 + wc] = s; }
    }
};
struct EpiSwiglu {
    static constexpr bool PERM = true;
    half_t* H; const float* ssq;
    __device__ __forceinline__ void operator()(const f32x4 (&acc)[2][2][4][2], const pg8::Unit& u, int wr, int wc, int fr, int fq) const {
        const int row0 = u.pm * 256 + wr * 64 + fr, col0 = u.pn * 128 + wc * 32 + 8 * fq;
#pragma unroll
        for (int ai = 0; ai < 2; ++ai)
#pragma unroll
            for (int m = 0; m < 4; ++m) { const int row = row0 + ai * 128 + m * 16; const float r = row_rstd(ssq, row);
                f32x4 o[2];
#pragma unroll
                for (int n = 0; n < 2; ++n) { const f32x4 g = acc[ai][0][m][n] * r, uu = acc[ai][1][m][n] * r;
                    o[n].x = g.x * sigmoidf_(g.x) * uu.x; o[n].y = g.y * sigmoidf_(g.y) * uu.y; o[n].z = g.z * sigmoidf_(g.z) * uu.z; o[n].w = g.w * sigmoidf_(g.w) * uu.w; }
                *(u32x4*)(H + (size_t)row * DFF + col0) = pack_h8(o[0], o[1]); }
    }
};

struct EpiNull {
    static constexpr bool PERM = true;
    __device__ __forceinline__ void operator()(const f32x4 (&acc)[2][2][4][2], const pg8::Unit&, int, int, int, int) const {
#pragma unroll
        for (int ai = 0; ai < 2; ++ai)
#pragma unroll
            for (int bj = 0; bj < 2; ++bj)
#pragma unroll
                for (int m = 0; m < 4; ++m)
#pragma unroll
                    for (int n = 0; n < 2; ++n) asm volatile("" :: "v"(acc[ai][bj][m][n]));
    }
};
struct Params {
    const float* x; const float* norm_mix; const float* w_in; const float* lru_conv_w; const float* lru_conv_b; const float* lru_w_gates; const float* lru_b_gates;
    const float* lru_lambda; const float* sc_conv_w; const float* fox_f_bias; const float* fox_qk_norm; const float* nsa_qk_norm; const float* nsa_cmp_pos;
    const float* nsa_cmp_w1; const float* nsa_cmp_w2; const float* nsa_gate_bias; const float* rel_bias; const float* out_norm; const float* w_out;
    const float* norm_ffn; const float* w_gate_up; const float* w_down; float* out; unsigned char* ws;
};

template <int MODE> __device__ __forceinline__ int src_col(int n) {
    if (MODE == 1) { if (n < 2048) return n; if (n < 2688) return n + 4; if (n < 2692) return 2048 + (n - 2688); if (n < 2704) return n; return -1; }
    if (MODE == 2) { const int pn = n >> 8, w = n & 255; return w < 128 ? pn * 128 + w : DFF + pn * 128 + (w - 128); }
    return n;
}
template <int MODE> __device__ __forceinline__ void p0_item(const float* W, int K, int Nsrc, const float* gain, half_t* WT, int item, int nbn, LAS unsigned* scr, int lane) {
    const int kb = item / nbn, nb = item % nbn, k0 = 64 * kb, n0 = 64 * nb;
    const int sc = src_col<MODE>(n0 + lane);
#pragma unroll 8
    for (int kk = 0; kk < 64; kk += 2) {
        float v0 = 0.f, v1 = 0.f;
        if (sc >= 0) { v0 = W[(size_t)(k0 + kk) * Nsrc + sc]; v1 = W[(size_t)(k0 + kk + 1) * Nsrc + sc]; }
        if (gain) { v0 *= gain[k0 + kk]; v1 *= gain[k0 + kk + 1]; }
        scr[lane * 33 + (kk >> 1)] = pack_h2(v0, v1);
    }
    LDS_WAIT(); asm volatile("" ::: "memory");
    const int c = lane & 7;
#pragma unroll
    for (int j = 0; j < 8; ++j) { const int nn = (lane >> 3) + 8 * j; const LAS unsigned* s = scr + nn * 33 + 4 * c;
        u32x4 o; o.x = s[0]; o.y = s[1]; o.z = s[2]; o.w = s[3];
        *(u32x4*)(WT + (size_t)(n0 + nn) * K + k0 + 8 * c) = o; }
    LDS_WAIT(); asm volatile("" ::: "memory");
}
__device__ __forceinline__ float wave_sum(float v) {
#pragma unroll
    for (int o = 1; o < 64; o <<= 1) v += __shfl_xor(v, o);
    return v;
}

__device__ __forceinline__ void attn_step_h(const float (&q)[64], float (&acc)[64], float& m, float& l, const half_t* kp, const half_t* vp, float bias, bool valid) {
    float sc = 0.f;
#pragma unroll
    for (int hh = 0; hh < 2; ++hh) {
#pragma unroll
        for (int j = 4 * hh; j < 4 * hh + 4; ++j) { const h8 kv = *(const h8*)(kp + 8 * j);
#pragma unroll
            for (int e = 0; e < 8; ++e) sc = fmaf(q[8 * j + e], (float)kv[e], sc); }
        __builtin_amdgcn_sched_barrier(0);
    }
    sc += bias;
    const float mn = valid ? fmaxf(m, sc) : m;
    const float alpha = __expf(m - mn), p = valid ? __expf(sc - mn) : 0.f;
    m = mn; l = l * alpha + p;
#pragma unroll
    for (int hh = 0; hh < 2; ++hh) {
#pragma unroll
        for (int j = 4 * hh; j < 4 * hh + 4; ++j) { const h8 vv = *(const h8*)(vp + 8 * j);
#pragma unroll
            for (int e = 0; e < 8; ++e) acc[8 * j + e] = fmaf(acc[8 * j + e], alpha, p * (float)vv[e]); }
        __builtin_amdgcn_sched_barrier(0);
    }
}
__device__ __forceinline__ float dot_f32(const float (&q)[64], const float* kp) {
    float sc = 0.f;
#pragma unroll
    for (int j = 0; j < 16; ++j) { const f32x4 kv = *(const f32x4*)(kp + 4 * j); sc = fmaf(q[4 * j], kv.x, sc); sc = fmaf(q[4 * j + 1], kv.y, sc); sc = fmaf(q[4 * j + 2], kv.z, sc); sc = fmaf(q[4 * j + 3], kv.w, sc); }
    return sc;
}
__device__ __forceinline__ void load_q(float (&q)[64], const half_t* qp, float scale) {
#pragma unroll
    for (int j = 0; j < 8; ++j) { const h8 v = *(const h8*)(qp + 8 * j);
#pragma unroll
        for (int e = 0; e < 8; ++e) q[8 * j + e] = (float)v[e] * scale; }
}

__device__ __forceinline__ void lru_gate_r(const float* wcol, float bias, const LAS float* xrow, LAS float* yout) {
    float w[64];
#pragma unroll
    for (int k = 0; k < 64; ++k) w[k] = wcol[(size_t)k * 64];
    for (int i = 0; i < 32; ++i) {
        const LAS float* xr = xrow + i * 256; float r = bias;
#pragma unroll
        for (int k = 0; k < 64; k += 4) { const f32x4 xv = *(const LAS f32x4*)(xr + k);
            r = fmaf(xv.x, w[k], r); r = fmaf(xv.y, w[k + 1], r); r = fmaf(xv.z, w[k + 2], r); r = fmaf(xv.w, w[k + 3], r); }
        yout[i * 256] = 1.f / (1.f + expf(-r));
    }
}

__device__ __forceinline__ void qk64(f32x16& S0, f32x16& S1, const h8 (&q)[4], const LAS unsigned char* Ks, int qi, int hb) {
    const LAS unsigned char* r0 = Ks + pi16(qi) * 144 + 16 * hb;
#pragma unroll
    for (int kk = 0; kk < 4; ++kk) { const h8 a0 = *(const LAS h8*)(r0 + 32 * kk); S0 = MFMA32(a0, q[kk], S0);
        const h8 a1 = *(const LAS h8*)(r0 + 32 * 144 + 32 * kk); S1 = MFMA32(a1, q[kk], S1); }
}
__device__ __forceinline__ void pv64(const f32x16& P0, const f32x16& P1, const LAS unsigned char* Vs, f32x16& O0, f32x16& O1, int qi, int hb) {
    h8 pf[4];
#pragma unroll
    for (int e = 0; e < 8; ++e) { pf[0][e] = (half_t)P0[e]; pf[1][e] = (half_t)P0[8 + e]; pf[2][e] = (half_t)P1[e]; pf[3][e] = (half_t)P1[8 + e]; }
    const LAS unsigned char* v0 = Vs + qi * 144 + 16 * hb;
#pragma unroll
    for (int s = 0; s < 4; ++s) { const h8 a0 = *(const LAS h8*)(v0 + 32 * s); O0 = MFMA32(a0, pf[s], O0);
        const h8 a1 = *(const LAS h8*)(v0 + 32 * 144 + 32 * s); O1 = MFMA32(a1, pf[s], O1); }
}
__device__ __forceinline__ float rowmax64(const f32x16& S0, const f32x16& S1) {
    float mx = fmaxf(S0[0], S1[0]);
#pragma unroll
    for (int r = 1; r < 16; ++r) mx = fmaxf(mx, fmaxf(S0[r], S1[r]));
    return fmaxf(mx, __shfl_xor(mx, 32));
}
__device__ __forceinline__ void softmax64(f32x16& S0, f32x16& S1, float& m, float& l, f32x16& O0, f32x16& O1) {
    const float mn = fmaxf(m, rowmax64(S0, S1)), alpha = __builtin_amdgcn_exp2f(m - mn);
    m = mn; float ps = 0.f;
#pragma unroll
    for (int r = 0; r < 16; ++r) { S0[r] = __builtin_amdgcn_exp2f(S0[r] - mn); S1[r] = __builtin_amdgcn_exp2f(S1[r] - mn); ps += S0[r] + S1[r]; }
    l = l * alpha + ps;
    if (__any(alpha != 1.f)) {
#pragma unroll
        for (int r = 0; r < 16; ++r) { O0[r] *= alpha; O1[r] *= alpha; }
    }
}
__device__ __forceinline__ void init_near(f32x16& S0, f32x16& S1, const LAS float* TRh, int dq, int hb, int step, int wlim) {
#pragma unroll
    for (int r = 0; r < 16; ++r) {
        const int k0 = 16 * (r >> 3) + 8 * hb + 4 * ((r >> 2) & 1) + (r & 3);
        const int d0 = dq - step * k0, d1 = dq - step * (k0 + 32);
        const float b0 = TRh[d0 < 0 ? 0 : (d0 > 128 ? 128 : d0)], b1 = TRh[d1 < 0 ? 0 : (d1 > 128 ? 128 : d1)];
        S0[r] = (d0 >= 0 && d0 < wlim) ? b0 : -INFINITY; S1[r] = (d1 >= 0 && d1 < wlim) ? b1 : -INFINITY;
    }
}
__device__ __forceinline__ void init_const(f32x16& S0, f32x16& S1, float c) {
#pragma unroll
    for (int r = 0; r < 16; ++r) { S0[r] = c; S1[r] = c; }
}

__device__ __forceinline__ void init_tab(f32x16& S0, f32x16& S1, const LAS float* TXh, int dq, int hb, int step, int dmax, bool sel) {
#pragma unroll
    for (int r = 0; r < 16; ++r) {
        const int k0 = 16 * (r >> 3) + 8 * hb + 4 * ((r >> 2) & 1) + (r & 3);
        int i0 = dq - step * k0, i1 = dq - step * (k0 + 32);
        i0 = i0 < -1 ? -1 : (i0 > dmax ? dmax : i0); i1 = i1 < -1 ? -1 : (i1 > dmax ? dmax : i1);
        S0[r] = TXh[sel ? i0 + 1 : 0]; S1[r] = TXh[sel ? i1 + 1 : 0];
    }
}
__device__ __forceinline__ void qk64z(f32x16& S0, f32x16& S1, const h8 (&q)[4], const LAS unsigned char* Ks, int qi, int hb) {
    const LAS unsigned char* r0 = Ks + pi16(qi) * 144 + 16 * hb;
    const f32x16 z = {0.f, 0.f, 0.f, 0.f, 0.f, 0.f, 0.f, 0.f, 0.f, 0.f, 0.f, 0.f, 0.f, 0.f, 0.f, 0.f};
    S0 = MFMA32(*(const LAS h8*)(r0), q[0], z); S1 = MFMA32(*(const LAS h8*)(r0 + 32 * 144), q[0], z);
#pragma unroll
    for (int kk = 1; kk < 4; ++kk) { const h8 a0 = *(const LAS h8*)(r0 + 32 * kk); S0 = MFMA32(a0, q[kk], S0);
        const h8 a1 = *(const LAS h8*)(r0 + 32 * 144 + 32 * kk); S1 = MFMA32(a1, q[kk], S1); }
}
__device__ __forceinline__ float exp_sum64(f32x16& S0, f32x16& S1) {
    float ps = 0.f;
#pragma unroll
    for (int r = 0; r < 16; ++r) { S0[r] = __builtin_amdgcn_exp2f(S0[r]); S1[r] = __builtin_amdgcn_exp2f(S1[r]); ps += S0[r] + S1[r]; }
    return ps;
}
__device__ __forceinline__ void pv64m(const f32x16& P0, const f32x16& P1, bool sel, const LAS unsigned char* Vs, f32x16& O0, f32x16& O1, int qi, int hb) {
    h8 pf[4];
#pragma unroll
    for (int e = 0; e < 8; ++e) { pf[0][e] = (half_t)P0[e]; pf[1][e] = (half_t)P0[8 + e]; pf[2][e] = (half_t)P1[e]; pf[3][e] = (half_t)P1[8 + e]; }
    const h8 hz = {0, 0, 0, 0, 0, 0, 0, 0};
#pragma unroll
    for (int s = 0; s < 4; ++s) pf[s] = sel ? pf[s] : hz;
    const LAS unsigned char* v0 = Vs + qi * 144 + 16 * hb;
#pragma unroll
    for (int s = 0; s < 4; ++s) { const h8 a0 = *(const LAS h8*)(v0 + 32 * s); O0 = MFMA32(a0, pf[s], O0);
        const h8 a1 = *(const LAS h8*)(v0 + 32 * 144 + 32 * s); O1 = MFMA32(a1, pf[s], O1); }
}

__device__ __forceinline__ void fox_tile(const LAS unsigned char* sbp, int h, const h8 (&q)[4], int qi, int hb, bool diag, int kbase, int t, float& m, float& l, f32x16& O0, f32x16& O1) {
    const LAS unsigned char* Kh = sbp + h * 4608; const LAS unsigned char* Vh = sbp + 18432 + h * 5120;
    const LAS float* cbh = (const LAS float*)(sbp + 38912) + h * 32;
    f32x16 S;
#pragma unroll
    for (int g = 0; g < 4; ++g) { const f32x4 c4 = *(const LAS f32x4*)(cbh + 16 * (g >> 1) + 8 * hb + 4 * (g & 1)); S[4 * g] = c4.x; S[4 * g + 1] = c4.y; S[4 * g + 2] = c4.z; S[4 * g + 3] = c4.w; }
#pragma unroll
    for (int kk = 0; kk < 4; ++kk) { const h8 a = *(const LAS h8*)(Kh + pi16(qi) * 144 + (16 * kk + 8 * hb) * 2); S = MFMA32(a, q[kk], S); }
    if (diag) {
#pragma unroll
        for (int r = 0; r < 16; ++r) { const int key = kbase + 16 * (r >> 3) + 8 * hb + 4 * ((r >> 2) & 1) + (r & 3); if (key > t) S[r] = -INFINITY; }
    }
    float mx = S[0];
#pragma unroll
    for (int r = 1; r < 16; ++r) mx = fmaxf(mx, S[r]);
    mx = fmaxf(mx, __shfl_xor(mx, 32));
    const float mn = fmaxf(m, mx), alpha = __builtin_amdgcn_exp2f(m - mn);
    m = mn;
    float ps = 0.f;
#pragma unroll
    for (int r = 0; r < 16; ++r) { S[r] = __builtin_amdgcn_exp2f(S[r] - mn); ps += S[r]; }
    l = l * alpha + ps;
    if (__any(alpha != 1.f)) {
#pragma unroll
        for (int r = 0; r < 16; ++r) { O0[r] *= alpha; O1[r] *= alpha; }
    }
    h8 pf0, pf1;
#pragma unroll
    for (int e = 0; e < 8; ++e) { pf0[e] = (half_t)S[e]; pf1[e] = (half_t)S[8 + e]; }
    { const h8 a = *(const LAS h8*)(Vh + qi * 80 + (8 * hb) * 2); O0 = MFMA32(a, pf0, O0); }
    { const h8 a = *(const LAS h8*)(Vh + qi * 80 + (16 + 8 * hb) * 2); O0 = MFMA32(a, pf1, O0); }
    { const h8 a = *(const LAS h8*)(Vh + (32 + qi) * 80 + (8 * hb) * 2); O1 = MFMA32(a, pf0, O1); }
    { const h8 a = *(const LAS h8*)(Vh + (32 + qi) * 80 + (16 + 8 * hb) * 2); O1 = MFMA32(a, pf1, O1); }
}
__device__ __forceinline__ void nsa_tile(bool near, int dq, int wlim, float cinit, const LAS float* TRh, const h8 (&q)[4], const LAS unsigned char* stage, float& m, float& l, f32x16& O0, f32x16& O1, int qi, int hb) {
    f32x16 S0, S1;
    if (near) init_near(S0, S1, TRh, dq, hb, 1, wlim); else init_const(S0, S1, cinit);
    qk64(S0, S1, q, stage, qi, hb);
    softmax64(S0, S1, m, l, O0, O1);
    pv64(S0, S1, stage + 9216, O0, O1, qi, hb);
}

#define MFMA16(a, b, c) __builtin_amdgcn_mfma_f32_16x16x32_f16(a, b, c, 0, 0, 0)
template <bool FINAL>
__device__ __forceinline__ void lru_unit(const Params& P, int L, int ui, LAS unsigned char* lds, const half_t* Z, const half_t* WGT, const float* LSPp, float* LRUAGG, half_t* MIXED, int wave, float& hcarry, bool first) {
    int tid = threadIdx.x; asm volatile("" : "+v"(tid)); const int lane = tid & 63;
    const int b = ui >> 7, sub = ui & 127, t0 = sub * 32; const size_t tokb = (size_t)b * SEQ;
    LAS float* xcF = (LAS float*)lds;
    LAS float* Aa = (LAS float*)(lds + 32768);
    LAS half_t* xcH = (LAS half_t*)(lds + 65536);
    LAS float* Sc = (LAS float*)(lds + 82944);
    {
        const int c = tid & 255, q2 = tid >> 8, ta = t0 + 16 * q2;
        const float w0 = P.lru_conv_w[(L * 4 + 0) * 256 + c], w1 = P.lru_conv_w[(L * 4 + 1) * 256 + c], w2 = P.lru_conv_w[(L * 4 + 2) * 256 + c], w3 = P.lru_conv_w[(L * 4 + 3) * 256 + c], cb = P.lru_conv_b[L * 256 + c];
        const half_t* zp = Z + (tokb + ta) * NZP + ZC_LRU_X + c;
        float x0 = ta >= 3 ? (float)zp[-3 * NZP] : 0.f, x1 = ta >= 2 ? (float)zp[-2 * NZP] : 0.f, x2 = ta >= 1 ? (float)zp[-1 * NZP] : 0.f;
#pragma unroll
        for (int i = 0; i < 16; ++i) { const float x3 = (float)zp[(size_t)i * NZP]; const float v = cb + w0 * x0 + w1 * x1 + w2 * x2 + w3 * x3;
            xcF[(16 * q2 + i) * 256 + c] = v; xcH[(16 * q2 + i) * 264 + c] = (half_t)v; x0 = x1; x1 = x2; x2 = x3; }
    }
    __syncthreads();
    {
        const int blk = wave & 3, th = wave >> 2, r16 = lane & 15, kq = lane >> 4;
        const h8 a0 = *(const LAS h8*)(xcH + (16 * th + r16) * 264 + blk * 64 + 8 * kq), a1 = *(const LAS h8*)(xcH + (16 * th + r16) * 264 + blk * 64 + 32 + 8 * kq);
#pragma unroll
        for (int cbk = 0; cbk < 4; ++cbk) {
            const half_t* wr = WGT + ((size_t)((L * 2 + 0) * 4 + blk) * 64 + 16 * cbk + r16) * 64 + 8 * kq; const half_t* wi = wr + 4 * 64 * 64;
            f32x4 ar = {0.f, 0.f, 0.f, 0.f}, ai = {0.f, 0.f, 0.f, 0.f};
            ar = MFMA16(a0, *(const h8*)wr, ar); ar = MFMA16(a1, *(const h8*)(wr + 32), ar);
            ai = MFMA16(a0, *(const h8*)wi, ai); ai = MFMA16(a1, *(const h8*)(wi + 32), ai);
            const int c = blk * 64 + 16 * cbk + r16;
            const float br = P.lru_b_gates[(L * 2 + 0) * 256 + c], bi = P.lru_b_gates[(L * 2 + 1) * 256 + c];
            const float lsp = LSPp[L * 256 + c];
#pragma unroll
            for (int rg = 0; rg < 4; ++rg) { const int tl = 16 * th + 4 * kq + rg;
                const float r = __builtin_amdgcn_rcpf(1.f + __builtin_amdgcn_exp2f(-LOG2E * (ar[rg] + br))), ii = __builtin_amdgcn_rcpf(1.f + __builtin_amdgcn_exp2f(-LOG2E * (ai[rg] + bi)));
                const float xc = xcF[tl * 256 + c];
                const float a = __builtin_amdgcn_exp2f(lsp * r), bb = __builtin_amdgcn_sqrtf(fmaxf(1.f - a * a, 0.f)) * (ii * xc);
                Aa[tl * 256 + c] = a; xcF[tl * 256 + c] = bb; }
        }
    }
    __syncthreads();
    if (tid < 256) {
        const int c = tid;
        if (!FINAL) {
            float h = 0.f, Ap = 1.f;
#pragma unroll 8
            for (int i = 0; i < 32; ++i) { const float a = Aa[i * 256 + c], bb = xcF[i * 256 + c]; h = fmaf(a, h, bb); Ap *= a; }
            float* ag = LRUAGG + (((size_t)b * 128 + sub) * 256 + c) * 2; ag[0] = Ap; ag[1] = h;
        } else {
            float h = hcarry;
            if (first) { h = 0.f; const float* ag = LRUAGG + ((size_t)b * 128 * 256 + c) * 2;
              for (int s0 = 0; s0 < sub; s0 += 16) {
                  typedef float f32x2 __attribute__((ext_vector_type(2)));
                  f32x2 pr[16];
#pragma unroll
                  for (int k = 0; k < 16; ++k) pr[k] = (s0 + k < sub) ? *(const f32x2*)(ag + (size_t)(s0 + k) * 512) : (f32x2){1.f, 0.f};
#pragma unroll
                  for (int k = 0; k < 16; ++k) h = fmaf(pr[k].x, h, pr[k].y); } }
            const half_t* gp = Z + (tokb + t0) * NZP + ZC_LRU_G + c;
#pragma unroll 8
            for (int i = 0; i < 32; ++i) { const float a = Aa[i * 256 + c], bb = xcF[i * 256 + c]; h = fmaf(a, h, bb);
                const float gx = (float)gp[(size_t)i * NZP];
                Aa[i * 256 + c] = h * gx * __builtin_amdgcn_rcpf(1.f + __builtin_amdgcn_exp2f(-2.f * LOG2E * 0.7978845608028654f * (gx + 0.044715f * gx * gx * gx))); }
            hcarry = h;
        }
    } else if (FINAL) {
        const int c = tid - 256;
        const float w0 = P.sc_conv_w[(L * 3 + 0) * 256 + c], w1 = P.sc_conv_w[(L * 3 + 1) * 256 + c], w2 = P.sc_conv_w[(L * 3 + 2) * 256 + c];
        const half_t* zp = Z + (tokb + t0) * NZP + c;
        float u0 = t0 >= 2 ? (float)zp[-2 * NZP + ZC_SC_C] * (float)zp[-2 * NZP + ZC_SC_X] : 0.f, u1 = t0 >= 1 ? (float)zp[-1 * NZP + ZC_SC_C] * (float)zp[-1 * NZP + ZC_SC_X] : 0.f;
#pragma unroll 8
        for (int i = 0; i < 32; ++i) { const half_t* zr = zp + (size_t)i * NZP; const float u2 = (float)zr[ZC_SC_C] * (float)zr[ZC_SC_X];
            Sc[i * 256 + c] = (float)zr[ZC_SC_B] * (w0 * u0 + w1 * u1 + w2 * u2); u0 = u1; u1 = u2; }
    }
    __syncthreads();
    if (FINAL) {
        const f32x4 ga = *(const f32x4*)(P.out_norm + (L * 4 + 0) * 256 + 4 * lane), gbv = *(const f32x4*)(P.out_norm + (L * 4 + 1) * 256 + 4 * lane);
#pragma unroll
        for (int i = 0; i < 4; ++i) { const int tl = wave * 4 + i; half_t* op = MIXED + (tokb + t0 + tl) * D + 4 * lane;
            { const f32x4 v = *(const LAS f32x4*)(Aa + tl * 256 + 4 * lane); const float rs = rsqrtf(wave_sum((v.x * v.x + v.y * v.y) + (v.z * v.z + v.w * v.w)) * (1.f / 256.f) + EPS);
              u32x2 o; o.x = pack_h2(v.x * rs * ga.x, v.y * rs * ga.y); o.y = pack_h2(v.z * rs * ga.z, v.w * rs * ga.w); *(u32x2*)op = o; }
            { const f32x4 v = *(const LAS f32x4*)(Sc + tl * 256 + 4 * lane); const float rs = rsqrtf(wave_sum((v.x * v.x + v.y * v.y) + (v.z * v.z + v.w * v.w)) * (1.f / 256.f) + EPS);
              u32x2 o; o.x = pack_h2(v.x * rs * gbv.x, v.y * rs * gbv.y); o.y = pack_h2(v.z * rs * gbv.z, v.w * rs * gbv.w); *(u32x2*)(op + 256) = o; }
        }
        __syncthreads();
    }
}

__global__ void __launch_bounds__(NTHR, 2) hymba_fwd(Params P) {
    extern __shared__ __attribute__((aligned(16))) unsigned char lds_raw[];
    LAS unsigned char* lds = (LAS unsigned char*)lds_raw;
    volatile LAS unsigned* MISC = (volatile LAS unsigned*)(lds + MISC_OFF);
    const int tid = threadIdx.x, lane = tid & 63, wave = __builtin_amdgcn_readfirstlane(tid >> 6);
    const int G = gridDim.x, bid = blockIdx.x;
    unsigned char* ws = P.ws;
    unsigned* ctl = (unsigned*)(ws + WS_CTL);
    float* SSQA = (float*)(ws + WS_SSQA); float* SSQB = (float*)(ws + WS_SSQB); float* CFOX = (float*)(ws + WS_CFOX); float* KVC = (float*)(ws + WS_KVC);
    float* LRUAGG = (float*)(ws + WS_LRUAGG); float* CB = (float*)(ws + WS_CB); float* YD = (float*)(ws + WS_YD);
    half_t* WIN_T = (half_t*)(ws + WS_WIN); half_t* WOUT_T = (half_t*)(ws + WS_WOUT); half_t* WGU_T = (half_t*)(ws + WS_WGU); half_t* WDN_T = (half_t*)(ws + WS_WDN);
    half_t* FOXVT = (half_t*)(ws + WS_FOXVT); half_t* VST = (half_t*)(ws + WS_VST); half_t* VWT = (half_t*)(ws + WS_VWT); half_t* KCH = (half_t*)(ws + WS_KCH); half_t* VCT = (half_t*)(ws + WS_VCT); half_t* W1T = (half_t*)(ws + WS_W1T); half_t* WGT = (half_t*)(ws + WS_WGT); half_t* XH = (half_t*)(ws + WS_XH); half_t* MIXED = (half_t*)(ws + WS_MIXED); half_t* Z = (half_t*)(ws + WS_Z); half_t* HB = (half_t*)(ws + WS_Z);

    for (int u = tid; u < 64; u += NTHR) MISC[u] = 0u;
    __syncthreads();
    XcdBarrier bar = xcd_barrier_post(ctl + CW_BAR, MISC + 8);

    const int gw = bid * NWAVES + wave, NGW = G * NWAVES;

#ifndef SKIP_P0
    for (int rp0 = 0; rp0 < REP_P0; ++rp0) {
        LAS unsigned* scr = (LAS unsigned*)(lds + wave * 8448);
        constexpr int I_IN = 16 * 44, I_OUT = 16 * 16, I_GU = 16 * 88, I_DN = 44 * 16, PER_L = I_IN + I_OUT + I_GU + I_DN;
        for (int it = gw; it < 2 * PER_L; it += NGW) {
            const int L = it / PER_L; int r = it % PER_L;
            if (r < I_IN) { p0_item<1>(P.w_in + (size_t)L * D * NIN_SRC, D, NIN_SRC, P.norm_mix + L * D, WIN_T + (size_t)L * NZP * D, r, 44, scr, lane); continue; } r -= I_IN;
            if (r < I_OUT) { p0_item<0>(P.w_out + (size_t)L * D * D, D, D, nullptr, WOUT_T + (size_t)L * D * D, r, 16, scr, lane); continue; } r -= I_OUT;
            if (r < I_GU) { p0_item<2>(P.w_gate_up + (size_t)L * D * 2 * DFF, D, 2 * DFF, P.norm_ffn + L * D, WGU_T + (size_t)L * 2 * DFF * D, r, 88, scr, lane); continue; } r -= I_GU;
            p0_item<0>(P.w_down + (size_t)L * DFF * D, DFF, D, nullptr, WDN_T + (size_t)L * D * DFF, r, 16, scr, lane);
        }
        for (int it = gw; it < 4 * 64 + 16; it += NGW) {
            if (it < 256) { const int ln = it >> 6; p0_item<0>(P.nsa_cmp_w1 + (size_t)ln * 2048 * 128, 2048, 128, nullptr, W1T + (size_t)ln * 128 * 2048, it & 63, 2, scr, lane); }
            else { const int gi = it - 256; p0_item<0>(P.lru_w_gates + (size_t)gi * 64 * 64, 64, 64, nullptr, WGT + (size_t)gi * 64 * 64, 0, 1, scr, lane); }
        }
        for (int o = gw; o < 2 * 2 * 128; o += NGW) {
            const int m = o & 127, ln = o >> 7;
            const float* pp = P.nsa_cmp_pos + (size_t)ln * 2048; const float* wp = P.nsa_cmp_w1 + (size_t)ln * 2048 * 128 + m;
            float s = 0.f;
            for (int i = lane; i < 2048; i += 64) s = fmaf(pp[i], wp[(size_t)i * 128], s);
            s = wave_sum(s);
            if (lane == 0) CB[o] = s;
        }
        for (int o = bid * NTHR + tid; o < 512; o += G * NTHR) CB[1024 + o] = -8.0f * LOG2E * log1pf(expf(-P.lru_lambda[o]));
        for (int row = gw; row < T; row += NGW) {
            const f32x4* xr = (const f32x4*)(P.x + (size_t)row * D) + lane;
            float s = 0.f;
#pragma unroll
            for (int j = 0; j < 4; ++j) { const f32x4 v = xr[64 * j]; s += (v.x * v.x + v.y * v.y) + (v.z * v.z + v.w * v.w);
                u32x2 o; o.x = pack_h2(v.x, v.y); o.y = pack_h2(v.z, v.w); *(u32x2*)(XH + (size_t)row * D + 4 * (lane + 64 * j)) = o; }
            s = wave_sum(s);
            if (lane < 16) SSQB[(size_t)row * 16 + lane] = lane == 0 ? s : 0.f;
        }
    }
#endif
    xcd_barrier(bar);

    for (int L = 0; L < 2; ++L) {
#ifndef SKIP_G1
        {
            pg8::Gemm g{XH, WIN_T + (size_t)L * NZP * D, T, NZP, D}; pg8::StaticOrder S; S.init(T, NZP, G, bid);
            EpiZ E{Z, SSQB};
            for (int rp = 0; rp < REP_G1; ++rp) pg8::gemm_phase<EpiZ, pg8::StaticOrder>(lds, g, S, E);
        }
#endif
        xcd_barrier(bar);

        {
#ifndef SKIP_P2AB
            {
                int tid = threadIdx.x; asm volatile("" : "+v"(tid)); const int lane = tid & 63;
                const int g8 = lane >> 3, sub = lane & 7;
                for (int dry = NORM_DRY; dry >= 0; --dry)
                for (int tok = gw; tok < T; tok += NGW) {
#pragma unroll
                    for (int rr = 0; rr < 2; ++rr) {
                        const int r = g8 + 8 * rr;
                        if (r < 14) {
                            int col; const float* gain;
                            if (r < 4) { col = ZC_FOX_Q + 64 * r; gain = P.fox_qk_norm + (L * 2 + 0) * 64; }
                            else if (r < 8) { col = ZC_FOX_K + 64 * (r - 4); gain = P.fox_qk_norm + (L * 2 + 1) * 64; }
                            else if (r < 12) { col = ZC_NSA_Q + 64 * (r - 8); gain = P.nsa_qk_norm + (L * 4 + 0) * 64; }
                            else if (r == 12) { col = ZC_KS; gain = P.nsa_qk_norm + (L * 4 + 2) * 64; }
                            else { col = ZC_KW; gain = P.nsa_qk_norm + (L * 4 + 3) * 64; }
                            half_t* p = Z + (size_t)tok * NZP + col + 8 * sub;
                            const h8 v = *(const h8*)p; float f[8]; float s = 0.f;
#pragma unroll
                            for (int e = 0; e < 8; ++e) { f[e] = (float)v[e]; s += f[e] * f[e]; }
                            s += __shfl_xor(s, 1); s += __shfl_xor(s, 2); s += __shfl_xor(s, 4);
                            const float rs = rsqrtf(s * (1.f / 64.f) + EPS) * ((r < 4 || (r >= 8 && r < 12)) ? QSCALE : 1.f);
                            const f32x4 g0 = *(const f32x4*)(gain + 8 * sub), g1 = *(const f32x4*)(gain + 8 * sub + 4);
                            if (dry) *(h8*)p = v; else
                            *(u32x4*)p = pack_h8((f32x4){f[0] * rs * g0.x, f[1] * rs * g0.y, f[2] * rs * g0.z, f[3] * rs * g0.w}, (f32x4){f[4] * rs * g1.x, f[5] * rs * g1.y, f[6] * rs * g1.z, f[7] * rs * g1.w});
                        }
                    }
                }
            }
            for (int rp = 0; rp < REP_CUM; ++rp)
            if (wave == 1 && (bid & 7) == 0 && (bid >> 3) < 32) {
                int tid = threadIdx.x; asm volatile("" : "+v"(tid)); const int lane = tid & 63;
                const int task = bid >> 3, b = task >> 2, h = task & 3;
                const float fb = P.fox_f_bias[L * 4 + h];
                float carry = 0.f;
                for (int it = 0; it < SEQ / 64; ++it) {
                    const size_t tok = (size_t)b * SEQ + it * 64 + lane;
                    float v = log_sigmoid((float)Z[tok * NZP + ZC_FOX_F + h] + fb);
#pragma unroll
                    for (int o = 1; o < 64; o <<= 1) { const float n = __shfl_up(v, o); if (lane >= o) v += n; }
                    v += carry;
                    CFOX[((size_t)b * 4 + h) * SEQ + it * 64 + lane] = v;
                    carry = __shfl(v, 63);
                }
            }
#endif
            for (int rp = 0; rp < REP_VT; ++rp)
            for (int ui = bid; ui < 512; ui += G) {
                int tid = threadIdx.x; asm volatile("" : "+v"(tid));
                const int b = ui >> 6, chunk = ui & 63; const size_t tokb = (size_t)b * SEQ + chunk * 64;
                LAS half_t* tb = (LAS half_t*)lds;
#pragma unroll
                for (int i = 0; i < 4; ++i) { const int p = tid + 512 * i, tk = p >> 5, c8 = p & 31;
                    *(LAS h8*)(tb + tk * 264 + 8 * c8) = *(const h8*)(Z + (tokb + tk) * NZP + ZC_FOX_V + 8 * c8); }
                LAS half_t* tb2 = tb + 64 * 264;
#pragma unroll
                for (int i = 0; i < 2; ++i) { const int p = tid + 512 * i, tk = p >> 4, c8 = p & 15;
                    *(LAS h8*)(tb2 + tk * 136 + 8 * c8) = *(const h8*)(Z + (tokb + tk) * NZP + (c8 < 8 ? ZC_VS + 8 * c8 : ZC_VW + 8 * (c8 - 8))); }
                __syncthreads();
                {
                    const int col = tid & 255, ktl = tid >> 8;
                    half_t* dst = FOXVT + ((size_t)(b * 128 + chunk * 2 + ktl) * 256 + col) * 32;
#pragma unroll
                    for (int j4 = 0; j4 < 4; ++j4) { h8 o;
#pragma unroll
                        for (int e = 0; e < 8; ++e) o[e] = tb[(32 * ktl + 8 * j4 + e) * 264 + col];
                        *(h8*)(dst + 8 * j4) = o; }
#pragma unroll
                    for (int i = 0; i < 2; ++i) { const int p = tid + 512 * i, which = p >> 9, d = (p >> 3) & 63, ch = p & 7; h8 o;
#pragma unroll
                        for (int e = 0; e < 8; ++e) o[e] = tb2[(8 * ch + e) * 136 + 64 * which + d];
                        *(h8*)((which ? VWT : VST) + ((size_t)(b * 64 + chunk) * 64 + d) * 64 + 8 * ch) = o; }
                }
                __syncthreads();
            }
#ifndef SKIP_P2LRU
            for (int rp = 0; rp < REP_P2LRU; ++rp)
            for (int ui = bid; ui < 1024; ui += G) { float hc = 0.f; lru_unit<false>(P, L, ui, lds, Z, WGT, CB + 1024, LRUAGG, MIXED, wave, hc, true); }
#endif
#ifndef SKIP_P2CMP
            for (int rp = 0; rp < REP_P2CMP; ++rp)
            for (int ui = bid; ui < 256; ui += G) {
                int tid = threadIdx.x; asm volatile("" : "+v"(tid)); const int lane = tid & 63, r16 = lane & 15, kq = lane >> 4;
                const int net = ui >> 7, b = (ui >> 4) & 7, n0 = (ui & 15) * 16;
                const size_t tokb = (size_t)b * SEQ;
                LAS float* hidb = (LAS float*)lds;
                {
                    const half_t* w1t = W1T + ((size_t)((L * 2 + net) * 128 + 16 * wave + r16)) * 2048 + 8 * kq;
                    int na = n0 + r16; if (na > 254) na = 254;
                    const half_t* za = Z + (tokb + 16 * na) * NZP + (net ? ZC_VC : ZC_KC) + 8 * kq;
                    f32x4 c0 = {0.f, 0.f, 0.f, 0.f}, c1 = {0.f, 0.f, 0.f, 0.f};
#pragma unroll 8
                    for (int s = 0; s < 64; s += 2) {
                        c0 = MFMA16(*(const h8*)(za + (size_t)(s >> 1) * NZP), *(const h8*)(w1t + 32 * s), c0);
                        c1 = MFMA16(*(const h8*)(za + (size_t)(s >> 1) * NZP + 32), *(const h8*)(w1t + 32 * s + 32), c1); }
                    const int m = 16 * wave + r16; const float cbm = CB[(L * 2 + net) * 128 + m];
#pragma unroll
                    for (int rg = 0; rg < 4; ++rg) hidb[(4 * kq + rg) * 132 + m] = gelu_tanh((c0[rg] + c1[rg]) + cbm);
                }
                __syncthreads();
                {
                    const int d = lane; const float* w2 = P.nsa_cmp_w2 + (size_t)(L * 2 + net) * 128 * 64 + d;
                    float o0 = 0.f, o1 = 0.f; const LAS float* hp = hidb + (2 * wave) * 132;
#pragma unroll 16
                    for (int m = 0; m < 128; ++m) { const float w = w2[m * 64]; o0 = fmaf(hp[m], w, o0); o1 = fmaf(hp[132 + m], w, o1); }
                    float ov[2] = {o0, o1};
#pragma unroll
                    for (int i = 0; i < 2; ++i) { float o = ov[i]; const int n = n0 + 2 * wave + i;
                        if (net == 0) { const float ss = wave_sum(o * o); o = o * rsqrtf(ss * (1.f / 64.f) + EPS) * P.nsa_qk_norm[(L * 4 + 1) * 64 + d]; }
                        if (n >= NCMP) o = 0.f;
                        if (net == 0) KCH[((size_t)b * 256 + n) * 64 + d] = (half_t)o; else VCT[((size_t)b * 64 + d) * 256 + n] = (half_t)o; }
                }
                __syncthreads();
            }
#endif
        }
        xcd_barrier(bar);

#ifndef SKIP_FOX
        for (int rp = 0; rp < REP_FOX; ++rp)
        for (int ui = bid; ui < 512; ui += G) {
            int tid = threadIdx.x; asm volatile("" : "+v"(tid)); const int lane = tid & 63, hb = lane >> 5, qi = lane & 31;
            const int h = wave & 3, rh = wave >> 2;
            const int b = ui & 7, qt = (ui >> 8) ? ((ui & 255) >> 3) : 63 - (ui >> 3), t0 = qt * 64, t = t0 + 32 * rh + qi;
            const size_t tokb = (size_t)b * SEQ;
            const float* cf = CFOX + (size_t)b * 4 * SEQ;
            constexpr int FX_VT = 18432, FX_CB = 38912, FX_STAGE = 39424, FX_EX = 2 * FX_STAGE, FX_MISC = FX_EX + 1024;
            LAS unsigned* misc = (LAS unsigned*)(lds + FX_MISC);
            if (wave == 0) {
                float gq = fabsf(P.fox_qk_norm[(L * 2 + 0) * 64 + lane]), gk = fabsf(P.fox_qk_norm[(L * 2 + 1) * 64 + lane]);
#pragma unroll
                for (int o = 1; o < 64; o <<= 1) { gq = fmaxf(gq, __shfl_xor(gq, o)); gk = fmaxf(gk, __shfl_xor(gk, o)); }
                const float bound = -(30.f + 16.f * gq * gk);
                bool c0 = false, c1 = false;
#pragma unroll
                for (int hh = 0; hh < 4; ++hh) { const float cref = cf[hh * SEQ + t0];
                    const int e0 = 32 * lane + 31, e1 = 32 * (lane + 64) + 31;
                    c0 = c0 || (e0 >= t0) || (cref - cf[hh * SEQ + (e0 < SEQ ? e0 : SEQ - 1)] > bound);
                    c1 = c1 || (e1 >= t0) || (cref - cf[hh * SEQ + (e1 < SEQ ? e1 : SEQ - 1)] > bound); }
                const unsigned long long b0 = __ballot(c0), b1 = __ballot(c1);
                if (lane == 0) misc[0] = b0 ? (unsigned)__builtin_ctzll(b0) : 64u + (unsigned)__builtin_ctzll(b1);
            }
            __syncthreads();
            const int kt_lo = __builtin_amdgcn_readfirstlane((int)misc[0]), kt_hi = 2 * qt + 1;
            h8 q[4];
#pragma unroll
            for (int kk = 0; kk < 4; ++kk) q[kk] = *(const h8*)(Z + (tokb + t) * NZP + ZC_FOX_Q + 64 * h + 16 * kk + 8 * hb);
            f32x16 O0, O1;
#pragma unroll
            for (int r = 0; r < 16; ++r) { O0[r] = 0.f; O1[r] = 0.f; }
            float m = -1e30f, l = 0.f;
            u32x4 krA[2], vrA[2], krB[2], vrB[2]; float cbA = 0.f, cbB = 0.f;
            const float cref = cf[((tid >> 5) & 3) * SEQ + t0];
#define FX_ISSUE(KR, VR, CB, kt_) do { _Pragma("unroll") for (int i_ = 0; i_ < 2; ++i_) { const int p_ = tid + 512 * i_; \
                KR[i_] = *(const u32x4*)(Z + (tokb + 32 * (kt_) + (p_ >> 5)) * NZP + ZC_FOX_K + 8 * (p_ & 31)); \
                VR[i_] = *(const u32x4*)(FOXVT + ((size_t)(b * 128 + (kt_)) * 256 + (p_ >> 2)) * 32 + 8 * (p_ & 3)); } \
                CB = cf[((tid >> 5) & 3) * SEQ + 32 * (kt_) + (tid & 31)]; } while (0)
#define FX_WRITE(KR, VR, CB, sb_) do { _Pragma("unroll") for (int i_ = 0; i_ < 2; ++i_) { const int p_ = tid + 512 * i_; \
                *(LAS u32x4*)(lds + (sb_) + ((p_ & 31) >> 3) * 4608 + (p_ >> 5) * 144 + (p_ & 7) * 16) = KR[i_]; \
                *(LAS u32x4*)(lds + (sb_) + FX_VT + ((p_ >> 2) >> 6) * 5120 + ((p_ >> 2) & 63) * 80 + (p_ & 3) * 16) = VR[i_]; } \
                if (tid < 128) *(LAS float*)(lds + (sb_) + FX_CB + tid * 4) = (cref - CB) * LOG2E; } while (0)
            FX_ISSUE(krA, vrA, cbA, kt_lo); FX_WRITE(krA, vrA, cbA, (kt_lo & 1) * FX_STAGE);
            FX_ISSUE(krA, vrA, cbA, (kt_lo + 1 <= kt_hi ? kt_lo + 1 : kt_hi));
            __syncthreads();
            int kt = kt_lo;
#define FX_BODY(KX, VX, CX, KY, VY, CY) do { \
                FX_ISSUE(KY, VY, CY, (kt + 2 <= kt_hi ? kt + 2 : kt_hi)); \
                if (32 * kt <= t0 + 32 * rh + 31) fox_tile(lds + (kt & 1) * FX_STAGE, h, q, qi, hb, 32 * kt + 31 > t0 + 32 * rh, 32 * kt, t, m, l, O0, O1); \
                if (kt + 1 <= kt_hi) FX_WRITE(KX, VX, CX, ((kt + 1) & 1) * FX_STAGE); \
                __syncthreads(); ++kt; } while (0)
            for (;;) { FX_BODY(krA, vrA, cbA, krB, vrB, cbB); if (kt > kt_hi) break; FX_BODY(krB, vrB, cbB, krA, vrA, cbA); if (kt > kt_hi) break; }
#undef FX_BODY
#undef FX_ISSUE
#undef FX_WRITE
            {
                l += __shfl_xor(l, 32);
                const float inv = __builtin_amdgcn_rcpf(l); float ss = 0.f;
#pragma unroll
                for (int r = 0; r < 16; ++r) { O0[r] *= inv; O1[r] *= inv; ss += O0[r] * O0[r] + O1[r] * O1[r]; }
                ss += __shfl_xor(ss, 32);
                LAS float* ex = (LAS float*)(lds + FX_EX);
                const int ridx = 32 * rh + qi;
                if (hb == 0) ex[ridx * 4 + h] = ss;
                __syncthreads();
                const float rs = rsqrtf((ex[ridx * 4] + ex[ridx * 4 + 1] + ex[ridx * 4 + 2] + ex[ridx * 4 + 3]) * (1.f / 256.f) + EPS);
                const float* gn = P.out_norm + (L * 4 + 2) * 256 + h * 64;
                half_t* op = MIXED + (tokb + t) * D + 512 + h * 64;
#pragma unroll
                for (int g = 0; g < 4; ++g) {
                    const int d0 = 8 * g + 4 * hb; const f32x4 g0 = *(const f32x4*)(gn + d0), g1 = *(const f32x4*)(gn + 32 + d0);
                    u32x2 o0, o1;
                    o0.x = pack_h2(O0[4 * g] * rs * g0.x, O0[4 * g + 1] * rs * g0.y); o0.y = pack_h2(O0[4 * g + 2] * rs * g0.z, O0[4 * g + 3] * rs * g0.w);
                    o1.x = pack_h2(O1[4 * g] * rs * g1.x, O1[4 * g + 1] * rs * g1.y); o1.y = pack_h2(O1[4 * g + 2] * rs * g1.z, O1[4 * g + 3] * rs * g1.w);
                    *(u32x2*)(op + d0) = o0; *(u32x2*)(op + 32 + d0) = o1;
                }
            }
            __syncthreads();
        }
#endif
#ifndef SKIP_NSA
        if (wave == 0) {
            int tidf = threadIdx.x; asm volatile("" : "+v"(tidf));
            float gq = fabsf(P.nsa_qk_norm[(L * 4 + 0) * 64 + tidf]), gk = fmaxf(fmaxf(fabsf(P.nsa_qk_norm[(L * 4 + 1) * 64 + tidf]), fabsf(P.nsa_qk_norm[(L * 4 + 2) * 64 + tidf])), fabsf(P.nsa_qk_norm[(L * 4 + 3) * 64 + tidf]));
            float rb = fmaxf(fabsf(P.rel_bias[tidf]), fabsf(P.rel_bias[64 + tidf]));
#pragma unroll
            for (int o = 1; o < 64; o <<= 1) { gq = fmaxf(gq, __shfl_xor(gq, o)); gk = fmaxf(gk, __shfl_xor(gk, o)); rb = fmaxf(rb, __shfl_xor(rb, o)); }
            if (tidf == 0) MISC[16] = ((8.f * gq * gk + 2.f * rb) * LOG2E <= 15.8f) ? 1u : 0u;
        }
        __syncthreads();
        const bool nsa_fast = __builtin_amdgcn_readfirstlane((int)MISC[16]) != 0;
        if (nsa_fast)
        for (int rp = 0; rp < REP_NSA; ++rp)
        for (int ui = bid; ui < 512; ui += G) {
            int tid = threadIdx.x; asm volatile("" : "+v"(tid)); const int lane = tid & 63, hb = lane >> 5, qi = lane & 31;
            const int h = wave & 3, rh = wave >> 2;
            const int b = ui & 7, qt = (ui >> 8) ? ((ui & 255) >> 3) : 63 - (ui >> 3), t0 = qt * 64, t = t0 + 32 * rh + qi, cur = qt, row = 32 * rh + qi;
            const size_t tokb = (size_t)b * SEQ;
            constexpr int NS_VT = 9216, NS_STAGE = 18432, NF_TRX = 36864, NF_IMP = NF_TRX + 4 * 520 * 4, NF_SELM = NF_IMP + 4 * 64 * 65 * 4, NF_EX = NF_SELM + 512, NF_STL = NF_EX + 1024, NF_MISC = NF_STL + 1024;
            static_assert(NF_MISC + 256 <= RING_BYTES, "NSA fast LDS map");
            LAS float* TRX = (LAS float*)(lds + NF_TRX); LAS float* impH = (LAS float*)(lds + NF_IMP); LAS unsigned* selm = (LAS unsigned*)(lds + NF_SELM);
            LAS float* ex = (LAS float*)(lds + NF_EX); LAS float* stl = (LAS float*)(lds + NF_STL); LAS unsigned* misc = (LAS unsigned*)(lds + NF_MISC);
            for (int e = tid; e < 4 * 520; e += NTHR) { const int hh = e / 520, i = e % 520, d = i - 1;
                TRX[e] = (i == 0 || i > 512) ? -INFINITY : (P.rel_bias[(d < 128 ? (int)c_bucket[d] : 31) * 4 + hh] - P.rel_bias[31 * 4 + hh]) * LOG2E; }
            for (int e = tid; e < 4 * 64 * 65; e += NTHR) impH[e] = 0.f;
            const LAS float* TXh = TRX + h * 520;
            h8 q[4];
#pragma unroll
            for (int kk = 0; kk < 4; ++kk) q[kk] = *(const h8*)(Z + (tokb + t) * NZP + ZC_NSA_Q + 64 * h + 16 * kk + 8 * hb);
            const float* gb = P.nsa_gate_bias + L * 12;
            const half_t* gz = Z + (tokb + t) * NZP + ZC_NSA_G;
            f32x16 T0, T1;
            u32x4 kr, vr, krB, vrB;
#define NS_ISSUE_R(KR, VR, kbase_, kstride_, vbase_, vstride_) do { KR = *(const u32x4*)((const char*)(kbase_) + (size_t)(tid >> 3) * (kstride_) + (tid & 7) * 16); \
                VR = *(const u32x4*)((const char*)(vbase_) + (size_t)(tid >> 3) * (vstride_) + (tid & 7) * 16); } while (0)
#define NS_WRITE_R(KR, VR, sb_) do { *(LAS u32x4*)(lds + (sb_) + (tid >> 3) * 144 + (tid & 7) * 16) = KR; *(LAS u32x4*)(lds + (sb_) + NS_VT + (tid >> 3) * 144 + (tid & 7) * 16) = VR; } while (0)
            {
                int cnt = (t0 + 63 - 31) / 16 + 1; if (cnt > NCMP) cnt = NCMP;
                const int ntc = (cnt + 63) >> 6;
                const half_t* kcb = KCH + (size_t)b * 256 * 64; const half_t* vcb = VCT + (size_t)b * 64 * 256;
                float l = 0.f;
#pragma unroll
                for (int r = 0; r < 16; ++r) { T0[r] = 0.f; T1[r] = 0.f; }
                for (int c = 0; c < ntc; ++c) {
                    __syncthreads();
                    NS_ISSUE_R(kr, vr, kcb + (size_t)c * 64 * 64, 128, vcb + c * 64, 512); NS_WRITE_R(kr, vr, 0);
                    __syncthreads();
                    f32x16 S0, S1; init_tab(S0, S1, TXh, t - 31 - 1024 * c, hb, 16, 511, true);
                    qk64(S0, S1, q, lds, qi, hb);
                    l += exp_sum64(S0, S1);
                    LAS float* ip = impH + (h * 64 + row) * 65 + 16 * c + 2 * hb;
#pragma unroll
                    for (int g = 0; g < 4; ++g) {
                        const int mo = 4 * (g >> 1) + (g & 1);
                        { const float v1 = 16.f * S0[4 * g + 3], v0 = 32.f * ((S0[4 * g] + S0[4 * g + 1]) + S0[4 * g + 2]) + v1;
                          __hip_atomic_fetch_add(ip + mo, v0, __ATOMIC_RELAXED, __HIP_MEMORY_SCOPE_WORKGROUP); if (16 * c + 2 * hb + mo + 1 < 64) __hip_atomic_fetch_add(ip + mo + 1, v1, __ATOMIC_RELAXED, __HIP_MEMORY_SCOPE_WORKGROUP); }
                        { const float v1 = 16.f * S1[4 * g + 3], v0 = 32.f * ((S1[4 * g] + S1[4 * g + 1]) + S1[4 * g + 2]) + v1;
                          __hip_atomic_fetch_add(ip + 8 + mo, v0, __ATOMIC_RELAXED, __HIP_MEMORY_SCOPE_WORKGROUP); if (16 * c + 2 * hb + 8 + mo + 1 < 64) __hip_atomic_fetch_add(ip + 8 + mo + 1, v1, __ATOMIC_RELAXED, __HIP_MEMORY_SCOPE_WORKGROUP); }
                    }
                    pv64m(S0, S1, true, lds + NS_VT, T0, T1, qi, hb);
                }
                l += __shfl_xor(l, 32);
                const float il = l > 0.f ? __builtin_amdgcn_rcpf(l) : 0.f;
                if (hb == 0) stl[row * 4 + h] = il;
                const float g0 = sigmoidf_((float)gz[0 * 4 + h] + gb[0 * 4 + h]) * il;
#pragma unroll
                for (int r = 0; r < 16; ++r) { T0[r] *= g0; T1[r] *= g0; }
            }
            __syncthreads();
            for (int rpQ = 0; rpQ < REP_NSELECT; ++rpQ)
            for (int rr = 0; rr < 8; ++rr) {
                const int rw = wave * 8 + rr;
                float v = ((impH[(0 * 64 + rw) * 65 + lane] * stl[rw * 4 + 0] + impH[(1 * 64 + rw) * 65 + lane] * stl[rw * 4 + 1]) + impH[(2 * 64 + rw) * 65 + lane] * stl[rw * 4 + 2]) + impH[(3 * 64 + rw) * 65 + lane] * stl[rw * 4 + 3];
                if (lane > cur) v = -INFINITY; else if (lane == 0 || lane == cur || lane == cur - 1) v = 1e30f;
                int rank = 0;
                for (int o = 0; o < 64; ++o) { const float w = __shfl(v, o); rank += (w > v || (w == v && o < lane)) ? 1 : 0; }
                const unsigned long long msk = __ballot(rank < 16);
                if (lane == 0) { selm[rw * 2] = (unsigned)msk; selm[rw * 2 + 1] = (unsigned)(msk >> 32); }
            }
            __syncthreads();
            if (wave == 0) {
                unsigned lo = selm[lane * 2], hi = selm[lane * 2 + 1];
#pragma unroll
                for (int o = 1; o < 64; o <<= 1) { lo |= __shfl_xor(lo, o); hi |= __shfl_xor(hi, o); }
                if (lane == 0) { misc[0] = lo; misc[1] = hi; }
            }
            __syncthreads();
            const unsigned long long mymask = (unsigned long long)selm[row * 2] | ((unsigned long long)selm[row * 2 + 1] << 32);
            unsigned long long um = (unsigned long long)(unsigned)__builtin_amdgcn_readfirstlane((int)misc[0]) | ((unsigned long long)(unsigned)__builtin_amdgcn_readfirstlane((int)misc[1]) << 32);
            um &= (cur >= 63) ? ~0ull : ((1ull << (cur + 1)) - 1ull);
            const unsigned long long um_all = um;
            for (int rpS = 0; rpS < REP_NSEL; ++rpS) {
                um = um_all; if (rpS) __syncthreads();
                f32x16 O0, O1;
#pragma unroll
                for (int r = 0; r < 16; ++r) { O0[r] = 0.f; O1[r] = 0.f; }
                float l = 0.f;
                int jc = __builtin_ctzll(um); um &= um - 1;
                int jn = -1; if (um) { jn = __builtin_ctzll(um); um &= um - 1; }
                int it = 0;
#define SEL_K(j_) (Z + (tokb + 64 * (j_)) * NZP + ZC_KS)
#define SEL_V(j_) (VST + (size_t)(b * 64 + (j_)) * 64 * 64)
                NS_ISSUE_R(kr, vr, SEL_K(jc), NZP * 2, SEL_V(jc), 128); NS_WRITE_R(kr, vr, 0);
                { const int je = jn >= 0 ? jn : jc; NS_ISSUE_R(kr, vr, SEL_K(je), NZP * 2, SEL_V(je), 128); }
                __syncthreads();
#define SEL_BODY(KX, VX, KY, VY) do { \
                    int jnn = -1; if (um) { jnn = __builtin_ctzll(um); um &= um - 1; } \
                    { const int je = jnn >= 0 ? jnn : jc; NS_ISSUE_R(KY, VY, SEL_K(je), NZP * 2, SEL_V(je), 128); } \
                    { const bool sel = (mymask >> jc) & 1ull; \
                      if (__any(sel)) { f32x16 S0, S1; const LAS unsigned char* st_ = lds + (it & 1) * NS_STAGE; \
                          if (jc >= cur - 2) { init_tab(S0, S1, TXh, t - 64 * jc, hb, 1, 511, sel); qk64(S0, S1, q, st_, qi, hb); } else qk64z(S0, S1, q, st_, qi, hb); \
                          const float ps_ = exp_sum64(S0, S1); l += sel ? ps_ : 0.f; \
                          pv64m(S0, S1, sel, st_ + NS_VT, O0, O1, qi, hb); } } \
                    if (jn >= 0) NS_WRITE_R(KX, VX, ((it + 1) & 1) * NS_STAGE); \
                    __syncthreads(); jc = jn; jn = jnn; ++it; } while (0)
                for (;;) { SEL_BODY(kr, vr, krB, vrB); if (jc < 0) break; SEL_BODY(krB, vrB, kr, vr); if (jc < 0) break; }
#undef SEL_BODY
#undef SEL_K
#undef SEL_V
                l += __shfl_xor(l, 32);
                const float g1 = sigmoidf_((float)gz[1 * 4 + h] + gb[1 * 4 + h]) * __builtin_amdgcn_rcpf(l);
                if (rpS == REP_NSEL - 1) {
#pragma unroll
                for (int r = 0; r < 16; ++r) { T0[r] += g1 * O0[r]; T1[r] += g1 * O1[r]; } }
            }
            __syncthreads();
            for (int rpW = 0; rpW < REP_NWIN; ++rpW) {
                if (rpW) __syncthreads();
                f32x16 O0, O1;
#pragma unroll
                for (int r = 0; r < 16; ++r) { O0[r] = 0.f; O1[r] = 0.f; }
                float l = 0.f;
                const int jlo = cur >= 8 ? cur - 8 : 0;
#define WIN_K(j_) (Z + (tokb + 64 * (j_)) * NZP + ZC_KW)
#define WIN_V(j_) (VWT + (size_t)(b * 64 + (j_)) * 64 * 64)
                NS_ISSUE_R(kr, vr, WIN_K(jlo), NZP * 2, WIN_V(jlo), 128); NS_WRITE_R(kr, vr, 0);
                { const int je = jlo + 1 <= cur ? jlo + 1 : cur; NS_ISSUE_R(kr, vr, WIN_K(je), NZP * 2, WIN_V(je), 128); }
                __syncthreads();
                int j = jlo;
#define WIN_BODY(KX, VX, KY, VY) do { \
                    { const int je = j + 2 <= cur ? j + 2 : cur; NS_ISSUE_R(KY, VY, WIN_K(je), NZP * 2, WIN_V(je), 128); } \
                    { f32x16 S0, S1; const LAS unsigned char* st_ = lds + ((j - jlo) & 1) * NS_STAGE; \
                      if (j >= cur - 2 || j == cur - 8) { init_tab(S0, S1, TXh, t - 64 * j, hb, 1, 512, true); qk64(S0, S1, q, st_, qi, hb); } else qk64z(S0, S1, q, st_, qi, hb); \
                      l += exp_sum64(S0, S1); \
                      pv64m(S0, S1, true, st_ + NS_VT, O0, O1, qi, hb); } \
                    if (j + 1 <= cur) NS_WRITE_R(KX, VX, (((j - jlo) + 1) & 1) * NS_STAGE); \
                    __syncthreads(); ++j; } while (0)
                for (;;) { WIN_BODY(kr, vr, krB, vrB); if (j > cur) break; WIN_BODY(krB, vrB, kr, vr); if (j > cur) break; }
#undef WIN_BODY
#undef WIN_K
#undef WIN_V
                l += __shfl_xor(l, 32);
                const float g2 = sigmoidf_((float)gz[2 * 4 + h] + gb[2 * 4 + h]) * __builtin_amdgcn_rcpf(l);
                if (rpW == REP_NWIN - 1) {
#pragma unroll
                for (int r = 0; r < 16; ++r) { T0[r] += g2 * O0[r]; T1[r] += g2 * O1[r]; } }
            }
#undef NS_ISSUE_R
#undef NS_WRITE_R
            {
                float ss = 0.f;
#pragma unroll
                for (int r = 0; r < 16; ++r) ss += T0[r] * T0[r] + T1[r] * T1[r];
                ss += __shfl_xor(ss, 32);
                if (hb == 0) ex[row * 4 + h] = ss;
                __syncthreads();
                const float rs = rsqrtf((ex[row * 4] + ex[row * 4 + 1] + ex[row * 4 + 2] + ex[row * 4 + 3]) * (1.f / 256.f) + EPS);
                const float* gn = P.out_norm + (L * 4 + 3) * 256 + h * 64;
                half_t* op = MIXED + (tokb + t) * D + 768 + h * 64;
#pragma unroll
                for (int g = 0; g < 4; ++g) {
                    const int d0 = 8 * g + 4 * hb; const f32x4 g0 = *(const f32x4*)(gn + d0), g1 = *(const f32x4*)(gn + 32 + d0);
                    u32x2 o0, o1;
                    o0.x = pack_h2(T0[4 * g] * rs * g0.x, T0[4 * g + 1] * rs * g0.y); o0.y = pack_h2(T0[4 * g + 2] * rs * g0.z, T0[4 * g + 3] * rs * g0.w);
                    o1.x = pack_h2(T1[4 * g] * rs * g1.x, T1[4 * g + 1] * rs * g1.y); o1.y = pack_h2(T1[4 * g + 2] * rs * g1.z, T1[4 * g + 3] * rs * g1.w);
                    *(u32x2*)(op + d0) = o0; *(u32x2*)(op + 32 + d0) = o1;
                }
            }
            __syncthreads();
        }
        else
        for (int rp = 0; rp < REP_NSA; ++rp)
        for (int ui = bid; ui < 512; ui += G) {
            int tid = threadIdx.x; asm volatile("" : "+v"(tid)); const int lane = tid & 63, hb = lane >> 5, qi = lane & 31;
            const int h = wave & 3, rh = wave >> 2;
            const int b = ui & 7, qt = (ui >> 8) ? ((ui & 255) >> 3) : 63 - (ui >> 3), t0 = qt * 64, t = t0 + 32 * rh + qi, cur = qt, row = 32 * rh + qi;
            const size_t tokb = (size_t)b * SEQ;
            constexpr int NS_VT = 9216, NS_STAGE = 18432, NS_TR = 36864, NS_IMP = 38976, NS_SELM = NS_IMP + 4 * 64 * 65 * 4, NS_EX = NS_SELM + 512, NS_MISC = NS_EX + 1024;
            static_assert(NS_MISC + 256 <= RING_BYTES, "NSA LDS map");
            LAS float* TR = (LAS float*)(lds + NS_TR); LAS float* impH = (LAS float*)(lds + NS_IMP); LAS unsigned* selm = (LAS unsigned*)(lds + NS_SELM);
            LAS float* ex = (LAS float*)(lds + NS_EX); LAS unsigned* misc = (LAS unsigned*)(lds + NS_MISC);
            for (int e = tid; e < 4 * 129; e += NTHR) { const int hh = e / 129, d = e % 129; TR[hh * 132 + d] = P.rel_bias[(d < 128 ? (int)c_bucket[d] : 31) * 4 + hh] * LOG2E; }
            for (int e = tid; e < 4 * 64 * 65; e += NTHR) impH[e] = 0.f;
            const LAS float* TRh = TR + h * 132;
            h8 q[4];
#pragma unroll
            for (int kk = 0; kk < 4; ++kk) q[kk] = *(const h8*)(Z + (tokb + t) * NZP + ZC_NSA_Q + 64 * h + 16 * kk + 8 * hb);
            const float* gb = P.nsa_gate_bias + L * 12;
            const half_t* gz = Z + (tokb + t) * NZP + ZC_NSA_G;
            f32x16 T0, T1;
            u32x4 kr, vr, krB, vrB;
#define NS_ISSUE_R(KR, VR, kbase_, kstride_, vbase_, vstride_) do { KR = *(const u32x4*)((const char*)(kbase_) + (size_t)(tid >> 3) * (kstride_) + (tid & 7) * 16); \
                VR = *(const u32x4*)((const char*)(vbase_) + (size_t)(tid >> 3) * (vstride_) + (tid & 7) * 16); } while (0)
#define NS_WRITE_R(KR, VR, sb_) do { *(LAS u32x4*)(lds + (sb_) + (tid >> 3) * 144 + (tid & 7) * 16) = KR; *(LAS u32x4*)(lds + (sb_) + NS_VT + (tid >> 3) * 144 + (tid & 7) * 16) = VR; } while (0)
#define NS_ISSUE(kbase_, kstride_, vbase_, vstride_) do { kr = *(const u32x4*)((const char*)(kbase_) + (size_t)(tid >> 3) * (kstride_) + (tid & 7) * 16); \
                vr = *(const u32x4*)((const char*)(vbase_) + (size_t)(tid >> 3) * (vstride_) + (tid & 7) * 16); } while (0)
#define NS_WRITE(sb_) do { *(LAS u32x4*)(lds + (sb_) + (tid >> 3) * 144 + (tid & 7) * 16) = kr; *(LAS u32x4*)(lds + (sb_) + NS_VT + (tid >> 3) * 144 + (tid & 7) * 16) = vr; } while (0)
            {
                int cnt = (t0 + 63 - 31) / 16 + 1; if (cnt > NCMP) cnt = NCMP;
                const int ntc = (cnt + 63) >> 6;
                const half_t* kcb = KCH + (size_t)b * 256 * 64; const half_t* vcb = VCT + (size_t)b * 64 * 256;
                float m = -1e30f, l = 0.f;
                for (int c = 0; c < ntc; ++c) {
                    __syncthreads();
                    NS_ISSUE(kcb + (size_t)c * 64 * 64, 128, vcb + c * 64, 512); NS_WRITE(0);
                    __syncthreads();
                    f32x16 S0, S1; init_near(S0, S1, TRh, t - 31 - 1024 * c, hb, 16, 1 << 30);
                    qk64(S0, S1, q, lds, qi, hb);
                    const float mn = fmaxf(m, rowmax64(S0, S1)), alpha = __builtin_amdgcn_exp2f(m - mn);
                    m = mn; float ps = 0.f;
#pragma unroll
                    for (int r = 0; r < 16; ++r) ps += __builtin_amdgcn_exp2f(S0[r] - mn) + __builtin_amdgcn_exp2f(S1[r] - mn);
                    l = l * alpha + ps;
                }
                l += __shfl_xor(l, 32);
                const float il = l > 0.f ? __builtin_amdgcn_rcpf(l) : 0.f;
#pragma unroll
                for (int r = 0; r < 16; ++r) { T0[r] = 0.f; T1[r] = 0.f; }
                for (int c = 0; c < ntc; ++c) {
                    __syncthreads();
                    NS_ISSUE(kcb + (size_t)c * 64 * 64, 128, vcb + c * 64, 512); NS_WRITE(0);
                    __syncthreads();
                    f32x16 S0, S1; init_near(S0, S1, TRh, t - 31 - 1024 * c, hb, 16, 1 << 30);
                    qk64(S0, S1, q, lds, qi, hb);
#pragma unroll
                    for (int r = 0; r < 16; ++r) { S0[r] = __builtin_amdgcn_exp2f(S0[r] - m) * il; S1[r] = __builtin_amdgcn_exp2f(S1[r] - m) * il; }
                    LAS float* ip = impH + (h * 64 + row) * 65 + 16 * c + 2 * hb;
#pragma unroll
                    for (int g = 0; g < 4; ++g) {
                        const int mo = 4 * (g >> 1) + (g & 1);
                        { const float v1 = 16.f * S0[4 * g + 3], v0 = 32.f * ((S0[4 * g] + S0[4 * g + 1]) + S0[4 * g + 2]) + v1;
                          __hip_atomic_fetch_add(ip + mo, v0, __ATOMIC_RELAXED, __HIP_MEMORY_SCOPE_WORKGROUP); if (16 * c + 2 * hb + mo + 1 < 64) __hip_atomic_fetch_add(ip + mo + 1, v1, __ATOMIC_RELAXED, __HIP_MEMORY_SCOPE_WORKGROUP); }
                        { const float v1 = 16.f * S1[4 * g + 3], v0 = 32.f * ((S1[4 * g] + S1[4 * g + 1]) + S1[4 * g + 2]) + v1;
                          __hip_atomic_fetch_add(ip + 8 + mo, v0, __ATOMIC_RELAXED, __HIP_MEMORY_SCOPE_WORKGROUP); if (16 * c + 2 * hb + 8 + mo + 1 < 64) __hip_atomic_fetch_add(ip + 8 + mo + 1, v1, __ATOMIC_RELAXED, __HIP_MEMORY_SCOPE_WORKGROUP); }
                    }
                    pv64(S0, S1, lds + NS_VT, T0, T1, qi, hb);
                }
                const float g0 = sigmoidf_((float)gz[0 * 4 + h] + gb[0 * 4 + h]);
#pragma unroll
                for (int r = 0; r < 16; ++r) { T0[r] *= g0; T1[r] *= g0; }
            }
            __syncthreads();
            for (int rr = 0; rr < 8; ++rr) {
                const int rw = wave * 8 + rr;
                float v = ((impH[(0 * 64 + rw) * 65 + lane] + impH[(1 * 64 + rw) * 65 + lane]) + impH[(2 * 64 + rw) * 65 + lane]) + impH[(3 * 64 + rw) * 65 + lane];
                if (lane > cur) v = -INFINITY; else if (lane == 0 || lane == cur || lane == cur - 1) v = 1e30f;
                int rank = 0;
                for (int o = 0; o < 64; ++o) { const float w = __shfl(v, o); rank += (w > v || (w == v && o < lane)) ? 1 : 0; }
                const unsigned long long msk = __ballot(rank < 16);
                if (lane == 0) { selm[rw * 2] = (unsigned)msk; selm[rw * 2 + 1] = (unsigned)(msk >> 32); }
            }
            __syncthreads();
            if (wave == 0) {
                unsigned lo = selm[lane * 2], hi = selm[lane * 2 + 1];
#pragma unroll
                for (int o = 1; o < 64; o <<= 1) { lo |= __shfl_xor(lo, o); hi |= __shfl_xor(hi, o); }
                if (lane == 0) { misc[0] = lo; misc[1] = hi; }
            }
            __syncthreads();
            const unsigned long long mymask = (unsigned long long)selm[row * 2] | ((unsigned long long)selm[row * 2 + 1] << 32);
            unsigned long long um = (unsigned long long)__builtin_amdgcn_readfirstlane((int)misc[0]) | ((unsigned long long)(unsigned)__builtin_amdgcn_readfirstlane((int)misc[1]) << 32);
            um &= (cur >= 63) ? ~0ull : ((1ull << (cur + 1)) - 1ull);
            const float cfar = TRh[128];
            {
                f32x16 O0, O1;
#pragma unroll
                for (int r = 0; r < 16; ++r) { O0[r] = 0.f; O1[r] = 0.f; }
                float m = -1e30f, l = 0.f;
                int jc = __builtin_ctzll(um); um &= um - 1;
                int jn = -1; if (um) { jn = __builtin_ctzll(um); um &= um - 1; }
                int it = 0;
#define SEL_K(j_) (Z + (tokb + 64 * (j_)) * NZP + ZC_KS)
#define SEL_V(j_) (VST + (size_t)(b * 64 + (j_)) * 64 * 64)
                NS_ISSUE_R(kr, vr, SEL_K(jc), NZP * 2, SEL_V(jc), 128); NS_WRITE_R(kr, vr, 0);
                { const int je = jn >= 0 ? jn : jc; NS_ISSUE_R(kr, vr, SEL_K(je), NZP * 2, SEL_V(je), 128); }
                __syncthreads();
#define SEL_BODY(KX, VX, KY, VY) do { \
                    int jnn = -1; if (um) { jnn = __builtin_ctzll(um); um &= um - 1; } \
                    { const int je = jnn >= 0 ? jnn : jc; NS_ISSUE_R(KY, VY, SEL_K(je), NZP * 2, SEL_V(je), 128); } \
                    { const bool sel = (mymask >> jc) & 1ull; \
                      if (__any(sel)) nsa_tile(jc >= cur - 2, t - 64 * jc, sel ? (1 << 30) : 0, sel ? cfar : -INFINITY, TRh, q, lds + (it & 1) * NS_STAGE, m, l, O0, O1, qi, hb); } \
                    if (jn >= 0) NS_WRITE_R(KX, VX, ((it + 1) & 1) * NS_STAGE); \
                    __syncthreads(); jc = jn; jn = jnn; ++it; } while (0)
                for (;;) { SEL_BODY(kr, vr, krB, vrB); if (jc < 0) break; SEL_BODY(krB, vrB, kr, vr); if (jc < 0) break; }
#undef SEL_BODY
#undef SEL_K
#undef SEL_V
                l += __shfl_xor(l, 32);
                const float g1 = sigmoidf_((float)gz[1 * 4 + h] + gb[1 * 4 + h]) * __builtin_amdgcn_rcpf(l);
#pragma unroll
                for (int r = 0; r < 16; ++r) { T0[r] += g1 * O0[r]; T1[r] += g1 * O1[r]; }
            }
            __syncthreads();
            {
                f32x16 O0, O1;
#pragma unroll
                for (int r = 0; r < 16; ++r) { O0[r] = 0.f; O1[r] = 0.f; }
                float m = -1e30f, l = 0.f;
                const int jlo = cur >= 8 ? cur - 8 : 0;
#define WIN_K(j_) (Z + (tokb + 64 * (j_)) * NZP + ZC_KW)
#define WIN_V(j_) (VWT + (size_t)(b * 64 + (j_)) * 64 * 64)
                NS_ISSUE_R(kr, vr, WIN_K(jlo), NZP * 2, WIN_V(jlo), 128); NS_WRITE_R(kr, vr, 0);
                { const int je = jlo + 1 <= cur ? jlo + 1 : cur; NS_ISSUE_R(kr, vr, WIN_K(je), NZP * 2, WIN_V(je), 128); }
                __syncthreads();
                int j = jlo;
#define WIN_BODY(KX, VX, KY, VY) do { \
                    { const int je = j + 2 <= cur ? j + 2 : cur; NS_ISSUE_R(KY, VY, WIN_K(je), NZP * 2, WIN_V(je), 128); } \
                    nsa_tile(j >= cur - 2 || j == cur - 8, t - 64 * j, 512, cfar, TRh, q, lds + ((j - jlo) & 1) * NS_STAGE, m, l, O0, O1, qi, hb); \
                    if (j + 1 <= cur) NS_WRITE_R(KX, VX, (((j - jlo) + 1) & 1) * NS_STAGE); \
                    __syncthreads(); ++j; } while (0)
                for (;;) { WIN_BODY(kr, vr, krB, vrB); if (j > cur) break; WIN_BODY(krB, vrB, kr, vr); if (j > cur) break; }
#undef WIN_BODY
#undef WIN_K
#undef WIN_V
                l += __shfl_xor(l, 32);
                const float g2 = sigmoidf_((float)gz[2 * 4 + h] + gb[2 * 4 + h]) * __builtin_amdgcn_rcpf(l);
#pragma unroll
                for (int r = 0; r < 16; ++r) { T0[r] += g2 * O0[r]; T1[r] += g2 * O1[r]; }
            }
#undef NS_ISSUE
#undef NS_WRITE
#undef NS_ISSUE_R
#undef NS_WRITE_R
            {
                float ss = 0.f;
#pragma unroll
                for (int r = 0; r < 16; ++r) ss += T0[r] * T0[r] + T1[r] * T1[r];
                ss += __shfl_xor(ss, 32);
                if (hb == 0) ex[row * 4 + h] = ss;
                __syncthreads();
                const float rs = rsqrtf((ex[row * 4] + ex[row * 4 + 1] + ex[row * 4 + 2] + ex[row * 4 + 3]) * (1.f / 256.f) + EPS);
                const float* gn = P.out_norm + (L * 4 + 3) * 256 + h * 64;
                half_t* op = MIXED + (tokb + t) * D + 768 + h * 64;
#pragma unroll
                for (int g = 0; g < 4; ++g) {
                    const int d0 = 8 * g + 4 * hb; const f32x4 g0 = *(const f32x4*)(gn + d0), g1 = *(const f32x4*)(gn + 32 + d0);
                    u32x2 o0, o1;
                    o0.x = pack_h2(T0[4 * g] * rs * g0.x, T0[4 * g + 1] * rs * g0.y); o0.y = pack_h2(T0[4 * g + 2] * rs * g0.z, T0[4 * g + 3] * rs * g0.w);
                    o1.x = pack_h2(T1[4 * g] * rs * g1.x, T1[4 * g + 1] * rs * g1.y); o1.y = pack_h2(T1[4 * g + 2] * rs * g1.z, T1[4 * g + 3] * rs * g1.w);
                    *(u32x2*)(op + d0) = o0; *(u32x2*)(op + 32 + d0) = o1;
                }
            }
            __syncthreads();
        }
#endif
#ifndef SKIP_LRU
        for (int rp = 0; rp < REP_LRU; ++rp)
        for (int gI = bid; gI < 256; gI += G) {
            float hc = 0.f;
            for (int k = 0; k < 4; ++k) lru_unit<true>(P, L, ((gI >> 5) << 7) + 4 * (gI & 31) + k, lds, Z, WGT, CB + 1024, LRUAGG, MIXED, wave, hc, k == 0);
        }
#endif
        xcd_barrier(bar);

#ifndef SKIP_G4
        {
            pg8::Gemm g{MIXED, WOUT_T + (size_t)L * D * D, T, D, D}; pg8::StaticOrder S; S.init(T, D, G, bid);
            EpiRes E{L == 0 ? P.x : P.out, P.out, XH, SSQA};
            for (int rp = 0; rp < REP_G4N; ++rp) { EpiNull EN; pg8::gemm_phase<EpiNull, pg8::StaticOrder>(lds, g, S, EN); }
            pg8::gemm_phase<EpiRes, pg8::StaticOrder>(lds, g, S, E);
        }
#endif
        xcd_barrier(bar);
#ifndef SKIP_G5
        {
            pg8::Gemm g{XH, WGU_T + (size_t)L * 2 * DFF * D, T, 2 * DFF, D}; pg8::StaticOrder S; S.init(T, 2 * DFF, G, bid);
            EpiSwiglu E{HB, SSQA};
            for (int rp = 0; rp < REP_G5; ++rp) pg8::gemm_phase<EpiSwiglu, pg8::StaticOrder>(lds, g, S, E);
        }
#endif
        xcd_barrier(bar);
#ifndef SKIP_G6
        {
            pg8::Gemm g{HB, WDN_T + (size_t)L * D * DFF, T, D, DFF}; pg8::StaticOrder S; S.init(T, D, G, bid);
            EpiRes E{P.out, P.out, L == 0 ? XH : nullptr, L == 0 ? SSQB : nullptr};
            for (int rp = 0; rp < REP_G6N; ++rp) { EpiNull EN; pg8::gemm_phase<EpiNull, pg8::StaticOrder>(lds, g, S, EN); }
            pg8::gemm_phase<EpiRes, pg8::StaticOrder>(lds, g, S, E);
        }
#endif
        if (L == 0) xcd_barrier(bar);
    }
}

extern "C" void kernel_launch(void* const* d_in, const int* in_sizes, int n_in, void* d_out, int out_size, void* d_ws, size_t ws_size, hipStream_t stream) {
    static int grid = 0;
    if (grid == 0) {
        if (n_in != 22 || ws_size < WS_END) { fprintf(stderr, "kernel_launch: unexpected n_in %d or ws_size %zu (< %zu)\n", n_in, ws_size, (size_t)WS_END); grid = -1; return; }
        int dev = 0, cus = 0, per_cu = 0;
        if (hipGetDevice(&dev) != hipSuccess || hipDeviceGetAttribute(&cus, hipDeviceAttributeMultiprocessorCount, dev) != hipSuccess) { grid = -1; return; }
        if (hipFuncSetAttribute((const void*)hymba_fwd, hipFuncAttributeMaxDynamicSharedMemorySize, LDS_BYTES) != hipSuccess) { fprintf(stderr, "kernel_launch: hipFuncSetAttribute failed\n"); grid = -1; return; }
        if (hipOccupancyMaxActiveBlocksPerMultiprocessor(&per_cu, (const void*)hymba_fwd, NTHR, LDS_BYTES) != hipSuccess || per_cu < 1) { fprintf(stderr, "kernel_launch: occupancy query says %d\n", per_cu); }
        (void)hipGetLastError();
        grid = cus;
    }
    if (grid < 0) return;
    (void)hipMemsetAsync((char*)d_ws + WS_CTL, 0, CTL_ZERO_BYTES, stream);
    Params p{};
    p.x = (const float*)d_in[0]; p.norm_mix = (const float*)d_in[1]; p.w_in = (const float*)d_in[2]; p.lru_conv_w = (const float*)d_in[3]; p.lru_conv_b = (const float*)d_in[4];
    p.lru_w_gates = (const float*)d_in[5]; p.lru_b_gates = (const float*)d_in[6]; p.lru_lambda = (const float*)d_in[7]; p.sc_conv_w = (const float*)d_in[8];
    p.fox_f_bias = (const float*)d_in[9]; p.fox_qk_norm = (const float*)d_in[10]; p.nsa_qk_norm = (const float*)d_in[11]; p.nsa_cmp_pos = (const float*)d_in[12];
    p.nsa_cmp_w1 = (const float*)d_in[13]; p.nsa_cmp_w2 = (const float*)d_in[14]; p.nsa_gate_bias = (const float*)d_in[15]; p.rel_bias = (const float*)d_in[16];
    p.out_norm = (const float*)d_in[17]; p.w_out = (const float*)d_in[18]; p.norm_ffn = (const float*)d_in[19]; p.w_gate_up = (const float*)d_in[20]; p.w_down = (const float*)d_in[21];
    p.out = (float*)d_out; p.ws = (unsigned char*)d_ws;
    hipLaunchKernelGGL(hymba_fwd, dim3(grid), dim3(NTHR), LDS_BYTES, stream, p);
}
```

```cpp
#include <hip/hip_runtime.h>
#include <stdint.h>
#include <stdio.h>

#define LAS __attribute__((address_space(3)))
typedef _Float16 half_t;
typedef _Float16 h8 __attribute__((ext_vector_type(8)));
typedef _Float16 h4 __attribute__((ext_vector_type(4)));
typedef _Float16 h2 __attribute__((ext_vector_type(2)));
typedef float f32x4 __attribute__((ext_vector_type(4)));
typedef unsigned u32x4 __attribute__((ext_vector_type(4)));
typedef unsigned u32x2 __attribute__((ext_vector_type(2)));
typedef float f32x16 __attribute__((ext_vector_type(16)));
#define MFMA32(a, b, c) __builtin_amdgcn_mfma_f32_32x32x16_f16(a, b, c, 0, 0, 0)
constexpr float LOG2E = 1.4426950408889634f, QSCALE = 0.125f * 1.4426950408889634f;
__device__ __forceinline__ int pi16(int r) { return (r & ~0xC) | ((r & 4) << 1) | ((r & 8) >> 1); }

constexpr int BATCH = 8, SEQ = 4096, T = BATCH * SEQ, D = 1024, NZP = 2816, DFF = 2816, NCMP = 255;
constexpr int NIN_SRC = 2704;
constexpr int ZC_LRU_X = 0, ZC_LRU_G = 256, ZC_SC_B = 512, ZC_SC_C = 768, ZC_SC_X = 1024, ZC_FOX_Q = 1280, ZC_FOX_K = 1536, ZC_FOX_V = 1792,
              ZC_NSA_Q = 2048, ZC_KC = 2304, ZC_VC = 2368, ZC_KS = 2432, ZC_VS = 2496, ZC_KW = 2560, ZC_VW = 2624, ZC_FOX_F = 2688, ZC_NSA_G = 2692;
constexpr float EPS = 1e-6f;
constexpr int NWAVES = 8, NTHR = 512;
#ifndef REP_G1
#define REP_G1 1
#endif
#ifndef REP_P0
#define REP_P0 1
#endif
#ifndef REP_G4N
#define REP_G4N 0
#endif
#ifndef REP_G6N
#define REP_G6N 0
#endif
#ifndef NORM_DRY
#define NORM_DRY 0
#endif
#ifndef REP_NSEL
#define REP_NSEL 1
#endif
#ifndef REP_NWIN
#define REP_NWIN 1
#endif
#ifndef REP_NSELECT
#define REP_NSELECT 1
#endif
#ifndef REP_G5
#define REP_G5 1
#endif
#ifndef REP_CUM
#define REP_CUM 1
#endif
#ifndef REP_VT
#define REP_VT 1
#endif
#ifndef REP_P2LRU
#define REP_P2LRU 1
#endif
#ifndef REP_P2CMP
#define REP_P2CMP 1
#endif
#ifndef REP_FOX
#define REP_FOX 1
#endif
#ifndef REP_NSA
#define REP_NSA 1
#endif
#ifndef REP_LRU
#define REP_LRU 1
#endif

constexpr size_t MiB = 1u << 20;
constexpr size_t WS_CTL = 0, CTL_ZERO_BYTES = 64 * 1024;
constexpr size_t WS_SSQA = 2 * MiB, WS_SSQB = 4 * MiB, WS_CFOX = 6 * MiB, WS_KVC = 7 * MiB, WS_LRUAGG = 9 * MiB, WS_CB = 11 * MiB;
constexpr size_t WS_WIN = 12 * MiB, WS_WOUT = 24 * MiB, WS_WGU = 28 * MiB, WS_WDN = 50 * MiB;
constexpr size_t WS_XH = 62 * MiB, WS_MIXED = 126 * MiB, WS_Z = 190 * MiB, WS_YD = 366 * MiB, WS_FOXVT = 398 * MiB, WS_VST = 414 * MiB, WS_VWT = 418 * MiB, WS_KCH = 422 * MiB, WS_VCT = 423 * MiB, WS_W1T = 424 * MiB, WS_WGT = 426 * MiB, WS_LRUA = 427 * MiB, WS_LRUB = 459 * MiB, WS_END = 491 * MiB;
static_assert(WS_WIN + 2 * (size_t)NZP * D * 2 <= WS_WOUT && WS_WOUT + 2 * (size_t)D * D * 2 <= WS_WGU && WS_WGU + 2 * (size_t)2 * DFF * D * 2 <= WS_WDN &&
              WS_WDN + 2 * (size_t)D * DFF * 2 <= WS_XH && WS_XH + (size_t)T * D * 2 <= WS_MIXED && WS_MIXED + (size_t)T * D * 2 <= WS_Z &&
              WS_Z + (size_t)T * NZP * 2 <= WS_YD && WS_YD + (size_t)T * 256 * 4 <= WS_FOXVT && WS_FOXVT + (size_t)T * 256 * 2 <= WS_VST, "ws map");
constexpr int CW_BAR = 1024;

constexpr int RING_BYTES = 131072, MISC_OFF = RING_BYTES, LDS_BYTES = 147456;

__device__ __constant__ unsigned char c_bucket[128] = {
 0,1,2,3,4,5,6,7,8,9,10,11,12,13,14,15,
 16,16,16,17,17,18,18,18,19,19,19,20,20,20,20,21,
 21,21,21,22,22,22,22,22,23,23,23,23,23,23,24,24,
 24,24,24,24,25,25,25,25,25,25,25,26,26,26,26,26,
 26,26,26,27,27,27,27,27,27,27,27,27,27,28,28,28,
 28,28,28,28,28,28,28,29,29,29,29,29,29,29,29,29,
 29,29,29,30,30,30,30,30,30,30,30,30,30,30,30,30,
 30,31,31,31,31,31,31,31,31,31,31,31,31,31,31,31};
__device__ __forceinline__ int rel_bucket(int d) { return d >= 128 ? 31 : (int)c_bucket[d < 0 ? 0 : d]; }

__device__ __forceinline__ float sigmoidf_(float x) { return __builtin_amdgcn_rcpf(1.f + __builtin_amdgcn_exp2f(-1.4426950408889634f * x)); }
__device__ __forceinline__ float gelu_tanh(float x) { return x * __builtin_amdgcn_rcpf(1.f + __builtin_amdgcn_exp2f(-2.f * 1.4426950408889634f * 0.7978845608028654f * (x + 0.044715f * x * x * x))); }
__device__ __forceinline__ float log_sigmoid(float x) { const float e = __builtin_amdgcn_exp2f(-1.4426950408889634f * fabsf(x)); return fminf(x, 0.f) - 0.6931471805599453f * __builtin_amdgcn_logf(1.f + e); }
__device__ __forceinline__ u32x4 pack_h8(f32x4 a, f32x4 b) {
    h8 h; h[0] = (half_t)a.x; h[1] = (half_t)a.y; h[2] = (half_t)a.z; h[3] = (half_t)a.w; h[4] = (half_t)b.x; h[5] = (half_t)b.y; h[6] = (half_t)b.z; h[7] = (half_t)b.w;
    return __builtin_bit_cast(u32x4, h);
}
__device__ __forceinline__ unsigned pack_h2(float a, float b) { h2 h; h[0] = (half_t)a; h[1] = (half_t)b; return __builtin_bit_cast(unsigned, h); }
#define LDS_WAIT() asm volatile("s_waitcnt lgkmcnt(0)" ::: "memory")

#define XB_TMO      128
#define XB_XCNT(j)  (256  + 64 * (j))
#define XB_XSUB(j)  (1280 + 64 * (j))
#define XB_XGEN(j)  (2304 + 64 * (j))
#define XB_TOP      3328
#define XB_TOPGEN   3392
#define XCD_BAR_WORDS 3456
#define XB_SPIN_CAP (1u << 20)
__device__ __forceinline__ unsigned xb_ld(unsigned* p)              { return __hip_atomic_load(p, __ATOMIC_RELAXED, __HIP_MEMORY_SCOPE_AGENT); }
__device__ __forceinline__ unsigned xb_add(unsigned* p, unsigned v) { return __hip_atomic_fetch_add(p, v, __ATOMIC_RELAXED, __HIP_MEMORY_SCOPE_AGENT); }
__device__ __forceinline__ unsigned xb_xcc_id() { return (unsigned)__builtin_amdgcn_s_getreg((3 << 11) | 20) & 0xFu; }
#define XB_SPIN(cond, bar) do { unsigned _sp = 0; while (cond) { __builtin_amdgcn_s_sleep(1); \
    if ((++_sp & 255u) == 0u) { if (xb_ld(&(bar)[XB_TMO])) break; if (_sp > XB_SPIN_CAP) { atomicAdd(&(bar)[XB_TMO], 1u); break; } } } } while (0)
struct XcdBarrier { unsigned* bar; unsigned x; volatile LAS unsigned* st; };
__device__ __forceinline__ XcdBarrier xcd_barrier_post(unsigned* bar, volatile LAS unsigned* st) {
    XcdBarrier b; b.bar = bar; b.x = xb_xcc_id(); b.st = st;
    if (threadIdx.x == 0) (void)xb_add(&bar[XB_XCNT(b.x)], 1u);
    return b;
}
__device__ __forceinline__ void xcd_barrier_complete(unsigned* bar, unsigned x, unsigned& nloc, unsigned& nx) {
    const unsigned G = gridDim.x * gridDim.y * gridDim.z;
    unsigned sum, cnt, mine, sp = 0u;
    for (;;) {
        sum = 0u; cnt = 0u; mine = 0u;
#pragma unroll
        for (unsigned j = 0; j < 16; ++j) { const unsigned c = xb_ld(&bar[XB_XCNT(j)]); sum += c; cnt += (c > 0u) ? 1u : 0u; mine = (j == x) ? c : mine; }
        if (sum == G) break;
        __builtin_amdgcn_s_sleep(1);
        if ((++sp & 255u) == 0u) { if (xb_ld(&bar[XB_TMO])) break; if (sp > XB_SPIN_CAP) { atomicAdd(&bar[XB_TMO], 1u); break; } }
    }
    nloc = mine > 0u ? mine : 1u; nx = cnt > 0u ? cnt : 1u;
}
__device__ __forceinline__ void xcd_barrier(const XcdBarrier& b) {
    asm volatile("s_waitcnt vmcnt(0)" ::: "memory");
    __syncthreads();
    if (threadIdx.x == 0) {
        unsigned* bar = b.bar;
        unsigned bx = b.x; asm volatile("" : "+s"(bx));
        __builtin_amdgcn_s_waitcnt(0);
        unsigned nloc = b.st[0], nx = b.st[1];
        if (nloc == 0u) { xcd_barrier_complete(bar, bx, nloc, nx); b.st[0] = nloc; b.st[1] = nx; }
        const unsigned old = xb_add(&bar[XB_XSUB(bx)], 1u);
        const unsigned gen = old / nloc;
        if (old + 1u == (gen + 1u) * nloc) {
            __builtin_amdgcn_fence(__ATOMIC_RELEASE, "agent");
            asm volatile("s_waitcnt vmcnt(0)" ::: "memory");
            const unsigned og = xb_add(&bar[XB_TOP], 1u);
            const unsigned tg = og / nx;
            if (og + 1u == (tg + 1u) * nx) xb_add(&bar[XB_TOPGEN], 1u);
            else XB_SPIN(xb_ld(&bar[XB_TOPGEN]) == tg, bar);
            __builtin_amdgcn_fence(__ATOMIC_ACQUIRE, "agent");
            xb_add(&bar[XB_XGEN(bx)], 1u);
            asm volatile("s_waitcnt vmcnt(0)" ::: "memory");
        } else {
            XB_SPIN(xb_ld(&bar[XB_XGEN(bx)]) == gen, bar);
            __builtin_amdgcn_fence(__ATOMIC_ACQUIRE, "agent");
            asm volatile("s_waitcnt vmcnt(0)" ::: "memory");
        }
    }
    __syncthreads();
}

namespace pg8 {
constexpr int BM = 256, BK = 64, HALF = 128, HTB = HALF * BK * 2, STAGE_BYTES = 8 * HTB, NXCD = 8, WGM = 8;
__host__ __device__ __forceinline__ int lds_byte(int r, int c) { const int st = (r >> 4) * 2 + (c >> 5), rr = r & 15, cc = c & 31, ob = rr * 64 + cc * 2; return st * 1024 + (ob ^ (((ob >> 9) & 1) << 5)); }
__host__ __device__ __forceinline__ void stage_rc(int b, int& R, int& C) { const int st = b / 1024, sb = b % 1024, swz = sb ^ (((sb >> 9) & 1) << 5); R = (st >> 1) * 16 + swz / 64; C = (st & 1) * 32 + (swz % 64) / 2; }
__host__ __device__ __forceinline__ int perm32(int rho) { const int n = rho >> 4, i = rho & 15; return 8 * (i >> 2) + 4 * n + (i & 3); }
struct Unit { int pm, pn; };
struct Gemm { const half_t* A; const half_t* Bt; int M, N, K; };
struct StaticOrder {
    int nM, nN, nwg, G, c;
    __host__ __device__ void init(int M, int N, int G_, int c_) { nM = M / BM; nN = N / BM; nwg = nM * nN; G = G_; c = c_; }
    __host__ __device__ bool next(int i, Unit& u) const {
        const long L = (long)i * G + c; if (L >= nwg) return false;
        int wgid = (int)L; { const int q = nwg / NXCD, r = nwg % NXCD, xcd = wgid % NXCD, off = wgid / NXCD; wgid = (xcd < r ? xcd * (q + 1) : r * (q + 1) + (xcd - r) * q) + off; }
        const int nig = WGM * nN, gid = wgid / nig, fm = gid * WGM, gsz = (nM - fm) < WGM ? (nM - fm) : WGM;
        u.pm = fm + ((wgid % nig) % gsz); u.pn = (wgid % nig) / gsz; return true;
    }
    __device__ __forceinline__ void a_ready(const Unit&) const {}
    __device__ __forceinline__ void done(const Unit&) const {}
};

template <class Epi, class Sched>
__device__ __forceinline__ void gemm_phase(LAS unsigned char* lds, const Gemm g, const Sched& S, const Epi& E) {
    int tid = threadIdx.x; asm volatile("" : "+v"(tid));
    const int wid = __builtin_amdgcn_readfirstlane(tid >> 6), lane = tid & 63, wr = wid >> 2, wc = wid & 3, fr = lane & 15, fq = lane >> 4;
    const int K = g.K, nt = K / BK;
    unsigned voffA[2], voffB[2];
#pragma unroll
    for (int i = 0; i < 2; ++i) { int R, C; stage_rc(tid * 16 + i * 8192, R, C); const int Rb = Epi::brow(R);
        voffA[i] = (unsigned)(R * K + C) * 2u; voffB[i] = (unsigned)(Rb * K + C) * 2u; }
    const size_t kstep = (size_t)(BK * 2);
    const size_t hstep = (size_t)HALF * K * 2;
    const size_t hstepB = (size_t)Epi::BHALF_ROWS * K * 2;
    const size_t tstep = 2 * hstep;
    const unsigned ldsw = (unsigned)wid * 1024u;
    const int aoff = lds_byte(wr * 64 + fr, fq * 8), boff = lds_byte(wc * 32 + fr, fq * 8);
#define PG8_SA(b, h) (((b) * 2 + (h)) * HTB)
#define PG8_SB(b, h) ((4 + (b) * 2 + (h)) * HTB)
#define PG8_STAGE(bufoff, gbase, voff) do { _Pragma("unroll") for (int _i = 0; _i < 2; ++_i) \
        __builtin_amdgcn_global_load_lds((const unsigned*)((const char*)(gbase) + (voff)[_i]), (LAS unsigned*)(lds + (bufoff) + ldsw + _i * 8192), 16, 0, 0); } while (0)
#define PG8_LDA(dst, b, h) do { _Pragma("unroll") for (int m = 0; m < 4; ++m) _Pragma("unroll") for (int k = 0; k < 2; ++k) dst[m][k] = *(const LAS h8*)(lds + PG8_SA(b, h) + aoff + m * 2048 + k * 1024); } while (0)
#define PG8_LDB(dst, b, h) do { _Pragma("unroll") for (int n = 0; n < 2; ++n) _Pragma("unroll") for (int k = 0; k < 2; ++k) dst[n][k] = *(const LAS h8*)(lds + PG8_SB(b, h) + boff + n * 2048 + k * 1024); } while (0)
#define PG8_MMA(ai, bj, At, Bt) do { __builtin_amdgcn_s_setprio(1); _Pragma("unroll") for (int m = 0; m < 4; ++m) _Pragma("unroll") for (int n = 0; n < 2; ++n) _Pragma("unroll") for (int k = 0; k < 2; ++k) \
        acc[ai][bj][m][n] = __builtin_amdgcn_mfma_f32_16x16x32_f16(Bt[n][k], At[m][k], acc[ai][bj][m][n], 0, 0, 0); __builtin_amdgcn_s_setprio(0); } while (0)
#define PG8_WAIT_V(n) asm volatile("s_waitcnt vmcnt(" #n ")" ::: "memory")
#define PG8_WAIT_L(n) asm volatile("s_waitcnt lgkmcnt(" #n ")" ::: "memory")
#define PG8_BAR __builtin_amdgcn_s_barrier()
#define PG8_SCHED __builtin_amdgcn_sched_barrier(0)
    Unit cur, nxt; int ui = 0;
    if (!S.next(0, cur)) return;
    f32x4 acc[2][2][4][2];
#pragma unroll
    for (int a = 0; a < 2; ++a)
#pragma unroll
        for (int b = 0; b < 2; ++b)
#pragma unroll
            for (int m = 0; m < 4; ++m)
#pragma unroll
                for (int n = 0; n < 2; ++n) acc[a][b][m][n] = (f32x4){0.f, 0.f, 0.f, 0.f};
    h8 At[4][2], B0[2][2], B1[2][2];
    const char* cA = (const char*)g.A + (size_t)cur.pm * tstep; const char* cB = (const char*)g.Bt + (size_t)cur.pn * tstep;
    S.a_ready(cur);
    PG8_STAGE(PG8_SB(0, 0), cB, voffB); PG8_STAGE(PG8_SA(0, 0), cA, voffA); PG8_STAGE(PG8_SB(0, 1), cB + hstepB, voffB); PG8_STAGE(PG8_SA(0, 1), cA + hstep, voffA);
    if (wr == 1) PG8_BAR;
    PG8_WAIT_V(4); PG8_BAR;
    PG8_STAGE(PG8_SB(1, 0), cB + kstep, voffB); PG8_STAGE(PG8_SA(1, 0), cA + kstep, voffA); PG8_STAGE(PG8_SB(1, 1), cB + hstepB + kstep, voffB);
    PG8_WAIT_V(6); PG8_BAR;
    for (;;) {
        const bool has_next = S.next(ui + 1, nxt);
        const char* nA = has_next ? (const char*)g.A + (size_t)nxt.pm * tstep : cA; const char* nB = has_next ? (const char*)g.Bt + (size_t)nxt.pn * tstep : cB;
        for (int t = 0; t < nt; t += 2) {
            const bool last = (t == nt - 2);
            const char* a1 = cA + (size_t)(t + 1) * kstep;
            const char* a2 = last ? nA : cA + (size_t)(t + 2) * kstep; const char* b2 = last ? nB : cB + (size_t)(t + 2) * kstep;
            const char* a3 = a2 + kstep; const char* b3 = b2 + kstep;
            if (last && has_next) S.a_ready(nxt);
            PG8_LDB(B0, 0, 0); PG8_SCHED; PG8_LDA(At, 0, 0); PG8_STAGE(PG8_SA(1, 1), a1 + hstep, voffA);
            PG8_WAIT_L(8); PG8_BAR; PG8_WAIT_L(0); PG8_MMA(0, 0, At, B0); PG8_BAR; PG8_SCHED;
            PG8_LDB(B1, 0, 1); PG8_STAGE(PG8_SB(0, 0), b2, voffB);
            PG8_BAR; PG8_WAIT_L(0); PG8_MMA(0, 1, At, B1); PG8_BAR;
            PG8_LDA(At, 0, 1); PG8_STAGE(PG8_SA(0, 0), a2, voffA);
            PG8_BAR; PG8_WAIT_L(0); PG8_MMA(1, 0, At, B0); PG8_BAR; PG8_SCHED;
            PG8_STAGE(PG8_SB(0, 1), b2 + hstepB, voffB);
            PG8_WAIT_V(6); PG8_BAR; PG8_MMA(1, 1, At, B1); PG8_BAR;
            PG8_LDB(B0, 1, 0); PG8_SCHED; PG8_LDA(At, 1, 0); PG8_STAGE(PG8_SA(0, 1), a2 + hstep, voffA);
            PG8_WAIT_L(8); PG8_BAR; PG8_WAIT_L(0); PG8_MMA(0, 0, At, B0); PG8_BAR; PG8_SCHED;
            PG8_LDB(B1, 1, 1); PG8_STAGE(PG8_SB(1, 0), b3, voffB);
            PG8_BAR; PG8_WAIT_L(0); PG8_MMA(0, 1, At, B1); PG8_BAR;
            PG8_LDA(At, 1, 1); PG8_STAGE(PG8_SA(1, 0), a3, voffA);
            PG8_BAR; PG8_WAIT_L(0); PG8_MMA(1, 0, At, B0); PG8_BAR; PG8_SCHED;
            PG8_STAGE(PG8_SB(1, 1), b3 + hstepB, voffB);
            PG8_WAIT_V(6); PG8_BAR; PG8_MMA(1, 1, At, B1); PG8_BAR;
        }
        E(acc, cur, wr, wc, fr, fq); S.done(cur);
        if (!has_next) break;
#pragma unroll
        for (int a = 0; a < 2; ++a)
#pragma unroll
            for (int b = 0; b < 2; ++b)
#pragma unroll
                for (int m = 0; m < 4; ++m)
#pragma unroll
                    for (int n = 0; n < 2; ++n) acc[a][b][m][n] = (f32x4){0.f, 0.f, 0.f, 0.f};
        cur = nxt; cA = nA; cB = nB; ++ui;
    }
    PG8_WAIT_V(0);
    if (wr == 0) PG8_BAR;
    PG8_BAR;
#undef PG8_SA
#undef PG8_SB
#undef PG8_STAGE
#undef PG8_LDA
#undef PG8_LDB
#undef PG8_MMA
#undef PG8_WAIT_V
#undef PG8_WAIT_L
#undef PG8_BAR
#undef PG8_SCHED
}
}

__device__ __forceinline__ float row_rstd(const float* ssq, int row) {
    const f32x4* p = (const f32x4*)(ssq + (size_t)row * 16);
    const f32x4 a = p[0], b = p[1], c = p[2], d = p[3];
    const float s = (((a.x + a.y) + (a.z + a.w)) + ((b.x + b.y) + (b.z + b.w))) + (((c.x + c.y) + (c.z + c.w)) + ((d.x + d.y) + (d.z + d.w)));
    return rsqrtf(s * (1.f / 1024.f) + EPS);
}
__device__ __forceinline__ void rows_rstd8(const float* ssq, int row0, int fq, float (&r)[8]) {
    f32x4 p[8];
#pragma unroll
    for (int i = 0; i < 8; ++i) p[i] = *(const f32x4*)(ssq + (size_t)(row0 + (i >> 2) * 128 + (i & 3) * 16) * 16 + 4 * fq);
#pragma unroll
    for (int i = 0; i < 8; ++i) { float s = (p[i].x + p[i].y) + (p[i].z + p[i].w); s += __shfl_xor(s, 16); s += __shfl_xor(s, 32); r[i] = rsqrtf(s * (1.f / 1024.f) + EPS); }
}
struct EpiZ {
    static constexpr bool PERM = true;
    static constexpr int BHALF_ROWS = 32;
    static __host__ __device__ __forceinline__ int brow(int R) { return 64 * ((R >> 5) & 3) + pg8::perm32(R & 31); }
    half_t* Z; const float* ssq;
    __device__ __forceinline__ void operator()(const f32x4 (&acc)[2][2][4][2], const pg8::Unit& u, int wr, int wc, int fr, int fq) const {
        const int row0 = u.pm * 256 + wr * 64 + fr, col0 = u.pn * 256 + wc * 64 + 8 * fq;
        float rr[8]; rows_rstd8(ssq, row0, fq, rr);
#pragma unroll
        for (int ai = 0; ai < 2; ++ai)
#pragma unroll
            for (int m = 0; m < 4; ++m) { const int row = row0 + ai * 128 + m * 16; const float r = rr[ai * 4 + m]; half_t* rp = Z + (size_t)row * NZP + col0;
#pragma unroll
                for (int bj = 0; bj < 2; ++bj) *(u32x4*)(rp + bj * 32) = pack_h8(acc[ai][bj][m][0] * r, acc[ai][bj][m][1] * r); }
    }
};
struct EpiRes {
    static constexpr bool PERM = true;
    static constexpr int BHALF_ROWS = 32;
    static __host__ __device__ __forceinline__ int brow(int R) { return 64 * ((R >> 5) & 3) + pg8::perm32(R & 31); }
    const float* xold; float* out; half_t* XH; float* ssq;
    __device__ __forceinline__ void operator()(const f32x4 (&acc)[2][2][4][2], const pg8::Unit& u, int wr, int wc, int fr, int fq) const {
        const int row0 = u.pm * 256 + wr * 64 + fr, col0 = u.pn * 256 + wc * 64 + 8 * fq;
#pragma unroll
        for (int ai = 0; ai < 2; ++ai) {
            f32x4 xo[4][2][2];
#pragma unroll
            for (int m = 0; m < 4; ++m)
#pragma unroll
                for (int bj = 0; bj < 2; ++bj) { const size_t o = (size_t)(row0 + ai * 128 + m * 16) * D + col0 + bj * 32; xo[m][bj][0] = *(const f32x4*)(xold + o); xo[m][bj][1] = *(const f32x4*)(xold + o + 4); }
#pragma unroll
            for (int m = 0; m < 4; ++m) { const int row = row0 + ai * 128 + m * 16; float s = 0.f;
#pragma unroll
                for (int bj = 0; bj < 2; ++bj) { const size_t o = (size_t)row * D + col0 + bj * 32;
                    const f32x4 v0 = xo[m][bj][0] + acc[ai][bj][m][0], v1 = xo[m][bj][1] + acc[ai][bj][m][1];
                    *(f32x4*)(out + o) = v0; *(f32x4*)(out + o + 4) = v1;
                    if (XH) *(u32x4*)(XH + o) = pack_h8(v0, v1);
                    s += (v0.x * v0.x + v0.y * v0.y) + (v0.z * v0.z + v0.w * v0.w) + (v1.x * v1.x + v1.y * v1.y) + (v1.z * v1.z + v1.w * v1.w); }
                s += __shfl_xor(s, 16); s += __shfl_xor(s, 32);
                if (fq == 0 && ssq) ssq[(size_t)row * 16 + u.pn * 4 + wc] = s; }
        }
    }
};
struct EpiSwiglu {
    static constexpr bool PERM = true;
    static constexpr int BHALF_ROWS = 128;
    static __host__ __device__ __forceinline__ int brow(int R) { return (R & ~31) + pg8::perm32(R & 31); }
    half_t* H; const float* ssq;
    __device__ __forceinline__ void operator()(const f32x4 (&acc)[2][2][4][2], const pg8::Unit& u, int wr, int wc, int fr, int fq) const {
        const int row0 = u.pm * 256 + wr * 64 + fr, col0 = u.pn * 128 + wc * 32 + 8 * fq;
        float rr[8]; rows_rstd8(ssq, row0, fq, rr);
#pragma unroll
        for (int ai = 0; ai < 2; ++ai)
#pragma unroll
            for (int m = 0; m < 4; ++m) { const int row = row0 + ai * 128 + m * 16; const float r = rr[ai * 4 + m];
                f32x4 o[2];
#pragma unroll
                for (int n = 0; n < 2; ++n) { const f32x4 g = acc[ai][0][m][n] * r, uu = acc[ai][1][m][n] * r;
                    o[n].x = g.x * sigmoidf_(g.x) * uu.x; o[n].y = g.y * sigmoidf_(g.y) * uu.y; o[n].z = g.z * sigmoidf_(g.z) * uu.z; o[n].w = g.w * sigmoidf_(g.w) * uu.w; }
                *(u32x4*)(H + (size_t)row * DFF + col0) = pack_h8(o[0], o[1]); }
    }
};

struct EpiNull {
    static constexpr bool PERM = true;
    static constexpr int BHALF_ROWS = 128;
    static __host__ __device__ __forceinline__ int brow(int R) { return (R & ~31) + pg8::perm32(R & 31); }
    __device__ __forceinline__ void operator()(const f32x4 (&acc)[2][2][4][2], const pg8::Unit&, int, int, int, int) const {
#pragma unroll
        for (int ai = 0; ai < 2; ++ai)
#pragma unroll
            for (int bj = 0; bj < 2; ++bj)
#pragma unroll
                for (int m = 0; m < 4; ++m)
#pragma unroll
                    for (int n = 0; n < 2; ++n) asm volatile("" :: "v"(acc[ai][bj][m][n]));
    }
};
struct Params {
    const float* x; const float* norm_mix; const float* w_in; const float* lru_conv_w; const float* lru_conv_b; const float* lru_w_gates; const float* lru_b_gates;
    const float* lru_lambda; const float* sc_conv_w; const float* fox_f_bias; const float* fox_qk_norm; const float* nsa_qk_norm; const float* nsa_cmp_pos;
    const float* nsa_cmp_w1; const float* nsa_cmp_w2; const float* nsa_gate_bias; const float* rel_bias; const float* out_norm; const float* w_out;
    const float* norm_ffn; const float* w_gate_up; const float* w_down; float* out; unsigned char* ws;
};

template <int MODE> __device__ __forceinline__ int src_col(int n) {
    if (MODE == 1) { if (n < 2048) return n; if (n < 2688) return n + 4; if (n < 2692) return 2048 + (n - 2688); if (n < 2704) return n; return -1; }
    if (MODE == 2) { const int pn = n >> 8, w = n & 255; return w < 128 ? pn * 128 + w : DFF + pn * 128 + (w - 128); }
    return n;
}
template <int MODE> __device__ __forceinline__ void p0_item(const float* W, int K, int Nsrc, const float* gain, half_t* WT, int item, int nbn, LAS unsigned* scr, int lane) {
    const int kb = item / nbn, nb = item % nbn, k0 = 64 * kb, n0 = 64 * nb;
    const int sc = src_col<MODE>(n0 + lane);
    float v[64];
    const float* wp = W + (size_t)k0 * Nsrc + (sc >= 0 ? sc : 0);
#pragma unroll
    for (int kk = 0; kk < 64; ++kk) v[kk] = wp[(size_t)kk * Nsrc];
#pragma unroll
    for (int kk = 0; kk < 64; kk += 2) {
        float v0 = sc >= 0 ? v[kk] : 0.f, v1 = sc >= 0 ? v[kk + 1] : 0.f;
        if (gain) { v0 *= gain[k0 + kk]; v1 *= gain[k0 + kk + 1]; }
        scr[lane * 33 + (kk >> 1)] = pack_h2(v0, v1);
    }
    LDS_WAIT(); asm volatile("" ::: "memory");
    const int c = lane & 7;
#pragma unroll
    for (int j = 0; j < 8; ++j) { const int nn = (lane >> 3) + 8 * j; const LAS unsigned* s = scr + nn * 33 + 4 * c;
        u32x4 o; o.x = s[0]; o.y = s[1]; o.z = s[2]; o.w = s[3];
        *(u32x4*)(WT + (size_t)(n0 + nn) * K + k0 + 8 * c) = o; }
    LDS_WAIT(); asm volatile("" ::: "memory");
}
__device__ __forceinline__ float wave_sum(float v) {
#pragma unroll
    for (int o = 1; o < 64; o <<= 1) v += __shfl_xor(v, o);
    return v;
}

__device__ __forceinline__ void attn_step_h(const float (&q)[64], float (&acc)[64], float& m, float& l, const half_t* kp, const half_t* vp, float bias, bool valid) {
    float sc = 0.f;
#pragma unroll
    for (int hh = 0; hh < 2; ++hh) {
#pragma unroll
        for (int j = 4 * hh; j < 4 * hh + 4; ++j) { const h8 kv = *(const h8*)(kp + 8 * j);
#pragma unroll
            for (int e = 0; e < 8; ++e) sc = fmaf(q[8 * j + e], (float)kv[e], sc); }
        __builtin_amdgcn_sched_barrier(0);
    }
    sc += bias;
    const float mn = valid ? fmaxf(m, sc) : m;
    const float alpha = __expf(m - mn), p = valid ? __expf(sc - mn) : 0.f;
    m = mn; l = l * alpha + p;
#pragma unroll
    for (int hh = 0; hh < 2; ++hh) {
#pragma unroll
        for (int j = 4 * hh; j < 4 * hh + 4; ++j) { const h8 vv = *(const h8*)(vp + 8 * j);
#pragma unroll
            for (int e = 0; e < 8; ++e) acc[8 * j + e] = fmaf(acc[8 * j + e], alpha, p * (float)vv[e]); }
        __builtin_amdgcn_sched_barrier(0);
    }
}
__device__ __forceinline__ float dot_f32(const float (&q)[64], const float* kp) {
    float sc = 0.f;
#pragma unroll
    for (int j = 0; j < 16; ++j) { const f32x4 kv = *(const f32x4*)(kp + 4 * j); sc = fmaf(q[4 * j], kv.x, sc); sc = fmaf(q[4 * j + 1], kv.y, sc); sc = fmaf(q[4 * j + 2], kv.z, sc); sc = fmaf(q[4 * j + 3], kv.w, sc); }
    return sc;
}
__device__ __forceinline__ void load_q(float (&q)[64], const half_t* qp, float scale) {
#pragma unroll
    for (int j = 0; j < 8; ++j) { const h8 v = *(const h8*)(qp + 8 * j);
#pragma unroll
        for (int e = 0; e < 8; ++e) q[8 * j + e] = (float)v[e] * scale; }
}

__device__ __forceinline__ void lru_gate_r(const float* wcol, float bias, const LAS float* xrow, LAS float* yout) {
    float w[64];
#pragma unroll
    for (int k = 0; k < 64; ++k) w[k] = wcol[(size_t)k * 64];
    for (int i = 0; i < 32; ++i) {
        const LAS float* xr = xrow + i * 256; float r = bias;
#pragma unroll
        for (int k = 0; k < 64; k += 4) { const f32x4 xv = *(const LAS f32x4*)(xr + k);
            r = fmaf(xv.x, w[k], r); r = fmaf(xv.y, w[k + 1], r); r = fmaf(xv.z, w[k + 2], r); r = fmaf(xv.w, w[k + 3], r); }
        yout[i * 256] = 1.f / (1.f + expf(-r));
    }
}

__device__ __forceinline__ void ld_frags(h8 (&f)[8], const LAS unsigned char* base) {
#pragma unroll
    for (int i = 0; i < 4; ++i) { f[2 * i] = *(const LAS h8*)(base + 32 * i); f[2 * i + 1] = *(const LAS h8*)(base + 32 * 144 + 32 * i); }
}
__device__ __forceinline__ void qk64(f32x16& S0, f32x16& S1, const h8 (&q)[4], const LAS unsigned char* Ks, int qi, int hb) {
    h8 ka[8]; ld_frags(ka, Ks + pi16(qi) * 144 + 16 * hb);
    __builtin_amdgcn_sched_barrier(0);
#pragma unroll
    for (int kk = 0; kk < 4; ++kk) { S0 = MFMA32(ka[2 * kk], q[kk], S0); S1 = MFMA32(ka[2 * kk + 1], q[kk], S1); }
}
__device__ __forceinline__ void pv64(const f32x16& P0, const f32x16& P1, const LAS unsigned char* Vs, f32x16& O0, f32x16& O1, int qi, int hb) {
    h8 va[8]; ld_frags(va, Vs + qi * 144 + 16 * hb);
    h8 pf[4];
#pragma unroll
    for (int e = 0; e < 8; ++e) { pf[0][e] = (half_t)P0[e]; pf[1][e] = (half_t)P0[8 + e]; pf[2][e] = (half_t)P1[e]; pf[3][e] = (half_t)P1[8 + e]; }
    __builtin_amdgcn_sched_barrier(0);
#pragma unroll
    for (int s = 0; s < 4; ++s) { O0 = MFMA32(va[2 * s], pf[s], O0); O1 = MFMA32(va[2 * s + 1], pf[s], O1); }
}
__device__ __forceinline__ float rowmax64(const f32x16& S0, const f32x16& S1) {
    float mx = fmaxf(S0[0], S1[0]);
#pragma unroll
    for (int r = 1; r < 16; ++r) mx = fmaxf(mx, fmaxf(S0[r], S1[r]));
    return fmaxf(mx, __shfl_xor(mx, 32));
}
__device__ __forceinline__ void softmax64(f32x16& S0, f32x16& S1, float& m, float& l, f32x16& O0, f32x16& O1) {
    const float mn = fmaxf(m, rowmax64(S0, S1)), alpha = __builtin_amdgcn_exp2f(m - mn);
    m = mn; float ps = 0.f;
#pragma unroll
    for (int r = 0; r < 16; ++r) { S0[r] = __builtin_amdgcn_exp2f(S0[r] - mn); S1[r] = __builtin_amdgcn_exp2f(S1[r] - mn); ps += S0[r] + S1[r]; }
    l = l * alpha + ps;
    if (__any(alpha != 1.f)) {
#pragma unroll
        for (int r = 0; r < 16; ++r) { O0[r] *= alpha; O1[r] *= alpha; }
    }
}
__device__ __forceinline__ void init_near(f32x16& S0, f32x16& S1, const LAS float* TRh, int dq, int hb, int step, int wlim) {
#pragma unroll
    for (int r = 0; r < 16; ++r) {
        const int k0 = 16 * (r >> 3) + 8 * hb + 4 * ((r >> 2) & 1) + (r & 3);
        const int d0 = dq - step * k0, d1 = dq - step * (k0 + 32);
        const float b0 = TRh[d0 < 0 ? 0 : (d0 > 128 ? 128 : d0)], b1 = TRh[d1 < 0 ? 0 : (d1 > 128 ? 128 : d1)];
        S0[r] = (d0 >= 0 && d0 < wlim) ? b0 : -INFINITY; S1[r] = (d1 >= 0 && d1 < wlim) ? b1 : -INFINITY;
    }
}
__device__ __forceinline__ void init_const(f32x16& S0, f32x16& S1, float c) {
#pragma unroll
    for (int r = 0; r < 16; ++r) { S0[r] = c; S1[r] = c; }
}

__device__ __forceinline__ void init_tab(f32x16& S0, f32x16& S1, const LAS float* TXh, int dq, int hb, int step, int dmax, bool sel) {
#pragma unroll
    for (int r = 0; r < 16; ++r) {
        const int k0 = 16 * (r >> 3) + 8 * hb + 4 * ((r >> 2) & 1) + (r & 3);
        int i0 = dq - step * k0, i1 = dq - step * (k0 + 32);
        i0 = i0 < -1 ? -1 : (i0 > dmax ? dmax : i0); i1 = i1 < -1 ? -1 : (i1 > dmax ? dmax : i1);
        S0[r] = TXh[sel ? i0 + 1 : 0]; S1[r] = TXh[sel ? i1 + 1 : 0];
    }
}
__device__ __forceinline__ void qk64z(f32x16& S0, f32x16& S1, const h8 (&q)[4], const LAS unsigned char* Ks, int qi, int hb) {
    h8 ka[8]; ld_frags(ka, Ks + pi16(qi) * 144 + 16 * hb);
    __builtin_amdgcn_sched_barrier(0);
    const f32x16 z = {0.f, 0.f, 0.f, 0.f, 0.f, 0.f, 0.f, 0.f, 0.f, 0.f, 0.f, 0.f, 0.f, 0.f, 0.f, 0.f};
    S0 = MFMA32(ka[0], q[0], z); S1 = MFMA32(ka[1], q[0], z);
#pragma unroll
    for (int kk = 1; kk < 4; ++kk) { S0 = MFMA32(ka[2 * kk], q[kk], S0); S1 = MFMA32(ka[2 * kk + 1], q[kk], S1); }
}
__device__ __forceinline__ float exp_sum64(f32x16& S0, f32x16& S1) {
    float ps = 0.f;
#pragma unroll
    for (int r = 0; r < 16; ++r) { S0[r] = __builtin_amdgcn_exp2f(S0[r]); S1[r] = __builtin_amdgcn_exp2f(S1[r]); ps += S0[r] + S1[r]; }
    return ps;
}
__device__ __forceinline__ void pv64m(const f32x16& P0, const f32x16& P1, bool sel, const LAS unsigned char* Vs, f32x16& O0, f32x16& O1, int qi, int hb) {
    h8 va[8]; ld_frags(va, Vs + qi * 144 + 16 * hb);
    h8 pf[4];
#pragma unroll
    for (int e = 0; e < 8; ++e) { pf[0][e] = (half_t)P0[e]; pf[1][e] = (half_t)P0[8 + e]; pf[2][e] = (half_t)P1[e]; pf[3][e] = (half_t)P1[8 + e]; }
    const h8 hz = {0, 0, 0, 0, 0, 0, 0, 0};
#pragma unroll
    for (int s = 0; s < 4; ++s) pf[s] = sel ? pf[s] : hz;
    __builtin_amdgcn_sched_barrier(0);
#pragma unroll
    for (int s = 0; s < 4; ++s) { O0 = MFMA32(va[2 * s], pf[s], O0); O1 = MFMA32(va[2 * s + 1], pf[s], O1); }
}

template <bool FAST>
__device__ __forceinline__ void fox_tile(const LAS unsigned char* sbp, int h, const h8 (&q)[4], int qi, int hb, bool diag, int kbase, int t, float& m, float& l, f32x16& O0, f32x16& O1) {
    const LAS unsigned char* Kh = sbp + h * 4608; const LAS unsigned char* Vh = sbp + 18432 + h * 5120;
    const LAS float* cbh = (const LAS float*)(sbp + 38912) + h * 32;
    f32x16 S;
#pragma unroll
    for (int g = 0; g < 4; ++g) { const f32x4 c4 = *(const LAS f32x4*)(cbh + 16 * (g >> 1) + 8 * hb + 4 * (g & 1)); S[4 * g] = c4.x; S[4 * g + 1] = c4.y; S[4 * g + 2] = c4.z; S[4 * g + 3] = c4.w; }
    h8 ka[4], va[4];
#pragma unroll
    for (int kk = 0; kk < 4; ++kk) ka[kk] = *(const LAS h8*)(Kh + pi16(qi) * 144 + (16 * kk + 8 * hb) * 2);
    va[0] = *(const LAS h8*)(Vh + qi * 80 + (8 * hb) * 2); va[1] = *(const LAS h8*)(Vh + qi * 80 + (16 + 8 * hb) * 2);
    va[2] = *(const LAS h8*)(Vh + (32 + qi) * 80 + (8 * hb) * 2); va[3] = *(const LAS h8*)(Vh + (32 + qi) * 80 + (16 + 8 * hb) * 2);
    __builtin_amdgcn_sched_barrier(0);
#pragma unroll
    for (int kk = 0; kk < 4; ++kk) S = MFMA32(ka[kk], q[kk], S);
    if (diag) {
#pragma unroll
        for (int r = 0; r < 16; ++r) { const int key = kbase + 16 * (r >> 3) + 8 * hb + 4 * ((r >> 2) & 1) + (r & 3); if (key > t) S[r] = -INFINITY; }
    }
    float mn = m, alpha = 1.f;
    if (!FAST) {
        float mx = S[0];
#pragma unroll
        for (int r = 1; r < 16; ++r) mx = fmaxf(mx, S[r]);
        mx = fmaxf(mx, __shfl_xor(mx, 32));
        mn = fmaxf(m, mx); alpha = __builtin_amdgcn_exp2f(m - mn);
        m = mn;
    }
    float ps = 0.f;
#pragma unroll
    for (int r = 0; r < 16; ++r) { S[r] = __builtin_amdgcn_exp2f(S[r] - mn); ps += S[r]; }
    l = l * alpha + ps;
    if (!FAST && __any(alpha != 1.f)) {
#pragma unroll
        for (int r = 0; r < 16; ++r) { O0[r] *= alpha; O1[r] *= alpha; }
    }
    h8 pf0, pf1;
#pragma unroll
    for (int e = 0; e < 8; ++e) { pf0[e] = (half_t)S[e]; pf1[e] = (half_t)S[8 + e]; }
    O0 = MFMA32(va[0], pf0, O0); O1 = MFMA32(va[2], pf0, O1); O0 = MFMA32(va[1], pf1, O0); O1 = MFMA32(va[3], pf1, O1);
}
__device__ __forceinline__ void nsa_tile(bool near, int dq, int wlim, float cinit, const LAS float* TRh, const h8 (&q)[4], const LAS unsigned char* stage, float& m, float& l, f32x16& O0, f32x16& O1, int qi, int hb) {
    f32x16 S0, S1;
    if (near) init_near(S0, S1, TRh, dq, hb, 1, wlim); else init_const(S0, S1, cinit);
    qk64(S0, S1, q, stage, qi, hb);
    softmax64(S0, S1, m, l, O0, O1);
    pv64(S0, S1, stage + 9216, O0, O1, qi, hb);
}

#define MFMA16(a, b, c) __builtin_amdgcn_mfma_f32_16x16x32_f16(a, b, c, 0, 0, 0)
template <bool FINAL>
__device__ __forceinline__ void lru_unit(const Params& P, int L, int ui, LAS unsigned char* lds, const half_t* Z, const half_t* WGT, const float* LSPp, float* LRUAGG, float* LRUA, float* LRUB, half_t* MIXED, int wave, float& hcarry, bool first) {
    int tid = threadIdx.x; asm volatile("" : "+v"(tid)); const int lane = tid & 63;
    const int b = ui >> 7, sub = ui & 127, t0 = sub * 32; const size_t tokb = (size_t)b * SEQ;
    LAS float* xcF = (LAS float*)lds;
    LAS float* Aa = (LAS float*)(lds + 32768);
    LAS half_t* xcH = (LAS half_t*)(lds + 65536);
    LAS float* Sc = (LAS float*)(lds + 82944);
    {
        const int c = tid & 255, q2 = tid >> 8, ta = t0 + 16 * q2;
        const float w0 = P.lru_conv_w[(L * 4 + 0) * 256 + c], w1 = P.lru_conv_w[(L * 4 + 1) * 256 + c], w2 = P.lru_conv_w[(L * 4 + 2) * 256 + c], w3 = P.lru_conv_w[(L * 4 + 3) * 256 + c], cb = P.lru_conv_b[L * 256 + c];
        const half_t* zp = Z + (tokb + ta) * NZP + ZC_LRU_X + c;
        float x0 = ta >= 3 ? (float)zp[-3 * NZP] : 0.f, x1 = ta >= 2 ? (float)zp[-2 * NZP] : 0.f, x2 = ta >= 1 ? (float)zp[-1 * NZP] : 0.f;
#pragma unroll
        for (int i = 0; i < 16; ++i) { const float x3 = (float)zp[(size_t)i * NZP]; const float v = cb + w0 * x0 + w1 * x1 + w2 * x2 + w3 * x3;
            xcF[(16 * q2 + i) * 256 + c] = v; xcH[(16 * q2 + i) * 264 + c] = (half_t)v; x0 = x1; x1 = x2; x2 = x3; }
    }
    __syncthreads();
    {
        const int blk = wave & 3, th = wave >> 2, r16 = lane & 15, kq = lane >> 4;
        const h8 a0 = *(const LAS h8*)(xcH + (16 * th + r16) * 264 + blk * 64 + 8 * kq), a1 = *(const LAS h8*)(xcH + (16 * th + r16) * 264 + blk * 64 + 32 + 8 * kq);
#pragma unroll
        for (int cbk = 0; cbk < 4; ++cbk) {
            const half_t* wr = WGT + ((size_t)((L * 2 + 0) * 4 + blk) * 64 + 16 * cbk + r16) * 64 + 8 * kq; const half_t* wi = wr + 4 * 64 * 64;
            f32x4 ar = {0.f, 0.f, 0.f, 0.f}, ai = {0.f, 0.f, 0.f, 0.f};
            ar = MFMA16(a0, *(const h8*)wr, ar); ar = MFMA16(a1, *(const h8*)(wr + 32), ar);
            ai = MFMA16(a0, *(const h8*)wi, ai); ai = MFMA16(a1, *(const h8*)(wi + 32), ai);
            const int c = blk * 64 + 16 * cbk + r16;
            const float br = P.lru_b_gates[(L * 2 + 0) * 256 + c], bi = P.lru_b_gates[(L * 2 + 1) * 256 + c];
            const float lsp = LSPp[L * 256 + c];
#pragma unroll
            for (int rg = 0; rg < 4; ++rg) { const int tl = 16 * th + 4 * kq + rg;
                const float r = __builtin_amdgcn_rcpf(1.f + __builtin_amdgcn_exp2f(-LOG2E * (ar[rg] + br))), ii = __builtin_amdgcn_rcpf(1.f + __builtin_amdgcn_exp2f(-LOG2E * (ai[rg] + bi)));
                const float xc = xcF[tl * 256 + c];
                const float a = __builtin_amdgcn_exp2f(lsp * r), bb = __builtin_amdgcn_sqrtf(fmaxf(1.f - a * a, 0.f)) * (ii * xc);
                Aa[tl * 256 + c] = a; xcF[tl * 256 + c] = bb; }
        }
    }
    __syncthreads();
    if (tid < 256) {
        const int c = tid;
        if (!FINAL) {
            float h = 0.f, Ap = 1.f;
#pragma unroll 8
            for (int i = 0; i < 32; ++i) { const float a = Aa[i * 256 + c], bb = xcF[i * 256 + c]; h = fmaf(a, h, bb); Ap *= a;
                LRUA[(tokb + t0 + i) * 256 + c] = a; LRUB[(tokb + t0 + i) * 256 + c] = bb; }
            float* ag = LRUAGG + (((size_t)b * 128 + sub) * 256 + c) * 2; ag[0] = Ap; ag[1] = h;
        } else {
            float h = hcarry;
            if (first) { h = 0.f; const float* ag = LRUAGG + ((size_t)b * 128 * 256 + c) * 2;
              for (int s0 = 0; s0 < sub; s0 += 16) {
                  typedef float f32x2 __attribute__((ext_vector_type(2)));
                  f32x2 pr[16];
#pragma unroll
                  for (int k = 0; k < 16; ++k) pr[k] = (s0 + k < sub) ? *(const f32x2*)(ag + (size_t)(s0 + k) * 512) : (f32x2){1.f, 0.f};
#pragma unroll
                  for (int k = 0; k < 16; ++k) h = fmaf(pr[k].x, h, pr[k].y); } }
            const half_t* gp = Z + (tokb + t0) * NZP + ZC_LRU_G + c;
#pragma unroll 8
            for (int i = 0; i < 32; ++i) { const float a = Aa[i * 256 + c], bb = xcF[i * 256 + c]; h = fmaf(a, h, bb);
                const float gx = (float)gp[(size_t)i * NZP];
                Aa[i * 256 + c] = h * gx * __builtin_amdgcn_rcpf(1.f + __builtin_amdgcn_exp2f(-2.f * LOG2E * 0.7978845608028654f * (gx + 0.044715f * gx * gx * gx))); }
            hcarry = h;
        }
    } else if (FINAL) {
        const int c = tid - 256;
        const float w0 = P.sc_conv_w[(L * 3 + 0) * 256 + c], w1 = P.sc_conv_w[(L * 3 + 1) * 256 + c], w2 = P.sc_conv_w[(L * 3 + 2) * 256 + c];
        const half_t* zp = Z + (tokb + t0) * NZP + c;
        float u0 = t0 >= 2 ? (float)zp[-2 * NZP + ZC_SC_C] * (float)zp[-2 * NZP + ZC_SC_X] : 0.f, u1 = t0 >= 1 ? (float)zp[-1 * NZP + ZC_SC_C] * (float)zp[-1 * NZP + ZC_SC_X] : 0.f;
#pragma unroll 8
        for (int i = 0; i < 32; ++i) { const half_t* zr = zp + (size_t)i * NZP; const float u2 = (float)zr[ZC_SC_C] * (float)zr[ZC_SC_X];
            Sc[i * 256 + c] = (float)zr[ZC_SC_B] * (w0 * u0 + w1 * u1 + w2 * u2); u0 = u1; u1 = u2; }
    }
    __syncthreads();
    if (FINAL) {
        const f32x4 ga = *(const f32x4*)(P.out_norm + (L * 4 + 0) * 256 + 4 * lane), gbv = *(const f32x4*)(P.out_norm + (L * 4 + 1) * 256 + 4 * lane);
#pragma unroll
        for (int i = 0; i < 4; ++i) { const int tl = wave * 4 + i; half_t* op = MIXED + (tokb + t0 + tl) * D + 4 * lane;
            { const f32x4 v = *(const LAS f32x4*)(Aa + tl * 256 + 4 * lane); const float rs = rsqrtf(wave_sum((v.x * v.x + v.y * v.y) + (v.z * v.z + v.w * v.w)) * (1.f / 256.f) + EPS);
              u32x2 o; o.x = pack_h2(v.x * rs * ga.x, v.y * rs * ga.y); o.y = pack_h2(v.z * rs * ga.z, v.w * rs * ga.w); *(u32x2*)op = o; }
            { const f32x4 v = *(const LAS f32x4*)(Sc + tl * 256 + 4 * lane); const float rs = rsqrtf(wave_sum((v.x * v.x + v.y * v.y) + (v.z * v.z + v.w * v.w)) * (1.f / 256.f) + EPS);
              u32x2 o; o.x = pack_h2(v.x * rs * gbv.x, v.y * rs * gbv.y); o.y = pack_h2(v.z * rs * gbv.z, v.w * rs * gbv.w); *(u32x2*)(op + 256) = o; }
        }
        __syncthreads();
    }
}

__device__ __forceinline__ void lru_final(const Params& P, int L, int ui, LAS unsigned char* lds, const half_t* Z, const float* LRUAGG, const float* LRUA, const float* LRUB, half_t* MIXED, int wave, float& hcarry, bool first) {
    int tid = threadIdx.x; asm volatile("" : "+v"(tid)); const int lane = tid & 63;
    const int b = ui >> 7, sub = ui & 127, t0 = sub * 32; const size_t tokb = (size_t)b * SEQ;
    LAS float* Aa = (LAS float*)lds;
    LAS float* Sc = (LAS float*)(lds + 32768);
    if (tid < 256) {
        const int c = tid;
        float av[32], bv[32]; half_t gv[32];
        const float* ap = LRUA + (tokb + t0) * 256 + c; const float* bp = LRUB + (tokb + t0) * 256 + c; const half_t* gp = Z + (tokb + t0) * NZP + ZC_LRU_G + c;
#pragma unroll
        for (int i = 0; i < 32; ++i) { av[i] = ap[i * 256]; bv[i] = bp[i * 256]; gv[i] = gp[(size_t)i * NZP]; }
        float h = hcarry;
        if (first) { h = 0.f; const float* ag = LRUAGG + ((size_t)b * 128 * 256 + c) * 2;
          for (int s0 = 0; s0 < sub; s0 += 16) {
              typedef float f32x2 __attribute__((ext_vector_type(2)));
              f32x2 pr[16];
#pragma unroll
              for (int k = 0; k < 16; ++k) pr[k] = (s0 + k < sub) ? *(const f32x2*)(ag + (size_t)(s0 + k) * 512) : (f32x2){1.f, 0.f};
#pragma unroll
              for (int k = 0; k < 16; ++k) h = fmaf(pr[k].x, h, pr[k].y); } }
#pragma unroll
        for (int i = 0; i < 32; ++i) { h = fmaf(av[i], h, bv[i]); const float gx = (float)gv[i];
            Aa[i * 256 + c] = h * gx * __builtin_amdgcn_rcpf(1.f + __builtin_amdgcn_exp2f(-2.f * LOG2E * 0.7978845608028654f * (gx + 0.044715f * gx * gx * gx))); }
        hcarry = h;
    } else {
        const int c = tid - 256;
        const float w0 = P.sc_conv_w[(L * 3 + 0) * 256 + c], w1 = P.sc_conv_w[(L * 3 + 1) * 256 + c], w2 = P.sc_conv_w[(L * 3 + 2) * 256 + c];
        const half_t* zp = Z + (tokb + t0) * NZP + c;
        float u0 = t0 >= 2 ? (float)zp[-2 * NZP + ZC_SC_C] * (float)zp[-2 * NZP + ZC_SC_X] : 0.f, u1 = t0 >= 1 ? (float)zp[-1 * NZP + ZC_SC_C] * (float)zp[-1 * NZP + ZC_SC_X] : 0.f;
#pragma unroll 8
        for (int i = 0; i < 32; ++i) { const half_t* zr = zp + (size_t)i * NZP; const float u2 = (float)zr[ZC_SC_C] * (float)zr[ZC_SC_X];
            Sc[i * 256 + c] = (float)zr[ZC_SC_B] * (w0 * u0 + w1 * u1 + w2 * u2); u0 = u1; u1 = u2; }
    }
    __syncthreads();
    {
        const f32x4 ga = *(const f32x4*)(P.out_norm + (L * 4 + 0) * 256 + 4 * lane), gbv = *(const f32x4*)(P.out_norm + (L * 4 + 1) * 256 + 4 * lane);
#pragma unroll
        for (int i = 0; i < 4; ++i) { const int tl = wave * 4 + i; half_t* op = MIXED + (tokb + t0 + tl) * D + 4 * lane;
            { const f32x4 v = *(const LAS f32x4*)(Aa + tl * 256 + 4 * lane); const float rs = rsqrtf(wave_sum((v.x * v.x + v.y * v.y) + (v.z * v.z + v.w * v.w)) * (1.f / 256.f) + EPS);
              u32x2 o; o.x = pack_h2(v.x * rs * ga.x, v.y * rs * ga.y); o.y = pack_h2(v.z * rs * ga.z, v.w * rs * ga.w); *(u32x2*)op = o; }
            { const f32x4 v = *(const LAS f32x4*)(Sc + tl * 256 + 4 * lane); const float rs = rsqrtf(wave_sum((v.x * v.x + v.y * v.y) + (v.z * v.z + v.w * v.w)) * (1.f / 256.f) + EPS);
              u32x2 o; o.x = pack_h2(v.x * rs * gbv.x, v.y * rs * gbv.y); o.y = pack_h2(v.z * rs * gbv.z, v.w * rs * gbv.w); *(u32x2*)(op + 256) = o; }
        }
    }
    __syncthreads();
}

constexpr int CW_Q = 8192;
__device__ __forceinline__ int q_next(unsigned* ctr, volatile LAS unsigned* slot) {
    __syncthreads();
    if (threadIdx.x == 0) *slot = __hip_atomic_fetch_add(ctr, 1u, __ATOMIC_RELAXED, __HIP_MEMORY_SCOPE_AGENT);
    __syncthreads();
    return __builtin_amdgcn_readfirstlane((int)*slot);
}
__device__ __forceinline__ unsigned long long ld_uptr(const LAS unsigned long long* pb, int i) {
    const unsigned long long v = pb[i];
    return ((unsigned long long)(unsigned)__builtin_amdgcn_readfirstlane((int)(v >> 32)) << 32) | (unsigned)__builtin_amdgcn_readfirstlane((int)(unsigned)v);
}
#define SECTION_ENV() \
    asm volatile("" ::: "memory"); \
    int bid = blockIdx.x; asm volatile("" : "+s"(bid));     \
    Params P; { unsigned poff_ = MISC_OFF + 512; asm volatile("" : "+s"(poff_)); const LAS unsigned long long* pb_ = (const LAS unsigned long long*)(lds + poff_); P.x = (const float*)(const __attribute__((address_space(1))) float*)ld_uptr(pb_, 0); P.norm_mix = (const float*)(const __attribute__((address_space(1))) float*)ld_uptr(pb_, 1); P.w_in = (const float*)(const __attribute__((address_space(1))) float*)ld_uptr(pb_, 2); P.lru_conv_w = (const float*)(const __attribute__((address_space(1))) float*)ld_uptr(pb_, 3); P.lru_conv_b = (const float*)(const __attribute__((address_space(1))) float*)ld_uptr(pb_, 4); P.lru_w_gates = (const float*)(const __attribute__((address_space(1))) float*)ld_uptr(pb_, 5); P.lru_b_gates = (const float*)(const __attribute__((address_space(1))) float*)ld_uptr(pb_, 6); P.lru_lambda = (const float*)(const __attribute__((address_space(1))) float*)ld_uptr(pb_, 7); P.sc_conv_w = (const float*)(const __attribute__((address_space(1))) float*)ld_uptr(pb_, 8); P.fox_f_bias = (const float*)(const __attribute__((address_space(1))) float*)ld_uptr(pb_, 9); P.fox_qk_norm = (const float*)(const __attribute__((address_space(1))) float*)ld_uptr(pb_, 10); P.nsa_qk_norm = (const float*)(const __attribute__((address_space(1))) float*)ld_uptr(pb_, 11); P.nsa_cmp_pos = (const float*)(const __attribute__((address_space(1))) float*)ld_uptr(pb_, 12); P.nsa_cmp_w1 = (const float*)(const __attribute__((address_space(1))) float*)ld_uptr(pb_, 13); P.nsa_cmp_w2 = (const float*)(const __attribute__((address_space(1))) float*)ld_uptr(pb_, 14); P.nsa_gate_bias = (const float*)(const __attribute__((address_space(1))) float*)ld_uptr(pb_, 15); P.rel_bias = (const float*)(const __attribute__((address_space(1))) float*)ld_uptr(pb_, 16); P.out_norm = (const float*)(const __attribute__((address_space(1))) float*)ld_uptr(pb_, 17); P.w_out = (const float*)(const __attribute__((address_space(1))) float*)ld_uptr(pb_, 18); P.norm_ffn = (const float*)(const __attribute__((address_space(1))) float*)ld_uptr(pb_, 19); P.w_gate_up = (const float*)(const __attribute__((address_space(1))) float*)ld_uptr(pb_, 20); P.w_down = (const float*)(const __attribute__((address_space(1))) float*)ld_uptr(pb_, 21); P.out = (float*)(__attribute__((address_space(1))) float*)ld_uptr(pb_, 22); P.ws = (unsigned char*)(__attribute__((address_space(1))) unsigned char*)ld_uptr(pb_, 23); } \
    unsigned char* ws = P.ws; (void)ws; \
    float* SSQA = (float*)(ws + WS_SSQA); float* SSQB = (float*)(ws + WS_SSQB); float* CFOX = (float*)(ws + WS_CFOX); \
    float* LRUAGG = (float*)(ws + WS_LRUAGG); float* CB = (float*)(ws + WS_CB); \
    half_t* WIN_T = (half_t*)(ws + WS_WIN); half_t* WOUT_T = (half_t*)(ws + WS_WOUT); half_t* WGU_T = (half_t*)(ws + WS_WGU); half_t* WDN_T = (half_t*)(ws + WS_WDN); \
    half_t* FOXVT = (half_t*)(ws + WS_FOXVT); half_t* VST = (half_t*)(ws + WS_VST); half_t* VWT = (half_t*)(ws + WS_VWT); half_t* KCH = (half_t*)(ws + WS_KCH); half_t* VCT = (half_t*)(ws + WS_VCT); \
    half_t* W1T = (half_t*)(ws + WS_W1T); half_t* WGT = (half_t*)(ws + WS_WGT); float* LRUA = (float*)(ws + WS_LRUA); float* LRUB = (float*)(ws + WS_LRUB); (void)LRUA; (void)LRUB; \
    half_t* XH = (half_t*)(ws + WS_XH); half_t* MIXED = (half_t*)(ws + WS_MIXED); half_t* Z = (half_t*)(ws + WS_Z); half_t* HB = (half_t*)(ws + WS_Z); \
    (void)SSQA; (void)SSQB; (void)CFOX; (void)LRUAGG; (void)CB; (void)WIN_T; (void)WOUT_T; (void)WGU_T; (void)WDN_T; (void)FOXVT; (void)VST; (void)VWT; (void)KCH; (void)VCT; (void)W1T; (void)WGT; (void)XH; (void)MIXED; (void)Z; (void)HB

__global__ void __launch_bounds__(NTHR, 2) hymba_fwd(Params Pk) {
    extern __shared__ __attribute__((aligned(16))) unsigned char lds_raw[];
    LAS unsigned char* lds = (LAS unsigned char*)lds_raw;
    volatile LAS unsigned* MISC = (volatile LAS unsigned*)(lds + MISC_OFF);
    const int tid = threadIdx.x, lane = tid & 63, wave = __builtin_amdgcn_readfirstlane(tid >> 6);
    const int G = gridDim.x, bid = blockIdx.x;
    if (tid == 0) { LAS unsigned long long* pb = (LAS unsigned long long*)(lds + MISC_OFF + 512); pb[0] = (unsigned long long)Pk.x; pb[1] = (unsigned long long)Pk.norm_mix; pb[2] = (unsigned long long)Pk.w_in; pb[3] = (unsigned long long)Pk.lru_conv_w; pb[4] = (unsigned long long)Pk.lru_conv_b; pb[5] = (unsigned long long)Pk.lru_w_gates; pb[6] = (unsigned long long)Pk.lru_b_gates; pb[7] = (unsigned long long)Pk.lru_lambda; pb[8] = (unsigned long long)Pk.sc_conv_w; pb[9] = (unsigned long long)Pk.fox_f_bias; pb[10] = (unsigned long long)Pk.fox_qk_norm; pb[11] = (unsigned long long)Pk.nsa_qk_norm; pb[12] = (unsigned long long)Pk.nsa_cmp_pos; pb[13] = (unsigned long long)Pk.nsa_cmp_w1; pb[14] = (unsigned long long)Pk.nsa_cmp_w2; pb[15] = (unsigned long long)Pk.nsa_gate_bias; pb[16] = (unsigned long long)Pk.rel_bias; pb[17] = (unsigned long long)Pk.out_norm; pb[18] = (unsigned long long)Pk.w_out; pb[19] = (unsigned long long)Pk.norm_ffn; pb[20] = (unsigned long long)Pk.w_gate_up; pb[21] = (unsigned long long)Pk.w_down; pb[22] = (unsigned long long)Pk.out; pb[23] = (unsigned long long)Pk.ws; }
    unsigned* ctl = (unsigned*)(Pk.ws + WS_CTL);

    for (int u = tid; u < 64; u += NTHR) MISC[u] = 0u;
    __syncthreads();
    XcdBarrier bar = xcd_barrier_post(ctl + CW_BAR, MISC + 8);

    const int gw = bid * NWAVES + wave, NGW = G * NWAVES;

#ifndef SKIP_P0
    for (int rp0 = 0; rp0 < REP_P0; ++rp0) {
        SECTION_ENV();
        LAS unsigned* scr = (LAS unsigned*)(lds + wave * 8448);
        constexpr int I_IN = 16 * 44, I_OUT = 16 * 16, I_GU = 16 * 88, I_DN = 44 * 16, PER_L = I_IN + I_OUT + I_GU + I_DN;
        for (int it = gw; it < 2 * PER_L; it += NGW) {
            const int L = it / PER_L; int r = it % PER_L;
            if (r < I_IN) { p0_item<1>(P.w_in + (size_t)L * D * NIN_SRC, D, NIN_SRC, P.norm_mix + L * D, WIN_T + (size_t)L * NZP * D, r, 44, scr, lane); continue; } r -= I_IN;
            if (r < I_OUT) { p0_item<0>(P.w_out + (size_t)L * D * D, D, D, nullptr, WOUT_T + (size_t)L * D * D, r, 16, scr, lane); continue; } r -= I_OUT;
            if (r < I_GU) { p0_item<2>(P.w_gate_up + (size_t)L * D * 2 * DFF, D, 2 * DFF, P.norm_ffn + L * D, WGU_T + (size_t)L * 2 * DFF * D, r, 88, scr, lane); continue; } r -= I_GU;
            p0_item<0>(P.w_down + (size_t)L * DFF * D, DFF, D, nullptr, WDN_T + (size_t)L * D * DFF, r, 16, scr, lane);
        }
        for (int it = gw; it < 4 * 64 + 16; it += NGW) {
            if (it < 256) { const int ln = it >> 6; p0_item<0>(P.nsa_cmp_w1 + (size_t)ln * 2048 * 128, 2048, 128, nullptr, W1T + (size_t)ln * 128 * 2048, it & 63, 2, scr, lane); }
            else { const int gi = it - 256; p0_item<0>(P.lru_w_gates + (size_t)gi * 64 * 64, 64, 64, nullptr, WGT + (size_t)gi * 64 * 64, 0, 1, scr, lane); }
        }
        for (int o = gw; o < 2 * 2 * 128; o += NGW) {
            const int m = o & 127, ln = o >> 7;
            const float* pp = P.nsa_cmp_pos + (size_t)ln * 2048; const float* wp = P.nsa_cmp_w1 + (size_t)ln * 2048 * 128 + m;
            float s = 0.f;
            for (int i = lane; i < 2048; i += 64) s = fmaf(pp[i], wp[(size_t)i * 128], s);
            s = wave_sum(s);
            if (lane == 0) CB[o] = s;
        }
        for (int o = bid * NTHR + tid; o < 512; o += G * NTHR) CB[1024 + o] = -8.0f * LOG2E * log1pf(expf(-P.lru_lambda[o]));
        for (int row = gw; row < T; row += NGW) {
            const f32x4* xr = (const f32x4*)(P.x + (size_t)row * D) + lane;
            float s = 0.f;
#pragma unroll
            for (int j = 0; j < 4; ++j) { const f32x4 v = xr[64 * j]; s += (v.x * v.x + v.y * v.y) + (v.z * v.z + v.w * v.w);
                u32x2 o; o.x = pack_h2(v.x, v.y); o.y = pack_h2(v.z, v.w); *(u32x2*)(XH + (size_t)row * D + 4 * (lane + 64 * j)) = o; }
            s = wave_sum(s);
            if (lane < 16) SSQB[(size_t)row * 16 + lane] = lane == 0 ? s : 0.f;
        }
    }
#endif
    xcd_barrier(bar);

    for (int L = 0; L < 2; ++L) {
#ifndef SKIP_G1
        {
            SECTION_ENV();
            pg8::Gemm g{XH, WIN_T + (size_t)L * NZP * D, T, NZP, D}; pg8::StaticOrder S; S.init(T, NZP, G, bid);
            EpiZ E{Z, SSQB};
            for (int rp = 0; rp < REP_G1; ++rp) pg8::gemm_phase<EpiZ, pg8::StaticOrder>(lds, g, S, E);
        }
#endif
        xcd_barrier(bar);

        {
            SECTION_ENV();
#ifndef SKIP_P2AB
            {
                int tid = threadIdx.x; asm volatile("" : "+v"(tid)); const int lane = tid & 63;
                const int g8 = lane >> 3, sub = lane & 7;
                for (int dry = NORM_DRY; dry >= 0; --dry)
                for (int tok = gw; tok < T; tok += NGW) {
#pragma unroll
                    for (int rr = 0; rr < 2; ++rr) {
                        const int r = g8 + 8 * rr;
                        if (r < 14) {
                            int col; const float* gain;
                            if (r < 4) { col = ZC_FOX_Q + 64 * r; gain = P.fox_qk_norm + (L * 2 + 0) * 64; }
                            else if (r < 8) { col = ZC_FOX_K + 64 * (r - 4); gain = P.fox_qk_norm + (L * 2 + 1) * 64; }
                            else if (r < 12) { col = ZC_NSA_Q + 64 * (r - 8); gain = P.nsa_qk_norm + (L * 4 + 0) * 64; }
                            else if (r == 12) { col = ZC_KS; gain = P.nsa_qk_norm + (L * 4 + 2) * 64; }
                            else { col = ZC_KW; gain = P.nsa_qk_norm + (L * 4 + 3) * 64; }
                            half_t* p = Z + (size_t)tok * NZP + col + 8 * sub;
                            const h8 v = *(const h8*)p; float f[8]; float s = 0.f;
#pragma unroll
                            for (int e = 0; e < 8; ++e) { f[e] = (float)v[e]; s += f[e] * f[e]; }
                            s += __shfl_xor(s, 1); s += __shfl_xor(s, 2); s += __shfl_xor(s, 4);
                            const float rs = rsqrtf(s * (1.f / 64.f) + EPS) * ((r < 4 || (r >= 8 && r < 12)) ? QSCALE : 1.f);
                            const f32x4 g0 = *(const f32x4*)(gain + 8 * sub), g1 = *(const f32x4*)(gain + 8 * sub + 4);
                            if (dry) *(h8*)p = v; else
                            *(u32x4*)p = pack_h8((f32x4){f[0] * rs * g0.x, f[1] * rs * g0.y, f[2] * rs * g0.z, f[3] * rs * g0.w}, (f32x4){f[4] * rs * g1.x, f[5] * rs * g1.y, f[6] * rs * g1.z, f[7] * rs * g1.w});
                        }
                    }
                }
            }
            for (int rp = 0; rp < REP_CUM; ++rp)
            if (wave == 1 && (bid & 7) == 0 && (bid >> 3) < 32) {
                int tid = threadIdx.x; asm volatile("" : "+v"(tid)); const int lane = tid & 63;
                const int task = bid >> 3, b = task >> 2, h = task & 3;
                const float fb = P.fox_f_bias[L * 4 + h];
                const half_t* zp = Z + ((size_t)b * SEQ + 64 * lane) * NZP + ZC_FOX_F + h;
                float vals[64];
#pragma unroll
                for (int j = 0; j < 64; ++j) vals[j] = (float)zp[(size_t)j * NZP];
                float run = 0.f;
#pragma unroll
                for (int j = 0; j < 64; ++j) { run += log_sigmoid(vals[j] + fb); vals[j] = run; }
                float incl = run;
#pragma unroll
                for (int o = 1; o < 64; o <<= 1) { const float n = __shfl_up(incl, o); if (lane >= o) incl += n; }
                const float excl = incl - run;
                float* cp = CFOX + ((size_t)b * 4 + h) * SEQ + 64 * lane;
#pragma unroll
                for (int j = 0; j < 64; j += 4) *(f32x4*)(cp + j) = (f32x4){vals[j] + excl, vals[j + 1] + excl, vals[j + 2] + excl, vals[j + 3] + excl};
            }
#endif
            for (int rp = 0; rp < REP_VT; ++rp)
            for (int ui = bid; ui < 512; ui += G) {
                int tid = threadIdx.x; asm volatile("" : "+v"(tid));
                const int b = ui >> 6, chunk = ui & 63; const size_t tokb = (size_t)b * SEQ + chunk * 64;
                LAS half_t* tb = (LAS half_t*)lds;
#pragma unroll
                for (int i = 0; i < 4; ++i) { const int p = tid + 512 * i, tk = p >> 5, c8 = p & 31;
                    *(LAS h8*)(tb + tk * 264 + 8 * c8) = *(const h8*)(Z + (tokb + tk) * NZP + ZC_FOX_V + 8 * c8); }
                LAS half_t* tb2 = tb + 64 * 264;
#pragma unroll
                for (int i = 0; i < 2; ++i) { const int p = tid + 512 * i, tk = p >> 4, c8 = p & 15;
                    *(LAS h8*)(tb2 + tk * 136 + 8 * c8) = *(const h8*)(Z + (tokb + tk) * NZP + (c8 < 8 ? ZC_VS + 8 * c8 : ZC_VW + 8 * (c8 - 8))); }
                __syncthreads();
                {
                    const int col = tid & 255, ktl = tid >> 8;
                    half_t* dst = FOXVT + ((size_t)(b * 128 + chunk * 2 + ktl) * 256 + col) * 32;
#pragma unroll
                    for (int j4 = 0; j4 < 4; ++j4) { h8 o;
#pragma unroll
                        for (int e = 0; e < 8; ++e) o[e] = tb[(32 * ktl + 8 * j4 + e) * 264 + col];
                        *(h8*)(dst + 8 * j4) = o; }
#pragma unroll
                    for (int i = 0; i < 2; ++i) { const int p = tid + 512 * i, which = p >> 9, d = (p >> 3) & 63, ch = p & 7; h8 o;
#pragma unroll
                        for (int e = 0; e < 8; ++e) o[e] = tb2[(8 * ch + e) * 136 + 64 * which + d];
                        *(h8*)((which ? VWT : VST) + ((size_t)(b * 64 + chunk) * 64 + d) * 64 + 8 * ch) = o; }
                }
                __syncthreads();
            }
#ifndef SKIP_P2LRU
            for (int rp = 0; rp < REP_P2LRU; ++rp)
            for (int ui = bid; ui < 1024; ui += G) { float hc = 0.f; lru_unit<false>(P, L, ui, lds, Z, WGT, CB + 1024, LRUAGG, LRUA, LRUB, MIXED, wave, hc, true); }
#endif
#ifndef SKIP_P2CMP
            for (int rp = 0; rp < REP_P2CMP; ++rp)
            for (int ui = bid; ui < 256; ui += G) {
                int tid = threadIdx.x; asm volatile("" : "+v"(tid)); const int lane = tid & 63, r16 = lane & 15, kq = lane >> 4;
                const int net = ui >> 7, b = (ui >> 4) & 7, n0 = (ui & 15) * 16;
                const size_t tokb = (size_t)b * SEQ;
                LAS half_t* zt = (LAS half_t*)lds;
                LAS float* w2s = (LAS float*)(lds + 39424);
                LAS float* hidb = (LAS float*)(lds + 39424 + 32768);
                {
                    const half_t* zsrc = Z + (tokb + 16 * n0) * NZP + (net ? ZC_VC : ZC_KC);
                    for (int e = tid; e < 272 * 8; e += NTHR) { const int tk = e >> 3, c8 = e & 7; int tt = 16 * n0 + tk; const int tcl = tt > SEQ - 1 ? SEQ - 1 - 16 * n0 : tk;
                        *(LAS h8*)(zt + tk * 72 + 8 * c8) = *(const h8*)(zsrc + (size_t)tcl * NZP + 8 * c8); }
                    const float* w2g = P.nsa_cmp_w2 + (size_t)(L * 2 + net) * 128 * 64;
                    for (int e = tid; e < 128 * 16; e += NTHR) *(LAS f32x4*)(w2s + 4 * e) = *(const f32x4*)(w2g + 4 * e);
                }
                const half_t* w1t = W1T + ((size_t)((L * 2 + net) * 128 + 16 * wave + r16)) * 2048 + 8 * kq;
                h8 bf[16];
#pragma unroll
                for (int s = 0; s < 16; ++s) bf[s] = *(const h8*)(w1t + 32 * s);
                __syncthreads();
                {
                    f32x4 c0 = {0.f, 0.f, 0.f, 0.f}, c1 = {0.f, 0.f, 0.f, 0.f};
                    const LAS half_t* za = zt + (16 * r16) * 72 + 8 * kq;
#pragma unroll
                    for (int qd = 0; qd < 4; ++qd) {
                        h8 bn[16];
                        if (qd < 3) {
#pragma unroll
                            for (int s = 0; s < 16; ++s) bn[s] = *(const h8*)(w1t + 32 * (16 * (qd + 1) + s));
                        }
#pragma unroll
                        for (int s = 0; s < 16; s += 2) { const int sg = 16 * qd + s;
                            c0 = MFMA16(*(const LAS h8*)(za + (sg >> 1) * 72), bf[s], c0);
                            c1 = MFMA16(*(const LAS h8*)(za + (sg >> 1) * 72 + 32), bf[s + 1], c1); }
                        if (qd < 3) {
#pragma unroll
                            for (int s = 0; s < 16; ++s) bf[s] = bn[s];
                        }
                    }
                    const int m = 16 * wave + r16; const float cbm = CB[(L * 2 + net) * 128 + m];
#pragma unroll
                    for (int rg = 0; rg < 4; ++rg) hidb[(4 * kq + rg) * 132 + m] = gelu_tanh((c0[rg] + c1[rg]) + cbm);
                }
                __syncthreads();
                {
                    const int d = lane;
                    float o0 = 0.f, o1 = 0.f; const LAS float* hp = hidb + (2 * wave) * 132;
#pragma unroll 16
                    for (int m = 0; m < 128; ++m) { const float w = w2s[m * 64 + d]; o0 = fmaf(hp[m], w, o0); o1 = fmaf(hp[132 + m], w, o1); }
                    float ov[2] = {o0, o1};
#pragma unroll
                    for (int i = 0; i < 2; ++i) { float o = ov[i]; const int n = n0 + 2 * wave + i;
                        if (net == 0) { const float ss = wave_sum(o * o); o = o * rsqrtf(ss * (1.f / 64.f) + EPS) * P.nsa_qk_norm[(L * 4 + 1) * 64 + d]; }
                        if (n >= NCMP) o = 0.f;
                        if (net == 0) KCH[((size_t)b * 256 + n) * 64 + d] = (half_t)o; else VCT[((size_t)b * 64 + d) * 256 + n] = (half_t)o; }
                }
                __syncthreads();
            }
#endif
        }
        xcd_barrier(bar);

        {
        SECTION_ENV();
#ifndef SKIP_NSA
        if (wave == 0) {
            int tidf = threadIdx.x; asm volatile("" : "+v"(tidf));
            float gq = fabsf(P.nsa_qk_norm[(L * 4 + 0) * 64 + tidf]), gk = fmaxf(fmaxf(fabsf(P.nsa_qk_norm[(L * 4 + 1) * 64 + tidf]), fabsf(P.nsa_qk_norm[(L * 4 + 2) * 64 + tidf])), fabsf(P.nsa_qk_norm[(L * 4 + 3) * 64 + tidf]));
            float rb = fmaxf(fabsf(P.rel_bias[tidf]), fabsf(P.rel_bias[64 + tidf]));
#pragma unroll
            for (int o = 1; o < 64; o <<= 1) { gq = fmaxf(gq, __shfl_xor(gq, o)); gk = fmaxf(gk, __shfl_xor(gk, o)); rb = fmaxf(rb, __shfl_xor(rb, o)); }
            if (tidf == 0) MISC[16] = ((8.f * gq * gk + 2.f * rb) * LOG2E <= 15.8f) ? 1u : 0u;
        }
        __syncthreads();
        const bool nsa_fast = __builtin_amdgcn_readfirstlane((int)MISC[16]) != 0;
        if (nsa_fast)
        for (;;) {
            const int ui = q_next(ctl + CW_Q + ((L * 4 + 0) * 8 + (bid & 7)) * 64, MISC + 20); if (ui >= 64) break;
            int tid = threadIdx.x; asm volatile("" : "+v"(tid)); const int lane = tid & 63, hb = lane >> 5, qi = lane & 31;
            const int h = wave & 3, rh = wave >> 2;
            const int b = bid & 7, qt = 63 - ui, t0 = qt * 64, t = t0 + 32 * rh + qi, cur = qt, row = 32 * rh + qi;
            const size_t tokb = (size_t)b * SEQ;
            constexpr int NS_VT = 9216, NS_STAGE = 18432, NF_TRX = 36864, NF_IMP = NF_TRX + 4 * 520 * 4, NF_SELM = NF_IMP + 4 * 64 * 65 * 4, NF_EX = NF_SELM + 512, NF_STL = NF_EX + 1024, NF_MISC = NF_STL + 1024;
            static_assert(NF_MISC + 256 <= RING_BYTES, "NSA fast LDS map");
            LAS float* TRX = (LAS float*)(lds + NF_TRX); LAS float* impH = (LAS float*)(lds + NF_IMP); LAS unsigned* selm = (LAS unsigned*)(lds + NF_SELM);
            LAS float* ex = (LAS float*)(lds + NF_EX); LAS float* stl = (LAS float*)(lds + NF_STL); LAS unsigned* misc = (LAS unsigned*)(lds + NF_MISC);
            for (int e = tid; e < 4 * 520; e += NTHR) { const int hh = e / 520, i = e % 520, d = i - 1;
                TRX[e] = (i == 0 || i > 512) ? -INFINITY : (P.rel_bias[(d < 128 ? (int)c_bucket[d] : 31) * 4 + hh] - P.rel_bias[31 * 4 + hh]) * LOG2E; }
            for (int e = tid; e < 4 * 64 * 65; e += NTHR) impH[e] = 0.f;
            const LAS float* TXh = TRX + h * 520;
            h8 q[4];
#pragma unroll
            for (int kk = 0; kk < 4; ++kk) q[kk] = *(const h8*)(Z + (tokb + t) * NZP + ZC_NSA_Q + 64 * h + 16 * kk + 8 * hb);
            const float* gb = P.nsa_gate_bias + L * 12;
            const half_t* gz = Z + (tokb + t) * NZP + ZC_NSA_G;
            f32x16 T0, T1;
            u32x4 kr, vr, krB, vrB;
#define NS_ISSUE_R(KR, VR, kbase_, kstride_, vbase_, vstride_) do { KR = *(const u32x4*)((const char*)(kbase_) + (size_t)(tid >> 3) * (kstride_) + (tid & 7) * 16); \
                VR = *(const u32x4*)((const char*)(vbase_) + (size_t)(tid >> 3) * (vstride_) + (tid & 7) * 16); } while (0)
#define NS_WRITE_R(KR, VR, sb_) do { *(LAS u32x4*)(lds + (sb_) + (tid >> 3) * 144 + (tid & 7) * 16) = KR; *(LAS u32x4*)(lds + (sb_) + NS_VT + (tid >> 3) * 144 + (tid & 7) * 16) = VR; } while (0)
            {
                int cnt = (t0 + 63 - 31) / 16 + 1; if (cnt > NCMP) cnt = NCMP;
                const int ntc = (cnt + 63) >> 6;
                const half_t* kcb = KCH + (size_t)b * 256 * 64; const half_t* vcb = VCT + (size_t)b * 64 * 256;
                float l = 0.f;
#pragma unroll
                for (int r = 0; r < 16; ++r) { T0[r] = 0.f; T1[r] = 0.f; }
                for (int c = 0; c < ntc; ++c) {
                    __syncthreads();
                    NS_ISSUE_R(kr, vr, kcb + (size_t)c * 64 * 64, 128, vcb + c * 64, 512); NS_WRITE_R(kr, vr, 0);
                    __syncthreads();
                    f32x16 S0, S1; init_tab(S0, S1, TXh, t - 31 - 1024 * c, hb, 16, 511, true);
                    qk64(S0, S1, q, lds, qi, hb);
                    l += exp_sum64(S0, S1);
                    LAS float* ip = impH + (h * 64 + row) * 65 + 16 * c + 2 * hb;
#pragma unroll
                    for (int g = 0; g < 4; ++g) {
                        const int mo = 4 * (g >> 1) + (g & 1);
                        { const float v1 = 16.f * S0[4 * g + 3], v0 = 32.f * ((S0[4 * g] + S0[4 * g + 1]) + S0[4 * g + 2]) + v1;
                          __hip_atomic_fetch_add(ip + mo, v0, __ATOMIC_RELAXED, __HIP_MEMORY_SCOPE_WORKGROUP); if (16 * c + 2 * hb + mo + 1 < 64) __hip_atomic_fetch_add(ip + mo + 1, v1, __ATOMIC_RELAXED, __HIP_MEMORY_SCOPE_WORKGROUP); }
                        { const float v1 = 16.f * S1[4 * g + 3], v0 = 32.f * ((S1[4 * g] + S1[4 * g + 1]) + S1[4 * g + 2]) + v1;
                          __hip_atomic_fetch_add(ip + 8 + mo, v0, __ATOMIC_RELAXED, __HIP_MEMORY_SCOPE_WORKGROUP); if (16 * c + 2 * hb + 8 + mo + 1 < 64) __hip_atomic_fetch_add(ip + 8 + mo + 1, v1, __ATOMIC_RELAXED, __HIP_MEMORY_SCOPE_WORKGROUP); }
                    }
                    pv64m(S0, S1, true, lds + NS_VT, T0, T1, qi, hb);
                }
                l += __shfl_xor(l, 32);
                const float il = l > 0.f ? __builtin_amdgcn_rcpf(l) : 0.f;
                if (hb == 0) stl[row * 4 + h] = il;
                const float g0 = sigmoidf_((float)gz[0 * 4 + h] + gb[0 * 4 + h]) * il;
#pragma unroll
                for (int r = 0; r < 16; ++r) { T0[r] *= g0; T1[r] *= g0; }
            }
            __syncthreads();
            for (int rpQ = 0; rpQ < REP_NSELECT; ++rpQ)
            for (int rr = 0; rr < 8; ++rr) {
                const int rw = wave * 8 + rr;
                float v = ((impH[(0 * 64 + rw) * 65 + lane] * stl[rw * 4 + 0] + impH[(1 * 64 + rw) * 65 + lane] * stl[rw * 4 + 1]) + impH[(2 * 64 + rw) * 65 + lane] * stl[rw * 4 + 2]) + impH[(3 * 64 + rw) * 65 + lane] * stl[rw * 4 + 3];
                if (lane > cur) v = -INFINITY; else if (lane == 0 || lane == cur || lane == cur - 1) v = 1e30f;
                int rank = 0;
#pragma unroll
                for (int o = 0; o < 64; ++o) { const float w = __builtin_bit_cast(float, __builtin_amdgcn_readlane(__builtin_bit_cast(int, v), o)); rank += (w > v || (w == v && o < lane)) ? 1 : 0; }
                const unsigned long long msk = __ballot(rank < 16);
                if (lane == 0) { selm[rw * 2] = (unsigned)msk; selm[rw * 2 + 1] = (unsigned)(msk >> 32); }
            }
            __syncthreads();
            if (wave == 0) {
                unsigned lo = selm[lane * 2], hi = selm[lane * 2 + 1];
#pragma unroll
                for (int o = 1; o < 64; o <<= 1) { lo |= __shfl_xor(lo, o); hi |= __shfl_xor(hi, o); }
                if (lane == 0) { misc[0] = lo; misc[1] = hi; }
            }
            __syncthreads();
            const unsigned long long mymask = (unsigned long long)selm[row * 2] | ((unsigned long long)selm[row * 2 + 1] << 32);
            unsigned long long um = (unsigned long long)(unsigned)__builtin_amdgcn_readfirstlane((int)misc[0]) | ((unsigned long long)(unsigned)__builtin_amdgcn_readfirstlane((int)misc[1]) << 32);
            um &= (cur >= 63) ? ~0ull : ((1ull << (cur + 1)) - 1ull);
            const unsigned long long um_all = um;
            for (int rpS = 0; rpS < REP_NSEL; ++rpS) {
                um = um_all; if (rpS) __syncthreads();
                f32x16 O0, O1;
#pragma unroll
                for (int r = 0; r < 16; ++r) { O0[r] = 0.f; O1[r] = 0.f; }
                float l = 0.f;
                int jc = __builtin_ctzll(um); um &= um - 1;
                int jn = -1; if (um) { jn = __builtin_ctzll(um); um &= um - 1; }
                int it = 0;
#define SEL_K(j_) (Z + (tokb + 64 * (j_)) * NZP + ZC_KS)
#define SEL_V(j_) (VST + (size_t)(b * 64 + (j_)) * 64 * 64)
                NS_ISSUE_R(kr, vr, SEL_K(jc), NZP * 2, SEL_V(jc), 128); NS_WRITE_R(kr, vr, 0);
                { const int je = jn >= 0 ? jn : jc; NS_ISSUE_R(kr, vr, SEL_K(je), NZP * 2, SEL_V(je), 128); }
                __syncthreads();
#define SEL_BODY(KX, VX, KY, VY) do { \
                    int jnn = -1; if (um) { jnn = __builtin_ctzll(um); um &= um - 1; } \
                    { const int je = jnn >= 0 ? jnn : jc; NS_ISSUE_R(KY, VY, SEL_K(je), NZP * 2, SEL_V(je), 128); } \
                    { const bool sel = (mymask >> jc) & 1ull; \
                      if (__any(sel)) { f32x16 S0, S1; const LAS unsigned char* st_ = lds + (it & 1) * NS_STAGE; \
                          if (jc >= cur - 2) { init_tab(S0, S1, TXh, t - 64 * jc, hb, 1, 511, sel); qk64(S0, S1, q, st_, qi, hb); } else qk64z(S0, S1, q, st_, qi, hb); \
                          const float ps_ = exp_sum64(S0, S1); l += sel ? ps_ : 0.f; \
                          pv64m(S0, S1, sel, st_ + NS_VT, O0, O1, qi, hb); } } \
                    if (jn >= 0) NS_WRITE_R(KX, VX, ((it + 1) & 1) * NS_STAGE); \
                    __syncthreads(); jc = jn; jn = jnn; ++it; } while (0)
                for (;;) { SEL_BODY(kr, vr, krB, vrB); if (jc < 0) break; SEL_BODY(krB, vrB, kr, vr); if (jc < 0) break; }
#undef SEL_BODY
#undef SEL_K
#undef SEL_V
                l += __shfl_xor(l, 32);
                const float g1 = sigmoidf_((float)gz[1 * 4 + h] + gb[1 * 4 + h]) * __builtin_amdgcn_rcpf(l);
                if (rpS == REP_NSEL - 1) {
#pragma unroll
                for (int r = 0; r < 16; ++r) { T0[r] += g1 * O0[r]; T1[r] += g1 * O1[r]; } }
            }
            __syncthreads();
            for (int rpW = 0; rpW < REP_NWIN; ++rpW) {
                if (rpW) __syncthreads();
                f32x16 O0, O1;
#pragma unroll
                for (int r = 0; r < 16; ++r) { O0[r] = 0.f; O1[r] = 0.f; }
                float l = 0.f;
                const int jlo = cur >= 8 ? cur - 8 : 0;
#define WIN_K(j_) (Z + (tokb + 64 * (j_)) * NZP + ZC_KW)
#define WIN_V(j_) (VWT + (size_t)(b * 64 + (j_)) * 64 * 64)
                NS_ISSUE_R(kr, vr, WIN_K(jlo), NZP * 2, WIN_V(jlo), 128); NS_WRITE_R(kr, vr, 0);
                { const int je = jlo + 1 <= cur ? jlo + 1 : cur; NS_ISSUE_R(kr, vr, WIN_K(je), NZP * 2, WIN_V(je), 128); }
                __syncthreads();
                int j = jlo;
#define WIN_BODY(KX, VX, KY, VY) do { \
                    { const int je = j + 2 <= cur ? j + 2 : cur; NS_ISSUE_R(KY, VY, WIN_K(je), NZP * 2, WIN_V(je), 128); } \
                    { f32x16 S0, S1; const LAS unsigned char* st_ = lds + ((j - jlo) & 1) * NS_STAGE; \
                      if (j >= cur - 2 || j == cur - 8) { init_tab(S0, S1, TXh, t - 64 * j, hb, 1, 512, true); qk64(S0, S1, q, st_, qi, hb); } else qk64z(S0, S1, q, st_, qi, hb); \
                      l += exp_sum64(S0, S1); \
                      pv64m(S0, S1, true, st_ + NS_VT, O0, O1, qi, hb); } \
                    if (j + 1 <= cur) NS_WRITE_R(KX, VX, (((j - jlo) + 1) & 1) * NS_STAGE); \
                    __syncthreads(); ++j; } while (0)
                for (;;) { WIN_BODY(kr, vr, krB, vrB); if (j > cur) break; WIN_BODY(krB, vrB, kr, vr); if (j > cur) break; }
#undef WIN_BODY
#undef WIN_K
#undef WIN_V
                l += __shfl_xor(l, 32);
                const float g2 = sigmoidf_((float)gz[2 * 4 + h] + gb[2 * 4 + h]) * __builtin_amdgcn_rcpf(l);
                if (rpW == REP_NWIN - 1) {
#pragma unroll
                for (int r = 0; r < 16; ++r) { T0[r] += g2 * O0[r]; T1[r] += g2 * O1[r]; } }
            }
#undef NS_ISSUE_R
#undef NS_WRITE_R
            {
                float ss = 0.f;
#pragma unroll
                for (int r = 0; r < 16; ++r) ss += T0[r] * T0[r] + T1[r] * T1[r];
                ss += __shfl_xor(ss, 32);
                if (hb == 0) ex[row * 4 + h] = ss;
                __syncthreads();
                const float rs = rsqrtf((ex[row * 4] + ex[row * 4 + 1] + ex[row * 4 + 2] + ex[row * 4 + 3]) * (1.f / 256.f) + EPS);
                const float* gn = P.out_norm + (L * 4 + 3) * 256 + h * 64;
                half_t* op = MIXED + (tokb + t) * D + 768 + h * 64;
#pragma unroll
                for (int g = 0; g < 4; ++g) {
                    const int d0 = 8 * g + 4 * hb; const f32x4 g0 = *(const f32x4*)(gn + d0), g1 = *(const f32x4*)(gn + 32 + d0);
                    u32x2 o0, o1;
                    o0.x = pack_h2(T0[4 * g] * rs * g0.x, T0[4 * g + 1] * rs * g0.y); o0.y = pack_h2(T0[4 * g + 2] * rs * g0.z, T0[4 * g + 3] * rs * g0.w);
                    o1.x = pack_h2(T1[4 * g] * rs * g1.x, T1[4 * g + 1] * rs * g1.y); o1.y = pack_h2(T1[4 * g + 2] * rs * g1.z, T1[4 * g + 3] * rs * g1.w);
                    *(u32x2*)(op + d0) = o0; *(u32x2*)(op + 32 + d0) = o1;
                }
            }
            __syncthreads();
        }
        else
        for (;;) {
            const int ui = q_next(ctl + CW_Q + ((L * 4 + 0) * 8 + (bid & 7)) * 64, MISC + 20); if (ui >= 64) break;
            int tid = threadIdx.x; asm volatile("" : "+v"(tid)); const int lane = tid & 63, hb = lane >> 5, qi = lane & 31;
            const int h = wave & 3, rh = wave >> 2;
            const int b = bid & 7, qt = 63 - ui, t0 = qt * 64, t = t0 + 32 * rh + qi, cur = qt, row = 32 * rh + qi;
            const size_t tokb = (size_t)b * SEQ;
            constexpr int NS_VT = 9216, NS_STAGE = 18432, NS_TR = 36864, NS_IMP = 38976, NS_SELM = NS_IMP + 4 * 64 * 65 * 4, NS_EX = NS_SELM + 512, NS_MISC = NS_EX + 1024;
            static_assert(NS_MISC + 256 <= RING_BYTES, "NSA LDS map");
            LAS float* TR = (LAS float*)(lds + NS_TR); LAS float* impH = (LAS float*)(lds + NS_IMP); LAS unsigned* selm = (LAS unsigned*)(lds + NS_SELM);
            LAS float* ex = (LAS float*)(lds + NS_EX); LAS unsigned* misc = (LAS unsigned*)(lds + NS_MISC);
            for (int e = tid; e < 4 * 129; e += NTHR) { const int hh = e / 129, d = e % 129; TR[hh * 132 + d] = P.rel_bias[(d < 128 ? (int)c_bucket[d] : 31) * 4 + hh] * LOG2E; }
            for (int e = tid; e < 4 * 64 * 65; e += NTHR) impH[e] = 0.f;
            const LAS float* TRh = TR + h * 132;
            h8 q[4];
#pragma unroll
            for (int kk = 0; kk < 4; ++kk) q[kk] = *(const h8*)(Z + (tokb + t) * NZP + ZC_NSA_Q + 64 * h + 16 * kk + 8 * hb);
            const float* gb = P.nsa_gate_bias + L * 12;
            const half_t* gz = Z + (tokb + t) * NZP + ZC_NSA_G;
            f32x16 T0, T1;
            u32x4 kr, vr, krB, vrB;
#define NS_ISSUE_R(KR, VR, kbase_, kstride_, vbase_, vstride_) do { KR = *(const u32x4*)((const char*)(kbase_) + (size_t)(tid >> 3) * (kstride_) + (tid & 7) * 16); \
                VR = *(const u32x4*)((const char*)(vbase_) + (size_t)(tid >> 3) * (vstride_) + (tid & 7) * 16); } while (0)
#define NS_WRITE_R(KR, VR, sb_) do { *(LAS u32x4*)(lds + (sb_) + (tid >> 3) * 144 + (tid & 7) * 16) = KR; *(LAS u32x4*)(lds + (sb_) + NS_VT + (tid >> 3) * 144 + (tid & 7) * 16) = VR; } while (0)
#define NS_ISSUE(kbase_, kstride_, vbase_, vstride_) do { kr = *(const u32x4*)((const char*)(kbase_) + (size_t)(tid >> 3) * (kstride_) + (tid & 7) * 16); \
                vr = *(const u32x4*)((const char*)(vbase_) + (size_t)(tid >> 3) * (vstride_) + (tid & 7) * 16); } while (0)
#define NS_WRITE(sb_) do { *(LAS u32x4*)(lds + (sb_) + (tid >> 3) * 144 + (tid & 7) * 16) = kr; *(LAS u32x4*)(lds + (sb_) + NS_VT + (tid >> 3) * 144 + (tid & 7) * 16) = vr; } while (0)
            {
                int cnt = (t0 + 63 - 31) / 16 + 1; if (cnt > NCMP) cnt = NCMP;
                const int ntc = (cnt + 63) >> 6;
                const half_t* kcb = KCH + (size_t)b * 256 * 64; const half_t* vcb = VCT + (size_t)b * 64 * 256;
                float m = -1e30f, l = 0.f;
                for (int c = 0; c < ntc; ++c) {
                    __syncthreads();
                    NS_ISSUE(kcb + (size_t)c * 64 * 64, 128, vcb + c * 64, 512); NS_WRITE(0);
                    __syncthreads();
                    f32x16 S0, S1; init_near(S0, S1, TRh, t - 31 - 1024 * c, hb, 16, 1 << 30);
                    qk64(S0, S1, q, lds, qi, hb);
                    const float mn = fmaxf(m, rowmax64(S0, S1)), alpha = __builtin_amdgcn_exp2f(m - mn);
                    m = mn; float ps = 0.f;
#pragma unroll
                    for (int r = 0; r < 16; ++r) ps += __builtin_amdgcn_exp2f(S0[r] - mn) + __builtin_amdgcn_exp2f(S1[r] - mn);
                    l = l * alpha + ps;
                }
                l += __shfl_xor(l, 32);
                const float il = l > 0.f ? __builtin_amdgcn_rcpf(l) : 0.f;
#pragma unroll
                for (int r = 0; r < 16; ++r) { T0[r] = 0.f; T1[r] = 0.f; }
                for (int c = 0; c < ntc; ++c) {
                    __syncthreads();
                    NS_ISSUE(kcb + (size_t)c * 64 * 64, 128, vcb + c * 64, 512); NS_WRITE(0);
                    __syncthreads();
                    f32x16 S0, S1; init_near(S0, S1, TRh, t - 31 - 1024 * c, hb, 16, 1 << 30);
                    qk64(S0, S1, q, lds, qi, hb);
#pragma unroll
                    for (int r = 0; r < 16; ++r) { S0[r] = __builtin_amdgcn_exp2f(S0[r] - m) * il; S1[r] = __builtin_amdgcn_exp2f(S1[r] - m) * il; }
                    LAS float* ip = impH + (h * 64 + row) * 65 + 16 * c + 2 * hb;
#pragma unroll
                    for (int g = 0; g < 4; ++g) {
                        const int mo = 4 * (g >> 1) + (g & 1);
                        { const float v1 = 16.f * S0[4 * g + 3], v0 = 32.f * ((S0[4 * g] + S0[4 * g + 1]) + S0[4 * g + 2]) + v1;
                          __hip_atomic_fetch_add(ip + mo, v0, __ATOMIC_RELAXED, __HIP_MEMORY_SCOPE_WORKGROUP); if (16 * c + 2 * hb + mo + 1 < 64) __hip_atomic_fetch_add(ip + mo + 1, v1, __ATOMIC_RELAXED, __HIP_MEMORY_SCOPE_WORKGROUP); }
                        { const float v1 = 16.f * S1[4 * g + 3], v0 = 32.f * ((S1[4 * g] + S1[4 * g + 1]) + S1[4 * g + 2]) + v1;
                          __hip_atomic_fetch_add(ip + 8 + mo, v0, __ATOMIC_RELAXED, __HIP_MEMORY_SCOPE_WORKGROUP); if (16 * c + 2 * hb + 8 + mo + 1 < 64) __hip_atomic_fetch_add(ip + 8 + mo + 1, v1, __ATOMIC_RELAXED, __HIP_MEMORY_SCOPE_WORKGROUP); }
                    }
                    pv64(S0, S1, lds + NS_VT, T0, T1, qi, hb);
                }
                const float g0 = sigmoidf_((float)gz[0 * 4 + h] + gb[0 * 4 + h]);
#pragma unroll
                for (int r = 0; r < 16; ++r) { T0[r] *= g0; T1[r] *= g0; }
            }
            __syncthreads();
            for (int rr = 0; rr < 8; ++rr) {
                const int rw = wave * 8 + rr;
                float v = ((impH[(0 * 64 + rw) * 65 + lane] + impH[(1 * 64 + rw) * 65 + lane]) + impH[(2 * 64 + rw) * 65 + lane]) + impH[(3 * 64 + rw) * 65 + lane];
                if (lane > cur) v = -INFINITY; else if (lane == 0 || lane == cur || lane == cur - 1) v = 1e30f;
                int rank = 0;
#pragma unroll
                for (int o = 0; o < 64; ++o) { const float w = __builtin_bit_cast(float, __builtin_amdgcn_readlane(__builtin_bit_cast(int, v), o)); rank += (w > v || (w == v && o < lane)) ? 1 : 0; }
                const unsigned long long msk = __ballot(rank < 16);
                if (lane == 0) { selm[rw * 2] = (unsigned)msk; selm[rw * 2 + 1] = (unsigned)(msk >> 32); }
            }
            __syncthreads();
            if (wave == 0) {
                unsigned lo = selm[lane * 2], hi = selm[lane * 2 + 1];
#pragma unroll
                for (int o = 1; o < 64; o <<= 1) { lo |= __shfl_xor(lo, o); hi |= __shfl_xor(hi, o); }
                if (lane == 0) { misc[0] = lo; misc[1] = hi; }
            }
            __syncthreads();
            const unsigned long long mymask = (unsigned long long)selm[row * 2] | ((unsigned long long)selm[row * 2 + 1] << 32);
            unsigned long long um = (unsigned long long)__builtin_amdgcn_readfirstlane((int)misc[0]) | ((unsigned long long)(unsigned)__builtin_amdgcn_readfirstlane((int)misc[1]) << 32);
            um &= (cur >= 63) ? ~0ull : ((1ull << (cur + 1)) - 1ull);
            const float cfar = TRh[128];
            {
                f32x16 O0, O1;
#pragma unroll
                for (int r = 0; r < 16; ++r) { O0[r] = 0.f; O1[r] = 0.f; }
                float m = -1e30f, l = 0.f;
                int jc = __builtin_ctzll(um); um &= um - 1;
                int jn = -1; if (um) { jn = __builtin_ctzll(um); um &= um - 1; }
                int it = 0;
#define SEL_K(j_) (Z + (tokb + 64 * (j_)) * NZP + ZC_KS)
#define SEL_V(j_) (VST + (size_t)(b * 64 + (j_)) * 64 * 64)
                NS_ISSUE_R(kr, vr, SEL_K(jc), NZP * 2, SEL_V(jc), 128); NS_WRITE_R(kr, vr, 0);
                { const int je = jn >= 0 ? jn : jc; NS_ISSUE_R(kr, vr, SEL_K(je), NZP * 2, SEL_V(je), 128); }
                __syncthreads();
#define SEL_BODY(KX, VX, KY, VY) do { \
                    int jnn = -1; if (um) { jnn = __builtin_ctzll(um); um &= um - 1; } \
                    { const int je = jnn >= 0 ? jnn : jc; NS_ISSUE_R(KY, VY, SEL_K(je), NZP * 2, SEL_V(je), 128); } \
                    { const bool sel = (mymask >> jc) & 1ull; \
                      if (__any(sel)) nsa_tile(jc >= cur - 2, t - 64 * jc, sel ? (1 << 30) : 0, sel ? cfar : -INFINITY, TRh, q, lds + (it & 1) * NS_STAGE, m, l, O0, O1, qi, hb); } \
                    if (jn >= 0) NS_WRITE_R(KX, VX, ((it + 1) & 1) * NS_STAGE); \
                    __syncthreads(); jc = jn; jn = jnn; ++it; } while (0)
                for (;;) { SEL_BODY(kr, vr, krB, vrB); if (jc < 0) break; SEL_BODY(krB, vrB, kr, vr); if (jc < 0) break; }
#undef SEL_BODY
#undef SEL_K
#undef SEL_V
                l += __shfl_xor(l, 32);
                const float g1 = sigmoidf_((float)gz[1 * 4 + h] + gb[1 * 4 + h]) * __builtin_amdgcn_rcpf(l);
#pragma unroll
                for (int r = 0; r < 16; ++r) { T0[r] += g1 * O0[r]; T1[r] += g1 * O1[r]; }
            }
            __syncthreads();
            {
                f32x16 O0, O1;
#pragma unroll
                for (int r = 0; r < 16; ++r) { O0[r] = 0.f; O1[r] = 0.f; }
                float m = -1e30f, l = 0.f;
                const int jlo = cur >= 8 ? cur - 8 : 0;
#define WIN_K(j_) (Z + (tokb + 64 * (j_)) * NZP + ZC_KW)
#define WIN_V(j_) (VWT + (size_t)(b * 64 + (j_)) * 64 * 64)
                NS_ISSUE_R(kr, vr, WIN_K(jlo), NZP * 2, WIN_V(jlo), 128); NS_WRITE_R(kr, vr, 0);
                { const int je = jlo + 1 <= cur ? jlo + 1 : cur; NS_ISSUE_R(kr, vr, WIN_K(je), NZP * 2, WIN_V(je), 128); }
                __syncthreads();
                int j = jlo;
#define WIN_BODY(KX, VX, KY, VY) do { \
                    { const int je = j + 2 <= cur ? j + 2 : cur; NS_ISSUE_R(KY, VY, WIN_K(je), NZP * 2, WIN_V(je), 128); } \
                    nsa_tile(j >= cur - 2 || j == cur - 8, t - 64 * j, 512, cfar, TRh, q, lds + ((j - jlo) & 1) * NS_STAGE, m, l, O0, O1, qi, hb); \
                    if (j + 1 <= cur) NS_WRITE_R(KX, VX, (((j - jlo) + 1) & 1) * NS_STAGE); \
                    __syncthreads(); ++j; } while (0)
                for (;;) { WIN_BODY(kr, vr, krB, vrB); if (j > cur) break; WIN_BODY(krB, vrB, kr, vr); if (j > cur) break; }
#undef WIN_BODY
#undef WIN_K
#undef WIN_V
                l += __shfl_xor(l, 32);
                const float g2 = sigmoidf_((float)gz[2 * 4 + h] + gb[2 * 4 + h]) * __builtin_amdgcn_rcpf(l);
#pragma unroll
                for (int r = 0; r < 16; ++r) { T0[r] += g2 * O0[r]; T1[r] += g2 * O1[r]; }
            }
#undef NS_ISSUE
#undef NS_WRITE
#undef NS_ISSUE_R
#undef NS_WRITE_R
            {
                float ss = 0.f;
#pragma unroll
                for (int r = 0; r < 16; ++r) ss += T0[r] * T0[r] + T1[r] * T1[r];
                ss += __shfl_xor(ss, 32);
                if (hb == 0) ex[row * 4 + h] = ss;
                __syncthreads();
                const float rs = rsqrtf((ex[row * 4] + ex[row * 4 + 1] + ex[row * 4 + 2] + ex[row * 4 + 3]) * (1.f / 256.f) + EPS);
                const float* gn = P.out_norm + (L * 4 + 3) * 256 + h * 64;
                half_t* op = MIXED + (tokb + t) * D + 768 + h * 64;
#pragma unroll
                for (int g = 0; g < 4; ++g) {
                    const int d0 = 8 * g + 4 * hb; const f32x4 g0 = *(const f32x4*)(gn + d0), g1 = *(const f32x4*)(gn + 32 + d0);
                    u32x2 o0, o1;
                    o0.x = pack_h2(T0[4 * g] * rs * g0.x, T0[4 * g + 1] * rs * g0.y); o0.y = pack_h2(T0[4 * g + 2] * rs * g0.z, T0[4 * g + 3] * rs * g0.w);
                    o1.x = pack_h2(T1[4 * g] * rs * g1.x, T1[4 * g + 1] * rs * g1.y); o1.y = pack_h2(T1[4 * g + 2] * rs * g1.z, T1[4 * g + 3] * rs * g1.w);
                    *(u32x2*)(op + d0) = o0; *(u32x2*)(op + 32 + d0) = o1;
                }
            }
            __syncthreads();
        }
#endif
#ifndef SKIP_FOX
        for (;;) {
            const int ui = q_next(ctl + CW_Q + ((L * 4 + 1) * 8 + (bid & 7)) * 64, MISC + 20); if (ui >= 64) break;
            int tid = threadIdx.x; asm volatile("" : "+v"(tid)); const int lane = tid & 63, hb = lane >> 5, qi = lane & 31;
            const int h = wave & 3, rh = wave >> 2;
            const int b = bid & 7, qt = 63 - ui, t0 = qt * 64, t = t0 + 32 * rh + qi;
            const size_t tokb = (size_t)b * SEQ;
            const float* cf = CFOX + (size_t)b * 4 * SEQ;
            constexpr int FX_VT = 18432, FX_CB = 38912, FX_STAGE = 39424, FX_EX = 2 * FX_STAGE, FX_MISC = FX_EX + 1024;
            LAS unsigned* misc = (LAS unsigned*)(lds + FX_MISC);
            if (wave == 0) {
                float gq = fabsf(P.fox_qk_norm[(L * 2 + 0) * 64 + lane]), gk = fabsf(P.fox_qk_norm[(L * 2 + 1) * 64 + lane]);
#pragma unroll
                for (int o = 1; o < 64; o <<= 1) { gq = fmaxf(gq, __shfl_xor(gq, o)); gk = fmaxf(gk, __shfl_xor(gk, o)); }
                const float bound = -(30.f + 16.f * gq * gk);
                const float sb2 = 8.f * gq * gk * LOG2E;
                if (lane == 0) { misc[1] = sb2 <= 15.8f ? 1u : 0u; misc[2] = __builtin_bit_cast(unsigned, 15.8f - sb2); }
                bool c0 = false, c1 = false;
#pragma unroll
                for (int hh = 0; hh < 4; ++hh) { const float cref = cf[hh * SEQ + t0];
                    const int e0 = 32 * lane + 31, e1 = 32 * (lane + 64) + 31;
                    c0 = c0 || (e0 >= t0) || (cref - cf[hh * SEQ + (e0 < SEQ ? e0 : SEQ - 1)] > bound);
                    c1 = c1 || (e1 >= t0) || (cref - cf[hh * SEQ + (e1 < SEQ ? e1 : SEQ - 1)] > bound); }
                const unsigned long long b0 = __ballot(c0), b1 = __ballot(c1);
                if (lane == 0) misc[0] = b0 ? (unsigned)__builtin_ctzll(b0) : 64u + (unsigned)__builtin_ctzll(b1);
            }
            __syncthreads();
            const int kt_lo = __builtin_amdgcn_readfirstlane((int)misc[0]), kt_hi = 2 * qt + 1;
            const bool fx_fast = __builtin_amdgcn_readfirstlane((int)misc[1]) != 0;
            const float fx_sh = __builtin_bit_cast(float, __builtin_amdgcn_readfirstlane((int)misc[2]));
            h8 q[4];
#pragma unroll
            for (int kk = 0; kk < 4; ++kk) q[kk] = *(const h8*)(Z + (tokb + t) * NZP + ZC_FOX_Q + 64 * h + 16 * kk + 8 * hb);
            f32x16 O0, O1;
#pragma unroll
            for (int r = 0; r < 16; ++r) { O0[r] = 0.f; O1[r] = 0.f; }
            float m = fx_fast ? -((cf[h * SEQ + t] - cf[h * SEQ + t0]) * LOG2E + fx_sh) : -1e30f, l = 0.f;
            u32x4 krA[2], vrA[2], krB[2], vrB[2]; float cbA = 0.f, cbB = 0.f;
            const float cref = cf[((tid >> 5) & 3) * SEQ + t0];
#define FX_ISSUE(KR, VR, CB, kt_) do { _Pragma("unroll") for (int i_ = 0; i_ < 2; ++i_) { const int p_ = tid + 512 * i_; \
                KR[i_] = *(const u32x4*)(Z + (tokb + 32 * (kt_) + (p_ >> 5)) * NZP + ZC_FOX_K + 8 * (p_ & 31)); \
                VR[i_] = *(const u32x4*)(FOXVT + ((size_t)(b * 128 + (kt_)) * 256 + (p_ >> 2)) * 32 + 8 * (p_ & 3)); } \
                CB = cf[((tid >> 5) & 3) * SEQ + 32 * (kt_) + (tid & 31)]; } while (0)
#define FX_WRITE(KR, VR, CB, sb_) do { _Pragma("unroll") for (int i_ = 0; i_ < 2; ++i_) { const int p_ = tid + 512 * i_; \
                *(LAS u32x4*)(lds + (sb_) + ((p_ & 31) >> 3) * 4608 + (p_ >> 5) * 144 + (p_ & 7) * 16) = KR[i_]; \
                *(LAS u32x4*)(lds + (sb_) + FX_VT + ((p_ >> 2) >> 6) * 5120 + ((p_ >> 2) & 63) * 80 + (p_ & 3) * 16) = VR[i_]; } \
                if (tid < 128) *(LAS float*)(lds + (sb_) + FX_CB + tid * 4) = (cref - CB) * LOG2E; } while (0)
            FX_ISSUE(krA, vrA, cbA, kt_lo); FX_WRITE(krA, vrA, cbA, (kt_lo & 1) * FX_STAGE);
            FX_ISSUE(krA, vrA, cbA, (kt_lo + 1 <= kt_hi ? kt_lo + 1 : kt_hi));
            __syncthreads();
            int kt = kt_lo;
#define FX_BODY(KX, VX, CX, KY, VY, CY) do { \
                FX_ISSUE(KY, VY, CY, (kt + 2 <= kt_hi ? kt + 2 : kt_hi)); \
                if (32 * kt <= t0 + 32 * rh + 31) { if (fx_fast) fox_tile<true>(lds + (kt & 1) * FX_STAGE, h, q, qi, hb, 32 * kt + 31 > t0 + 32 * rh, 32 * kt, t, m, l, O0, O1); \
                    else fox_tile<false>(lds + (kt & 1) * FX_STAGE, h, q, qi, hb, 32 * kt + 31 > t0 + 32 * rh, 32 * kt, t, m, l, O0, O1); } \
                if (kt + 1 <= kt_hi) FX_WRITE(KX, VX, CX, ((kt + 1) & 1) * FX_STAGE); \
                __syncthreads(); ++kt; } while (0)
            for (;;) { FX_BODY(krA, vrA, cbA, krB, vrB, cbB); if (kt > kt_hi) break; FX_BODY(krB, vrB, cbB, krA, vrA, cbA); if (kt > kt_hi) break; }
#undef FX_BODY
#undef FX_ISSUE
#undef FX_WRITE
            {
                l += __shfl_xor(l, 32);
                const float inv = __builtin_amdgcn_rcpf(l); float ss = 0.f;
#pragma unroll
                for (int r = 0; r < 16; ++r) { O0[r] *= inv; O1[r] *= inv; ss += O0[r] * O0[r] + O1[r] * O1[r]; }
                ss += __shfl_xor(ss, 32);
                LAS float* ex = (LAS float*)(lds + FX_EX);
                const int ridx = 32 * rh + qi;
                if (hb == 0) ex[ridx * 4 + h] = ss;
                __syncthreads();
                const float rs = rsqrtf((ex[ridx * 4] + ex[ridx * 4 + 1] + ex[ridx * 4 + 2] + ex[ridx * 4 + 3]) * (1.f / 256.f) + EPS);
                const float* gn = P.out_norm + (L * 4 + 2) * 256 + h * 64;
                half_t* op = MIXED + (tokb + t) * D + 512 + h * 64;
#pragma unroll
                for (int g = 0; g < 4; ++g) {
                    const int d0 = 8 * g + 4 * hb; const f32x4 g0 = *(const f32x4*)(gn + d0), g1 = *(const f32x4*)(gn + 32 + d0);
                    u32x2 o0, o1;
                    o0.x = pack_h2(O0[4 * g] * rs * g0.x, O0[4 * g + 1] * rs * g0.y); o0.y = pack_h2(O0[4 * g + 2] * rs * g0.z, O0[4 * g + 3] * rs * g0.w);
                    o1.x = pack_h2(O1[4 * g] * rs * g1.x, O1[4 * g + 1] * rs * g1.y); o1.y = pack_h2(O1[4 * g + 2] * rs * g1.z, O1[4 * g + 3] * rs * g1.w);
                    *(u32x2*)(op + d0) = o0; *(u32x2*)(op + 32 + d0) = o1;
                }
            }
            __syncthreads();
        }
#endif
#ifndef SKIP_LRU
        for (;;) {
            const int gI = q_next(ctl + CW_Q + ((L * 4 + 2) * 8 + (bid & 7)) * 64, MISC + 20); if (gI >= 64) break;
            float hc = 0.f;
            for (int k = 0; k < 2; ++k) lru_final(P, L, ((bid & 7) << 7) + 2 * gI + k, lds, Z, LRUAGG, LRUA, LRUB, MIXED, wave, hc, k == 0);
        }
#endif
        }
        xcd_barrier(bar);

#ifndef SKIP_G4
        {
            SECTION_ENV();
            pg8::Gemm g{MIXED, WOUT_T + (size_t)L * D * D, T, D, D}; pg8::StaticOrder S; S.init(T, D, G, bid);
            EpiRes E{L == 0 ? P.x : P.out, P.out, XH, SSQA};
            for (int rp = 0; rp < REP_G4N; ++rp) { EpiNull EN; pg8::gemm_phase<EpiNull, pg8::StaticOrder>(lds, g, S, EN); }
            pg8::gemm_phase<EpiRes, pg8::StaticOrder>(lds, g, S, E);
        }
#endif
        xcd_barrier(bar);
#ifndef SKIP_G5
        {
            SECTION_ENV();
            pg8::Gemm g{XH, WGU_T + (size_t)L * 2 * DFF * D, T, 2 * DFF, D}; pg8::StaticOrder S; S.init(T, 2 * DFF, G, bid);
            EpiSwiglu E{HB, SSQA};
            for (int rp = 0; rp < REP_G5; ++rp) pg8::gemm_phase<EpiSwiglu, pg8::StaticOrder>(lds, g, S, E);
        }
#endif
        xcd_barrier(bar);
#ifndef SKIP_G6
        {
            SECTION_ENV();
            pg8::Gemm g{HB, WDN_T + (size_t)L * D * DFF, T, D, DFF}; pg8::StaticOrder S; S.init(T, D, G, bid);
            EpiRes E{P.out, P.out, L == 0 ? XH : nullptr, L == 0 ? SSQB : nullptr};
            for (int rp = 0; rp < REP_G6N; ++rp) { EpiNull EN; pg8::gemm_phase<EpiNull, pg8::StaticOrder>(lds, g, S, EN); }
            pg8::gemm_phase<EpiRes, pg8::StaticOrder>(lds, g, S, E);
        }
#endif
        if (L == 0) xcd_barrier(bar);
    }
}

extern "C" void kernel_launch(void* const* d_in, const int* in_sizes, int n_in, void* d_out, int out_size, void* d_ws, size_t ws_size, hipStream_t stream) {
    static int grid = 0;
    if (grid == 0) {
        if (n_in != 22 || ws_size < WS_END) { fprintf(stderr, "kernel_launch: unexpected n_in %d or ws_size %zu (< %zu)\n", n_in, ws_size, (size_t)WS_END); grid = -1; return; }
        int dev = 0, cus = 0, per_cu = 0;
        if (hipGetDevice(&dev) != hipSuccess || hipDeviceGetAttribute(&cus, hipDeviceAttributeMultiprocessorCount, dev) != hipSuccess) { grid = -1; return; }
        if (hipFuncSetAttribute((const void*)hymba_fwd, hipFuncAttributeMaxDynamicSharedMemorySize, LDS_BYTES) != hipSuccess) { fprintf(stderr, "kernel_launch: hipFuncSetAttribute failed\n"); grid = -1; return; }
        if (hipOccupancyMaxActiveBlocksPerMultiprocessor(&per_cu, (const void*)hymba_fwd, NTHR, LDS_BYTES) != hipSuccess || per_cu < 1) { fprintf(stderr, "kernel_launch: occupancy query says %d\n", per_cu); }
        (void)hipGetLastError();
        grid = cus;
    }
    if (grid < 0) return;
    (void)hipMemsetAsync((char*)d_ws + WS_CTL, 0, CTL_ZERO_BYTES, stream);
    Params p{};
    p.x = (const float*)d_in[0]; p.norm_mix = (const float*)d_in[1]; p.w_in = (const float*)d_in[2]; p.lru_conv_w = (const float*)d_in[3]; p.lru_conv_b = (const float*)d_in[4];
    p.lru_w_gates = (const float*)d_in[5]; p.lru_b_gates = (const float*)d_in[6]; p.lru_lambda = (const float*)d_in[7]; p.sc_conv_w = (const float*)d_in[8];
    p.fox_f_bias = (const float*)d_in[9]; p.fox_qk_norm = (const float*)d_in[10]; p.nsa_qk_norm = (const float*)d_in[11]; p.nsa_cmp_pos = (const float*)d_in[12];
    p.nsa_cmp_w1 = (const float*)d_in[13]; p.nsa_cmp_w2 = (const float*)d_in[14]; p.nsa_gate_bias = (const float*)d_in[15]; p.rel_bias = (const float*)d_in[16];
    p.out_norm = (const float*)d_in[17]; p.w_out = (const float*)d_in[18]; p.norm_ffn = (const float*)d_in[19]; p.w_gate_up = (const float*)d_in[20]; p.w_down = (const float*)d_in[21];
    p.out = (float*)d_out; p.ws = (unsigned char*)d_ws;
    hipLaunchKernelGGL(hymba_fwd, dim3(grid), dim3(NTHR), LDS_BYTES, stream, p);
}
```

```cpp
#include <hip/hip_runtime.h>
#include <stdint.h>
#include <stdio.h>

#define LAS __attribute__((address_space(3)))
typedef _Float16 half_t;
typedef _Float16 h8 __attribute__((ext_vector_type(8)));
typedef _Float16 h4 __attribute__((ext_vector_type(4)));
typedef _Float16 h2 __attribute__((ext_vector_type(2)));
typedef float f32x4 __attribute__((ext_vector_type(4)));
typedef unsigned u32x4 __attribute__((ext_vector_type(4)));
typedef unsigned u32x2 __attribute__((ext_vector_type(2)));
typedef float f32x16 __attribute__((ext_vector_type(16)));
#define MFMA32(a, b, c) __builtin_amdgcn_mfma_f32_32x32x16_f16(a, b, c, 0, 0, 0)
constexpr float LOG2E = 1.4426950408889634f, QSCALE = 0.125f * 1.4426950408889634f;
__device__ __forceinline__ int pi16(int r) { return (r & ~0xC) | ((r & 4) << 1) | ((r & 8) >> 1); }

constexpr int BATCH = 8, SEQ = 4096, T = BATCH * SEQ, D = 1024, NZP = 2816, DFF = 2816, NCMP = 255;
constexpr int NIN_SRC = 2704;
constexpr int ZC_LRU_X = 0, ZC_LRU_G = 256, ZC_SC_B = 512, ZC_SC_C = 768, ZC_SC_X = 1024, ZC_FOX_Q = 1280, ZC_FOX_K = 1536, ZC_FOX_V = 1792,
              ZC_NSA_Q = 2048, ZC_KC = 2304, ZC_VC = 2368, ZC_KS = 2432, ZC_VS = 2496, ZC_KW = 2560, ZC_VW = 2624, ZC_FOX_F = 2688, ZC_NSA_G = 2692;
constexpr float EPS = 1e-6f;
constexpr int NWAVES = 8, NTHR = 512;
#ifndef REP_G1
#define REP_G1 1
#endif
#ifndef REP_P0
#define REP_P0 1
#endif
#ifndef REP_G4N
#define REP_G4N 0
#endif
#ifndef REP_G6N
#define REP_G6N 0
#endif
#ifndef NORM_DRY
#define NORM_DRY 0
#endif
#ifndef REP_NSEL
#define REP_NSEL 1
#endif
#ifndef REP_NWIN
#define REP_NWIN 1
#endif
#ifndef REP_NSELECT
#define REP_NSELECT 1
#endif
#ifndef REP_G5
#define REP_G5 1
#endif
#ifndef REP_CUM
#define REP_CUM 1
#endif
#ifndef REP_VT
#define REP_VT 1
#endif
#ifndef REP_P2LRU
#define REP_P2LRU 1
#endif
#ifndef REP_P2CMP
#define REP_P2CMP 1
#endif
#ifndef REP_FOX
#define REP_FOX 1
#endif
#ifndef REP_NSA
#define REP_NSA 1
#endif
#ifndef REP_LRU
#define REP_LRU 1
#endif

constexpr size_t MiB = 1u << 20;
constexpr size_t WS_CTL = 0, CTL_ZERO_BYTES = 64 * 1024;
constexpr size_t WS_SSQA = 2 * MiB, WS_SSQB = 4 * MiB, WS_CFOX = 6 * MiB, WS_KVC = 7 * MiB, WS_LRUAGG = 9 * MiB, WS_CB = 11 * MiB;
constexpr size_t WS_WIN = 12 * MiB, WS_WOUT = 24 * MiB, WS_WGU = 28 * MiB, WS_WDN = 50 * MiB;
constexpr size_t WS_XH = 62 * MiB, WS_MIXED = 126 * MiB, WS_Z = 190 * MiB, WS_YD = 366 * MiB, WS_FOXVT = 398 * MiB, WS_VST = 414 * MiB, WS_VWT = 418 * MiB, WS_KCH = 422 * MiB, WS_VCT = 423 * MiB, WS_W1T = 424 * MiB, WS_WGT = 426 * MiB, WS_LRUA = 427 * MiB, WS_LRUB = 459 * MiB, WS_END = 491 * MiB;
static_assert(WS_WIN + 2 * (size_t)NZP * D * 2 <= WS_WOUT && WS_WOUT + 2 * (size_t)D * D * 2 <= WS_WGU && WS_WGU + 2 * (size_t)2 * DFF * D * 2 <= WS_WDN &&
              WS_WDN + 2 * (size_t)D * DFF * 2 <= WS_XH && WS_XH + (size_t)T * D * 2 <= WS_MIXED && WS_MIXED + (size_t)T * D * 2 <= WS_Z &&
              WS_Z + (size_t)T * NZP * 2 <= WS_YD && WS_YD + (size_t)T * 256 * 4 <= WS_FOXVT && WS_FOXVT + (size_t)T * 256 * 2 <= WS_VST, "ws map");
constexpr int CW_BAR = 1024;

constexpr int RING_BYTES = 131072, MISC_OFF = RING_BYTES, LDS_BYTES = 147456;

__device__ __constant__ unsigned char c_bucket[128] = {
 0,1,2,3,4,5,6,7,8,9,10,11,12,13,14,15,
 16,16,16,17,17,18,18,18,19,19,19,20,20,20,20,21,
 21,21,21,22,22,22,22,22,23,23,23,23,23,23,24,24,
 24,24,24,24,25,25,25,25,25,25,25,26,26,26,26,26,
 26,26,26,27,27,27,27,27,27,27,27,27,27,28,28,28,
 28,28,28,28,28,28,28,29,29,29,29,29,29,29,29,29,
 29,29,29,30,30,30,30,30,30,30,30,30,30,30,30,30,
 30,31,31,31,31,31,31,31,31,31,31,31,31,31,31,31};
__device__ __forceinline__ int rel_bucket(int d) { return d >= 128 ? 31 : (int)c_bucket[d < 0 ? 0 : d]; }

__device__ __forceinline__ float sigmoidf_(float x) { return __builtin_amdgcn_rcpf(1.f + __builtin_amdgcn_exp2f(-1.4426950408889634f * x)); }
__device__ __forceinline__ float gelu_tanh(float x) { return x * __builtin_amdgcn_rcpf(1.f + __builtin_amdgcn_exp2f(-2.f * 1.4426950408889634f * 0.7978845608028654f * (x + 0.044715f * x * x * x))); }
__device__ __forceinline__ float log_sigmoid(float x) { const float e = __builtin_amdgcn_exp2f(-1.4426950408889634f * fabsf(x)); return fminf(x, 0.f) - 0.6931471805599453f * __builtin_amdgcn_logf(1.f + e); }
__device__ __forceinline__ u32x4 pack_h8(f32x4 a, f32x4 b) {
    h8 h; h[0] = (half_t)a.x; h[1] = (half_t)a.y; h[2] = (half_t)a.z; h[3] = (half_t)a.w; h[4] = (half_t)b.x; h[5] = (half_t)b.y; h[6] = (half_t)b.z; h[7] = (half_t)b.w;
    return __builtin_bit_cast(u32x4, h);
}
__device__ __forceinline__ unsigned pack_h2(float a, float b) { h2 h; h[0] = (half_t)a; h[1] = (half_t)b; return __builtin_bit_cast(unsigned, h); }
#define LDS_WAIT() asm volatile("s_waitcnt lgkmcnt(0)" ::: "memory")

#define XB_TMO      128
#define XB_XCNT(j)  (256  + 64 * (j))
#define XB_XSUB(j)  (1280 + 64 * (j))
#define XB_XGEN(j)  (2304 + 64 * (j))
#define XB_TOP      3328
#define XB_TOPGEN   3392
#define XCD_BAR_WORDS 3456
#define XB_SPIN_CAP (1u << 20)
__device__ __forceinline__ unsigned xb_ld(unsigned* p)              { return __hip_atomic_load(p, __ATOMIC_RELAXED, __HIP_MEMORY_SCOPE_AGENT); }
__device__ __forceinline__ unsigned xb_add(unsigned* p, unsigned v) { return __hip_atomic_fetch_add(p, v, __ATOMIC_RELAXED, __HIP_MEMORY_SCOPE_AGENT); }
__device__ __forceinline__ unsigned xb_xcc_id() { return (unsigned)__builtin_amdgcn_s_getreg((3 << 11) | 20) & 0xFu; }
#define XB_SPIN(cond, bar) do { unsigned _sp = 0; while (cond) { __builtin_amdgcn_s_sleep(1); \
    if ((++_sp & 255u) == 0u) { if (xb_ld(&(bar)[XB_TMO])) break; if (_sp > XB_SPIN_CAP) { atomicAdd(&(bar)[XB_TMO], 1u); break; } } } } while (0)
struct XcdBarrier { unsigned* bar; unsigned x; volatile LAS unsigned* st; };
__device__ __forceinline__ XcdBarrier xcd_barrier_post(unsigned* bar, volatile LAS unsigned* st) {
    XcdBarrier b; b.bar = bar; b.x = xb_xcc_id(); b.st = st;
    if (threadIdx.x == 0) (void)xb_add(&bar[XB_XCNT(b.x)], 1u);
    return b;
}
__device__ __forceinline__ void xcd_barrier_complete(unsigned* bar, unsigned x, unsigned& nloc, unsigned& nx) {
    const unsigned G = gridDim.x * gridDim.y * gridDim.z;
    unsigned sum, cnt, mine, sp = 0u;
    for (;;) {
        sum = 0u; cnt = 0u; mine = 0u;
#pragma unroll
        for (unsigned j = 0; j < 16; ++j) { const unsigned c = xb_ld(&bar[XB_XCNT(j)]); sum += c; cnt += (c > 0u) ? 1u : 0u; mine = (j == x) ? c : mine; }
        if (sum == G) break;
        __builtin_amdgcn_s_sleep(1);
        if ((++sp & 255u) == 0u) { if (xb_ld(&bar[XB_TMO])) break; if (sp > XB_SPIN_CAP) { atomicAdd(&bar[XB_TMO], 1u); break; } }
    }
    nloc = mine > 0u ? mine : 1u; nx = cnt > 0u ? cnt : 1u;
}
__device__ __forceinline__ void xcd_barrier(const XcdBarrier& b) {
    asm volatile("s_waitcnt vmcnt(0)" ::: "memory");
    __syncthreads();
    if (threadIdx.x == 0) {
        unsigned* bar = b.bar;
        unsigned bx = b.x; asm volatile("" : "+s"(bx));
        __builtin_amdgcn_s_waitcnt(0);
        unsigned nloc = b.st[0], nx = b.st[1];
        if (nloc == 0u) { xcd_barrier_complete(bar, bx, nloc, nx); b.st[0] = nloc; b.st[1] = nx; }
        const unsigned old = xb_add(&bar[XB_XSUB(bx)], 1u);
        const unsigned gen = old / nloc;
        if (old + 1u == (gen + 1u) * nloc) {
            __builtin_amdgcn_fence(__ATOMIC_RELEASE, "agent");
            asm volatile("s_waitcnt vmcnt(0)" ::: "memory");
            const unsigned og = xb_add(&bar[XB_TOP], 1u);
            const unsigned tg = og / nx;
            if (og + 1u == (tg + 1u) * nx) xb_add(&bar[XB_TOPGEN], 1u);
            else XB_SPIN(xb_ld(&bar[XB_TOPGEN]) == tg, bar);
            __builtin_amdgcn_fence(__ATOMIC_ACQUIRE, "agent");
            xb_add(&bar[XB_XGEN(bx)], 1u);
            asm volatile("s_waitcnt vmcnt(0)" ::: "memory");
        } else {
            XB_SPIN(xb_ld(&bar[XB_XGEN(bx)]) == gen, bar);
            __builtin_amdgcn_fence(__ATOMIC_ACQUIRE, "agent");
            asm volatile("s_waitcnt vmcnt(0)" ::: "memory");
        }
    }
    __syncthreads();
}

namespace pg8 {
constexpr int BM = 256, BK = 64, HALF = 128, HTB = HALF * BK * 2, STAGE_BYTES = 8 * HTB, NXCD = 8, WGM = 8;
__host__ __device__ __forceinline__ int lds_byte(int r, int c) { const int st = (r >> 4) * 2 + (c >> 5), rr = r & 15, cc = c & 31, ob = rr * 64 + cc * 2; return st * 1024 + (ob ^ (((ob >> 9) & 1) << 5)); }
__host__ __device__ __forceinline__ void stage_rc(int b, int& R, int& C) { const int st = b / 1024, sb = b % 1024, swz = sb ^ (((sb >> 9) & 1) << 5); R = (st >> 1) * 16 + swz / 64; C = (st & 1) * 32 + (swz % 64) / 2; }
__host__ __device__ __forceinline__ int perm32(int rho) { const int n = rho >> 4, i = rho & 15; return 8 * (i >> 2) + 4 * n + (i & 3); }
struct Unit { int pm, pn; };
struct Gemm { const half_t* A; const half_t* Bt; int M, N, K; };
struct StaticOrder {
    int nM, nN, nwg, G, c;
    __host__ __device__ void init(int M, int N, int G_, int c_) { nM = M / BM; nN = N / BM; nwg = nM * nN; G = G_; c = c_; }
    __host__ __device__ bool next(int i, Unit& u) const {
        const long L = (long)i * G + c; if (L >= nwg) return false;
        int wgid = (int)L; { const int q = nwg / NXCD, r = nwg % NXCD, xcd = wgid % NXCD, off = wgid / NXCD; wgid = (xcd < r ? xcd * (q + 1) : r * (q + 1) + (xcd - r) * q) + off; }
        const int nig = WGM * nN, gid = wgid / nig, fm = gid * WGM, gsz = (nM - fm) < WGM ? (nM - fm) : WGM;
        u.pm = fm + ((wgid % nig) % gsz); u.pn = (wgid % nig) / gsz; return true;
    }
    __device__ __forceinline__ void a_ready(const Unit&) const {}
    __device__ __forceinline__ void done(const Unit&) const {}
};

template <class Epi, class Sched>
__device__ __forceinline__ void gemm_phase(LAS unsigned char* lds, const Gemm g, const Sched& S, const Epi& E) {
    int tid = threadIdx.x; asm volatile("" : "+v"(tid));
    const int wid = __builtin_amdgcn_readfirstlane(tid >> 6), lane = tid & 63, wr = wid >> 2, wc = wid & 3, fr = lane & 15, fq = lane >> 4;
    const int K = g.K, nt = K / BK;
    unsigned voffA[2], voffB[2];
#pragma unroll
    for (int i = 0; i < 2; ++i) { int R, C; stage_rc(tid * 16 + i * 8192, R, C); const int Rb = Epi::brow(R);
        voffA[i] = (unsigned)(R * K + C) * 2u; voffB[i] = (unsigned)(Rb * K + C) * 2u; }
    const size_t kstep = (size_t)(BK * 2);
    const size_t hstep = (size_t)HALF * K * 2;
    const size_t hstepB = (size_t)Epi::BHALF_ROWS * K * 2;
    const size_t tstep = 2 * hstep;
    const unsigned ldsw = (unsigned)wid * 1024u;
    const int aoff = lds_byte(wr * 64 + fr, fq * 8), boff = lds_byte(wc * 32 + fr, fq * 8);
#define PG8_SA(b, h) (((b) * 2 + (h)) * HTB)
#define PG8_SB(b, h) ((4 + (b) * 2 + (h)) * HTB)
#define PG8_STAGE(bufoff, gbase, voff) do { _Pragma("unroll") for (int _i = 0; _i < 2; ++_i) \
        __builtin_amdgcn_global_load_lds((const unsigned*)((const char*)(gbase) + (voff)[_i]), (LAS unsigned*)(lds + (bufoff) + ldsw + _i * 8192), 16, 0, 0); } while (0)
#define PG8_LDA(dst, b, h) do { _Pragma("unroll") for (int m = 0; m < 4; ++m) _Pragma("unroll") for (int k = 0; k < 2; ++k) dst[m][k] = *(const LAS h8*)(lds + PG8_SA(b, h) + aoff + m * 2048 + k * 1024); } while (0)
#define PG8_LDB(dst, b, h) do { _Pragma("unroll") for (int n = 0; n < 2; ++n) _Pragma("unroll") for (int k = 0; k < 2; ++k) dst[n][k] = *(const LAS h8*)(lds + PG8_SB(b, h) + boff + n * 2048 + k * 1024); } while (0)
#define PG8_MMA(ai, bj, At, Bt) do { __builtin_amdgcn_s_setprio(1); _Pragma("unroll") for (int m = 0; m < 4; ++m) _Pragma("unroll") for (int n = 0; n < 2; ++n) _Pragma("unroll") for (int k = 0; k < 2; ++k) \
        acc[ai][bj][m][n] = __builtin_amdgcn_mfma_f32_16x16x32_f16(Bt[n][k], At[m][k], acc[ai][bj][m][n], 0, 0, 0); __builtin_amdgcn_s_setprio(0); } while (0)
#define PG8_WAIT_V(n) asm volatile("s_waitcnt vmcnt(" #n ")" ::: "memory")
#define PG8_WAIT_L(n) asm volatile("s_waitcnt lgkmcnt(" #n ")" ::: "memory")
#define PG8_BAR __builtin_amdgcn_s_barrier()
#define PG8_SCHED __builtin_amdgcn_sched_barrier(0)
    Unit cur, nxt; int ui = 0;
    if (!S.next(0, cur)) return;
    f32x4 acc[2][2][4][2];
#pragma unroll
    for (int a = 0; a < 2; ++a)
#pragma unroll
        for (int b = 0; b < 2; ++b)
#pragma unroll
            for (int m = 0; m < 4; ++m)
#pragma unroll
                for (int n = 0; n < 2; ++n) acc[a][b][m][n] = (f32x4){0.f, 0.f, 0.f, 0.f};
    h8 At[4][2], B0[2][2], B1[2][2];
    const char* cA = (const char*)g.A + (size_t)cur.pm * tstep; const char* cB = (const char*)g.Bt + (size_t)cur.pn * tstep;
    S.a_ready(cur);
    PG8_STAGE(PG8_SB(0, 0), cB, voffB); PG8_STAGE(PG8_SA(0, 0), cA, voffA); PG8_STAGE(PG8_SB(0, 1), cB + hstepB, voffB); PG8_STAGE(PG8_SA(0, 1), cA + hstep, voffA);
    if (wr == 1) PG8_BAR;
    PG8_WAIT_V(4); PG8_BAR;
    PG8_STAGE(PG8_SB(1, 0), cB + kstep, voffB); PG8_STAGE(PG8_SA(1, 0), cA + kstep, voffA); PG8_STAGE(PG8_SB(1, 1), cB + hstepB + kstep, voffB);
    PG8_WAIT_V(6); PG8_BAR;
    for (;;) {
        const bool has_next = S.next(ui + 1, nxt);
        const char* nA = has_next ? (const char*)g.A + (size_t)nxt.pm * tstep : cA; const char* nB = has_next ? (const char*)g.Bt + (size_t)nxt.pn * tstep : cB;
        for (int t = 0; t < nt; t += 2) {
            const bool last = (t == nt - 2);
            const char* a1 = cA + (size_t)(t + 1) * kstep;
            const char* a2 = last ? nA : cA + (size_t)(t + 2) * kstep; const char* b2 = last ? nB : cB + (size_t)(t + 2) * kstep;
            const char* a3 = a2 + kstep; const char* b3 = b2 + kstep;
            if (last && has_next) S.a_ready(nxt);
            PG8_LDB(B0, 0, 0); PG8_SCHED; PG8_LDA(At, 0, 0); PG8_STAGE(PG8_SA(1, 1), a1 + hstep, voffA);
            PG8_WAIT_L(8); PG8_BAR; PG8_WAIT_L(0); PG8_MMA(0, 0, At, B0); PG8_BAR; PG8_SCHED;
            PG8_LDB(B1, 0, 1); PG8_STAGE(PG8_SB(0, 0), b2, voffB);
            PG8_BAR; PG8_WAIT_L(0); PG8_MMA(0, 1, At, B1); PG8_BAR;
            PG8_LDA(At, 0, 1); PG8_STAGE(PG8_SA(0, 0), a2, voffA);
            PG8_BAR; PG8_WAIT_L(0); PG8_MMA(1, 0, At, B0); PG8_BAR; PG8_SCHED;
            PG8_STAGE(PG8_SB(0, 1), b2 + hstepB, voffB);
            PG8_WAIT_V(6); PG8_BAR; PG8_MMA(1, 1, At, B1); PG8_BAR;
            PG8_LDB(B0, 1, 0); PG8_SCHED; PG8_LDA(At, 1, 0); PG8_STAGE(PG8_SA(0, 1), a2 + hstep, voffA);
            PG8_WAIT_L(8); PG8_BAR; PG8_WAIT_L(0); PG8_MMA(0, 0, At, B0); PG8_BAR; PG8_SCHED;
            PG8_LDB(B1, 1, 1); PG8_STAGE(PG8_SB(1, 0), b3, voffB);
            PG8_BAR; PG8_WAIT_L(0); PG8_MMA(0, 1, At, B1); PG8_BAR;
            PG8_LDA(At, 1, 1); PG8_STAGE(PG8_SA(1, 0), a3, voffA);
            PG8_BAR; PG8_WAIT_L(0); PG8_MMA(1, 0, At, B0); PG8_BAR; PG8_SCHED;
            PG8_STAGE(PG8_SB(1, 1), b3 + hstepB, voffB);
            PG8_WAIT_V(6); PG8_BAR; PG8_MMA(1, 1, At, B1); PG8_BAR;
        }
        E(acc, cur, wr, wc, fr, fq); S.done(cur);
        if (!has_next) break;
#pragma unroll
        for (int a = 0; a < 2; ++a)
#pragma unroll
            for (int b = 0; b < 2; ++b)
#pragma unroll
                for (int m = 0; m < 4; ++m)
#pragma unroll
                    for (int n = 0; n < 2; ++n) acc[a][b][m][n] = (f32x4){0.f, 0.f, 0.f, 0.f};
        cur = nxt; cA = nA; cB = nB; ++ui;
    }
    PG8_WAIT_V(0);
    if (wr == 0) PG8_BAR;
    PG8_BAR;
#undef PG8_SA
#undef PG8_SB
#undef PG8_STAGE
#undef PG8_LDA
#undef PG8_LDB
#undef PG8_MMA
#undef PG8_WAIT_V
#undef PG8_WAIT_L
#undef PG8_BAR
#undef PG8_SCHED
}
}

__device__ __forceinline__ float row_rstd(const float* ssq, int row) {
    const f32x4* p = (const f32x4*)(ssq + (size_t)row * 16);
    const f32x4 a = p[0], b = p[1], c = p[2], d = p[3];
    const float s = (((a.x + a.y) + (a.z + a.w)) + ((b.x + b.y) + (b.z + b.w))) + (((c.x + c.y) + (c.z + c.w)) + ((d.x + d.y) + (d.z + d.w)));
    return rsqrtf(s * (1.f / 1024.f) + EPS);
}
__device__ __forceinline__ void rows_rstd8(const float* ssq, int row0, int fq, float (&r)[8]) {
    f32x4 p[8];
#pragma unroll
    for (int i = 0; i < 8; ++i) p[i] = *(const f32x4*)(ssq + (size_t)(row0 + (i >> 2) * 128 + (i & 3) * 16) * 16 + 4 * fq);
#pragma unroll
    for (int i = 0; i < 8; ++i) { float s = (p[i].x + p[i].y) + (p[i].z + p[i].w); s += __shfl_xor(s, 16); s += __shfl_xor(s, 32); r[i] = rsqrtf(s * (1.f / 1024.f) + EPS); }
}
struct EpiZ {
    static constexpr bool PERM = true;
    static constexpr int BHALF_ROWS = 32;
    static __host__ __device__ __forceinline__ int brow(int R) { return 64 * ((R >> 5) & 3) + pg8::perm32(R & 31); }
    half_t* Z; const float* ssq;
    __device__ __forceinline__ void operator()(const f32x4 (&acc)[2][2][4][2], const pg8::Unit& u, int wr, int wc, int fr, int fq) const {
        const int row0 = u.pm * 256 + wr * 64 + fr, col0 = u.pn * 256 + wc * 64 + 8 * fq;
        float rr[8]; rows_rstd8(ssq, row0, fq, rr);
#pragma unroll
        for (int ai = 0; ai < 2; ++ai)
#pragma unroll
            for (int m = 0; m < 4; ++m) { const int row = row0 + ai * 128 + m * 16; const float r = rr[ai * 4 + m]; half_t* rp = Z + (size_t)row * NZP + col0;
#pragma unroll
                for (int bj = 0; bj < 2; ++bj) *(u32x4*)(rp + bj * 32) = pack_h8(acc[ai][bj][m][0] * r, acc[ai][bj][m][1] * r); }
    }
};
struct EpiRes {
    static constexpr bool PERM = true;
    static constexpr int BHALF_ROWS = 32;
    static __host__ __device__ __forceinline__ int brow(int R) { return 64 * ((R >> 5) & 3) + pg8::perm32(R & 31); }
    const float* xold; float* out; half_t* XH; float* ssq;
    __device__ __forceinline__ void operator()(const f32x4 (&acc)[2][2][4][2], const pg8::Unit& u, int wr, int wc, int fr, int fq) const {
        const int row0 = u.pm * 256 + wr * 64 + fr, col0 = u.pn * 256 + wc * 64 + 8 * fq;
#pragma unroll
        for (int ai = 0; ai < 2; ++ai) {
            f32x4 xo[4][2][2];
#pragma unroll
            for (int m = 0; m < 4; ++m)
#pragma unroll
                for (int bj = 0; bj < 2; ++bj) { const size_t o = (size_t)(row0 + ai * 128 + m * 16) * D + col0 + bj * 32; xo[m][bj][0] = *(const f32x4*)(xold + o); xo[m][bj][1] = *(const f32x4*)(xold + o + 4); }
#pragma unroll
            for (int m = 0; m < 4; ++m) { const int row = row0 + ai * 128 + m * 16; float s = 0.f;
#pragma unroll
                for (int bj = 0; bj < 2; ++bj) { const size_t o = (size_t)row * D + col0 + bj * 32;
                    const f32x4 v0 = xo[m][bj][0] + acc[ai][bj][m][0], v1 = xo[m][bj][1] + acc[ai][bj][m][1];
                    *(f32x4*)(out + o) = v0; *(f32x4*)(out + o + 4) = v1;
                    if (XH) *(u32x4*)(XH + o) = pack_h8(v0, v1);
                    s += (v0.x * v0.x + v0.y * v0.y) + (v0.z * v0.z + v0.w * v0.w) + (v1.x * v1.x + v1.y * v1.y) + (v1.z * v1.z + v1.w * v1.w); }
                s += __shfl_xor(s, 16); s += __shfl_xor(s, 32);
                if (fq == 0 && ssq) ssq[(size_t)row * 16 + u.pn * 4 + wc] = s; }
        }
    }
};
struct EpiSwiglu {
    static constexpr bool PERM = true;
    static constexpr int BHALF_ROWS = 128;
    static __host__ __device__ __forceinline__ int brow(int R) { return (R & ~31) + pg8::perm32(R & 31); }
    half_t* H; const float* ssq;
    __device__ __forceinline__ void operator()(const f32x4 (&acc)[2][2][4][2], const pg8::Unit& u, int wr, int wc, int fr, int fq) const {
        const int row0 = u.pm * 256 + wr * 64 + fr, col0 = u.pn * 128 + wc * 32 + 8 * fq;
        float rr[8]; rows_rstd8(ssq, row0, fq, rr);
#pragma unroll
        for (int ai = 0; ai < 2; ++ai)
#pragma unroll
            for (int m = 0; m < 4; ++m) { const int row = row0 + ai * 128 + m * 16; const float r = rr[ai * 4 + m];
                f32x4 o[2];
#pragma unroll
                for (int n = 0; n < 2; ++n) { const f32x4 g = acc[ai][0][m][n] * r, uu = acc[ai][1][m][n] * r;
                    o[n].x = g.x * sigmoidf_(g.x) * uu.x; o[n].y = g.y * sigmoidf_(g.y) * uu.y; o[n].z = g.z * sigmoidf_(g.z) * uu.z; o[n].w = g.w * sigmoidf_(g.w) * uu.w; }
                *(u32x4*)(H + (size_t)row * DFF + col0) = pack_h8(o[0], o[1]); }
    }
};

struct EpiNull {
    static constexpr bool PERM = true;
    static constexpr int BHALF_ROWS = 128;
    static __host__ __device__ __forceinline__ int brow(int R) { return (R & ~31) + pg8::perm32(R & 31); }
    __device__ __forceinline__ void operator()(const f32x4 (&acc)[2][2][4][2], const pg8::Unit&, int, int, int, int) const {
#pragma unroll
        for (int ai = 0; ai < 2; ++ai)
#pragma unroll
            for (int bj = 0; bj < 2; ++bj)
#pragma unroll
                for (int m = 0; m < 4; ++m)
#pragma unroll
                    for (int n = 0; n < 2; ++n) asm volatile("" :: "v"(acc[ai][bj][m][n]));
    }
};
struct Params {
    const float* x; const float* norm_mix; const float* w_in; const float* lru_conv_w; const float* lru_conv_b; const float* lru_w_gates; const float* lru_b_gates;
    const float* lru_lambda; const float* sc_conv_w; const float* fox_f_bias; const float* fox_qk_norm; const float* nsa_qk_norm; const float* nsa_cmp_pos;
    const float* nsa_cmp_w1; const float* nsa_cmp_w2; const float* nsa_gate_bias; const float* rel_bias; const float* out_norm; const float* w_out;
    const float* norm_ffn; const float* w_gate_up; const float* w_down; float* out; unsigned char* ws;
};

template <int MODE> __device__ __forceinline__ int src_col(int n) {
    if (MODE == 1) { if (n < 2048) return n; if (n < 2688) return n + 4; if (n < 2692) return 2048 + (n - 2688); if (n < 2704) return n; return -1; }
    if (MODE == 2) { const int pn = n >> 8, w = n & 255; return w < 128 ? pn * 128 + w : DFF + pn * 128 + (w - 128); }
    return n;
}
template <int MODE> __device__ __forceinline__ void p0_item(const float* W, int K, int Nsrc, const float* gain, half_t* WT, int item, int nbn, LAS unsigned* scr, int lane) {
    const int kb = item / nbn, nb = item % nbn, k0 = 64 * kb, n0 = 64 * nb;
    const int sc = src_col<MODE>(n0 + lane);
    float v[64];
    const float* wp = W + (size_t)k0 * Nsrc + (sc >= 0 ? sc : 0);
#pragma unroll
    for (int kk = 0; kk < 64; ++kk) v[kk] = wp[(size_t)kk * Nsrc];
#pragma unroll
    for (int kk = 0; kk < 64; kk += 2) {
        float v0 = sc >= 0 ? v[kk] : 0.f, v1 = sc >= 0 ? v[kk + 1] : 0.f;
        if (gain) { v0 *= gain[k0 + kk]; v1 *= gain[k0 + kk + 1]; }
        scr[lane * 33 + (kk >> 1)] = pack_h2(v0, v1);
    }
    LDS_WAIT(); asm volatile("" ::: "memory");
    const int c = lane & 7;
#pragma unroll
    for (int j = 0; j < 8; ++j) { const int nn = (lane >> 3) + 8 * j; const LAS unsigned* s = scr + nn * 33 + 4 * c;
        u32x4 o; o.x = s[0]; o.y = s[1]; o.z = s[2]; o.w = s[3];
        *(u32x4*)(WT + (size_t)(n0 + nn) * K + k0 + 8 * c) = o; }
    LDS_WAIT(); asm volatile("" ::: "memory");
}
__device__ __forceinline__ float wave_sum(float v) {
#pragma unroll
    for (int o = 1; o < 64; o <<= 1) v += __shfl_xor(v, o);
    return v;
}

__device__ __forceinline__ void attn_step_h(const float (&q)[64], float (&acc)[64], float& m, float& l, const half_t* kp, const half_t* vp, float bias, bool valid) {
    float sc = 0.f;
#pragma unroll
    for (int hh = 0; hh < 2; ++hh) {
#pragma unroll
        for (int j = 4 * hh; j < 4 * hh + 4; ++j) { const h8 kv = *(const h8*)(kp + 8 * j);
#pragma unroll
            for (int e = 0; e < 8; ++e) sc = fmaf(q[8 * j + e], (float)kv[e], sc); }
        __builtin_amdgcn_sched_barrier(0);
    }
    sc += bias;
    const float mn = valid ? fmaxf(m, sc) : m;
    const float alpha = __expf(m - mn), p = valid ? __expf(sc - mn) : 0.f;
    m = mn; l = l * alpha + p;
#pragma unroll
    for (int hh = 0; hh < 2; ++hh) {
#pragma unroll
        for (int j = 4 * hh; j < 4 * hh + 4; ++j) { const h8 vv = *(const h8*)(vp + 8 * j);
#pragma unroll
            for (int e = 0; e < 8; ++e) acc[8 * j + e] = fmaf(acc[8 * j + e], alpha, p * (float)vv[e]); }
        __builtin_amdgcn_sched_barrier(0);
    }
}
__device__ __forceinline__ float dot_f32(const float (&q)[64], const float* kp) {
    float sc = 0.f;
#pragma unroll
    for (int j = 0; j < 16; ++j) { const f32x4 kv = *(const f32x4*)(kp + 4 * j); sc = fmaf(q[4 * j], kv.x, sc); sc = fmaf(q[4 * j + 1], kv.y, sc); sc = fmaf(q[4 * j + 2], kv.z, sc); sc = fmaf(q[4 * j + 3], kv.w, sc); }
    return sc;
}
__device__ __forceinline__ void load_q(float (&q)[64], const half_t* qp, float scale) {
#pragma unroll
    for (int j = 0; j < 8; ++j) { const h8 v = *(const h8*)(qp + 8 * j);
#pragma unroll
        for (int e = 0; e < 8; ++e) q[8 * j + e] = (float)v[e] * scale; }
}

__device__ __forceinline__ void lru_gate_r(const float* wcol, float bias, const LAS float* xrow, LAS float* yout) {
    float w[64];
#pragma unroll
    for (int k = 0; k < 64; ++k) w[k] = wcol[(size_t)k * 64];
    for (int i = 0; i < 32; ++i) {
        const LAS float* xr = xrow + i * 256; float r = bias;
#pragma unroll
        for (int k = 0; k < 64; k += 4) { const f32x4 xv = *(const LAS f32x4*)(xr + k);
            r = fmaf(xv.x, w[k], r); r = fmaf(xv.y, w[k + 1], r); r = fmaf(xv.z, w[k + 2], r); r = fmaf(xv.w, w[k + 3], r); }
        yout[i * 256] = 1.f / (1.f + expf(-r));
    }
}

__device__ __forceinline__ void ld_frags(h8 (&f)[8], const LAS unsigned char* base) {
#pragma unroll
    for (int i = 0; i < 4; ++i) { f[2 * i] = *(const LAS h8*)(base + 32 * i); f[2 * i + 1] = *(const LAS h8*)(base + 32 * 144 + 32 * i); }
}
__device__ __forceinline__ void qk64(f32x16& S0, f32x16& S1, const h8 (&q)[4], const LAS unsigned char* Ks, int qi, int hb) {
    h8 ka[8]; ld_frags(ka, Ks + pi16(qi) * 144 + 16 * hb);
    __builtin_amdgcn_sched_barrier(0);
#pragma unroll
    for (int kk = 0; kk < 4; ++kk) { S0 = MFMA32(ka[2 * kk], q[kk], S0); S1 = MFMA32(ka[2 * kk + 1], q[kk], S1); }
}
__device__ __forceinline__ void pv64(const f32x16& P0, const f32x16& P1, const LAS unsigned char* Vs, f32x16& O0, f32x16& O1, int qi, int hb) {
    h8 va[8]; ld_frags(va, Vs + qi * 144 + 16 * hb);
    h8 pf[4];
#pragma unroll
    for (int e = 0; e < 8; ++e) { pf[0][e] = (half_t)P0[e]; pf[1][e] = (half_t)P0[8 + e]; pf[2][e] = (half_t)P1[e]; pf[3][e] = (half_t)P1[8 + e]; }
    __builtin_amdgcn_sched_barrier(0);
#pragma unroll
    for (int s = 0; s < 4; ++s) { O0 = MFMA32(va[2 * s], pf[s], O0); O1 = MFMA32(va[2 * s + 1], pf[s], O1); }
}
__device__ __forceinline__ float rowmax64(const f32x16& S0, const f32x16& S1) {
    float mx = fmaxf(S0[0], S1[0]);
#pragma unroll
    for (int r = 1; r < 16; ++r) mx = fmaxf(mx, fmaxf(S0[r], S1[r]));
    return fmaxf(mx, __shfl_xor(mx, 32));
}
__device__ __forceinline__ void softmax64(f32x16& S0, f32x16& S1, float& m, float& l, f32x16& O0, f32x16& O1) {
    const float mn = fmaxf(m, rowmax64(S0, S1)), alpha = __builtin_amdgcn_exp2f(m - mn);
    m = mn; float ps = 0.f;
#pragma unroll
    for (int r = 0; r < 16; ++r) { S0[r] = __builtin_amdgcn_exp2f(S0[r] - mn); S1[r] = __builtin_amdgcn_exp2f(S1[r] - mn); ps += S0[r] + S1[r]; }
    l = l * alpha + ps;
    if (__any(alpha != 1.f)) {
#pragma unroll
        for (int r = 0; r < 16; ++r) { O0[r] *= alpha; O1[r] *= alpha; }
    }
}
__device__ __forceinline__ void init_near(f32x16& S0, f32x16& S1, const LAS float* TRh, int dq, int hb, int step, int wlim) {
#pragma unroll
    for (int r = 0; r < 16; ++r) {
        const int k0 = 16 * (r >> 3) + 8 * hb + 4 * ((r >> 2) & 1) + (r & 3);
        const int d0 = dq - step * k0, d1 = dq - step * (k0 + 32);
        const float b0 = TRh[d0 < 0 ? 0 : (d0 > 128 ? 128 : d0)], b1 = TRh[d1 < 0 ? 0 : (d1 > 128 ? 128 : d1)];
        S0[r] = (d0 >= 0 && d0 < wlim) ? b0 : -INFINITY; S1[r] = (d1 >= 0 && d1 < wlim) ? b1 : -INFINITY;
    }
}
__device__ __forceinline__ void init_const(f32x16& S0, f32x16& S1, float c) {
#pragma unroll
    for (int r = 0; r < 16; ++r) { S0[r] = c; S1[r] = c; }
}

__device__ __forceinline__ void init_tab(f32x16& S0, f32x16& S1, const LAS float* TXh, int dq, int hb, int step, int dmax, bool sel) {
#pragma unroll
    for (int r = 0; r < 16; ++r) {
        const int k0 = 16 * (r >> 3) + 8 * hb + 4 * ((r >> 2) & 1) + (r & 3);
        int i0 = dq - step * k0, i1 = dq - step * (k0 + 32);
        i0 = i0 < -1 ? -1 : (i0 > dmax ? dmax : i0); i1 = i1 < -1 ? -1 : (i1 > dmax ? dmax : i1);
        S0[r] = TXh[sel ? i0 + 1 : 0]; S1[r] = TXh[sel ? i1 + 1 : 0];
    }
}
__device__ __forceinline__ void qk64z(f32x16& S0, f32x16& S1, const h8 (&q)[4], const LAS unsigned char* Ks, int qi, int hb) {
    h8 ka[8]; ld_frags(ka, Ks + pi16(qi) * 144 + 16 * hb);
    __builtin_amdgcn_sched_barrier(0);
    const f32x16 z = {0.f, 0.f, 0.f, 0.f, 0.f, 0.f, 0.f, 0.f, 0.f, 0.f, 0.f, 0.f, 0.f, 0.f, 0.f, 0.f};
    S0 = MFMA32(ka[0], q[0], z); S1 = MFMA32(ka[1], q[0], z);
#pragma unroll
    for (int kk = 1; kk < 4; ++kk) { S0 = MFMA32(ka[2 * kk], q[kk], S0); S1 = MFMA32(ka[2 * kk + 1], q[kk], S1); }
}
__device__ __forceinline__ float exp_sum64(f32x16& S0, f32x16& S1) {
    float ps = 0.f;
#pragma unroll
    for (int r = 0; r < 16; ++r) { S0[r] = __builtin_amdgcn_exp2f(S0[r]); S1[r] = __builtin_amdgcn_exp2f(S1[r]); ps += S0[r] + S1[r]; }
    return ps;
}
__device__ __forceinline__ void pv64m(const f32x16& P0, const f32x16& P1, bool sel, const LAS unsigned char* Vs, f32x16& O0, f32x16& O1, int qi, int hb) {
    h8 va[8]; ld_frags(va, Vs + qi * 144 + 16 * hb);
    h8 pf[4];
#pragma unroll
    for (int e = 0; e < 8; ++e) { pf[0][e] = (half_t)P0[e]; pf[1][e] = (half_t)P0[8 + e]; pf[2][e] = (half_t)P1[e]; pf[3][e] = (half_t)P1[8 + e]; }
    const h8 hz = {0, 0, 0, 0, 0, 0, 0, 0};
#pragma unroll
    for (int s = 0; s < 4; ++s) pf[s] = sel ? pf[s] : hz;
    __builtin_amdgcn_sched_barrier(0);
#pragma unroll
    for (int s = 0; s < 4; ++s) { O0 = MFMA32(va[2 * s], pf[s], O0); O1 = MFMA32(va[2 * s + 1], pf[s], O1); }
}

template <bool FAST>
__device__ __forceinline__ void fox_tile(const LAS unsigned char* sbp, int h, const h8 (&q)[4], int qi, int hb, bool diag, int kbase, int t, float& m, float& l, f32x16& O0, f32x16& O1) {
    const LAS unsigned char* Kh = sbp + h * 4608; const LAS unsigned char* Vh = sbp + 18432 + h * 5120;
    const LAS float* cbh = (const LAS float*)(sbp + 38912) + h * 32;
    f32x16 S;
#pragma unroll
    for (int g = 0; g < 4; ++g) { const f32x4 c4 = *(const LAS f32x4*)(cbh + 16 * (g >> 1) + 8 * hb + 4 * (g & 1)); S[4 * g] = c4.x; S[4 * g + 1] = c4.y; S[4 * g + 2] = c4.z; S[4 * g + 3] = c4.w; }
    h8 ka[4], va[4];
#pragma unroll
    for (int kk = 0; kk < 4; ++kk) ka[kk] = *(const LAS h8*)(Kh + pi16(qi) * 144 + (16 * kk + 8 * hb) * 2);
    va[0] = *(const LAS h8*)(Vh + qi * 80 + (8 * hb) * 2); va[1] = *(const LAS h8*)(Vh + qi * 80 + (16 + 8 * hb) * 2);
    va[2] = *(const LAS h8*)(Vh + (32 + qi) * 80 + (8 * hb) * 2); va[3] = *(const LAS h8*)(Vh + (32 + qi) * 80 + (16 + 8 * hb) * 2);
    __builtin_amdgcn_sched_barrier(0);
#pragma unroll
    for (int kk = 0; kk < 4; ++kk) S = MFMA32(ka[kk], q[kk], S);
    if (diag) {
#pragma unroll
        for (int r = 0; r < 16; ++r) { const int key = kbase + 16 * (r >> 3) + 8 * hb + 4 * ((r >> 2) & 1) + (r & 3); if (key > t) S[r] = -INFINITY; }
    }
    float mn = m, alpha = 1.f;
    if (!FAST) {
        float mx = S[0];
#pragma unroll
        for (int r = 1; r < 16; ++r) mx = fmaxf(mx, S[r]);
        mx = fmaxf(mx, __shfl_xor(mx, 32));
        mn = fmaxf(m, mx); alpha = __builtin_amdgcn_exp2f(m - mn);
        m = mn;
    }
    float ps = 0.f;
#pragma unroll
    for (int r = 0; r < 16; ++r) { S[r] = __builtin_amdgcn_exp2f(S[r] - mn); ps += S[r]; }
    l = l * alpha + ps;
    if (!FAST && __any(alpha != 1.f)) {
#pragma unroll
        for (int r = 0; r < 16; ++r) { O0[r] *= alpha; O1[r] *= alpha; }
    }
    h8 pf0, pf1;
#pragma unroll
    for (int e = 0; e < 8; ++e) { pf0[e] = (half_t)S[e]; pf1[e] = (half_t)S[8 + e]; }
    O0 = MFMA32(va[0], pf0, O0); O1 = MFMA32(va[2], pf0, O1); O0 = MFMA32(va[1], pf1, O0); O1 = MFMA32(va[3], pf1, O1);
}
__device__ __forceinline__ void nsa_tile(bool near, int dq, int wlim, float cinit, const LAS float* TRh, const h8 (&q)[4], const LAS unsigned char* stage, float& m, float& l, f32x16& O0, f32x16& O1, int qi, int hb) {
    f32x16 S0, S1;
    if (near) init_near(S0, S1, TRh, dq, hb, 1, wlim); else init_const(S0, S1, cinit);
    qk64(S0, S1, q, stage, qi, hb);
    softmax64(S0, S1, m, l, O0, O1);
    pv64(S0, S1, stage + 9216, O0, O1, qi, hb);
}

#define MFMA16(a, b, c) __builtin_amdgcn_mfma_f32_16x16x32_f16(a, b, c, 0, 0, 0)
template <bool FINAL>
__device__ __forceinline__ void lru_unit(const Params& P, int L, int ui, LAS unsigned char* lds, const half_t* Z, const half_t* WGT, const float* LSPp, float* LRUAGG, float* LRUA, float* LRUB, half_t* MIXED, int wave, float& hcarry, bool first) {
    int tid = threadIdx.x; asm volatile("" : "+v"(tid)); const int lane = tid & 63;
    const int b = ui >> 7, sub = ui & 127, t0 = sub * 32; const size_t tokb = (size_t)b * SEQ;
    LAS float* xcF = (LAS float*)lds;
    LAS float* Aa = (LAS float*)(lds + 32768);
    LAS half_t* xcH = (LAS half_t*)(lds + 65536);
    LAS float* Sc = (LAS float*)(lds + 82944);
    {
        const int c = tid & 255, q2 = tid >> 8, ta = t0 + 16 * q2;
        const float w0 = P.lru_conv_w[(L * 4 + 0) * 256 + c], w1 = P.lru_conv_w[(L * 4 + 1) * 256 + c], w2 = P.lru_conv_w[(L * 4 + 2) * 256 + c], w3 = P.lru_conv_w[(L * 4 + 3) * 256 + c], cb = P.lru_conv_b[L * 256 + c];
        const half_t* zp = Z + (tokb + ta) * NZP + ZC_LRU_X + c;
        float x0 = ta >= 3 ? (float)zp[-3 * NZP] : 0.f, x1 = ta >= 2 ? (float)zp[-2 * NZP] : 0.f, x2 = ta >= 1 ? (float)zp[-1 * NZP] : 0.f;
#pragma unroll
        for (int i = 0; i < 16; ++i) { const float x3 = (float)zp[(size_t)i * NZP]; const float v = cb + w0 * x0 + w1 * x1 + w2 * x2 + w3 * x3;
            xcF[(16 * q2 + i) * 256 + c] = v; xcH[(16 * q2 + i) * 264 + c] = (half_t)v; x0 = x1; x1 = x2; x2 = x3; }
    }
    __syncthreads();
    {
        const int blk = wave & 3, th = wave >> 2, r16 = lane & 15, kq = lane >> 4;
        const h8 a0 = *(const LAS h8*)(xcH + (16 * th + r16) * 264 + blk * 64 + 8 * kq), a1 = *(const LAS h8*)(xcH + (16 * th + r16) * 264 + blk * 64 + 32 + 8 * kq);
#pragma unroll
        for (int cbk = 0; cbk < 4; ++cbk) {
            const half_t* wr = WGT + ((size_t)((L * 2 + 0) * 4 + blk) * 64 + 16 * cbk + r16) * 64 + 8 * kq; const half_t* wi = wr + 4 * 64 * 64;
            f32x4 ar = {0.f, 0.f, 0.f, 0.f}, ai = {0.f, 0.f, 0.f, 0.f};
            ar = MFMA16(a0, *(const h8*)wr, ar); ar = MFMA16(a1, *(const h8*)(wr + 32), ar);
            ai = MFMA16(a0, *(const h8*)wi, ai); ai = MFMA16(a1, *(const h8*)(wi + 32), ai);
            const int c = blk * 64 + 16 * cbk + r16;
            const float br = P.lru_b_gates[(L * 2 + 0) * 256 + c], bi = P.lru_b_gates[(L * 2 + 1) * 256 + c];
            const float lsp = LSPp[L * 256 + c];
#pragma unroll
            for (int rg = 0; rg < 4; ++rg) { const int tl = 16 * th + 4 * kq + rg;
                const float r = __builtin_amdgcn_rcpf(1.f + __builtin_amdgcn_exp2f(-LOG2E * (ar[rg] + br))), ii = __builtin_amdgcn_rcpf(1.f + __builtin_amdgcn_exp2f(-LOG2E * (ai[rg] + bi)));
                const float xc = xcF[tl * 256 + c];
                const float a = __builtin_amdgcn_exp2f(lsp * r), bb = __builtin_amdgcn_sqrtf(fmaxf(1.f - a * a, 0.f)) * (ii * xc);
                Aa[tl * 256 + c] = a; xcF[tl * 256 + c] = bb; }
        }
    }
    __syncthreads();
    if (tid < 256) {
        const int c = tid;
        if (!FINAL) {
            float h = 0.f, Ap = 1.f;
#pragma unroll 8
            for (int i = 0; i < 32; ++i) { const float a = Aa[i * 256 + c], bb = xcF[i * 256 + c]; h = fmaf(a, h, bb); Ap *= a;
                LRUA[(tokb + t0 + i) * 256 + c] = a; LRUB[(tokb + t0 + i) * 256 + c] = bb; }
            float* ag = LRUAGG + (((size_t)b * 128 + sub) * 256 + c) * 2; ag[0] = Ap; ag[1] = h;
        } else {
            float h = hcarry;
            if (first) { h = 0.f; const float* ag = LRUAGG + ((size_t)b * 128 * 256 + c) * 2;
              for (int s0 = 0; s0 < sub; s0 += 16) {
                  typedef float f32x2 __attribute__((ext_vector_type(2)));
                  f32x2 pr[16];
#pragma unroll
                  for (int k = 0; k < 16; ++k) pr[k] = (s0 + k < sub) ? *(const f32x2*)(ag + (size_t)(s0 + k) * 512) : (f32x2){1.f, 0.f};
#pragma unroll
                  for (int k = 0; k < 16; ++k) h = fmaf(pr[k].x, h, pr[k].y); } }
            const half_t* gp = Z + (tokb + t0) * NZP + ZC_LRU_G + c;
#pragma unroll 8
            for (int i = 0; i < 32; ++i) { const float a = Aa[i * 256 + c], bb = xcF[i * 256 + c]; h = fmaf(a, h, bb);
                const float gx = (float)gp[(size_t)i * NZP];
                Aa[i * 256 + c] = h * gx * __builtin_amdgcn_rcpf(1.f + __builtin_amdgcn_exp2f(-2.f * LOG2E * 0.7978845608028654f * (gx + 0.044715f * gx * gx * gx))); }
            hcarry = h;
        }
    } else if (FINAL) {
        const int c = tid - 256;
        const float w0 = P.sc_conv_w[(L * 3 + 0) * 256 + c], w1 = P.sc_conv_w[(L * 3 + 1) * 256 + c], w2 = P.sc_conv_w[(L * 3 + 2) * 256 + c];
        const half_t* zp = Z + (tokb + t0) * NZP + c;
        float u0 = t0 >= 2 ? (float)zp[-2 * NZP + ZC_SC_C] * (float)zp[-2 * NZP + ZC_SC_X] : 0.f, u1 = t0 >= 1 ? (float)zp[-1 * NZP + ZC_SC_C] * (float)zp[-1 * NZP + ZC_SC_X] : 0.f;
#pragma unroll 8
        for (int i = 0; i < 32; ++i) { const half_t* zr = zp + (size_t)i * NZP; const float u2 = (float)zr[ZC_SC_C] * (float)zr[ZC_SC_X];
            Sc[i * 256 + c] = (float)zr[ZC_SC_B] * (w0 * u0 + w1 * u1 + w2 * u2); u0 = u1; u1 = u2; }
    }
    __syncthreads();
    if (FINAL) {
        const f32x4 ga = *(const f32x4*)(P.out_norm + (L * 4 + 0) * 256 + 4 * lane), gbv = *(const f32x4*)(P.out_norm + (L * 4 + 1) * 256 + 4 * lane);
#pragma unroll
        for (int i = 0; i < 4; ++i) { const int tl = wave * 4 + i; half_t* op = MIXED + (tokb + t0 + tl) * D + 4 * lane;
            { const f32x4 v = *(const LAS f32x4*)(Aa + tl * 256 + 4 * lane); const float rs = rsqrtf(wave_sum((v.x * v.x + v.y * v.y) + (v.z * v.z + v.w * v.w)) * (1.f / 256.f) + EPS);
              u32x2 o; o.x = pack_h2(v.x * rs * ga.x, v.y * rs * ga.y); o.y = pack_h2(v.z * rs * ga.z, v.w * rs * ga.w); *(u32x2*)op = o; }
            { const f32x4 v = *(const LAS f32x4*)(Sc + tl * 256 + 4 * lane); const float rs = rsqrtf(wave_sum((v.x * v.x + v.y * v.y) + (v.z * v.z + v.w * v.w)) * (1.f / 256.f) + EPS);
              u32x2 o; o.x = pack_h2(v.x * rs * gbv.x, v.y * rs * gbv.y); o.y = pack_h2(v.z * rs * gbv.z, v.w * rs * gbv.w); *(u32x2*)(op + 256) = o; }
        }
        __syncthreads();
    }
}

__device__ __forceinline__ void lru_final(const Params& P, int L, int ui, LAS unsigned char* lds, const half_t* Z, const float* LRUAGG, const float* LRUA, const float* LRUB, half_t* MIXED, int wave, float& hcarry, bool first) {
    int tid = threadIdx.x; asm volatile("" : "+v"(tid)); const int lane = tid & 63;
    const int b = ui >> 7, sub = ui & 127, t0 = sub * 32; const size_t tokb = (size_t)b * SEQ;
    LAS float* Aa = (LAS float*)lds;
    LAS float* Sc = (LAS float*)(lds + 32768);
    if (tid < 256) {
        const int c = tid;
        float av[32], bv[32]; half_t gv[32];
        const float* ap = LRUA + (tokb + t0) * 256 + c; const float* bp = LRUB + (tokb + t0) * 256 + c; const half_t* gp = Z + (tokb + t0) * NZP + ZC_LRU_G + c;
#pragma unroll
        for (int i = 0; i < 32; ++i) { av[i] = ap[i * 256]; bv[i] = bp[i * 256]; gv[i] = gp[(size_t)i * NZP]; }
        float h = hcarry;
        if (first) { h = 0.f; const float* ag = LRUAGG + ((size_t)b * 128 * 256 + c) * 2;
          for (int s0 = 0; s0 < sub; s0 += 16) {
              typedef float f32x2 __attribute__((ext_vector_type(2)));
              f32x2 pr[16];
#pragma unroll
              for (int k = 0; k < 16; ++k) pr[k] = (s0 + k < sub) ? *(const f32x2*)(ag + (size_t)(s0 + k) * 512) : (f32x2){1.f, 0.f};
#pragma unroll
              for (int k = 0; k < 16; ++k) h = fmaf(pr[k].x, h, pr[k].y); } }
#pragma unroll
        for (int i = 0; i < 32; ++i) { h = fmaf(av[i], h, bv[i]); const float gx = (float)gv[i];
            Aa[i * 256 + c] = h * gx * __builtin_amdgcn_rcpf(1.f + __builtin_amdgcn_exp2f(-2.f * LOG2E * 0.7978845608028654f * (gx + 0.044715f * gx * gx * gx))); }
        hcarry = h;
    } else {
        const int c = tid - 256;
        const float w0 = P.sc_conv_w[(L * 3 + 0) * 256 + c], w1 = P.sc_conv_w[(L * 3 + 1) * 256 + c], w2 = P.sc_conv_w[(L * 3 + 2) * 256 + c];
        const half_t* zp = Z + (tokb + t0) * NZP + c;
        float u0 = t0 >= 2 ? (float)zp[-2 * NZP + ZC_SC_C] * (float)zp[-2 * NZP + ZC_SC_X] : 0.f, u1 = t0 >= 1 ? (float)zp[-1 * NZP + ZC_SC_C] * (float)zp[-1 * NZP + ZC_SC_X] : 0.f;
#pragma unroll 8
        for (int i = 0; i < 32; ++i) { const half_t* zr = zp + (size_t)i * NZP; const float u2 = (float)zr[ZC_SC_C] * (float)zr[ZC_SC_X];
            Sc[i * 256 + c] = (float)zr[ZC_SC_B] * (w0 * u0 + w1 * u1 + w2 * u2); u0 = u1; u1 = u2; }
    }
    __syncthreads();
    {
        const f32x4 ga = *(const f32x4*)(P.out_norm + (L * 4 + 0) * 256 + 4 * lane), gbv = *(const f32x4*)(P.out_norm + (L * 4 + 1) * 256 + 4 * lane);
#pragma unroll
        for (int i = 0; i < 4; ++i) { const int tl = wave * 4 + i; half_t* op = MIXED + (tokb + t0 + tl) * D + 4 * lane;
            { const f32x4 v = *(const LAS f32x4*)(Aa + tl * 256 + 4 * lane); const float rs = rsqrtf(wave_sum((v.x * v.x + v.y * v.y) + (v.z * v.z + v.w * v.w)) * (1.f / 256.f) + EPS);
              u32x2 o; o.x = pack_h2(v.x * rs * ga.x, v.y * rs * ga.y); o.y = pack_h2(v.z * rs * ga.z, v.w * rs * ga.w); *(u32x2*)op = o; }
            { const f32x4 v = *(const LAS f32x4*)(Sc + tl * 256 + 4 * lane); const float rs = rsqrtf(wave_sum((v.x * v.x + v.y * v.y) + (v.z * v.z + v.w * v.w)) * (1.f / 256.f) + EPS);
              u32x2 o; o.x = pack_h2(v.x * rs * gbv.x, v.y * rs * gbv.y); o.y = pack_h2(v.z * rs * gbv.z, v.w * rs * gbv.w); *(u32x2*)(op + 256) = o; }
        }
    }
    __syncthreads();
}

constexpr int CW_Q = 8192;
__device__ __forceinline__ int q_next(unsigned* ctr, volatile LAS unsigned* slot) {
    __syncthreads();
    if (threadIdx.x == 0) *slot = __hip_atomic_fetch_add(ctr, 1u, __ATOMIC_RELAXED, __HIP_MEMORY_SCOPE_AGENT);
    __syncthreads();
    return __builtin_amdgcn_readfirstlane((int)*slot);
}
__device__ __forceinline__ unsigned long long ld_uptr(const LAS unsigned long long* pb, int i) {
    const unsigned long long v = pb[i];
    return ((unsigned long long)(unsigned)__builtin_amdgcn_readfirstlane((int)(v >> 32)) << 32) | (unsigned)__builtin_amdgcn_readfirstlane((int)(unsigned)v);
}
#define SECTION_ENV() \
    asm volatile("" ::: "memory"); \
    int bid = blockIdx.x; asm volatile("" : "+s"(bid));     \
    Params P; { unsigned poff_ = MISC_OFF + 512; asm volatile("" : "+s"(poff_)); const LAS unsigned long long* pb_ = (const LAS unsigned long long*)(lds + poff_); P.x = (const float*)(const __attribute__((address_space(1))) float*)ld_uptr(pb_, 0); P.norm_mix = (const float*)(const __attribute__((address_space(1))) float*)ld_uptr(pb_, 1); P.w_in = (const float*)(const __attribute__((address_space(1))) float*)ld_uptr(pb_, 2); P.lru_conv_w = (const float*)(const __attribute__((address_space(1))) float*)ld_uptr(pb_, 3); P.lru_conv_b = (const float*)(const __attribute__((address_space(1))) float*)ld_uptr(pb_, 4); P.lru_w_gates = (const float*)(const __attribute__((address_space(1))) float*)ld_uptr(pb_, 5); P.lru_b_gates = (const float*)(const __attribute__((address_space(1))) float*)ld_uptr(pb_, 6); P.lru_lambda = (const float*)(const __attribute__((address_space(1))) float*)ld_uptr(pb_, 7); P.sc_conv_w = (const float*)(const __attribute__((address_space(1))) float*)ld_uptr(pb_, 8); P.fox_f_bias = (const float*)(const __attribute__((address_space(1))) float*)ld_uptr(pb_, 9); P.fox_qk_norm = (const float*)(const __attribute__((address_space(1))) float*)ld_uptr(pb_, 10); P.nsa_qk_norm = (const float*)(const __attribute__((address_space(1))) float*)ld_uptr(pb_, 11); P.nsa_cmp_pos = (const float*)(const __attribute__((address_space(1))) float*)ld_uptr(pb_, 12); P.nsa_cmp_w1 = (const float*)(const __attribute__((address_space(1))) float*)ld_uptr(pb_, 13); P.nsa_cmp_w2 = (const float*)(const __attribute__((address_space(1))) float*)ld_uptr(pb_, 14); P.nsa_gate_bias = (const float*)(const __attribute__((address_space(1))) float*)ld_uptr(pb_, 15); P.rel_bias = (const float*)(const __attribute__((address_space(1))) float*)ld_uptr(pb_, 16); P.out_norm = (const float*)(const __attribute__((address_space(1))) float*)ld_uptr(pb_, 17); P.w_out = (const float*)(const __attribute__((address_space(1))) float*)ld_uptr(pb_, 18); P.norm_ffn = (const float*)(const __attribute__((address_space(1))) float*)ld_uptr(pb_, 19); P.w_gate_up = (const float*)(const __attribute__((address_space(1))) float*)ld_uptr(pb_, 20); P.w_down = (const float*)(const __attribute__((address_space(1))) float*)ld_uptr(pb_, 21); P.out = (float*)(__attribute__((address_space(1))) float*)ld_uptr(pb_, 22); P.ws = (unsigned char*)(__attribute__((address_space(1))) unsigned char*)ld_uptr(pb_, 23); } \
    unsigned char* ws = P.ws; (void)ws; \
    float* SSQA = (float*)(ws + WS_SSQA); float* SSQB = (float*)(ws + WS_SSQB); float* CFOX = (float*)(ws + WS_CFOX); \
    float* LRUAGG = (float*)(ws + WS_LRUAGG); float* CB = (float*)(ws + WS_CB); \
    half_t* WIN_T = (half_t*)(ws + WS_WIN); half_t* WOUT_T = (half_t*)(ws + WS_WOUT); half_t* WGU_T = (half_t*)(ws + WS_WGU); half_t* WDN_T = (half_t*)(ws + WS_WDN); \
    half_t* FOXVT = (half_t*)(ws + WS_FOXVT); half_t* VST = (half_t*)(ws + WS_VST); half_t* VWT = (half_t*)(ws + WS_VWT); half_t* KCH = (half_t*)(ws + WS_KCH); half_t* VCT = (half_t*)(ws + WS_VCT); \
    half_t* W1T = (half_t*)(ws + WS_W1T); half_t* WGT = (half_t*)(ws + WS_WGT); float* LRUA = (float*)(ws + WS_LRUA); float* LRUB = (float*)(ws + WS_LRUB); (void)LRUA; (void)LRUB; \
    half_t* XH = (half_t*)(ws + WS_XH); half_t* MIXED = (half_t*)(ws + WS_MIXED); half_t* Z = (half_t*)(ws + WS_Z); half_t* HB = (half_t*)(ws + WS_Z); \
    (void)SSQA; (void)SSQB; (void)CFOX; (void)LRUAGG; (void)CB; (void)WIN_T; (void)WOUT_T; (void)WGU_T; (void)WDN_T; (void)FOXVT; (void)VST; (void)VWT; (void)KCH; (void)VCT; (void)W1T; (void)WGT; (void)XH; (void)MIXED; (void)Z; (void)HB

__global__ void __launch_bounds__(NTHR, 2) hymba_fwd(Params Pk) {
    extern __shared__ __attribute__((aligned(16))) unsigned char lds_raw[];
    LAS unsigned char* lds = (LAS unsigned char*)lds_raw;
    volatile LAS unsigned* MISC = (volatile LAS unsigned*)(lds + MISC_OFF);
    const int tid = threadIdx.x, lane = tid & 63, wave = __builtin_amdgcn_readfirstlane(tid >> 6);
    const int G = gridDim.x, bid = blockIdx.x;
    if (tid == 0) { LAS unsigned long long* pb = (LAS unsigned long long*)(lds + MISC_OFF + 512); pb[0] = (unsigned long long)Pk.x; pb[1] = (unsigned long long)Pk.norm_mix; pb[2] = (unsigned long long)Pk.w_in; pb[3] = (unsigned long long)Pk.lru_conv_w; pb[4] = (unsigned long long)Pk.lru_conv_b; pb[5] = (unsigned long long)Pk.lru_w_gates; pb[6] = (unsigned long long)Pk.lru_b_gates; pb[7] = (unsigned long long)Pk.lru_lambda; pb[8] = (unsigned long long)Pk.sc_conv_w; pb[9] = (unsigned long long)Pk.fox_f_bias; pb[10] = (unsigned long long)Pk.fox_qk_norm; pb[11] = (unsigned long long)Pk.nsa_qk_norm; pb[12] = (unsigned long long)Pk.nsa_cmp_pos; pb[13] = (unsigned long long)Pk.nsa_cmp_w1; pb[14] = (unsigned long long)Pk.nsa_cmp_w2; pb[15] = (unsigned long long)Pk.nsa_gate_bias; pb[16] = (unsigned long long)Pk.rel_bias; pb[17] = (unsigned long long)Pk.out_norm; pb[18] = (unsigned long long)Pk.w_out; pb[19] = (unsigned long long)Pk.norm_ffn; pb[20] = (unsigned long long)Pk.w_gate_up; pb[21] = (unsigned long long)Pk.w_down; pb[22] = (unsigned long long)Pk.out; pb[23] = (unsigned long long)Pk.ws; }
    unsigned* ctl = (unsigned*)(Pk.ws + WS_CTL);

    for (int u = tid; u < 64; u += NTHR) MISC[u] = 0u;
    __syncthreads();
    XcdBarrier bar = xcd_barrier_post(ctl + CW_BAR, MISC + 8);

    const int gw = bid * NWAVES + wave, NGW = G * NWAVES;

#ifndef SKIP_P0
    for (int rp0 = 0; rp0 < REP_P0; ++rp0) {
        SECTION_ENV();
        LAS unsigned* scr = (LAS unsigned*)(lds + wave * 8448);
        constexpr int I_IN = 16 * 44, I_OUT = 16 * 16, I_GU = 16 * 88, I_DN = 44 * 16, PER_L = I_IN + I_OUT + I_GU + I_DN;
        for (int it = gw; it < 2 * PER_L; it += NGW) {
            const int L = it / PER_L; int r = it % PER_L;
            if (r < I_IN) { p0_item<1>(P.w_in + (size_t)L * D * NIN_SRC, D, NIN_SRC, P.norm_mix + L * D, WIN_T + (size_t)L * NZP * D, r, 44, scr, lane); continue; } r -= I_IN;
            if (r < I_OUT) { p0_item<0>(P.w_out + (size_t)L * D * D, D, D, nullptr, WOUT_T + (size_t)L * D * D, r, 16, scr, lane); continue; } r -= I_OUT;
            if (r < I_GU) { p0_item<2>(P.w_gate_up + (size_t)L * D * 2 * DFF, D, 2 * DFF, P.norm_ffn + L * D, WGU_T + (size_t)L * 2 * DFF * D, r, 88, scr, lane); continue; } r -= I_GU;
            p0_item<0>(P.w_down + (size_t)L * DFF * D, DFF, D, nullptr, WDN_T + (size_t)L * D * DFF, r, 16, scr, lane);
        }
        for (int it = gw; it < 4 * 64 + 16; it += NGW) {
            if (it < 256) { const int ln = it >> 6; p0_item<0>(P.nsa_cmp_w1 + (size_t)ln * 2048 * 128, 2048, 128, nullptr, W1T + (size_t)ln * 128 * 2048, it & 63, 2, scr, lane); }
            else { const int gi = it - 256; p0_item<0>(P.lru_w_gates + (size_t)gi * 64 * 64, 64, 64, nullptr, WGT + (size_t)gi * 64 * 64, 0, 1, scr, lane); }
        }
        for (int og = gw; og < 4 * 512; og += NGW) {
            const int o = og & 511, qr = og >> 9, m = o & 127, ln = o >> 7;
            const float* pp = P.nsa_cmp_pos + (size_t)ln * 2048 + qr * 512; const float* wp = P.nsa_cmp_w1 + ((size_t)ln * 2048 + qr * 512) * 128 + m;
            float s = 0.f;
#pragma unroll
            for (int i = 0; i < 8; ++i) s = fmaf(pp[lane + 64 * i], wp[(size_t)(lane + 64 * i) * 128], s);
            s = wave_sum(s);
            if (lane == 0) CB[qr * 512 + o] = s;
        }
        for (int o = bid * NTHR + tid; o < 512; o += G * NTHR) CB[2048 + o] = -8.0f * LOG2E * log1pf(expf(-P.lru_lambda[o]));
        for (int row0 = gw; row0 < T; row0 += 4 * NGW) {
            f32x4 v[4][4];
#pragma unroll
            for (int rr = 0; rr < 4; ++rr)
#pragma unroll
                for (int j = 0; j < 4; ++j) v[rr][j] = ((const f32x4*)(P.x + (size_t)(row0 + rr * NGW) * D) + lane)[64 * j];
#pragma unroll
            for (int rr = 0; rr < 4; ++rr) { const int row = row0 + rr * NGW; float s = 0.f;
#pragma unroll
                for (int j = 0; j < 4; ++j) { const f32x4 w = v[rr][j]; s += (w.x * w.x + w.y * w.y) + (w.z * w.z + w.w * w.w);
                    u32x2 o; o.x = pack_h2(w.x, w.y); o.y = pack_h2(w.z, w.w); *(u32x2*)(XH + (size_t)row * D + 4 * (lane + 64 * j)) = o; }
                s = wave_sum(s);
                if (lane < 16) SSQB[(size_t)row * 16 + lane] = lane == 0 ? s : 0.f; }
        }
    }
#endif
    xcd_barrier(bar);

    for (int L = 0; L < 2; ++L) {
#ifndef SKIP_G1
        {
            SECTION_ENV();
            pg8::Gemm g{XH, WIN_T + (size_t)L * NZP * D, T, NZP, D}; pg8::StaticOrder S; S.init(T, NZP, G, bid);
            EpiZ E{Z, SSQB};
            for (int rp = 0; rp < REP_G1; ++rp) pg8::gemm_phase<EpiZ, pg8::StaticOrder>(lds, g, S, E);
        }
#endif
        xcd_barrier(bar);

        {
            SECTION_ENV();
#ifndef SKIP_P2AB
            {
                int tid = threadIdx.x; asm volatile("" : "+v"(tid)); const int lane = tid & 63;
                const int g8 = lane >> 3, sub = lane & 7;
                for (int dry = NORM_DRY; dry >= 0; --dry)
                for (int tok = gw; tok < T; tok += NGW) {
#pragma unroll
                    for (int rr = 0; rr < 2; ++rr) {
                        const int r = g8 + 8 * rr;
                        if (r < 14) {
                            int col; const float* gain;
                            if (r < 4) { col = ZC_FOX_Q + 64 * r; gain = P.fox_qk_norm + (L * 2 + 0) * 64; }
                            else if (r < 8) { col = ZC_FOX_K + 64 * (r - 4); gain = P.fox_qk_norm + (L * 2 + 1) * 64; }
                            else if (r < 12) { col = ZC_NSA_Q + 64 * (r - 8); gain = P.nsa_qk_norm + (L * 4 + 0) * 64; }
                            else if (r == 12) { col = ZC_KS; gain = P.nsa_qk_norm + (L * 4 + 2) * 64; }
                            else { col = ZC_KW; gain = P.nsa_qk_norm + (L * 4 + 3) * 64; }
                            half_t* p = Z + (size_t)tok * NZP + col + 8 * sub;
                            const h8 v = *(const h8*)p; float f[8]; float s = 0.f;
#pragma unroll
                            for (int e = 0; e < 8; ++e) { f[e] = (float)v[e]; s += f[e] * f[e]; }
                            s += __shfl_xor(s, 1); s += __shfl_xor(s, 2); s += __shfl_xor(s, 4);
                            const float rs = rsqrtf(s * (1.f / 64.f) + EPS) * ((r < 4 || (r >= 8 && r < 12)) ? QSCALE : 1.f);
                            const f32x4 g0 = *(const f32x4*)(gain + 8 * sub), g1 = *(const f32x4*)(gain + 8 * sub + 4);
                            if (dry) *(h8*)p = v; else
                            *(u32x4*)p = pack_h8((f32x4){f[0] * rs * g0.x, f[1] * rs * g0.y, f[2] * rs * g0.z, f[3] * rs * g0.w}, (f32x4){f[4] * rs * g1.x, f[5] * rs * g1.y, f[6] * rs * g1.z, f[7] * rs * g1.w});
                        }
                    }
                }
            }
            for (int rp = 0; rp < REP_CUM; ++rp)
            if (wave == 1)
            for (int task = 0; task < 32; ++task) if ((task * 8) % G == bid) {
                int tid = threadIdx.x; asm volatile("" : "+v"(tid)); const int lane = tid & 63;
                const int b = task >> 2, h = task & 3;
                const float fb = P.fox_f_bias[L * 4 + h];
                const half_t* zp = Z + ((size_t)b * SEQ + 64 * lane) * NZP + ZC_FOX_F + h;
                float vals[64];
#pragma unroll
                for (int j = 0; j < 64; ++j) vals[j] = (float)zp[(size_t)j * NZP];
                float run = 0.f;
#pragma unroll
                for (int j = 0; j < 64; ++j) { run += log_sigmoid(vals[j] + fb); vals[j] = run; }
                float incl = run;
#pragma unroll
                for (int o = 1; o < 64; o <<= 1) { const float n = __shfl_up(incl, o); if (lane >= o) incl += n; }
                const float excl = incl - run;
                float* cp = CFOX + ((size_t)b * 4 + h) * SEQ + 64 * lane;
#pragma unroll
                for (int j = 0; j < 64; j += 4) *(f32x4*)(cp + j) = (f32x4){vals[j] + excl, vals[j + 1] + excl, vals[j + 2] + excl, vals[j + 3] + excl};
            }
#endif
            for (int rp = 0; rp < REP_VT; ++rp)
            for (int ui = bid; ui < 512; ui += G) {
                int tid = threadIdx.x; asm volatile("" : "+v"(tid));
                const int b = ui >> 6, chunk = ui & 63; const size_t tokb = (size_t)b * SEQ + chunk * 64;
                LAS half_t* tb = (LAS half_t*)lds;
#pragma unroll
                for (int i = 0; i < 4; ++i) { const int p = tid + 512 * i, tk = p >> 5, c8 = p & 31;
                    *(LAS h8*)(tb + tk * 264 + 8 * c8) = *(const h8*)(Z + (tokb + tk) * NZP + ZC_FOX_V + 8 * c8); }
                LAS half_t* tb2 = tb + 64 * 264;
#pragma unroll
                for (int i = 0; i < 2; ++i) { const int p = tid + 512 * i, tk = p >> 4, c8 = p & 15;
                    *(LAS h8*)(tb2 + tk * 136 + 8 * c8) = *(const h8*)(Z + (tokb + tk) * NZP + (c8 < 8 ? ZC_VS + 8 * c8 : ZC_VW + 8 * (c8 - 8))); }
                __syncthreads();
                {
                    const int col = tid & 255, ktl = tid >> 8;
                    half_t* dst = FOXVT + ((size_t)(b * 128 + chunk * 2 + ktl) * 256 + col) * 32;
#pragma unroll
                    for (int j4 = 0; j4 < 4; ++j4) { h8 o;
#pragma unroll
                        for (int e = 0; e < 8; ++e) o[e] = tb[(32 * ktl + 8 * j4 + e) * 264 + col];
                        *(h8*)(dst + 8 * j4) = o; }
#pragma unroll
                    for (int i = 0; i < 2; ++i) { const int p = tid + 512 * i, which = p >> 9, d = (p >> 3) & 63, ch = p & 7; h8 o;
#pragma unroll
                        for (int e = 0; e < 8; ++e) o[e] = tb2[(8 * ch + e) * 136 + 64 * which + d];
                        *(h8*)((which ? VWT : VST) + ((size_t)(b * 64 + chunk) * 64 + d) * 64 + 8 * ch) = o; }
                }
                __syncthreads();
            }
#ifndef SKIP_P2CMP
            for (int rp = 0; rp < REP_P2CMP; ++rp)
            for (int ui = bid; ui < 256; ui += G) {
                int tid = threadIdx.x; asm volatile("" : "+v"(tid)); const int lane = tid & 63, r16 = lane & 15, kq = lane >> 4;
                const int net = ui >> 7, b = (ui >> 4) & 7, n0 = (ui & 15) * 16;
                const size_t tokb = (size_t)b * SEQ;
                LAS half_t* zt = (LAS half_t*)lds;
                LAS float* w2s = (LAS float*)(lds + 39424);
                LAS float* hidb = (LAS float*)(lds + 39424 + 32768);
                {
                    const half_t* zsrc = Z + (tokb + 16 * n0) * NZP + (net ? ZC_VC : ZC_KC);
                    for (int e = tid; e < 272 * 8; e += NTHR) { const int tk = e >> 3, c8 = e & 7; int tt = 16 * n0 + tk; const int tcl = tt > SEQ - 1 ? SEQ - 1 - 16 * n0 : tk;
                        *(LAS h8*)(zt + tk * 72 + 8 * c8) = *(const h8*)(zsrc + (size_t)tcl * NZP + 8 * c8); }
                    const float* w2g = P.nsa_cmp_w2 + (size_t)(L * 2 + net) * 128 * 64;
                    for (int e = tid; e < 128 * 16; e += NTHR) *(LAS f32x4*)(w2s + 4 * e) = *(const f32x4*)(w2g + 4 * e);
                }
                const half_t* w1t = W1T + ((size_t)((L * 2 + net) * 128 + 16 * wave + r16)) * 2048 + 8 * kq;
                h8 bf[16];
#pragma unroll
                for (int s = 0; s < 16; ++s) bf[s] = *(const h8*)(w1t + 32 * s);
                __syncthreads();
                {
                    f32x4 c0 = {0.f, 0.f, 0.f, 0.f}, c1 = {0.f, 0.f, 0.f, 0.f};
                    const LAS half_t* za = zt + (16 * r16) * 72 + 8 * kq;
#pragma unroll
                    for (int qd = 0; qd < 4; ++qd) {
                        h8 bn[16];
                        if (qd < 3) {
#pragma unroll
                            for (int s = 0; s < 16; ++s) bn[s] = *(const h8*)(w1t + 32 * (16 * (qd + 1) + s));
                        }
#pragma unroll
                        for (int s = 0; s < 16; s += 2) { const int sg = 16 * qd + s;
                            c0 = MFMA16(*(const LAS h8*)(za + (sg >> 1) * 72), bf[s], c0);
                            c1 = MFMA16(*(const LAS h8*)(za + (sg >> 1) * 72 + 32), bf[s + 1], c1); }
                        if (qd < 3) {
#pragma unroll
                            for (int s = 0; s < 16; ++s) bf[s] = bn[s];
                        }
                    }
                    const int m = 16 * wave + r16; const int cbi = (L * 2 + net) * 128 + m; const float cbm = ((CB[cbi] + CB[512 + cbi]) + CB[1024 + cbi]) + CB[1536 + cbi];
#pragma unroll
                    for (int rg = 0; rg < 4; ++rg) hidb[(4 * kq + rg) * 132 + m] = gelu_tanh((c0[rg] + c1[rg]) + cbm);
                }
                __syncthreads();
                {
                    const int d = lane;
                    float o0 = 0.f, o1 = 0.f; const LAS float* hp = hidb + (2 * wave) * 132;
#pragma unroll 16
                    for (int m = 0; m < 128; ++m) { const float w = w2s[m * 64 + d]; o0 = fmaf(hp[m], w, o0); o1 = fmaf(hp[132 + m], w, o1); }
                    float ov[2] = {o0, o1};
#pragma unroll
                    for (int i = 0; i < 2; ++i) { float o = ov[i]; const int n = n0 + 2 * wave + i;
                        if (net == 0) { const float ss = wave_sum(o * o); o = o * rsqrtf(ss * (1.f / 64.f) + EPS) * P.nsa_qk_norm[(L * 4 + 1) * 64 + d]; }
                        if (n >= NCMP) o = 0.f;
                        if (net == 0) KCH[((size_t)b * 256 + n) * 64 + d] = (half_t)o; else VCT[((size_t)b * 64 + d) * 256 + n] = (half_t)o; }
                }
                __syncthreads();
            }
#endif
#ifndef SKIP_P2LRU
            for (;;) { const int ui = q_next(ctl + CW_Q + (L * 4 + 3) * 8 * 64, MISC + 20); if (ui >= 1024) break;
                float hc = 0.f; lru_unit<false>(P, L, ui, lds, Z, WGT, CB + 2048, LRUAGG, LRUA, LRUB, MIXED, wave, hc, true); }
#endif
        }
        xcd_barrier(bar);

        {
        SECTION_ENV();
#ifndef SKIP_NSA
        if (wave == 0) {
            int tidf = threadIdx.x; asm volatile("" : "+v"(tidf));
            float gq = fabsf(P.nsa_qk_norm[(L * 4 + 0) * 64 + tidf]), gk = fmaxf(fmaxf(fabsf(P.nsa_qk_norm[(L * 4 + 1) * 64 + tidf]), fabsf(P.nsa_qk_norm[(L * 4 + 2) * 64 + tidf])), fabsf(P.nsa_qk_norm[(L * 4 + 3) * 64 + tidf]));
            float rb = fmaxf(fabsf(P.rel_bias[tidf]), fabsf(P.rel_bias[64 + tidf]));
#pragma unroll
            for (int o = 1; o < 64; o <<= 1) { gq = fmaxf(gq, __shfl_xor(gq, o)); gk = fmaxf(gk, __shfl_xor(gk, o)); rb = fmaxf(rb, __shfl_xor(rb, o)); }
            if (tidf == 0) MISC[16] = ((8.f * gq * gk + 2.f * rb) * LOG2E <= 15.8f) ? 1u : 0u;
        }
        __syncthreads();
        const bool nsa_fast = __builtin_amdgcn_readfirstlane((int)MISC[16]) != 0;
        if (nsa_fast)
        for (;;) {
            const int ui = q_next(ctl + CW_Q + ((L * 4 + 0) * 8 + (bid & 7)) * 64, MISC + 20); if (ui >= 64) break;
            int tid = threadIdx.x; asm volatile("" : "+v"(tid)); const int lane = tid & 63, hb = lane >> 5, qi = lane & 31;
            const int h = wave & 3, rh = wave >> 2;
            const int b = bid & 7, qt = 63 - ui, t0 = qt * 64, t = t0 + 32 * rh + qi, cur = qt, row = 32 * rh + qi;
            const size_t tokb = (size_t)b * SEQ;
            constexpr int NS_VT = 9216, NS_STAGE = 18432, NF_TRX = 36864, NF_IMP = NF_TRX + 4 * 520 * 4, NF_SELM = NF_IMP + 4 * 64 * 65 * 4, NF_EX = NF_SELM + 512, NF_STL = NF_EX + 1024, NF_MISC = NF_STL + 1024;
            static_assert(NF_MISC + 256 <= RING_BYTES, "NSA fast LDS map");
            LAS float* TRX = (LAS float*)(lds + NF_TRX); LAS float* impH = (LAS float*)(lds + NF_IMP); LAS unsigned* selm = (LAS unsigned*)(lds + NF_SELM);
            LAS float* ex = (LAS float*)(lds + NF_EX); LAS float* stl = (LAS float*)(lds + NF_STL); LAS unsigned* misc = (LAS unsigned*)(lds + NF_MISC);
            for (int e = tid; e < 4 * 520; e += NTHR) { const int hh = e / 520, i = e % 520, d = i - 1;
                TRX[e] = (i == 0 || i > 512) ? -INFINITY : (P.rel_bias[(d < 128 ? (int)c_bucket[d] : 31) * 4 + hh] - P.rel_bias[31 * 4 + hh]) * LOG2E; }
            for (int e = tid; e < 4 * 64 * 65; e += NTHR) impH[e] = 0.f;
            const LAS float* TXh = TRX + h * 520;
            h8 q[4];
#pragma unroll
            for (int kk = 0; kk < 4; ++kk) q[kk] = *(const h8*)(Z + (tokb + t) * NZP + ZC_NSA_Q + 64 * h + 16 * kk + 8 * hb);
            const float* gb = P.nsa_gate_bias + L * 12;
            const half_t* gz = Z + (tokb + t) * NZP + ZC_NSA_G;
            f32x16 T0, T1;
            u32x4 kr, vr, krB, vrB;
#define NS_ISSUE_R(KR, VR, kbase_, kstride_, vbase_, vstride_) do { KR = *(const u32x4*)((const char*)(kbase_) + (size_t)(tid >> 3) * (kstride_) + (tid & 7) * 16); \
                VR = *(const u32x4*)((const char*)(vbase_) + (size_t)(tid >> 3) * (vstride_) + (tid & 7) * 16); } while (0)
#define NS_WRITE_R(KR, VR, sb_) do { *(LAS u32x4*)(lds + (sb_) + (tid >> 3) * 144 + (tid & 7) * 16) = KR; *(LAS u32x4*)(lds + (sb_) + NS_VT + (tid >> 3) * 144 + (tid & 7) * 16) = VR; } while (0)
            {
                int cnt = (t0 + 63 - 31) / 16 + 1; if (cnt > NCMP) cnt = NCMP;
                const int ntc = (cnt + 63) >> 6;
                const half_t* kcb = KCH + (size_t)b * 256 * 64; const half_t* vcb = VCT + (size_t)b * 64 * 256;
                float l = 0.f;
#pragma unroll
                for (int r = 0; r < 16; ++r) { T0[r] = 0.f; T1[r] = 0.f; }
                for (int c = 0; c < ntc; ++c) {
                    __syncthreads();
                    NS_ISSUE_R(kr, vr, kcb + (size_t)c * 64 * 64, 128, vcb + c * 64, 512); NS_WRITE_R(kr, vr, 0);
                    __syncthreads();
                    f32x16 S0, S1; init_tab(S0, S1, TXh, t - 31 - 1024 * c, hb, 16, 511, true);
                    qk64(S0, S1, q, lds, qi, hb);
                    l += exp_sum64(S0, S1);
                    LAS float* ip = impH + (h * 64 + row) * 65 + 16 * c + 2 * hb;
#pragma unroll
                    for (int g = 0; g < 4; ++g) {
                        const int mo = 4 * (g >> 1) + (g & 1);
                        { const float v1 = 16.f * S0[4 * g + 3], v0 = 32.f * ((S0[4 * g] + S0[4 * g + 1]) + S0[4 * g + 2]) + v1;
                          __hip_atomic_fetch_add(ip + mo, v0, __ATOMIC_RELAXED, __HIP_MEMORY_SCOPE_WORKGROUP); if (16 * c + 2 * hb + mo + 1 < 64) __hip_atomic_fetch_add(ip + mo + 1, v1, __ATOMIC_RELAXED, __HIP_MEMORY_SCOPE_WORKGROUP); }
                        { const float v1 = 16.f * S1[4 * g + 3], v0 = 32.f * ((S1[4 * g] + S1[4 * g + 1]) + S1[4 * g + 2]) + v1;
                          __hip_atomic_fetch_add(ip + 8 + mo, v0, __ATOMIC_RELAXED, __HIP_MEMORY_SCOPE_WORKGROUP); if (16 * c + 2 * hb + 8 + mo + 1 < 64) __hip_atomic_fetch_add(ip + 8 + mo + 1, v1, __ATOMIC_RELAXED, __HIP_MEMORY_SCOPE_WORKGROUP); }
                    }
                    pv64m(S0, S1, true, lds + NS_VT, T0, T1, qi, hb);
                }
                l += __shfl_xor(l, 32);
                const float il = l > 0.f ? __builtin_amdgcn_rcpf(l) : 0.f;
                if (hb == 0) stl[row * 4 + h] = il;
                const float g0 = sigmoidf_((float)gz[0 * 4 + h] + gb[0 * 4 + h]) * il;
#pragma unroll
                for (int r = 0; r < 16; ++r) { T0[r] *= g0; T1[r] *= g0; }
            }
            __syncthreads();
            for (int rpQ = 0; rpQ < REP_NSELECT; ++rpQ)
            for (int rr = 0; rr < 8; ++rr) {
                const int rw = wave * 8 + rr;
                float v = ((impH[(0 * 64 + rw) * 65 + lane] * stl[rw * 4 + 0] + impH[(1 * 64 + rw) * 65 + lane] * stl[rw * 4 + 1]) + impH[(2 * 64 + rw) * 65 + lane] * stl[rw * 4 + 2]) + impH[(3 * 64 + rw) * 65 + lane] * stl[rw * 4 + 3];
                if (lane > cur) v = -INFINITY; else if (lane == 0 || lane == cur || lane == cur - 1) v = 1e30f;
                int rank = 0;
#pragma unroll
                for (int o = 0; o < 64; ++o) { const float w = __builtin_bit_cast(float, __builtin_amdgcn_readlane(__builtin_bit_cast(int, v), o)); rank += (w > v || (w == v && o < lane)) ? 1 : 0; }
                const unsigned long long msk = __ballot(rank < 16);
                if (lane == 0) { selm[rw * 2] = (unsigned)msk; selm[rw * 2 + 1] = (unsigned)(msk >> 32); }
            }
            __syncthreads();
            if (wave == 0) {
                unsigned lo = selm[lane * 2], hi = selm[lane * 2 + 1];
#pragma unroll
                for (int o = 1; o < 64; o <<= 1) { lo |= __shfl_xor(lo, o); hi |= __shfl_xor(hi, o); }
                if (lane == 0) { misc[0] = lo; misc[1] = hi; }
            }
            __syncthreads();
            const unsigned long long mymask = (unsigned long long)selm[row * 2] | ((unsigned long long)selm[row * 2 + 1] << 32);
            unsigned long long um = (unsigned long long)(unsigned)__builtin_amdgcn_readfirstlane((int)misc[0]) | ((unsigned long long)(unsigned)__builtin_amdgcn_readfirstlane((int)misc[1]) << 32);
            um &= (cur >= 63) ? ~0ull : ((1ull << (cur + 1)) - 1ull);
            const unsigned long long um_all = um;
            for (int rpS = 0; rpS < REP_NSEL; ++rpS) {
                um = um_all; if (rpS) __syncthreads();
                f32x16 O0, O1;
#pragma unroll
                for (int r = 0; r < 16; ++r) { O0[r] = 0.f; O1[r] = 0.f; }
                float l = 0.f;
                int jc = __builtin_ctzll(um); um &= um - 1;
                int jn = -1; if (um) { jn = __builtin_ctzll(um); um &= um - 1; }
                int it = 0;
#define SEL_K(j_) (Z + (tokb + 64 * (j_)) * NZP + ZC_KS)
#define SEL_V(j_) (VST + (size_t)(b * 64 + (j_)) * 64 * 64)
                NS_ISSUE_R(kr, vr, SEL_K(jc), NZP * 2, SEL_V(jc), 128); NS_WRITE_R(kr, vr, 0);
                { const int je = jn >= 0 ? jn : jc; NS_ISSUE_R(kr, vr, SEL_K(je), NZP * 2, SEL_V(je), 128); }
                __syncthreads();
#define SEL_BODY(KX, VX, KY, VY) do { \
                    int jnn = -1; if (um) { jnn = __builtin_ctzll(um); um &= um - 1; } \
                    { const int je = jnn >= 0 ? jnn : jc; NS_ISSUE_R(KY, VY, SEL_K(je), NZP * 2, SEL_V(je), 128); } \
                    { const bool sel = (mymask >> jc) & 1ull; \
                      if (__any(sel)) { f32x16 S0, S1; const LAS unsigned char* st_ = lds + (it & 1) * NS_STAGE; \
                          if (jc >= cur - 2) { init_tab(S0, S1, TXh, t - 64 * jc, hb, 1, 511, sel); qk64(S0, S1, q, st_, qi, hb); } else qk64z(S0, S1, q, st_, qi, hb); \
                          const float ps_ = exp_sum64(S0, S1); l += sel ? ps_ : 0.f; \
                          pv64m(S0, S1, sel, st_ + NS_VT, O0, O1, qi, hb); } } \
                    if (jn >= 0) NS_WRITE_R(KX, VX, ((it + 1) & 1) * NS_STAGE); \
                    __syncthreads(); jc = jn; jn = jnn; ++it; } while (0)
                for (;;) { SEL_BODY(kr, vr, krB, vrB); if (jc < 0) break; SEL_BODY(krB, vrB, kr, vr); if (jc < 0) break; }
#undef SEL_BODY
#undef SEL_K
#undef SEL_V
                l += __shfl_xor(l, 32);
                const float g1 = sigmoidf_((float)gz[1 * 4 + h] + gb[1 * 4 + h]) * __builtin_amdgcn_rcpf(l);
                if (rpS == REP_NSEL - 1) {
#pragma unroll
                for (int r = 0; r < 16; ++r) { T0[r] += g1 * O0[r]; T1[r] += g1 * O1[r]; } }
            }
            __syncthreads();
            for (int rpW = 0; rpW < REP_NWIN; ++rpW) {
                if (rpW) __syncthreads();
                f32x16 O0, O1;
#pragma unroll
                for (int r = 0; r < 16; ++r) { O0[r] = 0.f; O1[r] = 0.f; }
                float l = 0.f;
                const int jlo = cur >= 8 ? cur - 8 : 0;
#define WIN_K(j_) (Z + (tokb + 64 * (j_)) * NZP + ZC_KW)
#define WIN_V(j_) (VWT + (size_t)(b * 64 + (j_)) * 64 * 64)
                NS_ISSUE_R(kr, vr, WIN_K(jlo), NZP * 2, WIN_V(jlo), 128); NS_WRITE_R(kr, vr, 0);
                { const int je = jlo + 1 <= cur ? jlo + 1 : cur; NS_ISSUE_R(kr, vr, WIN_K(je), NZP * 2, WIN_V(je), 128); }
                __syncthreads();
                int j = jlo;
#define WIN_BODY(KX, VX, KY, VY) do { \
                    { const int je = j + 2 <= cur ? j + 2 : cur; NS_ISSUE_R(KY, VY, WIN_K(je), NZP * 2, WIN_V(je), 128); } \
                    { f32x16 S0, S1; const LAS unsigned char* st_ = lds + ((j - jlo) & 1) * NS_STAGE; \
                      if (j >= cur - 2 || j == cur - 8) { init_tab(S0, S1, TXh, t - 64 * j, hb, 1, 512, true); qk64(S0, S1, q, st_, qi, hb); } else qk64z(S0, S1, q, st_, qi, hb); \
                      l += exp_sum64(S0, S1); \
                      pv64m(S0, S1, true, st_ + NS_VT, O0, O1, qi, hb); } \
                    if (j + 1 <= cur) NS_WRITE_R(KX, VX, (((j - jlo) + 1) & 1) * NS_STAGE); \
                    __syncthreads(); ++j; } while (0)
                for (;;) { WIN_BODY(kr, vr, krB, vrB); if (j > cur) break; WIN_BODY(krB, vrB, kr, vr); if (j > cur) break; }
#undef WIN_BODY
#undef WIN_K
#undef WIN_V
                l += __shfl_xor(l, 32);
                const float g2 = sigmoidf_((float)gz[2 * 4 + h] + gb[2 * 4 + h]) * __builtin_amdgcn_rcpf(l);
                if (rpW == REP_NWIN - 1) {
#pragma unroll
                for (int r = 0; r < 16; ++r) { T0[r] += g2 * O0[r]; T1[r] += g2 * O1[r]; } }
            }
#undef NS_ISSUE_R
#undef NS_WRITE_R
            {
                float ss = 0.f;
#pragma unroll
                for (int r = 0; r < 16; ++r) ss += T0[r] * T0[r] + T1[r] * T1[r];
                ss += __shfl_xor(ss, 32);
                if (hb == 0) ex[row * 4 + h] = ss;
                __syncthreads();
                const float rs = rsqrtf((ex[row * 4] + ex[row * 4 + 1] + ex[row * 4 + 2] + ex[row * 4 + 3]) * (1.f / 256.f) + EPS);
                const float* gn = P.out_norm + (L * 4 + 3) * 256 + h * 64;
                half_t* op = MIXED + (tokb + t) * D + 768 + h * 64;
#pragma unroll
                for (int g = 0; g < 4; ++g) {
                    const int d0 = 8 * g + 4 * hb; const f32x4 g0 = *(const f32x4*)(gn + d0), g1 = *(const f32x4*)(gn + 32 + d0);
                    u32x2 o0, o1;
                    o0.x = pack_h2(T0[4 * g] * rs * g0.x, T0[4 * g + 1] * rs * g0.y); o0.y = pack_h2(T0[4 * g + 2] * rs * g0.z, T0[4 * g + 3] * rs * g0.w);
                    o1.x = pack_h2(T1[4 * g] * rs * g1.x, T1[4 * g + 1] * rs * g1.y); o1.y = pack_h2(T1[4 * g + 2] * rs * g1.z, T1[4 * g + 3] * rs * g1.w);
                    *(u32x2*)(op + d0) = o0; *(u32x2*)(op + 32 + d0) = o1;
                }
            }
            __syncthreads();
        }
        else
        for (;;) {
            const int ui = q_next(ctl + CW_Q + ((L * 4 + 0) * 8 + (bid & 7)) * 64, MISC + 20); if (ui >= 64) break;
            int tid = threadIdx.x; asm volatile("" : "+v"(tid)); const int lane = tid & 63, hb = lane >> 5, qi = lane & 31;
            const int h = wave & 3, rh = wave >> 2;
            const int b = bid & 7, qt = 63 - ui, t0 = qt * 64, t = t0 + 32 * rh + qi, cur = qt, row = 32 * rh + qi;
            const size_t tokb = (size_t)b * SEQ;
            constexpr int NS_VT = 9216, NS_STAGE = 18432, NS_TR = 36864, NS_IMP = 38976, NS_SELM = NS_IMP + 4 * 64 * 65 * 4, NS_EX = NS_SELM + 512, NS_MISC = NS_EX + 1024;
            static_assert(NS_MISC + 256 <= RING_BYTES, "NSA LDS map");
            LAS float* TR = (LAS float*)(lds + NS_TR); LAS float* impH = (LAS float*)(lds + NS_IMP); LAS unsigned* selm = (LAS unsigned*)(lds + NS_SELM);
            LAS float* ex = (LAS float*)(lds + NS_EX); LAS unsigned* misc = (LAS unsigned*)(lds + NS_MISC);
            for (int e = tid; e < 4 * 129; e += NTHR) { const int hh = e / 129, d = e % 129; TR[hh * 132 + d] = P.rel_bias[(d < 128 ? (int)c_bucket[d] : 31) * 4 + hh] * LOG2E; }
            for (int e = tid; e < 4 * 64 * 65; e += NTHR) impH[e] = 0.f;
            const LAS float* TRh = TR + h * 132;
            h8 q[4];
#pragma unroll
            for (int kk = 0; kk < 4; ++kk) q[kk] = *(const h8*)(Z + (tokb + t) * NZP + ZC_NSA_Q + 64 * h + 16 * kk + 8 * hb);
            const float* gb = P.nsa_gate_bias + L * 12;
            const half_t* gz = Z + (tokb + t) * NZP + ZC_NSA_G;
            f32x16 T0, T1;
            u32x4 kr, vr, krB, vrB;
#define NS_ISSUE_R(KR, VR, kbase_, kstride_, vbase_, vstride_) do { KR = *(const u32x4*)((const char*)(kbase_) + (size_t)(tid >> 3) * (kstride_) + (tid & 7) * 16); \
                VR = *(const u32x4*)((const char*)(vbase_) + (size_t)(tid >> 3) * (vstride_) + (tid & 7) * 16); } while (0)
#define NS_WRITE_R(KR, VR, sb_) do { *(LAS u32x4*)(lds + (sb_) + (tid >> 3) * 144 + (tid & 7) * 16) = KR; *(LAS u32x4*)(lds + (sb_) + NS_VT + (tid >> 3) * 144 + (tid & 7) * 16) = VR; } while (0)
#define NS_ISSUE(kbase_, kstride_, vbase_, vstride_) do { kr = *(const u32x4*)((const char*)(kbase_) + (size_t)(tid >> 3) * (kstride_) + (tid & 7) * 16); \
                vr = *(const u32x4*)((const char*)(vbase_) + (size_t)(tid >> 3) * (vstride_) + (tid & 7) * 16); } while (0)
#define NS_WRITE(sb_) do { *(LAS u32x4*)(lds + (sb_) + (tid >> 3) * 144 + (tid & 7) * 16) = kr; *(LAS u32x4*)(lds + (sb_) + NS_VT + (tid >> 3) * 144 + (tid & 7) * 16) = vr; } while (0)
            {
                int cnt = (t0 + 63 - 31) / 16 + 1; if (cnt > NCMP) cnt = NCMP;
                const int ntc = (cnt + 63) >> 6;
                const half_t* kcb = KCH + (size_t)b * 256 * 64; const half_t* vcb = VCT + (size_t)b * 64 * 256;
                float m = -1e30f, l = 0.f;
                for (int c = 0; c < ntc; ++c) {
                    __syncthreads();
                    NS_ISSUE(kcb + (size_t)c * 64 * 64, 128, vcb + c * 64, 512); NS_WRITE(0);
                    __syncthreads();
                    f32x16 S0, S1; init_near(S0, S1, TRh, t - 31 - 1024 * c, hb, 16, 1 << 30);
                    qk64(S0, S1, q, lds, qi, hb);
                    const float mn = fmaxf(m, rowmax64(S0, S1)), alpha = __builtin_amdgcn_exp2f(m - mn);
                    m = mn; float ps = 0.f;
#pragma unroll
                    for (int r = 0; r < 16; ++r) ps += __builtin_amdgcn_exp2f(S0[r] - mn) + __builtin_amdgcn_exp2f(S1[r] - mn);
                    l = l * alpha + ps;
                }
                l += __shfl_xor(l, 32);
                const float il = l > 0.f ? __builtin_amdgcn_rcpf(l) : 0.f;
#pragma unroll
                for (int r = 0; r < 16; ++r) { T0[r] = 0.f; T1[r] = 0.f; }
                for (int c = 0; c < ntc; ++c) {
                    __syncthreads();
                    NS_ISSUE(kcb + (size_t)c * 64 * 64, 128, vcb + c * 64, 512); NS_WRITE(0);
                    __syncthreads();
                    f32x16 S0, S1; init_near(S0, S1, TRh, t - 31 - 1024 * c, hb, 16, 1 << 30);
                    qk64(S0, S1, q, lds, qi, hb);
#pragma unroll
                    for (int r = 0; r < 16; ++r) { S0[r] = __builtin_amdgcn_exp2f(S0[r] - m) * il; S1[r] = __builtin_amdgcn_exp2f(S1[r] - m) * il; }
                    LAS float* ip = impH + (h * 64 + row) * 65 + 16 * c + 2 * hb;
#pragma unroll
                    for (int g = 0; g < 4; ++g) {
                        const int mo = 4 * (g >> 1) + (g & 1);
                        { const float v1 = 16.f * S0[4 * g + 3], v0 = 32.f * ((S0[4 * g] + S0[4 * g + 1]) + S0[4 * g + 2]) + v1;
                          __hip_atomic_fetch_add(ip + mo, v0, __ATOMIC_RELAXED, __HIP_MEMORY_SCOPE_WORKGROUP); if (16 * c + 2 * hb + mo + 1 < 64) __hip_atomic_fetch_add(ip + mo + 1, v1, __ATOMIC_RELAXED, __HIP_MEMORY_SCOPE_WORKGROUP); }
                        { const float v1 = 16.f * S1[4 * g + 3], v0 = 32.f * ((S1[4 * g] + S1[4 * g + 1]) + S1[4 * g + 2]) + v1;
                          __hip_atomic_fetch_add(ip + 8 + mo, v0, __ATOMIC_RELAXED, __HIP_MEMORY_SCOPE_WORKGROUP); if (16 * c + 2 * hb + 8 + mo + 1 < 64) __hip_atomic_fetch_add(ip + 8 + mo + 1, v1, __ATOMIC_RELAXED, __HIP_MEMORY_SCOPE_WORKGROUP); }
                    }
                    pv64(S0, S1, lds + NS_VT, T0, T1, qi, hb);
                }
                const float g0 = sigmoidf_((float)gz[0 * 4 + h] + gb[0 * 4 + h]);
#pragma unroll
                for (int r = 0; r < 16; ++r) { T0[r] *= g0; T1[r] *= g0; }
            }
            __syncthreads();
            for (int rr = 0; rr < 8; ++rr) {
                const int rw = wave * 8 + rr;
                float v = ((impH[(0 * 64 + rw) * 65 + lane] + impH[(1 * 64 + rw) * 65 + lane]) + impH[(2 * 64 + rw) * 65 + lane]) + impH[(3 * 64 + rw) * 65 + lane];
                if (lane > cur) v = -INFINITY; else if (lane == 0 || lane == cur || lane == cur - 1) v = 1e30f;
                int rank = 0;
#pragma unroll
                for (int o = 0; o < 64; ++o) { const float w = __builtin_bit_cast(float, __builtin_amdgcn_readlane(__builtin_bit_cast(int, v), o)); rank += (w > v || (w == v && o < lane)) ? 1 : 0; }
                const unsigned long long msk = __ballot(rank < 16);
                if (lane == 0) { selm[rw * 2] = (unsigned)msk; selm[rw * 2 + 1] = (unsigned)(msk >> 32); }
            }
            __syncthreads();
            if (wave == 0) {
                unsigned lo = selm[lane * 2], hi = selm[lane * 2 + 1];
#pragma unroll
                for (int o = 1; o < 64; o <<= 1) { lo |= __shfl_xor(lo, o); hi |= __shfl_xor(hi, o); }
                if (lane == 0) { misc[0] = lo; misc[1] = hi; }
            }
            __syncthreads();
            const unsigned long long mymask = (unsigned long long)selm[row * 2] | ((unsigned long long)selm[row * 2 + 1] << 32);
            unsigned long long um = (unsigned long long)__builtin_amdgcn_readfirstlane((int)misc[0]) | ((unsigned long long)(unsigned)__builtin_amdgcn_readfirstlane((int)misc[1]) << 32);
            um &= (cur >= 63) ? ~0ull : ((1ull << (cur + 1)) - 1ull);
            const float cfar = TRh[128];
            {
                f32x16 O0, O1;
#pragma unroll
                for (int r = 0; r < 16; ++r) { O0[r] = 0.f; O1[r] = 0.f; }
                float m = -1e30f, l = 0.f;
                int jc = __builtin_ctzll(um); um &= um - 1;
                int jn = -1; if (um) { jn = __builtin_ctzll(um); um &= um - 1; }
                int it = 0;
#define SEL_K(j_) (Z + (tokb + 64 * (j_)) * NZP + ZC_KS)
#define SEL_V(j_) (VST + (size_t)(b * 64 + (j_)) * 64 * 64)
                NS_ISSUE_R(kr, vr, SEL_K(jc), NZP * 2, SEL_V(jc), 128); NS_WRITE_R(kr, vr, 0);
                { const int je = jn >= 0 ? jn : jc; NS_ISSUE_R(kr, vr, SEL_K(je), NZP * 2, SEL_V(je), 128); }
                __syncthreads();
#define SEL_BODY(KX, VX, KY, VY) do { \
                    int jnn = -1; if (um) { jnn = __builtin_ctzll(um); um &= um - 1; } \
                    { const int je = jnn >= 0 ? jnn : jc; NS_ISSUE_R(KY, VY, SEL_K(je), NZP * 2, SEL_V(je), 128); } \
                    { const bool sel = (mymask >> jc) & 1ull; \
                      if (__any(sel)) nsa_tile(jc >= cur - 2, t - 64 * jc, sel ? (1 << 30) : 0, sel ? cfar : -INFINITY, TRh, q, lds + (it & 1) * NS_STAGE, m, l, O0, O1, qi, hb); } \
                    if (jn >= 0) NS_WRITE_R(KX, VX, ((it + 1) & 1) * NS_STAGE); \
                    __syncthreads(); jc = jn; jn = jnn; ++it; } while (0)
                for (;;) { SEL_BODY(kr, vr, krB, vrB); if (jc < 0) break; SEL_BODY(krB, vrB, kr, vr); if (jc < 0) break; }
#undef SEL_BODY
#undef SEL_K
#undef SEL_V
                l += __shfl_xor(l, 32);
                const float g1 = sigmoidf_((float)gz[1 * 4 + h] + gb[1 * 4 + h]) * __builtin_amdgcn_rcpf(l);
#pragma unroll
                for (int r = 0; r < 16; ++r) { T0[r] += g1 * O0[r]; T1[r] += g1 * O1[r]; }
            }
            __syncthreads();
            {
                f32x16 O0, O1;
#pragma unroll
                for (int r = 0; r < 16; ++r) { O0[r] = 0.f; O1[r] = 0.f; }
                float m = -1e30f, l = 0.f;
                const int jlo = cur >= 8 ? cur - 8 : 0;
#define WIN_K(j_) (Z + (tokb + 64 * (j_)) * NZP + ZC_KW)
#define WIN_V(j_) (VWT + (size_t)(b * 64 + (j_)) * 64 * 64)
                NS_ISSUE_R(kr, vr, WIN_K(jlo), NZP * 2, WIN_V(jlo), 128); NS_WRITE_R(kr, vr, 0);
                { const int je = jlo + 1 <= cur ? jlo + 1 : cur; NS_ISSUE_R(kr, vr, WIN_K(je), NZP * 2, WIN_V(je), 128); }
                __syncthreads();
                int j = jlo;
#define WIN_BODY(KX, VX, KY, VY) do { \
                    { const int je = j + 2 <= cur ? j + 2 : cur; NS_ISSUE_R(KY, VY, WIN_K(je), NZP * 2, WIN_V(je), 128); } \
                    nsa_tile(j >= cur - 2 || j == cur - 8, t - 64 * j, 512, cfar, TRh, q, lds + ((j - jlo) & 1) * NS_STAGE, m, l, O0, O1, qi, hb); \
                    if (j + 1 <= cur) NS_WRITE_R(KX, VX, (((j - jlo) + 1) & 1) * NS_STAGE); \
                    __syncthreads(); ++j; } while (0)
                for (;;) { WIN_BODY(kr, vr, krB, vrB); if (j > cur) break; WIN_BODY(krB, vrB, kr, vr); if (j > cur) break; }
#undef WIN_BODY
#undef WIN_K
#undef WIN_V
                l += __shfl_xor(l, 32);
                const float g2 = sigmoidf_((float)gz[2 * 4 + h] + gb[2 * 4 + h]) * __builtin_amdgcn_rcpf(l);
#pragma unroll
                for (int r = 0; r < 16; ++r) { T0[r] += g2 * O0[r]; T1[r] += g2 * O1[r]; }
            }
#undef NS_ISSUE
#undef NS_WRITE
#undef NS_ISSUE_R
#undef NS_WRITE_R
            {
                float ss = 0.f;
#pragma unroll
                for (int r = 0; r < 16; ++r) ss += T0[r] * T0[r] + T1[r] * T1[r];
                ss += __shfl_xor(ss, 32);
                if (hb == 0) ex[row * 4 + h] = ss;
                __syncthreads();
                const float rs = rsqrtf((ex[row * 4] + ex[row * 4 + 1] + ex[row * 4 + 2] + ex[row * 4 + 3]) * (1.f / 256.f) + EPS);
                const float* gn = P.out_norm + (L * 4 + 3) * 256 + h * 64;
                half_t* op = MIXED + (tokb + t) * D + 768 + h * 64;
#pragma unroll
                for (int g = 0; g < 4; ++g) {
                    const int d0 = 8 * g + 4 * hb; const f32x4 g0 = *(const f32x4*)(gn + d0), g1 = *(const f32x4*)(gn + 32 + d0);
                    u32x2 o0, o1;
                    o0.x = pack_h2(T0[4 * g] * rs * g0.x, T0[4 * g + 1] * rs * g0.y); o0.y = pack_h2(T0[4 * g + 2] * rs * g0.z, T0[4 * g + 3] * rs * g0.w);
                    o1.x = pack_h2(T1[4 * g] * rs * g1.x, T1[4 * g + 1] * rs * g1.y); o1.y = pack_h2(T1[4 * g + 2] * rs * g1.z, T1[4 * g + 3] * rs * g1.w);
                    *(u32x2*)(op + d0) = o0; *(u32x2*)(op + 32 + d0) = o1;
                }
            }
            __syncthreads();
        }
#endif
#ifndef SKIP_FOX
        for (;;) {
            const int ui = q_next(ctl + CW_Q + ((L * 4 + 1) * 8 + (bid & 7)) * 64, MISC + 20); if (ui >= 64) break;
            int tid = threadIdx.x; asm volatile("" : "+v"(tid)); const int lane = tid & 63, hb = lane >> 5, qi = lane & 31;
            const int h = wave & 3, rh = wave >> 2;
            const int b = bid & 7, qt = 63 - ui, t0 = qt * 64, t = t0 + 32 * rh + qi;
            const size_t tokb = (size_t)b * SEQ;
            const float* cf = CFOX + (size_t)b * 4 * SEQ;
            constexpr int FX_VT = 18432, FX_CB = 38912, FX_STAGE = 39424, FX_EX = 2 * FX_STAGE, FX_MISC = FX_EX + 1024;
            LAS unsigned* misc = (LAS unsigned*)(lds + FX_MISC);
            if (wave == 0) {
                float gq = fabsf(P.fox_qk_norm[(L * 2 + 0) * 64 + lane]), gk = fabsf(P.fox_qk_norm[(L * 2 + 1) * 64 + lane]);
#pragma unroll
                for (int o = 1; o < 64; o <<= 1) { gq = fmaxf(gq, __shfl_xor(gq, o)); gk = fmaxf(gk, __shfl_xor(gk, o)); }
                const float bound = -(30.f + 16.f * gq * gk);
                const float sb2 = 8.f * gq * gk * LOG2E;
                if (lane == 0) { misc[1] = sb2 <= 15.8f ? 1u : 0u; misc[2] = __builtin_bit_cast(unsigned, 15.8f - sb2); }
                bool c0 = false, c1 = false;
#pragma unroll
                for (int hh = 0; hh < 4; ++hh) { const float cref = cf[hh * SEQ + t0];
                    const int e0 = 32 * lane + 31, e1 = 32 * (lane + 64) + 31;
                    c0 = c0 || (e0 >= t0) || (cref - cf[hh * SEQ + (e0 < SEQ ? e0 : SEQ - 1)] > bound);
                    c1 = c1 || (e1 >= t0) || (cref - cf[hh * SEQ + (e1 < SEQ ? e1 : SEQ - 1)] > bound); }
                const unsigned long long b0 = __ballot(c0), b1 = __ballot(c1);
                if (lane == 0) misc[0] = b0 ? (unsigned)__builtin_ctzll(b0) : 64u + (unsigned)__builtin_ctzll(b1);
            }
            __syncthreads();
            const int kt_lo = __builtin_amdgcn_readfirstlane((int)misc[0]), kt_hi = 2 * qt + 1;
            const bool fx_fast = __builtin_amdgcn_readfirstlane((int)misc[1]) != 0;
            const float fx_sh = __builtin_bit_cast(float, __builtin_amdgcn_readfirstlane((int)misc[2]));
            h8 q[4];
#pragma unroll
            for (int kk = 0; kk < 4; ++kk) q[kk] = *(const h8*)(Z + (tokb + t) * NZP + ZC_FOX_Q + 64 * h + 16 * kk + 8 * hb);
            f32x16 O0, O1;
#pragma unroll
            for (int r = 0; r < 16; ++r) { O0[r] = 0.f; O1[r] = 0.f; }
            float m = fx_fast ? -((cf[h * SEQ + t] - cf[h * SEQ + t0]) * LOG2E + fx_sh) : -1e30f, l = 0.f;
            u32x4 krA[2], vrA[2], krB[2], vrB[2]; float cbA = 0.f, cbB = 0.f;
            const float cref = cf[((tid >> 5) & 3) * SEQ + t0];
#define FX_ISSUE(KR, VR, CB, kt_) do { _Pragma("unroll") for (int i_ = 0; i_ < 2; ++i_) { const int p_ = tid + 512 * i_; \
                KR[i_] = *(const u32x4*)(Z + (tokb + 32 * (kt_) + (p_ >> 5)) * NZP + ZC_FOX_K + 8 * (p_ & 31)); \
                VR[i_] = *(const u32x4*)(FOXVT + ((size_t)(b * 128 + (kt_)) * 256 + (p_ >> 2)) * 32 + 8 * (p_ & 3)); } \
                CB = cf[((tid >> 5) & 3) * SEQ + 32 * (kt_) + (tid & 31)]; } while (0)
#define FX_WRITE(KR, VR, CB, sb_) do { _Pragma("unroll") for (int i_ = 0; i_ < 2; ++i_) { const int p_ = tid + 512 * i_; \
                *(LAS u32x4*)(lds + (sb_) + ((p_ & 31) >> 3) * 4608 + (p_ >> 5) * 144 + (p_ & 7) * 16) = KR[i_]; \
                *(LAS u32x4*)(lds + (sb_) + FX_VT + ((p_ >> 2) >> 6) * 5120 + ((p_ >> 2) & 63) * 80 + (p_ & 3) * 16) = VR[i_]; } \
                if (tid < 128) *(LAS float*)(lds + (sb_) + FX_CB + tid * 4) = (cref - CB) * LOG2E; } while (0)
            FX_ISSUE(krA, vrA, cbA, kt_lo); FX_WRITE(krA, vrA, cbA, (kt_lo & 1) * FX_STAGE);
            FX_ISSUE(krA, vrA, cbA, (kt_lo + 1 <= kt_hi ? kt_lo + 1 : kt_hi));
            __syncthreads();
            int kt = kt_lo;
#define FX_BODY(KX, VX, CX, KY, VY, CY) do { \
                FX_ISSUE(KY, VY, CY, (kt + 2 <= kt_hi ? kt + 2 : kt_hi)); \
                if (32 * kt <= t0 + 32 * rh + 31) { if (fx_fast) fox_tile<true>(lds + (kt & 1) * FX_STAGE, h, q, qi, hb, 32 * kt + 31 > t0 + 32 * rh, 32 * kt, t, m, l, O0, O1); \
                    else fox_tile<false>(lds + (kt & 1) * FX_STAGE, h, q, qi, hb, 32 * kt + 31 > t0 + 32 * rh, 32 * kt, t, m, l, O0, O1); } \
                if (kt + 1 <= kt_hi) FX_WRITE(KX, VX, CX, ((kt + 1) & 1) * FX_STAGE); \
                __syncthreads(); ++kt; } while (0)
            for (;;) { FX_BODY(krA, vrA, cbA, krB, vrB, cbB); if (kt > kt_hi) break; FX_BODY(krB, vrB, cbB, krA, vrA, cbA); if (kt > kt_hi) break; }
#undef FX_BODY
#undef FX_ISSUE
#undef FX_WRITE
            {
                l += __shfl_xor(l, 32);
                const float inv = __builtin_amdgcn_rcpf(l); float ss = 0.f;
#pragma unroll
                for (int r = 0; r < 16; ++r) { O0[r] *= inv; O1[r] *= inv; ss += O0[r] * O0[r] + O1[r] * O1[r]; }
                ss += __shfl_xor(ss, 32);
                LAS float* ex = (LAS float*)(lds + FX_EX);
                const int ridx = 32 * rh + qi;
                if (hb == 0) ex[ridx * 4 + h] = ss;
                __syncthreads();
                const float rs = rsqrtf((ex[ridx * 4] + ex[ridx * 4 + 1] + ex[ridx * 4 + 2] + ex[ridx * 4 + 3]) * (1.f / 256.f) + EPS);
                const float* gn = P.out_norm + (L * 4 + 2) * 256 + h * 64;
                half_t* op = MIXED + (tokb + t) * D + 512 + h * 64;
#pragma unroll
                for (int g = 0; g < 4; ++g) {
                    const int d0 = 8 * g + 4 * hb; const f32x4 g0 = *(const f32x4*)(gn + d0), g1 = *(const f32x4*)(gn + 32 + d0);
                    u32x2 o0, o1;
                    o0.x = pack_h2(O0[4 * g] * rs * g0.x, O0[4 * g + 1] * rs * g0.y); o0.y = pack_h2(O0[4 * g + 2] * rs * g0.z, O0[4 * g + 3] * rs * g0.w);
                    o1.x = pack_h2(O1[4 * g] * rs * g1.x, O1[4 * g + 1] * rs * g1.y); o1.y = pack_h2(O1[4 * g + 2] * rs * g1.z, O1[4 * g + 3] * rs * g1.w);
                    *(u32x2*)(op + d0) = o0; *(u32x2*)(op + 32 + d0) = o1;
                }
            }
            __syncthreads();
        }
#endif
#ifndef SKIP_LRU
        for (;;) {
            const int gI = q_next(ctl + CW_Q + ((L * 4 + 2) * 8 + (bid & 7)) * 64, MISC + 20); if (gI >= 64) break;
            float hc = 0.f;
            for (int k = 0; k < 2; ++k) lru_final(P, L, ((bid & 7) << 7) + 2 * gI + k, lds, Z, LRUAGG, LRUA, LRUB, MIXED, wave, hc, k == 0);
        }
#endif
        }
        xcd_barrier(bar);

#ifndef SKIP_G4
        {
            SECTION_ENV();
            pg8::Gemm g{MIXED, WOUT_T + (size_t)L * D * D, T, D, D}; pg8::StaticOrder S; S.init(T, D, G, bid);
            EpiRes E{L == 0 ? P.x : P.out, P.out, XH, SSQA};
            for (int rp = 0; rp < REP_G4N; ++rp) { EpiNull EN; pg8::gemm_phase<EpiNull, pg8::StaticOrder>(lds, g, S, EN); }
            pg8::gemm_phase<EpiRes, pg8::StaticOrder>(lds, g, S, E);
        }
#endif
        xcd_barrier(bar);
#ifndef SKIP_G5
        {
            SECTION_ENV();
            pg8::Gemm g{XH, WGU_T + (size_t)L * 2 * DFF * D, T, 2 * DFF, D}; pg8::StaticOrder S; S.init(T, 2 * DFF, G, bid);
            EpiSwiglu E{HB, SSQA};
            for (int rp = 0; rp < REP_G5; ++rp) pg8::gemm_phase<EpiSwiglu, pg8::StaticOrder>(lds, g, S, E);
        }
#endif
        xcd_barrier(bar);
#ifndef SKIP_G6
        {
            SECTION_ENV();
            pg8::Gemm g{HB, WDN_T + (size_t)L * D * DFF, T, D, DFF}; pg8::StaticOrder S; S.init(T, D, G, bid);
            EpiRes E{P.out, P.out, L == 0 ? XH : nullptr, L == 0 ? SSQB : nullptr};
            for (int rp = 0; rp < REP_G6N; ++rp) { EpiNull EN; pg8::gemm_phase<EpiNull, pg8::StaticOrder>(lds, g, S, EN); }
            pg8::gemm_phase<EpiRes, pg8::StaticOrder>(lds, g, S, E);
        }
#endif
        if (L == 0) xcd_barrier(bar);
    }
}

extern "C" void kernel_launch(void* const* d_in, const int* in_sizes, int n_in, void* d_out, int out_size, void* d_ws, size_t ws_size, hipStream_t stream) {
    static int grid = 0;
    if (grid == 0) {
        if (n_in != 22 || ws_size < WS_END) { fprintf(stderr, "kernel_launch: unexpected n_in %d or ws_size %zu (< %zu)\n", n_in, ws_size, (size_t)WS_END); grid = -1; return; }
        int dev = 0, cus = 0, per_cu = 0;
        if (hipGetDevice(&dev) != hipSuccess || hipDeviceGetAttribute(&cus, hipDeviceAttributeMultiprocessorCount, dev) != hipSuccess) { grid = -1; return; }
        if (hipFuncSetAttribute((const void*)hymba_fwd, hipFuncAttributeMaxDynamicSharedMemorySize, LDS_BYTES) != hipSuccess) { fprintf(stderr, "kernel_launch: hipFuncSetAttribute failed\n"); grid = -1; return; }
        if (hipOccupancyMaxActiveBlocksPerMultiprocessor(&per_cu, (const void*)hymba_fwd, NTHR, LDS_BYTES) != hipSuccess || per_cu < 1) { fprintf(stderr, "kernel_launch: occupancy query says %d\n", per_cu); }
        (void)hipGetLastError();
        grid = cus;
    }
    if (grid < 0) return;
    (void)hipMemsetAsync((char*)d_ws + WS_CTL, 0, CTL_ZERO_BYTES, stream);
    Params p{};
    p.x = (const float*)d_in[0]; p.norm_mix = (const float*)d_in[1]; p.w_in = (const float*)d_in[2]; p.lru_conv_w = (const float*)d_in[3]; p.lru_conv_b = (const float*)d_in[4];
    p.lru_w_gates = (const float*)d_in[5]; p.lru_b_gates = (const float*)d_in[6]; p.lru_lambda = (const float*)d_in[7]; p.sc_conv_w = (const float*)d_in[8];
    p.fox_f_bias = (const float*)d_in[9]; p.fox_qk_norm = (const float*)d_in[10]; p.nsa_qk_norm = (const float*)d_in[11]; p.nsa_cmp_pos = (const float*)d_in[12];
    p.nsa_cmp_w1 = (const float*)d_in[13]; p.nsa_cmp_w2 = (const float*)d_in[14]; p.nsa_gate_bias = (const float*)d_in[15]; p.rel_bias = (const float*)d_in[16];
    p.out_norm = (const float*)d_in[17]; p.w_out = (const float*)d_in[18]; p.norm_ffn = (const float*)d_in[19]; p.w_gate_up = (const float*)d_in[20]; p.w_down = (const float*)d_in[21];
    p.out = (float*)d_out; p.ws = (unsigned char*)d_ws;
    hipLaunchKernelGGL(hymba_fwd, dim3(grid), dim3(NTHR), LDS_BYTES, stream, p);
}
```

```cpp
#include <hip/hip_runtime.h>
#include <stdint.h>
#include <stdio.h>

#define LAS __attribute__((address_space(3)))
typedef _Float16 half_t;
typedef _Float16 h8 __attribute__((ext_vector_type(8)));
typedef _Float16 h4 __attribute__((ext_vector_type(4)));
typedef _Float16 h2 __attribute__((ext_vector_type(2)));
typedef float f32x4 __attribute__((ext_vector_type(4)));
typedef unsigned u32x4 __attribute__((ext_vector_type(4)));
typedef unsigned u32x2 __attribute__((ext_vector_type(2)));
typedef float f32x16 __attribute__((ext_vector_type(16)));
#define MFMA32(a, b, c) __builtin_amdgcn_mfma_f32_32x32x16_f16(a, b, c, 0, 0, 0)
constexpr float LOG2E = 1.4426950408889634f, QSCALE = 0.125f * 1.4426950408889634f;
__device__ __forceinline__ int pi16(int r) { return (r & ~0xC) | ((r & 4) << 1) | ((r & 8) >> 1); }

constexpr int BATCH = 8, SEQ = 4096, T = BATCH * SEQ, D = 1024, NZP = 2816, DFF = 2816, NCMP = 255;
constexpr int NIN_SRC = 2704;
constexpr int ZC_LRU_X = 0, ZC_LRU_G = 256, ZC_SC_B = 512, ZC_SC_C = 768, ZC_SC_X = 1024, ZC_FOX_Q = 1280, ZC_FOX_K = 1536, ZC_FOX_V = 1792,
              ZC_NSA_Q = 2048, ZC_KC = 2304, ZC_VC = 2368, ZC_KS = 2432, ZC_VS = 2496, ZC_KW = 2560, ZC_VW = 2624, ZC_FOX_F = 2688, ZC_NSA_G = 2692;
constexpr float EPS = 1e-6f;
constexpr int NWAVES = 8, NTHR = 512;
#ifndef REP_G1
#define REP_G1 1
#endif
#ifndef REP_P0
#define REP_P0 1
#endif
#ifndef REP_G4N
#define REP_G4N 0
#endif
#ifndef REP_G6N
#define REP_G6N 0
#endif
#ifndef NORM_DRY
#define NORM_DRY 0
#endif
#ifndef REP_NSEL
#define REP_NSEL 1
#endif
#ifndef REP_NWIN
#define REP_NWIN 1
#endif
#ifndef REP_NSELECT
#define REP_NSELECT 1
#endif
#ifndef REP_G5
#define REP_G5 1
#endif
#ifndef REP_CUM
#define REP_CUM 1
#endif
#ifndef REP_VT
#define REP_VT 1
#endif
#ifndef REP_P2LRU
#define REP_P2LRU 1
#endif
#ifndef REP_P2CMP
#define REP_P2CMP 1
#endif
#ifndef REP_FOX
#define REP_FOX 1
#endif
#ifndef REP_NSA
#define REP_NSA 1
#endif
#ifndef REP_LRU
#define REP_LRU 1
#endif

constexpr size_t MiB = 1u << 20;
constexpr size_t WS_CTL = 0, CTL_ZERO_BYTES = 64 * 1024;
constexpr size_t WS_SSQA = 2 * MiB, WS_SSQB = 4 * MiB, WS_CFOX = 6 * MiB, WS_KVC = 7 * MiB, WS_LRUAGG = 9 * MiB, WS_CB = 11 * MiB;
constexpr size_t WS_WIN = 12 * MiB, WS_WOUT = 24 * MiB, WS_WGU = 28 * MiB, WS_WDN = 50 * MiB;
constexpr size_t WS_XH = 62 * MiB, WS_MIXED = 126 * MiB, WS_Z = 190 * MiB, WS_YD = 366 * MiB, WS_FOXVT = 398 * MiB, WS_VST = 414 * MiB, WS_VWT = 418 * MiB, WS_KCH = 422 * MiB, WS_VCT = 423 * MiB, WS_W1T = 424 * MiB, WS_WGT = 426 * MiB, WS_LRUA = 427 * MiB, WS_LRUB = 459 * MiB, WS_END = 491 * MiB;
static_assert(WS_WIN + 2 * (size_t)NZP * D * 2 <= WS_WOUT && WS_WOUT + 2 * (size_t)D * D * 2 <= WS_WGU && WS_WGU + 2 * (size_t)2 * DFF * D * 2 <= WS_WDN &&
              WS_WDN + 2 * (size_t)D * DFF * 2 <= WS_XH && WS_XH + (size_t)T * D * 2 <= WS_MIXED && WS_MIXED + (size_t)T * D * 2 <= WS_Z &&
              WS_Z + (size_t)T * NZP * 2 <= WS_YD && WS_YD + (size_t)T * 256 * 4 <= WS_FOXVT && WS_FOXVT + (size_t)T * 256 * 2 <= WS_VST, "ws map");
constexpr int CW_BAR = 1024;

constexpr int RING_BYTES = 131072, MISC_OFF = RING_BYTES, LDS_BYTES = 147456;

__device__ __constant__ unsigned char c_bucket[128] = {
 0,1,2,3,4,5,6,7,8,9,10,11,12,13,14,15,
 16,16,16,17,17,18,18,18,19,19,19,20,20,20,20,21,
 21,21,21,22,22,22,22,22,23,23,23,23,23,23,24,24,
 24,24,24,24,25,25,25,25,25,25,25,26,26,26,26,26,
 26,26,26,27,27,27,27,27,27,27,27,27,27,28,28,28,
 28,28,28,28,28,28,28,29,29,29,29,29,29,29,29,29,
 29,29,29,30,30,30,30,30,30,30,30,30,30,30,30,30,
 30,31,31,31,31,31,31,31,31,31,31,31,31,31,31,31};
__device__ __forceinline__ int rel_bucket(int d) { return d >= 128 ? 31 : (int)c_bucket[d < 0 ? 0 : d]; }

__device__ __forceinline__ float sigmoidf_(float x) { return __builtin_amdgcn_rcpf(1.f + __builtin_amdgcn_exp2f(-1.4426950408889634f * x)); }
__device__ __forceinline__ float gelu_tanh(float x) { return x * __builtin_amdgcn_rcpf(1.f + __builtin_amdgcn_exp2f(-2.f * 1.4426950408889634f * 0.7978845608028654f * (x + 0.044715f * x * x * x))); }
__device__ __forceinline__ float log_sigmoid(float x) { const float e = __builtin_amdgcn_exp2f(-1.4426950408889634f * fabsf(x)); return fminf(x, 0.f) - 0.6931471805599453f * __builtin_amdgcn_logf(1.f + e); }
__device__ __forceinline__ u32x4 pack_h8(f32x4 a, f32x4 b) {
    h8 h; h[0] = (half_t)a.x; h[1] = (half_t)a.y; h[2] = (half_t)a.z; h[3] = (half_t)a.w; h[4] = (half_t)b.x; h[5] = (half_t)b.y; h[6] = (half_t)b.z; h[7] = (half_t)b.w;
    return __builtin_bit_cast(u32x4, h);
}
__device__ __forceinline__ unsigned pack_h2(float a, float b) { h2 h; h[0] = (half_t)a; h[1] = (half_t)b; return __builtin_bit_cast(unsigned, h); }
#define LDS_WAIT() asm volatile("s_waitcnt lgkmcnt(0)" ::: "memory")

#define XB_TMO      128
#define XB_XCNT(j)  (256  + 64 * (j))
#define XB_XSUB(j)  (1280 + 64 * (j))
#define XB_XGEN(j)  (2304 + 64 * (j))
#define XB_TOP      3328
#define XB_TOPGEN   3392
#define XCD_BAR_WORDS 3456
#define XB_SPIN_CAP (1u << 20)
__device__ __forceinline__ unsigned xb_ld(unsigned* p)              { return __hip_atomic_load(p, __ATOMIC_RELAXED, __HIP_MEMORY_SCOPE_AGENT); }
__device__ __forceinline__ unsigned xb_add(unsigned* p, unsigned v) { return __hip_atomic_fetch_add(p, v, __ATOMIC_RELAXED, __HIP_MEMORY_SCOPE_AGENT); }
__device__ __forceinline__ unsigned xb_xcc_id() { return (unsigned)__builtin_amdgcn_s_getreg((3 << 11) | 20) & 0xFu; }
#define XB_SPIN(cond, bar) do { unsigned _sp = 0; while (cond) { __builtin_amdgcn_s_sleep(1); \
    if ((++_sp & 255u) == 0u) { if (xb_ld(&(bar)[XB_TMO])) break; if (_sp > XB_SPIN_CAP) { atomicAdd(&(bar)[XB_TMO], 1u); break; } } } } while (0)
struct XcdBarrier { unsigned* bar; unsigned x; volatile LAS unsigned* st; };
__device__ __forceinline__ XcdBarrier xcd_barrier_post(unsigned* bar, volatile LAS unsigned* st) {
    XcdBarrier b; b.bar = bar; b.x = xb_xcc_id(); b.st = st;
    if (threadIdx.x == 0) (void)xb_add(&bar[XB_XCNT(b.x)], 1u);
    return b;
}
__device__ __forceinline__ void xcd_barrier_complete(unsigned* bar, unsigned x, unsigned& nloc, unsigned& nx) {
    const unsigned G = gridDim.x * gridDim.y * gridDim.z;
    unsigned sum, cnt, mine, sp = 0u;
    for (;;) {
        sum = 0u; cnt = 0u; mine = 0u;
#pragma unroll
        for (unsigned j = 0; j < 16; ++j) { const unsigned c = xb_ld(&bar[XB_XCNT(j)]); sum += c; cnt += (c > 0u) ? 1u : 0u; mine = (j == x) ? c : mine; }
        if (sum == G) break;
        __builtin_amdgcn_s_sleep(1);
        if ((++sp & 255u) == 0u) { if (xb_ld(&bar[XB_TMO])) break; if (sp > XB_SPIN_CAP) { atomicAdd(&bar[XB_TMO], 1u); break; } }
    }
    nloc = mine > 0u ? mine : 1u; nx = cnt > 0u ? cnt : 1u;
}
__device__ __forceinline__ void xcd_barrier(const XcdBarrier& b) {
    asm volatile("s_waitcnt vmcnt(0)" ::: "memory");
    __syncthreads();
    if (threadIdx.x == 0) {
        unsigned* bar = b.bar;
        unsigned bx = b.x; asm volatile("" : "+s"(bx));
        __builtin_amdgcn_s_waitcnt(0);
        unsigned nloc = b.st[0], nx = b.st[1];
        if (nloc == 0u) { xcd_barrier_complete(bar, bx, nloc, nx); b.st[0] = nloc; b.st[1] = nx; }
        const unsigned old = xb_add(&bar[XB_XSUB(bx)], 1u);
        const unsigned gen = old / nloc;
        if (old + 1u == (gen + 1u) * nloc) {
            __builtin_amdgcn_fence(__ATOMIC_RELEASE, "agent");
            asm volatile("s_waitcnt vmcnt(0)" ::: "memory");
            const unsigned og = xb_add(&bar[XB_TOP], 1u);
            const unsigned tg = og / nx;
            if (og + 1u == (tg + 1u) * nx) xb_add(&bar[XB_TOPGEN], 1u);
            else XB_SPIN(xb_ld(&bar[XB_TOPGEN]) == tg, bar);
            __builtin_amdgcn_fence(__ATOMIC_ACQUIRE, "agent");
            xb_add(&bar[XB_XGEN(bx)], 1u);
            asm volatile("s_waitcnt vmcnt(0)" ::: "memory");
        } else {
            XB_SPIN(xb_ld(&bar[XB_XGEN(bx)]) == gen, bar);
            __builtin_amdgcn_fence(__ATOMIC_ACQUIRE, "agent");
            asm volatile("s_waitcnt vmcnt(0)" ::: "memory");
        }
    }
    __syncthreads();
}

namespace pg8 {
constexpr int BM = 256, BK = 64, HALF = 128, HTB = HALF * BK * 2, STAGE_BYTES = 8 * HTB, NXCD = 8, WGM = 8;
__host__ __device__ __forceinline__ int lds_byte(int r, int c) { const int st = (r >> 4) * 2 + (c >> 5), rr = r & 15, cc = c & 31, ob = rr * 64 + cc * 2; return st * 1024 + (ob ^ (((ob >> 9) & 1) << 5)); }
__host__ __device__ __forceinline__ void stage_rc(int b, int& R, int& C) { const int st = b / 1024, sb = b % 1024, swz = sb ^ (((sb >> 9) & 1) << 5); R = (st >> 1) * 16 + swz / 64; C = (st & 1) * 32 + (swz % 64) / 2; }
__host__ __device__ __forceinline__ int perm32(int rho) { const int n = rho >> 4, i = rho & 15; return 8 * (i >> 2) + 4 * n + (i & 3); }
struct Unit { int pm, pn; };
struct Gemm { const half_t* A; const half_t* Bt; int M, N, K; };
struct StaticOrder {
    int nM, nN, nwg, G, c;
    __host__ __device__ void init(int M, int N, int G_, int c_) { nM = M / BM; nN = N / BM; nwg = nM * nN; G = G_; c = c_; }
    __host__ __device__ bool next(int i, Unit& u) const {
        const long L = (long)i * G + c; if (L >= nwg) return false;
        int wgid = (int)L; { const int q = nwg / NXCD, r = nwg % NXCD, xcd = wgid % NXCD, off = wgid / NXCD; wgid = (xcd < r ? xcd * (q + 1) : r * (q + 1) + (xcd - r) * q) + off; }
        const int nig = WGM * nN, gid = wgid / nig, fm = gid * WGM, gsz = (nM - fm) < WGM ? (nM - fm) : WGM;
        u.pm = fm + ((wgid % nig) % gsz); u.pn = (wgid % nig) / gsz; return true;
    }
    __device__ __forceinline__ void a_ready(const Unit&) const {}
    __device__ __forceinline__ void done(const Unit&) const {}
};

template <class Epi, class Sched>
__device__ __forceinline__ void gemm_phase(LAS unsigned char* lds, const Gemm g, const Sched& S, const Epi& E) {
    int tid = threadIdx.x; asm volatile("" : "+v"(tid));
    const int wid = __builtin_amdgcn_readfirstlane(tid >> 6), lane = tid & 63, wr = wid >> 2, wc = wid & 3, fr = lane & 15, fq = lane >> 4;
    const int K = g.K, nt = K / BK;
    unsigned voffA[2], voffB[2];
#pragma unroll
    for (int i = 0; i < 2; ++i) { int R, C; stage_rc(tid * 16 + i * 8192, R, C); const int Rb = Epi::brow(R);
        voffA[i] = (unsigned)(R * K + C) * 2u; voffB[i] = (unsigned)(Rb * K + C) * 2u; }
    const size_t kstep = (size_t)(BK * 2);
    const size_t hstep = (size_t)HALF * K * 2;
    const size_t hstepB = (size_t)Epi::BHALF_ROWS * K * 2;
    const size_t tstep = 2 * hstep;
    const unsigned ldsw = (unsigned)wid * 1024u;
    const int aoff = lds_byte(wr * 64 + fr, fq * 8), boff = lds_byte(wc * 32 + fr, fq * 8);
#define PG8_SA(b, h) (((b) * 2 + (h)) * HTB)
#define PG8_SB(b, h) ((4 + (b) * 2 + (h)) * HTB)
#define PG8_STAGE(bufoff, gbase, voff) do { _Pragma("unroll") for (int _i = 0; _i < 2; ++_i) \
        __builtin_amdgcn_global_load_lds((const unsigned*)((const char*)(gbase) + (voff)[_i]), (LAS unsigned*)(lds + (bufoff) + ldsw + _i * 8192), 16, 0, 0); } while (0)
#define PG8_LDA(dst, b, h) do { _Pragma("unroll") for (int m = 0; m < 4; ++m) _Pragma("unroll") for (int k = 0; k < 2; ++k) dst[m][k] = *(const LAS h8*)(lds + PG8_SA(b, h) + aoff + m * 2048 + k * 1024); } while (0)
#define PG8_LDB(dst, b, h) do { _Pragma("unroll") for (int n = 0; n < 2; ++n) _Pragma("unroll") for (int k = 0; k < 2; ++k) dst[n][k] = *(const LAS h8*)(lds + PG8_SB(b, h) + boff + n * 2048 + k * 1024); } while (0)
#define PG8_MMA(ai, bj, At, Bt) do { __builtin_amdgcn_s_setprio(1); _Pragma("unroll") for (int m = 0; m < 4; ++m) _Pragma("unroll") for (int n = 0; n < 2; ++n) _Pragma("unroll") for (int k = 0; k < 2; ++k) \
        acc[ai][bj][m][n] = __builtin_amdgcn_mfma_f32_16x16x32_f16(Bt[n][k], At[m][k], acc[ai][bj][m][n], 0, 0, 0); __builtin_amdgcn_s_setprio(0); } while (0)
#define PG8_WAIT_V(n) asm volatile("s_waitcnt vmcnt(" #n ")" ::: "memory")
#define PG8_WAIT_L(n) asm volatile("s_waitcnt lgkmcnt(" #n ")" ::: "memory")
#define PG8_BAR __builtin_amdgcn_s_barrier()
#define PG8_SCHED __builtin_amdgcn_sched_barrier(0)
    Unit cur, nxt; int ui = 0;
    if (!S.next(0, cur)) return;
    f32x4 acc[2][2][4][2];
#pragma unroll
    for (int a = 0; a < 2; ++a)
#pragma unroll
        for (int b = 0; b < 2; ++b)
#pragma unroll
            for (int m = 0; m < 4; ++m)
#pragma unroll
                for (int n = 0; n < 2; ++n) acc[a][b][m][n] = (f32x4){0.f, 0.f, 0.f, 0.f};
    h8 At[4][2], B0[2][2], B1[2][2];
    const char* cA = (const char*)g.A + (size_t)cur.pm * tstep; const char* cB = (const char*)g.Bt + (size_t)cur.pn * tstep;
    S.a_ready(cur);
    PG8_STAGE(PG8_SB(0, 0), cB, voffB); PG8_STAGE(PG8_SA(0, 0), cA, voffA); PG8_STAGE(PG8_SB(0, 1), cB + hstepB, voffB); PG8_STAGE(PG8_SA(0, 1), cA + hstep, voffA);
    if (wr == 1) PG8_BAR;
    PG8_WAIT_V(4); PG8_BAR;
    PG8_STAGE(PG8_SB(1, 0), cB + kstep, voffB); PG8_STAGE(PG8_SA(1, 0), cA + kstep, voffA); PG8_STAGE(PG8_SB(1, 1), cB + hstepB + kstep, voffB);
    PG8_WAIT_V(6); PG8_BAR;
    for (;;) {
        const bool has_next = S.next(ui + 1, nxt);
        const char* nA = has_next ? (const char*)g.A + (size_t)nxt.pm * tstep : cA; const char* nB = has_next ? (const char*)g.Bt + (size_t)nxt.pn * tstep : cB;
        for (int t = 0; t < nt; t += 2) {
            const bool last = (t == nt - 2);
            const char* a1 = cA + (size_t)(t + 1) * kstep;
            const char* a2 = last ? nA : cA + (size_t)(t + 2) * kstep; const char* b2 = last ? nB : cB + (size_t)(t + 2) * kstep;
            const char* a3 = a2 + kstep; const char* b3 = b2 + kstep;
            if (last && has_next) S.a_ready(nxt);
            PG8_LDB(B0, 0, 0); PG8_SCHED; PG8_LDA(At, 0, 0); PG8_STAGE(PG8_SA(1, 1), a1 + hstep, voffA);
            PG8_WAIT_L(8); PG8_BAR; PG8_WAIT_L(0); PG8_MMA(0, 0, At, B0); PG8_BAR; PG8_SCHED;
            PG8_LDB(B1, 0, 1); PG8_STAGE(PG8_SB(0, 0), b2, voffB);
            PG8_BAR; PG8_WAIT_L(0); PG8_MMA(0, 1, At, B1); PG8_BAR;
            PG8_LDA(At, 0, 1); PG8_STAGE(PG8_SA(0, 0), a2, voffA);
            PG8_BAR; PG8_WAIT_L(0); PG8_MMA(1, 0, At, B0); PG8_BAR; PG8_SCHED;
            PG8_STAGE(PG8_SB(0, 1), b2 + hstepB, voffB);
            PG8_WAIT_V(6); PG8_BAR; PG8_MMA(1, 1, At, B1); PG8_BAR;
            PG8_LDB(B0, 1, 0); PG8_SCHED; PG8_LDA(At, 1, 0); PG8_STAGE(PG8_SA(0, 1), a2 + hstep, voffA);
            PG8_WAIT_L(8); PG8_BAR; PG8_WAIT_L(0); PG8_MMA(0, 0, At, B0); PG8_BAR; PG8_SCHED;
            PG8_LDB(B1, 1, 1); PG8_STAGE(PG8_SB(1, 0), b3, voffB);
            PG8_BAR; PG8_WAIT_L(0); PG8_MMA(0, 1, At, B1); PG8_BAR;
            PG8_LDA(At, 1, 1); PG8_STAGE(PG8_SA(1, 0), a3, voffA);
            PG8_BAR; PG8_WAIT_L(0); PG8_MMA(1, 0, At, B0); PG8_BAR; PG8_SCHED;
            PG8_STAGE(PG8_SB(1, 1), b3 + hstepB, voffB);
            PG8_WAIT_V(6); PG8_BAR; PG8_MMA(1, 1, At, B1); PG8_BAR;
        }
        E(acc, cur, wr, wc, fr, fq); S.done(cur);
        if (!has_next) break;
#pragma unroll
        for (int a = 0; a < 2; ++a)
#pragma unroll
            for (int b = 0; b < 2; ++b)
#pragma unroll
                for (int m = 0; m < 4; ++m)
#pragma unroll
                    for (int n = 0; n < 2; ++n) acc[a][b][m][n] = (f32x4){0.f, 0.f, 0.f, 0.f};
        cur = nxt; cA = nA; cB = nB; ++ui;
    }
    PG8_WAIT_V(0);
    if (wr == 0) PG8_BAR;
    PG8_BAR;
#undef PG8_SA
#undef PG8_SB
#undef PG8_STAGE
#undef PG8_LDA
#undef PG8_LDB
#undef PG8_MMA
#undef PG8_WAIT_V
#undef PG8_WAIT_L
#undef PG8_BAR
#undef PG8_SCHED
}
}

__device__ __forceinline__ float row_rstd(const float* ssq, int row) {
    const f32x4* p = (const f32x4*)(ssq + (size_t)row * 16);
    const f32x4 a = p[0], b = p[1], c = p[2], d = p[3];
    const float s = (((a.x + a.y) + (a.z + a.w)) + ((b.x + b.y) + (b.z + b.w))) + (((c.x + c.y) + (c.z + c.w)) + ((d.x + d.y) + (d.z + d.w)));
    return rsqrtf(s * (1.f / 1024.f) + EPS);
}
__device__ __forceinline__ void rows_rstd8(const float* ssq, int row0, int fq, float (&r)[8]) {
    f32x4 p[8];
#pragma unroll
    for (int i = 0; i < 8; ++i) p[i] = *(const f32x4*)(ssq + (size_t)(row0 + (i >> 2) * 128 + (i & 3) * 16) * 16 + 4 * fq);
#pragma unroll
    for (int i = 0; i < 8; ++i) { float s = (p[i].x + p[i].y) + (p[i].z + p[i].w); s += __shfl_xor(s, 16); s += __shfl_xor(s, 32); r[i] = rsqrtf(s * (1.f / 1024.f) + EPS); }
}
struct EpiZ {
    static constexpr bool PERM = true;
    static constexpr int BHALF_ROWS = 32;
    static __host__ __device__ __forceinline__ int brow(int R) { return 64 * ((R >> 5) & 3) + pg8::perm32(R & 31); }
    half_t* Z; const float* ssq;
    __device__ __forceinline__ void operator()(const f32x4 (&acc)[2][2][4][2], const pg8::Unit& u, int wr, int wc, int fr, int fq) const {
        const int row0 = u.pm * 256 + wr * 64 + fr, col0 = u.pn * 256 + wc * 64 + 8 * fq;
        float rr[8]; rows_rstd8(ssq, row0, fq, rr);
#pragma unroll
        for (int ai = 0; ai < 2; ++ai)
#pragma unroll
            for (int m = 0; m < 4; ++m) { const int row = row0 + ai * 128 + m * 16; const float r = rr[ai * 4 + m]; half_t* rp = Z + (size_t)row * NZP + col0;
#pragma unroll
                for (int bj = 0; bj < 2; ++bj) *(u32x4*)(rp + bj * 32) = pack_h8(acc[ai][bj][m][0] * r, acc[ai][bj][m][1] * r); }
    }
};
struct EpiRes {
    static constexpr bool PERM = true;
    static constexpr int BHALF_ROWS = 32;
    static __host__ __device__ __forceinline__ int brow(int R) { return 64 * ((R >> 5) & 3) + pg8::perm32(R & 31); }
    const float* xf;
    float* out;
    half_t* XH; float* ssq;
    __device__ __forceinline__ void operator()(const f32x4 (&acc)[2][2][4][2], const pg8::Unit& u, int wr, int wc, int fr, int fq) const {
        const int row0 = u.pm * 256 + wr * 64 + fr, col0 = u.pn * 256 + wc * 64 + 8 * fq;
#pragma unroll
        for (int ai = 0; ai < 2; ++ai) {
            f32x4 xo[4][2][2];
            if (xf) {
#pragma unroll
                for (int m = 0; m < 4; ++m)
#pragma unroll
                    for (int bj = 0; bj < 2; ++bj) { const size_t o = (size_t)(row0 + ai * 128 + m * 16) * D + col0 + bj * 32; xo[m][bj][0] = *(const f32x4*)(xf + o); xo[m][bj][1] = *(const f32x4*)(xf + o + 4); }
            } else {
                h8 xh[4][2];
#pragma unroll
                for (int m = 0; m < 4; ++m)
#pragma unroll
                    for (int bj = 0; bj < 2; ++bj) xh[m][bj] = *(const h8*)(XH + (size_t)(row0 + ai * 128 + m * 16) * D + col0 + bj * 32);
#pragma unroll
                for (int m = 0; m < 4; ++m)
#pragma unroll
                    for (int bj = 0; bj < 2; ++bj) { xo[m][bj][0] = (f32x4){(float)xh[m][bj][0], (float)xh[m][bj][1], (float)xh[m][bj][2], (float)xh[m][bj][3]};
                        xo[m][bj][1] = (f32x4){(float)xh[m][bj][4], (float)xh[m][bj][5], (float)xh[m][bj][6], (float)xh[m][bj][7]}; }
            }
#pragma unroll
            for (int m = 0; m < 4; ++m) { const int row = row0 + ai * 128 + m * 16; float s = 0.f;
#pragma unroll
                for (int bj = 0; bj < 2; ++bj) { const size_t o = (size_t)row * D + col0 + bj * 32;
                    const f32x4 v0 = xo[m][bj][0] + acc[ai][bj][m][0], v1 = xo[m][bj][1] + acc[ai][bj][m][1];
                    if (out) { *(f32x4*)(out + o) = v0; *(f32x4*)(out + o + 4) = v1; }
                    else *(u32x4*)(XH + o) = pack_h8(v0, v1);
                    s += (v0.x * v0.x + v0.y * v0.y) + (v0.z * v0.z + v0.w * v0.w) + (v1.x * v1.x + v1.y * v1.y) + (v1.z * v1.z + v1.w * v1.w); }
                s += __shfl_xor(s, 16); s += __shfl_xor(s, 32);
                if (fq == 0 && ssq) ssq[(size_t)row * 16 + u.pn * 4 + wc] = s; }
        }
    }
};
struct EpiSwiglu {
    static constexpr bool PERM = true;
    static constexpr int BHALF_ROWS = 128;
    static __host__ __device__ __forceinline__ int brow(int R) { return (R & ~31) + pg8::perm32(R & 31); }
    half_t* H; const float* ssq;
    __device__ __forceinline__ void operator()(const f32x4 (&acc)[2][2][4][2], const pg8::Unit& u, int wr, int wc, int fr, int fq) const {
        const int row0 = u.pm * 256 + wr * 64 + fr, col0 = u.pn * 128 + wc * 32 + 8 * fq;
        float rr[8]; rows_rstd8(ssq, row0, fq, rr);
#pragma unroll
        for (int ai = 0; ai < 2; ++ai)
#pragma unroll
            for (int m = 0; m < 4; ++m) { const int row = row0 + ai * 128 + m * 16; const float r = rr[ai * 4 + m];
                f32x4 o[2];
#pragma unroll
                for (int n = 0; n < 2; ++n) { const f32x4 g = acc[ai][0][m][n] * r, uu = acc[ai][1][m][n] * r;
                    o[n].x = g.x * sigmoidf_(g.x) * uu.x; o[n].y = g.y * sigmoidf_(g.y) * uu.y; o[n].z = g.z * sigmoidf_(g.z) * uu.z; o[n].w = g.w * sigmoidf_(g.w) * uu.w; }
                *(u32x4*)(H + (size_t)row * DFF + col0) = pack_h8(o[0], o[1]); }
    }
};

struct EpiNull {
    static constexpr bool PERM = true;
    static constexpr int BHALF_ROWS = 128;
    static __host__ __device__ __forceinline__ int brow(int R) { return (R & ~31) + pg8::perm32(R & 31); }
    __device__ __forceinline__ void operator()(const f32x4 (&acc)[2][2][4][2], const pg8::Unit&, int, int, int, int) const {
#pragma unroll
        for (int ai = 0; ai < 2; ++ai)
#pragma unroll
            for (int bj = 0; bj < 2; ++bj)
#pragma unroll
                for (int m = 0; m < 4; ++m)
#pragma unroll
                    for (int n = 0; n < 2; ++n) asm volatile("" :: "v"(acc[ai][bj][m][n]));
    }
};
struct Params {
    const float* x; const float* norm_mix; const float* w_in; const float* lru_conv_w; const float* lru_conv_b; const float* lru_w_gates; const float* lru_b_gates;
    const float* lru_lambda; const float* sc_conv_w; const float* fox_f_bias; const float* fox_qk_norm; const float* nsa_qk_norm; const float* nsa_cmp_pos;
    const float* nsa_cmp_w1; const float* nsa_cmp_w2; const float* nsa_gate_bias; const float* rel_bias; const float* out_norm; const float* w_out;
    const float* norm_ffn; const float* w_gate_up; const float* w_down; float* out; unsigned char* ws;
};

template <int MODE> __device__ __forceinline__ int src_col(int n) {
    if (MODE == 1) { if (n < 2048) return n; if (n < 2688) return n + 4; if (n < 2692) return 2048 + (n - 2688); if (n < 2704) return n; return -1; }
    if (MODE == 2) { const int pn = n >> 8, w = n & 255; return w < 128 ? pn * 128 + w : DFF + pn * 128 + (w - 128); }
    return n;
}
template <int MODE> __device__ __forceinline__ void p0_item(const float* W, int K, int Nsrc, const float* gain, half_t* WT, int item, int nbn, LAS unsigned* scr, int lane) {
    const int kb = item / nbn, nb = item % nbn, k0 = 64 * kb, n0 = 64 * nb;
    const int sc = src_col<MODE>(n0 + lane);
    float v[64];
    const float* wp = W + (size_t)k0 * Nsrc + (sc >= 0 ? sc : 0);
#pragma unroll
    for (int kk = 0; kk < 64; ++kk) v[kk] = wp[(size_t)kk * Nsrc];
#pragma unroll
    for (int kk = 0; kk < 64; kk += 2) {
        float v0 = sc >= 0 ? v[kk] : 0.f, v1 = sc >= 0 ? v[kk + 1] : 0.f;
        if (gain) { v0 *= gain[k0 + kk]; v1 *= gain[k0 + kk + 1]; }
        scr[lane * 33 + (kk >> 1)] = pack_h2(v0, v1);
    }
    LDS_WAIT(); asm volatile("" ::: "memory");
    const int c = lane & 7;
#pragma unroll
    for (int j = 0; j < 8; ++j) { const int nn = (lane >> 3) + 8 * j; const LAS unsigned* s = scr + nn * 33 + 4 * c;
        u32x4 o; o.x = s[0]; o.y = s[1]; o.z = s[2]; o.w = s[3];
        *(u32x4*)(WT + (size_t)(n0 + nn) * K + k0 + 8 * c) = o; }
    LDS_WAIT(); asm volatile("" ::: "memory");
}
__device__ __forceinline__ float wave_sum(float v) {
#pragma unroll
    for (int o = 1; o < 64; o <<= 1) v += __shfl_xor(v, o);
    return v;
}

__device__ __forceinline__ void attn_step_h(const float (&q)[64], float (&acc)[64], float& m, float& l, const half_t* kp, const half_t* vp, float bias, bool valid) {
    float sc = 0.f;
#pragma unroll
    for (int hh = 0; hh < 2; ++hh) {
#pragma unroll
        for (int j = 4 * hh; j < 4 * hh + 4; ++j) { const h8 kv = *(const h8*)(kp + 8 * j);
#pragma unroll
            for (int e = 0; e < 8; ++e) sc = fmaf(q[8 * j + e], (float)kv[e], sc); }
        __builtin_amdgcn_sched_barrier(0);
    }
    sc += bias;
    const float mn = valid ? fmaxf(m, sc) : m;
    const float alpha = __expf(m - mn), p = valid ? __expf(sc - mn) : 0.f;
    m = mn; l = l * alpha + p;
#pragma unroll
    for (int hh = 0; hh < 2; ++hh) {
#pragma unroll
        for (int j = 4 * hh; j < 4 * hh + 4; ++j) { const h8 vv = *(const h8*)(vp + 8 * j);
#pragma unroll
            for (int e = 0; e < 8; ++e) acc[8 * j + e] = fmaf(acc[8 * j + e], alpha, p * (float)vv[e]); }
        __builtin_amdgcn_sched_barrier(0);
    }
}
__device__ __forceinline__ float dot_f32(const float (&q)[64], const float* kp) {
    float sc = 0.f;
#pragma unroll
    for (int j = 0; j < 16; ++j) { const f32x4 kv = *(const f32x4*)(kp + 4 * j); sc = fmaf(q[4 * j], kv.x, sc); sc = fmaf(q[4 * j + 1], kv.y, sc); sc = fmaf(q[4 * j + 2], kv.z, sc); sc = fmaf(q[4 * j + 3], kv.w, sc); }
    return sc;
}
__device__ __forceinline__ void load_q(float (&q)[64], const half_t* qp, float scale) {
#pragma unroll
    for (int j = 0; j < 8; ++j) { const h8 v = *(const h8*)(qp + 8 * j);
#pragma unroll
        for (int e = 0; e < 8; ++e) q[8 * j + e] = (float)v[e] * scale; }
}

__device__ __forceinline__ void lru_gate_r(const float* wcol, float bias, const LAS float* xrow, LAS float* yout) {
    float w[64];
#pragma unroll
    for (int k = 0; k < 64; ++k) w[k] = wcol[(size_t)k * 64];
    for (int i = 0; i < 32; ++i) {
        const LAS float* xr = xrow + i * 256; float r = bias;
#pragma unroll
        for (int k = 0; k < 64; k += 4) { const f32x4 xv = *(const LAS f32x4*)(xr + k);
            r = fmaf(xv.x, w[k], r); r = fmaf(xv.y, w[k + 1], r); r = fmaf(xv.z, w[k + 2], r); r = fmaf(xv.w, w[k + 3], r); }
        yout[i * 256] = 1.f / (1.f + expf(-r));
    }
}

__device__ __forceinline__ void ld_frags(h8 (&f)[8], const LAS unsigned char* base) {
#pragma unroll
    for (int i = 0; i < 4; ++i) { f[2 * i] = *(const LAS h8*)(base + 32 * i); f[2 * i + 1] = *(const LAS h8*)(base + 32 * 144 + 32 * i); }
}
__device__ __forceinline__ void qk64(f32x16& S0, f32x16& S1, const h8 (&q)[4], const LAS unsigned char* Ks, int qi, int hb) {
    h8 ka[8]; ld_frags(ka, Ks + pi16(qi) * 144 + 16 * hb);
    __builtin_amdgcn_sched_barrier(0);
#pragma unroll
    for (int kk = 0; kk < 4; ++kk) { S0 = MFMA32(ka[2 * kk], q[kk], S0); S1 = MFMA32(ka[2 * kk + 1], q[kk], S1); }
}
__device__ __forceinline__ void pv64(const f32x16& P0, const f32x16& P1, const LAS unsigned char* Vs, f32x16& O0, f32x16& O1, int qi, int hb) {
    h8 va[8]; ld_frags(va, Vs + qi * 144 + 16 * hb);
    h8 pf[4];
#pragma unroll
    for (int e = 0; e < 8; ++e) { pf[0][e] = (half_t)P0[e]; pf[1][e] = (half_t)P0[8 + e]; pf[2][e] = (half_t)P1[e]; pf[3][e] = (half_t)P1[8 + e]; }
    __builtin_amdgcn_sched_barrier(0);
#pragma unroll
    for (int s = 0; s < 4; ++s) { O0 = MFMA32(va[2 * s], pf[s], O0); O1 = MFMA32(va[2 * s + 1], pf[s], O1); }
}
__device__ __forceinline__ float rowmax64(const f32x16& S0, const f32x16& S1) {
    float mx = fmaxf(S0[0], S1[0]);
#pragma unroll
    for (int r = 1; r < 16; ++r) mx = fmaxf(mx, fmaxf(S0[r], S1[r]));
    return fmaxf(mx, __shfl_xor(mx, 32));
}
__device__ __forceinline__ void softmax64(f32x16& S0, f32x16& S1, float& m, float& l, f32x16& O0, f32x16& O1) {
    const float mn = fmaxf(m, rowmax64(S0, S1)), alpha = __builtin_amdgcn_exp2f(m - mn);
    m = mn; float ps = 0.f;
#pragma unroll
    for (int r = 0; r < 16; ++r) { S0[r] = __builtin_amdgcn_exp2f(S0[r] - mn); S1[r] = __builtin_amdgcn_exp2f(S1[r] - mn); ps += S0[r] + S1[r]; }
    l = l * alpha + ps;
    if (__any(alpha != 1.f)) {
#pragma unroll
        for (int r = 0; r < 16; ++r) { O0[r] *= alpha; O1[r] *= alpha; }
    }
}
__device__ __forceinline__ void init_near(f32x16& S0, f32x16& S1, const LAS float* TRh, int dq, int hb, int step, int wlim) {
#pragma unroll
    for (int r = 0; r < 16; ++r) {
        const int k0 = 16 * (r >> 3) + 8 * hb + 4 * ((r >> 2) & 1) + (r & 3);
        const int d0 = dq - step * k0, d1 = dq - step * (k0 + 32);
        const float b0 = TRh[d0 < 0 ? 0 : (d0 > 128 ? 128 : d0)], b1 = TRh[d1 < 0 ? 0 : (d1 > 128 ? 128 : d1)];
        S0[r] = (d0 >= 0 && d0 < wlim) ? b0 : -INFINITY; S1[r] = (d1 >= 0 && d1 < wlim) ? b1 : -INFINITY;
    }
}
__device__ __forceinline__ void init_const(f32x16& S0, f32x16& S1, float c) {
#pragma unroll
    for (int r = 0; r < 16; ++r) { S0[r] = c; S1[r] = c; }
}

__device__ __forceinline__ void init_tab(f32x16& S0, f32x16& S1, const LAS float* TXh, int dq, int hb, int step, int dmax, bool sel) {
#pragma unroll
    for (int r = 0; r < 16; ++r) {
        const int k0 = 16 * (r >> 3) + 8 * hb + 4 * ((r >> 2) & 1) + (r & 3);
        int i0 = dq - step * k0, i1 = dq - step * (k0 + 32);
        i0 = i0 < -1 ? -1 : (i0 > dmax ? dmax : i0); i1 = i1 < -1 ? -1 : (i1 > dmax ? dmax : i1);
        S0[r] = TXh[sel ? i0 + 1 : 0]; S1[r] = TXh[sel ? i1 + 1 : 0];
    }
}
__device__ __forceinline__ void qk64z(f32x16& S0, f32x16& S1, const h8 (&q)[4], const LAS unsigned char* Ks, int qi, int hb) {
    h8 ka[8]; ld_frags(ka, Ks + pi16(qi) * 144 + 16 * hb);
    __builtin_amdgcn_sched_barrier(0);
    const f32x16 z = {0.f, 0.f, 0.f, 0.f, 0.f, 0.f, 0.f, 0.f, 0.f, 0.f, 0.f, 0.f, 0.f, 0.f, 0.f, 0.f};
    S0 = MFMA32(ka[0], q[0], z); S1 = MFMA32(ka[1], q[0], z);
#pragma unroll
    for (int kk = 1; kk < 4; ++kk) { S0 = MFMA32(ka[2 * kk], q[kk], S0); S1 = MFMA32(ka[2 * kk + 1], q[kk], S1); }
}
__device__ __forceinline__ float exp_sum64(f32x16& S0, f32x16& S1) {
    float ps = 0.f;
#pragma unroll
    for (int r = 0; r < 16; ++r) { S0[r] = __builtin_amdgcn_exp2f(S0[r]); S1[r] = __builtin_amdgcn_exp2f(S1[r]); ps += S0[r] + S1[r]; }
    return ps;
}
__device__ __forceinline__ void pv64m(const f32x16& P0, const f32x16& P1, bool sel, const LAS unsigned char* Vs, f32x16& O0, f32x16& O1, int qi, int hb) {
    h8 va[8]; ld_frags(va, Vs + qi * 144 + 16 * hb);
    h8 pf[4];
#pragma unroll
    for (int e = 0; e < 8; ++e) { pf[0][e] = (half_t)P0[e]; pf[1][e] = (half_t)P0[8 + e]; pf[2][e] = (half_t)P1[e]; pf[3][e] = (half_t)P1[8 + e]; }
    const h8 hz = {0, 0, 0, 0, 0, 0, 0, 0};
#pragma unroll
    for (int s = 0; s < 4; ++s) pf[s] = sel ? pf[s] : hz;
    __builtin_amdgcn_sched_barrier(0);
#pragma unroll
    for (int s = 0; s < 4; ++s) { O0 = MFMA32(va[2 * s], pf[s], O0); O1 = MFMA32(va[2 * s + 1], pf[s], O1); }
}

template <bool FAST>
__device__ __forceinline__ void fox_tile(const LAS unsigned char* sbp, int h, const h8 (&q)[4], int qi, int hb, bool diag, int kbase, int t, float& m, float& l, f32x16& O0, f32x16& O1) {
    const LAS unsigned char* Kh = sbp + h * 4608; const LAS unsigned char* Vh = sbp + 18432 + h * 5120;
    const LAS float* cbh = (const LAS float*)(sbp + 38912) + h * 32;
    f32x16 S;
#pragma unroll
    for (int g = 0; g < 4; ++g) { const f32x4 c4 = *(const LAS f32x4*)(cbh + 16 * (g >> 1) + 8 * hb + 4 * (g & 1)); S[4 * g] = c4.x; S[4 * g + 1] = c4.y; S[4 * g + 2] = c4.z; S[4 * g + 3] = c4.w; }
    h8 ka[4], va[4];
#pragma unroll
    for (int kk = 0; kk < 4; ++kk) ka[kk] = *(const LAS h8*)(Kh + pi16(qi) * 144 + (16 * kk + 8 * hb) * 2);
    va[0] = *(const LAS h8*)(Vh + qi * 80 + (8 * hb) * 2); va[1] = *(const LAS h8*)(Vh + qi * 80 + (16 + 8 * hb) * 2);
    va[2] = *(const LAS h8*)(Vh + (32 + qi) * 80 + (8 * hb) * 2); va[3] = *(const LAS h8*)(Vh + (32 + qi) * 80 + (16 + 8 * hb) * 2);
    __builtin_amdgcn_sched_barrier(0);
#pragma unroll
    for (int kk = 0; kk < 4; ++kk) S = MFMA32(ka[kk], q[kk], S);
    if (diag) {
#pragma unroll
        for (int r = 0; r < 16; ++r) { const int key = kbase + 16 * (r >> 3) + 8 * hb + 4 * ((r >> 2) & 1) + (r & 3); if (key > t) S[r] = -INFINITY; }
    }
    float mn = m, alpha = 1.f;
    if (!FAST) {
        float mx = S[0];
#pragma unroll
        for (int r = 1; r < 16; ++r) mx = fmaxf(mx, S[r]);
        mx = fmaxf(mx, __shfl_xor(mx, 32));
        mn = fmaxf(m, mx); alpha = __builtin_amdgcn_exp2f(m - mn);
        m = mn;
    }
    float ps = 0.f;
#pragma unroll
    for (int r = 0; r < 16; ++r) { S[r] = __builtin_amdgcn_exp2f(S[r] - mn); ps += S[r]; }
    l = l * alpha + ps;
    if (!FAST && __any(alpha != 1.f)) {
#pragma unroll
        for (int r = 0; r < 16; ++r) { O0[r] *= alpha; O1[r] *= alpha; }
    }
    h8 pf0, pf1;
#pragma unroll
    for (int e = 0; e < 8; ++e) { pf0[e] = (half_t)S[e]; pf1[e] = (half_t)S[8 + e]; }
    O0 = MFMA32(va[0], pf0, O0); O1 = MFMA32(va[2], pf0, O1); O0 = MFMA32(va[1], pf1, O0); O1 = MFMA32(va[3], pf1, O1);
}
__device__ __forceinline__ void nsa_tile(bool near, int dq, int wlim, float cinit, const LAS float* TRh, const h8 (&q)[4], const LAS unsigned char* stage, float& m, float& l, f32x16& O0, f32x16& O1, int qi, int hb) {
    f32x16 S0, S1;
    if (near) init_near(S0, S1, TRh, dq, hb, 1, wlim); else init_const(S0, S1, cinit);
    qk64(S0, S1, q, stage, qi, hb);
    softmax64(S0, S1, m, l, O0, O1);
    pv64(S0, S1, stage + 9216, O0, O1, qi, hb);
}

#define MFMA16(a, b, c) __builtin_amdgcn_mfma_f32_16x16x32_f16(a, b, c, 0, 0, 0)
template <bool FINAL>
__device__ __forceinline__ void lru_unit(const Params& P, int L, int ui, LAS unsigned char* lds, const half_t* Z, const half_t* WGT, const float* LSPp, float* LRUAGG, float* LRUA, float* LRUB, half_t* MIXED, int wave, float& hcarry, bool first) {
    int tid = threadIdx.x; asm volatile("" : "+v"(tid)); const int lane = tid & 63;
    const int b = ui >> 7, sub = ui & 127, t0 = sub * 32; const size_t tokb = (size_t)b * SEQ;
    LAS float* xcF = (LAS float*)lds;
    LAS float* Aa = (LAS float*)(lds + 32768);
    LAS half_t* xcH = (LAS half_t*)(lds + 65536);
    LAS float* Sc = (LAS float*)(lds + 82944);
    {
        const int c = tid & 255, q2 = tid >> 8, ta = t0 + 16 * q2;
        const float w0 = P.lru_conv_w[(L * 4 + 0) * 256 + c], w1 = P.lru_conv_w[(L * 4 + 1) * 256 + c], w2 = P.lru_conv_w[(L * 4 + 2) * 256 + c], w3 = P.lru_conv_w[(L * 4 + 3) * 256 + c], cb = P.lru_conv_b[L * 256 + c];
        const half_t* zp = Z + (tokb + ta) * NZP + ZC_LRU_X + c;
        float x0 = ta >= 3 ? (float)zp[-3 * NZP] : 0.f, x1 = ta >= 2 ? (float)zp[-2 * NZP] : 0.f, x2 = ta >= 1 ? (float)zp[-1 * NZP] : 0.f;
#pragma unroll
        for (int i = 0; i < 16; ++i) { const float x3 = (float)zp[(size_t)i * NZP]; const float v = cb + w0 * x0 + w1 * x1 + w2 * x2 + w3 * x3;
            xcF[(16 * q2 + i) * 256 + c] = v; xcH[(16 * q2 + i) * 264 + c] = (half_t)v; x0 = x1; x1 = x2; x2 = x3; }
    }
    __syncthreads();
    {
        const int blk = wave & 3, th = wave >> 2, r16 = lane & 15, kq = lane >> 4;
        const h8 a0 = *(const LAS h8*)(xcH + (16 * th + r16) * 264 + blk * 64 + 8 * kq), a1 = *(const LAS h8*)(xcH + (16 * th + r16) * 264 + blk * 64 + 32 + 8 * kq);
#pragma unroll
        for (int cbk = 0; cbk < 4; ++cbk) {
            const half_t* wr = WGT + ((size_t)((L * 2 + 0) * 4 + blk) * 64 + 16 * cbk + r16) * 64 + 8 * kq; const half_t* wi = wr + 4 * 64 * 64;
            f32x4 ar = {0.f, 0.f, 0.f, 0.f}, ai = {0.f, 0.f, 0.f, 0.f};
            ar = MFMA16(a0, *(const h8*)wr, ar); ar = MFMA16(a1, *(const h8*)(wr + 32), ar);
            ai = MFMA16(a0, *(const h8*)wi, ai); ai = MFMA16(a1, *(const h8*)(wi + 32), ai);
            const int c = blk * 64 + 16 * cbk + r16;
            const float br = P.lru_b_gates[(L * 2 + 0) * 256 + c], bi = P.lru_b_gates[(L * 2 + 1) * 256 + c];
            const float lsp = LSPp[L * 256 + c];
#pragma unroll
            for (int rg = 0; rg < 4; ++rg) { const int tl = 16 * th + 4 * kq + rg;
                const float r = __builtin_amdgcn_rcpf(1.f + __builtin_amdgcn_exp2f(-LOG2E * (ar[rg] + br))), ii = __builtin_amdgcn_rcpf(1.f + __builtin_amdgcn_exp2f(-LOG2E * (ai[rg] + bi)));
                const float xc = xcF[tl * 256 + c];
                const float a = __builtin_amdgcn_exp2f(lsp * r), bb = __builtin_amdgcn_sqrtf(fmaxf(1.f - a * a, 0.f)) * (ii * xc);
                Aa[tl * 256 + c] = a; xcF[tl * 256 + c] = bb; }
        }
    }
    __syncthreads();
    if (tid < 256) {
        const int c = tid;
        if (!FINAL) {
            float h = 0.f, Ap = 1.f;
#pragma unroll 8
            for (int i = 0; i < 32; ++i) { const float a = Aa[i * 256 + c], bb = xcF[i * 256 + c]; h = fmaf(a, h, bb); Ap *= a;
                LRUA[(tokb + t0 + i) * 256 + c] = a; LRUB[(tokb + t0 + i) * 256 + c] = bb; }
            float* ag = LRUAGG + (((size_t)b * 128 + sub) * 256 + c) * 2; ag[0] = Ap; ag[1] = h;
        } else {
            float h = hcarry;
            if (first) { h = 0.f; const float* ag = LRUAGG + ((size_t)b * 128 * 256 + c) * 2;
              for (int s0 = 0; s0 < sub; s0 += 16) {
                  typedef float f32x2 __attribute__((ext_vector_type(2)));
                  f32x2 pr[16];
#pragma unroll
                  for (int k = 0; k < 16; ++k) pr[k] = (s0 + k < sub) ? *(const f32x2*)(ag + (size_t)(s0 + k) * 512) : (f32x2){1.f, 0.f};
#pragma unroll
                  for (int k = 0; k < 16; ++k) h = fmaf(pr[k].x, h, pr[k].y); } }
            const half_t* gp = Z + (tokb + t0) * NZP + ZC_LRU_G + c;
#pragma unroll 8
            for (int i = 0; i < 32; ++i) { const float a = Aa[i * 256 + c], bb = xcF[i * 256 + c]; h = fmaf(a, h, bb);
                const float gx = (float)gp[(size_t)i * NZP];
                Aa[i * 256 + c] = h * gx * __builtin_amdgcn_rcpf(1.f + __builtin_amdgcn_exp2f(-2.f * LOG2E * 0.7978845608028654f * (gx + 0.044715f * gx * gx * gx))); }
            hcarry = h;
        }
    } else if (FINAL) {
        const int c = tid - 256;
        const float w0 = P.sc_conv_w[(L * 3 + 0) * 256 + c], w1 = P.sc_conv_w[(L * 3 + 1) * 256 + c], w2 = P.sc_conv_w[(L * 3 + 2) * 256 + c];
        const half_t* zp = Z + (tokb + t0) * NZP + c;
        float u0 = t0 >= 2 ? (float)zp[-2 * NZP + ZC_SC_C] * (float)zp[-2 * NZP + ZC_SC_X] : 0.f, u1 = t0 >= 1 ? (float)zp[-1 * NZP + ZC_SC_C] * (float)zp[-1 * NZP + ZC_SC_X] : 0.f;
#pragma unroll 8
        for (int i = 0; i < 32; ++i) { const half_t* zr = zp + (size_t)i * NZP; const float u2 = (float)zr[ZC_SC_C] * (float)zr[ZC_SC_X];
            Sc[i * 256 + c] = (float)zr[ZC_SC_B] * (w0 * u0 + w1 * u1 + w2 * u2); u0 = u1; u1 = u2; }
    }
    __syncthreads();
    if (FINAL) {
        const f32x4 ga = *(const f32x4*)(P.out_norm + (L * 4 + 0) * 256 + 4 * lane), gbv = *(const f32x4*)(P.out_norm + (L * 4 + 1) * 256 + 4 * lane);
#pragma unroll
        for (int i = 0; i < 4; ++i) { const int tl = wave * 4 + i; half_t* op = MIXED + (tokb + t0 + tl) * D + 4 * lane;
            { const f32x4 v = *(const LAS f32x4*)(Aa + tl * 256 + 4 * lane); const float rs = rsqrtf(wave_sum((v.x * v.x + v.y * v.y) + (v.z * v.z + v.w * v.w)) * (1.f / 256.f) + EPS);
              u32x2 o; o.x = pack_h2(v.x * rs * ga.x, v.y * rs * ga.y); o.y = pack_h2(v.z * rs * ga.z, v.w * rs * ga.w); *(u32x2*)op = o; }
            { const f32x4 v = *(const LAS f32x4*)(Sc + tl * 256 + 4 * lane); const float rs = rsqrtf(wave_sum((v.x * v.x + v.y * v.y) + (v.z * v.z + v.w * v.w)) * (1.f / 256.f) + EPS);
              u32x2 o; o.x = pack_h2(v.x * rs * gbv.x, v.y * rs * gbv.y); o.y = pack_h2(v.z * rs * gbv.z, v.w * rs * gbv.w); *(u32x2*)(op + 256) = o; }
        }
        __syncthreads();
    }
}

__device__ __forceinline__ void lru_final(const Params& P, int L, int ui, LAS unsigned char* lds, const half_t* Z, const float* LRUAGG, const float* LRUA, const float* LRUB, half_t* MIXED, int wave, float& hcarry, bool first) {
    int tid = threadIdx.x; asm volatile("" : "+v"(tid)); const int lane = tid & 63;
    const int b = ui >> 7, sub = ui & 127, t0 = sub * 32; const size_t tokb = (size_t)b * SEQ;
    LAS float* Aa = (LAS float*)lds;
    LAS float* Sc = (LAS float*)(lds + 32768);
    if (tid < 256) {
        const int c = tid;
        float av[32], bv[32]; half_t gv[32];
        const float* ap = LRUA + (tokb + t0) * 256 + c; const float* bp = LRUB + (tokb + t0) * 256 + c; const half_t* gp = Z + (tokb + t0) * NZP + ZC_LRU_G + c;
#pragma unroll
        for (int i = 0; i < 32; ++i) { av[i] = ap[i * 256]; bv[i] = bp[i * 256]; gv[i] = gp[(size_t)i * NZP]; }
        float h = hcarry;
        if (first) { h = 0.f; const float* ag = LRUAGG + ((size_t)b * 128 * 256 + c) * 2;
          for (int s0 = 0; s0 < sub; s0 += 16) {
              typedef float f32x2 __attribute__((ext_vector_type(2)));
              f32x2 pr[16];
#pragma unroll
              for (int k = 0; k < 16; ++k) pr[k] = (s0 + k < sub) ? *(const f32x2*)(ag + (size_t)(s0 + k) * 512) : (f32x2){1.f, 0.f};
#pragma unroll
              for (int k = 0; k < 16; ++k) h = fmaf(pr[k].x, h, pr[k].y); } }
#pragma unroll
        for (int i = 0; i < 32; ++i) { h = fmaf(av[i], h, bv[i]); const float gx = (float)gv[i];
            Aa[i * 256 + c] = h * gx * __builtin_amdgcn_rcpf(1.f + __builtin_amdgcn_exp2f(-2.f * LOG2E * 0.7978845608028654f * (gx + 0.044715f * gx * gx * gx))); }
        hcarry = h;
    } else {
        const int c = tid - 256;
        const float w0 = P.sc_conv_w[(L * 3 + 0) * 256 + c], w1 = P.sc_conv_w[(L * 3 + 1) * 256 + c], w2 = P.sc_conv_w[(L * 3 + 2) * 256 + c];
        const half_t* zp = Z + (tokb + t0) * NZP + c;
        float u0 = t0 >= 2 ? (float)zp[-2 * NZP + ZC_SC_C] * (float)zp[-2 * NZP + ZC_SC_X] : 0.f, u1 = t0 >= 1 ? (float)zp[-1 * NZP + ZC_SC_C] * (float)zp[-1 * NZP + ZC_SC_X] : 0.f;
#pragma unroll 8
        for (int i = 0; i < 32; ++i) { const half_t* zr = zp + (size_t)i * NZP; const float u2 = (float)zr[ZC_SC_C] * (float)zr[ZC_SC_X];
            Sc[i * 256 + c] = (float)zr[ZC_SC_B] * (w0 * u0 + w1 * u1 + w2 * u2); u0 = u1; u1 = u2; }
    }
    __syncthreads();
    {
        const f32x4 ga = *(const f32x4*)(P.out_norm + (L * 4 + 0) * 256 + 4 * lane), gbv = *(const f32x4*)(P.out_norm + (L * 4 + 1) * 256 + 4 * lane);
#pragma unroll
        for (int i = 0; i < 4; ++i) { const int tl = wave * 4 + i; half_t* op = MIXED + (tokb + t0 + tl) * D + 4 * lane;
            { const f32x4 v = *(const LAS f32x4*)(Aa + tl * 256 + 4 * lane); const float rs = rsqrtf(wave_sum((v.x * v.x + v.y * v.y) + (v.z * v.z + v.w * v.w)) * (1.f / 256.f) + EPS);
              u32x2 o; o.x = pack_h2(v.x * rs * ga.x, v.y * rs * ga.y); o.y = pack_h2(v.z * rs * ga.z, v.w * rs * ga.w); *(u32x2*)op = o; }
            { const f32x4 v = *(const LAS f32x4*)(Sc + tl * 256 + 4 * lane); const float rs = rsqrtf(wave_sum((v.x * v.x + v.y * v.y) + (v.z * v.z + v.w * v.w)) * (1.f / 256.f) + EPS);
              u32x2 o; o.x = pack_h2(v.x * rs * gbv.x, v.y * rs * gbv.y); o.y = pack_h2(v.z * rs * gbv.z, v.w * rs * gbv.w); *(u32x2*)(op + 256) = o; }
        }
    }
    __syncthreads();
}

constexpr int CW_Q = 8192;
__device__ __forceinline__ int q_next(unsigned* ctr, volatile LAS unsigned* slot) {
    __syncthreads();
    if (threadIdx.x == 0) *slot = __hip_atomic_fetch_add(ctr, 1u, __ATOMIC_RELAXED, __HIP_MEMORY_SCOPE_AGENT);
    __syncthreads();
    return __builtin_amdgcn_readfirstlane((int)*slot);
}
__device__ __forceinline__ unsigned long long ld_uptr(const LAS unsigned long long* pb, int i) {
    const unsigned long long v = pb[i];
    return ((unsigned long long)(unsigned)__builtin_amdgcn_readfirstlane((int)(v >> 32)) << 32) | (unsigned)__builtin_amdgcn_readfirstlane((int)(unsigned)v);
}
#define SECTION_ENV() \
    asm volatile("" ::: "memory"); \
    int bid = blockIdx.x; asm volatile("" : "+s"(bid));     \
    Params P; { unsigned poff_ = MISC_OFF + 512; asm volatile("" : "+s"(poff_)); const LAS unsigned long long* pb_ = (const LAS unsigned long long*)(lds + poff_); P.x = (const float*)(const __attribute__((address_space(1))) float*)ld_uptr(pb_, 0); P.norm_mix = (const float*)(const __attribute__((address_space(1))) float*)ld_uptr(pb_, 1); P.w_in = (const float*)(const __attribute__((address_space(1))) float*)ld_uptr(pb_, 2); P.lru_conv_w = (const float*)(const __attribute__((address_space(1))) float*)ld_uptr(pb_, 3); P.lru_conv_b = (const float*)(const __attribute__((address_space(1))) float*)ld_uptr(pb_, 4); P.lru_w_gates = (const float*)(const __attribute__((address_space(1))) float*)ld_uptr(pb_, 5); P.lru_b_gates = (const float*)(const __attribute__((address_space(1))) float*)ld_uptr(pb_, 6); P.lru_lambda = (const float*)(const __attribute__((address_space(1))) float*)ld_uptr(pb_, 7); P.sc_conv_w = (const float*)(const __attribute__((address_space(1))) float*)ld_uptr(pb_, 8); P.fox_f_bias = (const float*)(const __attribute__((address_space(1))) float*)ld_uptr(pb_, 9); P.fox_qk_norm = (const float*)(const __attribute__((address_space(1))) float*)ld_uptr(pb_, 10); P.nsa_qk_norm = (const float*)(const __attribute__((address_space(1))) float*)ld_uptr(pb_, 11); P.nsa_cmp_pos = (const float*)(const __attribute__((address_space(1))) float*)ld_uptr(pb_, 12); P.nsa_cmp_w1 = (const float*)(const __attribute__((address_space(1))) float*)ld_uptr(pb_, 13); P.nsa_cmp_w2 = (const float*)(const __attribute__((address_space(1))) float*)ld_uptr(pb_, 14); P.nsa_gate_bias = (const float*)(const __attribute__((address_space(1))) float*)ld_uptr(pb_, 15); P.rel_bias = (const float*)(const __attribute__((address_space(1))) float*)ld_uptr(pb_, 16); P.out_norm = (const float*)(const __attribute__((address_space(1))) float*)ld_uptr(pb_, 17); P.w_out = (const float*)(const __attribute__((address_space(1))) float*)ld_uptr(pb_, 18); P.norm_ffn = (const float*)(const __attribute__((address_space(1))) float*)ld_uptr(pb_, 19); P.w_gate_up = (const float*)(const __attribute__((address_space(1))) float*)ld_uptr(pb_, 20); P.w_down = (const float*)(const __attribute__((address_space(1))) float*)ld_uptr(pb_, 21); P.out = (float*)(__attribute__((address_space(1))) float*)ld_uptr(pb_, 22); P.ws = (unsigned char*)(__attribute__((address_space(1))) unsigned char*)ld_uptr(pb_, 23); } \
    unsigned char* ws = P.ws; (void)ws; \
    float* SSQA = (float*)(ws + WS_SSQA); float* SSQB = (float*)(ws + WS_SSQB); float* CFOX = (float*)(ws + WS_CFOX); \
    float* LRUAGG = (float*)(ws + WS_LRUAGG); float* CB = (float*)(ws + WS_CB); \
    half_t* WIN_T = (half_t*)(ws + WS_WIN); half_t* WOUT_T = (half_t*)(ws + WS_WOUT); half_t* WGU_T = (half_t*)(ws + WS_WGU); half_t* WDN_T = (half_t*)(ws + WS_WDN); \
    half_t* FOXVT = (half_t*)(ws + WS_FOXVT); half_t* VST = (half_t*)(ws + WS_VST); half_t* VWT = (half_t*)(ws + WS_VWT); half_t* KCH = (half_t*)(ws + WS_KCH); half_t* VCT = (half_t*)(ws + WS_VCT); \
    half_t* W1T = (half_t*)(ws + WS_W1T); half_t* WGT = (half_t*)(ws + WS_WGT); float* LRUA = (float*)(ws + WS_LRUA); float* LRUB = (float*)(ws + WS_LRUB); (void)LRUA; (void)LRUB; \
    half_t* XH = (half_t*)(ws + WS_XH); half_t* MIXED = (half_t*)(ws + WS_MIXED); half_t* Z = (half_t*)(ws + WS_Z); half_t* HB = (half_t*)(ws + WS_Z); \
    (void)SSQA; (void)SSQB; (void)CFOX; (void)LRUAGG; (void)CB; (void)WIN_T; (void)WOUT_T; (void)WGU_T; (void)WDN_T; (void)FOXVT; (void)VST; (void)VWT; (void)KCH; (void)VCT; (void)W1T; (void)WGT; (void)XH; (void)MIXED; (void)Z; (void)HB

__global__ void __launch_bounds__(NTHR, 2) hymba_fwd(Params Pk) {
    extern __shared__ __attribute__((aligned(16))) unsigned char lds_raw[];
    LAS unsigned char* lds = (LAS unsigned char*)lds_raw;
    volatile LAS unsigned* MISC = (volatile LAS unsigned*)(lds + MISC_OFF);
    const int tid = threadIdx.x, lane = tid & 63, wave = __builtin_amdgcn_readfirstlane(tid >> 6);
    const int G = gridDim.x, bid = blockIdx.x;
    if (tid == 0) { LAS unsigned long long* pb = (LAS unsigned long long*)(lds + MISC_OFF + 512); pb[0] = (unsigned long long)Pk.x; pb[1] = (unsigned long long)Pk.norm_mix; pb[2] = (unsigned long long)Pk.w_in; pb[3] = (unsigned long long)Pk.lru_conv_w; pb[4] = (unsigned long long)Pk.lru_conv_b; pb[5] = (unsigned long long)Pk.lru_w_gates; pb[6] = (unsigned long long)Pk.lru_b_gates; pb[7] = (unsigned long long)Pk.lru_lambda; pb[8] = (unsigned long long)Pk.sc_conv_w; pb[9] = (unsigned long long)Pk.fox_f_bias; pb[10] = (unsigned long long)Pk.fox_qk_norm; pb[11] = (unsigned long long)Pk.nsa_qk_norm; pb[12] = (unsigned long long)Pk.nsa_cmp_pos; pb[13] = (unsigned long long)Pk.nsa_cmp_w1; pb[14] = (unsigned long long)Pk.nsa_cmp_w2; pb[15] = (unsigned long long)Pk.nsa_gate_bias; pb[16] = (unsigned long long)Pk.rel_bias; pb[17] = (unsigned long long)Pk.out_norm; pb[18] = (unsigned long long)Pk.w_out; pb[19] = (unsigned long long)Pk.norm_ffn; pb[20] = (unsigned long long)Pk.w_gate_up; pb[21] = (unsigned long long)Pk.w_down; pb[22] = (unsigned long long)Pk.out; pb[23] = (unsigned long long)Pk.ws; }
    unsigned* ctl = (unsigned*)(Pk.ws + WS_CTL);

    for (int u = tid; u < 64; u += NTHR) MISC[u] = 0u;
    __syncthreads();
    XcdBarrier bar = xcd_barrier_post(ctl + CW_BAR, MISC + 8);

    const int gw = bid * NWAVES + wave, NGW = G * NWAVES;

#ifndef SKIP_P0
    for (int rp0 = 0; rp0 < REP_P0; ++rp0) {
        SECTION_ENV();
        LAS unsigned* scr = (LAS unsigned*)(lds + wave * 8448);
        constexpr int I_IN = 16 * 44, I_OUT = 16 * 16, I_GU = 16 * 88, I_DN = 44 * 16, PER_L = I_IN + I_OUT + I_GU + I_DN;
        for (int it = gw; it < 2 * PER_L; it += NGW) {
            const int L = it / PER_L; int r = it % PER_L;
            if (r < I_IN) { p0_item<1>(P.w_in + (size_t)L * D * NIN_SRC, D, NIN_SRC, P.norm_mix + L * D, WIN_T + (size_t)L * NZP * D, r, 44, scr, lane); continue; } r -= I_IN;
            if (r < I_OUT) { p0_item<0>(P.w_out + (size_t)L * D * D, D, D, nullptr, WOUT_T + (size_t)L * D * D, r, 16, scr, lane); continue; } r -= I_OUT;
            if (r < I_GU) { p0_item<2>(P.w_gate_up + (size_t)L * D * 2 * DFF, D, 2 * DFF, P.norm_ffn + L * D, WGU_T + (size_t)L * 2 * DFF * D, r, 88, scr, lane); continue; } r -= I_GU;
            p0_item<0>(P.w_down + (size_t)L * DFF * D, DFF, D, nullptr, WDN_T + (size_t)L * D * DFF, r, 16, scr, lane);
        }
        for (int it = gw; it < 4 * 64 + 16; it += NGW) {
            if (it < 256) { const int ln = it >> 6; p0_item<0>(P.nsa_cmp_w1 + (size_t)ln * 2048 * 128, 2048, 128, nullptr, W1T + (size_t)ln * 128 * 2048, it & 63, 2, scr, lane); }
            else { const int gi = it - 256; p0_item<0>(P.lru_w_gates + (size_t)gi * 64 * 64, 64, 64, nullptr, WGT + (size_t)gi * 64 * 64, 0, 1, scr, lane); }
        }
        for (int og = gw; og < 4 * 512; og += NGW) {
            const int o = og & 511, qr = og >> 9, m = o & 127, ln = o >> 7;
            const float* pp = P.nsa_cmp_pos + (size_t)ln * 2048 + qr * 512; const float* wp = P.nsa_cmp_w1 + ((size_t)ln * 2048 + qr * 512) * 128 + m;
            float s = 0.f;
#pragma unroll
            for (int i = 0; i < 8; ++i) s = fmaf(pp[lane + 64 * i], wp[(size_t)(lane + 64 * i) * 128], s);
            s = wave_sum(s);
            if (lane == 0) CB[qr * 512 + o] = s;
        }
        for (int o = bid * NTHR + tid; o < 512; o += G * NTHR) CB[2048 + o] = -8.0f * LOG2E * log1pf(expf(-P.lru_lambda[o]));
        for (int row0 = gw; row0 < T; row0 += 4 * NGW) {
            f32x4 v[4][4];
#pragma unroll
            for (int rr = 0; rr < 4; ++rr)
#pragma unroll
                for (int j = 0; j < 4; ++j) v[rr][j] = ((const f32x4*)(P.x + (size_t)(row0 + rr * NGW) * D) + lane)[64 * j];
#pragma unroll
            for (int rr = 0; rr < 4; ++rr) { const int row = row0 + rr * NGW; float s = 0.f;
#pragma unroll
                for (int j = 0; j < 4; ++j) { const f32x4 w = v[rr][j]; s += (w.x * w.x + w.y * w.y) + (w.z * w.z + w.w * w.w);
                    u32x2 o; o.x = pack_h2(w.x, w.y); o.y = pack_h2(w.z, w.w); *(u32x2*)(XH + (size_t)row * D + 4 * (lane + 64 * j)) = o; }
                s = wave_sum(s);
                if (lane < 16) SSQB[(size_t)row * 16 + lane] = lane == 0 ? s : 0.f; }
        }
    }
#endif
    xcd_barrier(bar);

    for (int L = 0; L < 2; ++L) {
#ifndef SKIP_G1
        {
            SECTION_ENV();
            pg8::Gemm g{XH, WIN_T + (size_t)L * NZP * D, T, NZP, D}; pg8::StaticOrder S; S.init(T, NZP, G, bid);
            EpiZ E{Z, SSQB};
            for (int rp = 0; rp < REP_G1; ++rp) pg8::gemm_phase<EpiZ, pg8::StaticOrder>(lds, g, S, E);
        }
#endif
        xcd_barrier(bar);

        {
            SECTION_ENV();
#ifndef SKIP_P2AB
            {
                int tid = threadIdx.x; asm volatile("" : "+v"(tid)); const int lane = tid & 63;
                const int g8 = lane >> 3, sub = lane & 7;
                for (int dry = NORM_DRY; dry >= 0; --dry)
                for (int tok = gw; tok < T; tok += NGW) {
#pragma unroll
                    for (int rr = 0; rr < 2; ++rr) {
                        const int r = g8 + 8 * rr;
                        if (r < 14) {
                            int col; const float* gain;
                            if (r < 4) { col = ZC_FOX_Q + 64 * r; gain = P.fox_qk_norm + (L * 2 + 0) * 64; }
                            else if (r < 8) { col = ZC_FOX_K + 64 * (r - 4); gain = P.fox_qk_norm + (L * 2 + 1) * 64; }
                            else if (r < 12) { col = ZC_NSA_Q + 64 * (r - 8); gain = P.nsa_qk_norm + (L * 4 + 0) * 64; }
                            else if (r == 12) { col = ZC_KS; gain = P.nsa_qk_norm + (L * 4 + 2) * 64; }
                            else { col = ZC_KW; gain = P.nsa_qk_norm + (L * 4 + 3) * 64; }
                            half_t* p = Z + (size_t)tok * NZP + col + 8 * sub;
                            const h8 v = *(const h8*)p; float f[8]; float s = 0.f;
#pragma unroll
                            for (int e = 0; e < 8; ++e) { f[e] = (float)v[e]; s += f[e] * f[e]; }
                            s += __shfl_xor(s, 1); s += __shfl_xor(s, 2); s += __shfl_xor(s, 4);
                            const float rs = rsqrtf(s * (1.f / 64.f) + EPS) * ((r < 4 || (r >= 8 && r < 12)) ? QSCALE : 1.f);
                            const f32x4 g0 = *(const f32x4*)(gain + 8 * sub), g1 = *(const f32x4*)(gain + 8 * sub + 4);
                            if (dry) *(h8*)p = v; else
                            *(u32x4*)p = pack_h8((f32x4){f[0] * rs * g0.x, f[1] * rs * g0.y, f[2] * rs * g0.z, f[3] * rs * g0.w}, (f32x4){f[4] * rs * g1.x, f[5] * rs * g1.y, f[6] * rs * g1.z, f[7] * rs * g1.w});
                        }
                    }
                }
            }
            for (int rp = 0; rp < REP_CUM; ++rp)
            if (wave == 1)
            for (int task = 0; task < 32; ++task) if ((task * 8) % G == bid) {
                int tid = threadIdx.x; asm volatile("" : "+v"(tid)); const int lane = tid & 63;
                const int b = task >> 2, h = task & 3;
                const float fb = P.fox_f_bias[L * 4 + h];
                const half_t* zp = Z + ((size_t)b * SEQ + 64 * lane) * NZP + ZC_FOX_F + h;
                float vals[64];
#pragma unroll
                for (int j = 0; j < 64; ++j) vals[j] = (float)zp[(size_t)j * NZP];
                float run = 0.f;
#pragma unroll
                for (int j = 0; j < 64; ++j) { run += log_sigmoid(vals[j] + fb); vals[j] = run; }
                float incl = run;
#pragma unroll
                for (int o = 1; o < 64; o <<= 1) { const float n = __shfl_up(incl, o); if (lane >= o) incl += n; }
                const float excl = incl - run;
                float* cp = CFOX + ((size_t)b * 4 + h) * SEQ + 64 * lane;
#pragma unroll
                for (int j = 0; j < 64; j += 4) *(f32x4*)(cp + j) = (f32x4){vals[j] + excl, vals[j + 1] + excl, vals[j + 2] + excl, vals[j + 3] + excl};
            }
#endif
            for (int rp = 0; rp < REP_VT; ++rp)
            for (int ui = bid; ui < 512; ui += G) {
                int tid = threadIdx.x; asm volatile("" : "+v"(tid));
                const int b = ui >> 6, chunk = ui & 63; const size_t tokb = (size_t)b * SEQ + chunk * 64;
                LAS half_t* tb = (LAS half_t*)lds;
#pragma unroll
                for (int i = 0; i < 4; ++i) { const int p = tid + 512 * i, tk = p >> 5, c8 = p & 31;
                    *(LAS h8*)(tb + tk * 264 + 8 * c8) = *(const h8*)(Z + (tokb + tk) * NZP + ZC_FOX_V + 8 * c8); }
                LAS half_t* tb2 = tb + 64 * 264;
#pragma unroll
                for (int i = 0; i < 2; ++i) { const int p = tid + 512 * i, tk = p >> 4, c8 = p & 15;
                    *(LAS h8*)(tb2 + tk * 136 + 8 * c8) = *(const h8*)(Z + (tokb + tk) * NZP + (c8 < 8 ? ZC_VS + 8 * c8 : ZC_VW + 8 * (c8 - 8))); }
                __syncthreads();
                {
                    const int col = tid & 255, ktl = tid >> 8;
                    half_t* dst = FOXVT + ((size_t)(b * 128 + chunk * 2 + ktl) * 256 + col) * 32;
#pragma unroll
                    for (int j4 = 0; j4 < 4; ++j4) { h8 o;
#pragma unroll
                        for (int e = 0; e < 8; ++e) o[e] = tb[(32 * ktl + 8 * j4 + e) * 264 + col];
                        *(h8*)(dst + 8 * j4) = o; }
#pragma unroll
                    for (int i = 0; i < 2; ++i) { const int p = tid + 512 * i, which = p >> 9, d = (p >> 3) & 63, ch = p & 7; h8 o;
#pragma unroll
                        for (int e = 0; e < 8; ++e) o[e] = tb2[(8 * ch + e) * 136 + 64 * which + d];
                        *(h8*)((which ? VWT : VST) + ((size_t)(b * 64 + chunk) * 64 + d) * 64 + 8 * ch) = o; }
                }
                __syncthreads();
            }
#ifndef SKIP_P2CMP
            for (int rp = 0; rp < REP_P2CMP; ++rp)
            for (int ui = bid; ui < 256; ui += G) {
                int tid = threadIdx.x; asm volatile("" : "+v"(tid)); const int lane = tid & 63, r16 = lane & 15, kq = lane >> 4;
                const int net = ui >> 7, b = (ui >> 4) & 7, n0 = (ui & 15) * 16;
                const size_t tokb = (size_t)b * SEQ;
                LAS half_t* zt = (LAS half_t*)lds;
                LAS float* w2s = (LAS float*)(lds + 39424);
                LAS float* hidb = (LAS float*)(lds + 39424 + 32768);
                {
                    const half_t* zsrc = Z + (tokb + 16 * n0) * NZP + (net ? ZC_VC : ZC_KC);
                    for (int e = tid; e < 272 * 8; e += NTHR) { const int tk = e >> 3, c8 = e & 7; int tt = 16 * n0 + tk; const int tcl = tt > SEQ - 1 ? SEQ - 1 - 16 * n0 : tk;
                        *(LAS h8*)(zt + tk * 72 + 8 * c8) = *(const h8*)(zsrc + (size_t)tcl * NZP + 8 * c8); }
                    const float* w2g = P.nsa_cmp_w2 + (size_t)(L * 2 + net) * 128 * 64;
                    for (int e = tid; e < 128 * 16; e += NTHR) *(LAS f32x4*)(w2s + 4 * e) = *(const f32x4*)(w2g + 4 * e);
                }
                const half_t* w1t = W1T + ((size_t)((L * 2 + net) * 128 + 16 * wave + r16)) * 2048 + 8 * kq;
                h8 bf[16];
#pragma unroll
                for (int s = 0; s < 16; ++s) bf[s] = *(const h8*)(w1t + 32 * s);
                __syncthreads();
                {
                    f32x4 c0 = {0.f, 0.f, 0.f, 0.f}, c1 = {0.f, 0.f, 0.f, 0.f};
                    const LAS half_t* za = zt + (16 * r16) * 72 + 8 * kq;
#pragma unroll
                    for (int qd = 0; qd < 4; ++qd) {
                        h8 bn[16];
                        if (qd < 3) {
#pragma unroll
                            for (int s = 0; s < 16; ++s) bn[s] = *(const h8*)(w1t + 32 * (16 * (qd + 1) + s));
                        }
#pragma unroll
                        for (int s = 0; s < 16; s += 2) { const int sg = 16 * qd + s;
                            c0 = MFMA16(*(const LAS h8*)(za + (sg >> 1) * 72), bf[s], c0);
                            c1 = MFMA16(*(const LAS h8*)(za + (sg >> 1) * 72 + 32), bf[s + 1], c1); }
                        if (qd < 3) {
#pragma unroll
                            for (int s = 0; s < 16; ++s) bf[s] = bn[s];
                        }
                    }
                    const int m = 16 * wave + r16; const int cbi = (L * 2 + net) * 128 + m; const float cbm = ((CB[cbi] + CB[512 + cbi]) + CB[1024 + cbi]) + CB[1536 + cbi];
#pragma unroll
                    for (int rg = 0; rg < 4; ++rg) hidb[(4 * kq + rg) * 132 + m] = gelu_tanh((c0[rg] + c1[rg]) + cbm);
                }
                __syncthreads();
                {
                    const int d = lane;
                    float o0 = 0.f, o1 = 0.f; const LAS float* hp = hidb + (2 * wave) * 132;
#pragma unroll 16
                    for (int m = 0; m < 128; ++m) { const float w = w2s[m * 64 + d]; o0 = fmaf(hp[m], w, o0); o1 = fmaf(hp[132 + m], w, o1); }
                    float ov[2] = {o0, o1};
#pragma unroll
                    for (int i = 0; i < 2; ++i) { float o = ov[i]; const int n = n0 + 2 * wave + i;
                        if (net == 0) { const float ss = wave_sum(o * o); o = o * rsqrtf(ss * (1.f / 64.f) + EPS) * P.nsa_qk_norm[(L * 4 + 1) * 64 + d]; }
                        if (n >= NCMP) o = 0.f;
                        if (net == 0) KCH[((size_t)b * 256 + n) * 64 + d] = (half_t)o; else VCT[((size_t)b * 64 + d) * 256 + n] = (half_t)o; }
                }
                __syncthreads();
            }
#endif
#ifndef SKIP_P2LRU
            for (;;) { const int ui = q_next(ctl + CW_Q + (L * 4 + 3) * 8 * 64, MISC + 20); if (ui >= 1024) break;
                float hc = 0.f; lru_unit<false>(P, L, ui, lds, Z, WGT, CB + 2048, LRUAGG, LRUA, LRUB, MIXED, wave, hc, true); }
#endif
        }
        xcd_barrier(bar);

        {
        SECTION_ENV();
#ifndef SKIP_NSA
        if (wave == 0) {
            int tidf = threadIdx.x; asm volatile("" : "+v"(tidf));
            float gq = fabsf(P.nsa_qk_norm[(L * 4 + 0) * 64 + tidf]), gk = fmaxf(fmaxf(fabsf(P.nsa_qk_norm[(L * 4 + 1) * 64 + tidf]), fabsf(P.nsa_qk_norm[(L * 4 + 2) * 64 + tidf])), fabsf(P.nsa_qk_norm[(L * 4 + 3) * 64 + tidf]));
            float rb = fmaxf(fabsf(P.rel_bias[tidf]), fabsf(P.rel_bias[64 + tidf]));
#pragma unroll
            for (int o = 1; o < 64; o <<= 1) { gq = fmaxf(gq, __shfl_xor(gq, o)); gk = fmaxf(gk, __shfl_xor(gk, o)); rb = fmaxf(rb, __shfl_xor(rb, o)); }
            if (tidf == 0) MISC[16] = ((8.f * gq * gk + 2.f * rb) * LOG2E <= 15.8f) ? 1u : 0u;
        }
        __syncthreads();
        const bool nsa_fast = __builtin_amdgcn_readfirstlane((int)MISC[16]) != 0;
        if (nsa_fast)
        for (;;) {
            const int ui = q_next(ctl + CW_Q + ((L * 4 + 0) * 8 + (bid & 7)) * 64, MISC + 20); if (ui >= 64) break;
            int tid = threadIdx.x; asm volatile("" : "+v"(tid)); const int lane = tid & 63, hb = lane >> 5, qi = lane & 31;
            const int h = wave & 3, rh = wave >> 2;
            const int b = bid & 7, qt = 63 - ui, t0 = qt * 64, t = t0 + 32 * rh + qi, cur = qt, row = 32 * rh + qi;
            const size_t tokb = (size_t)b * SEQ;
            constexpr int NS_VT = 9216, NS_STAGE = 18432, NF_TRX = 36864, NF_IMP = NF_TRX + 4 * 520 * 4, NF_SELM = NF_IMP + 4 * 64 * 65 * 4, NF_EX = NF_SELM + 512, NF_STL = NF_EX + 1024, NF_MISC = NF_STL + 1024;
            static_assert(NF_MISC + 256 <= RING_BYTES, "NSA fast LDS map");
            LAS float* TRX = (LAS float*)(lds + NF_TRX); LAS float* impH = (LAS float*)(lds + NF_IMP); LAS unsigned* selm = (LAS unsigned*)(lds + NF_SELM);
            LAS float* ex = (LAS float*)(lds + NF_EX); LAS float* stl = (LAS float*)(lds + NF_STL); LAS unsigned* misc = (LAS unsigned*)(lds + NF_MISC);
            for (int e = tid; e < 4 * 520; e += NTHR) { const int hh = e / 520, i = e % 520, d = i - 1;
                TRX[e] = (i == 0 || i > 512) ? -INFINITY : (P.rel_bias[(d < 128 ? (int)c_bucket[d] : 31) * 4 + hh] - P.rel_bias[31 * 4 + hh]) * LOG2E; }
            for (int e = tid; e < 4 * 64 * 65; e += NTHR) impH[e] = 0.f;
            const LAS float* TXh = TRX + h * 520;
            h8 q[4];
#pragma unroll
            for (int kk = 0; kk < 4; ++kk) q[kk] = *(const h8*)(Z + (tokb + t) * NZP + ZC_NSA_Q + 64 * h + 16 * kk + 8 * hb);
            const float* gb = P.nsa_gate_bias + L * 12;
            const half_t* gz = Z + (tokb + t) * NZP + ZC_NSA_G;
            f32x16 T0, T1;
            u32x4 kr, vr, krB, vrB;
#define NS_ISSUE_R(KR, VR, kbase_, kstride_, vbase_, vstride_) do { KR = *(const u32x4*)((const char*)(kbase_) + (size_t)(tid >> 3) * (kstride_) + (tid & 7) * 16); \
                VR = *(const u32x4*)((const char*)(vbase_) + (size_t)(tid >> 3) * (vstride_) + (tid & 7) * 16); } while (0)
#define NS_WRITE_R(KR, VR, sb_) do { *(LAS u32x4*)(lds + (sb_) + (tid >> 3) * 144 + (tid & 7) * 16) = KR; *(LAS u32x4*)(lds + (sb_) + NS_VT + (tid >> 3) * 144 + (tid & 7) * 16) = VR; } while (0)
            {
                int cnt = (t0 + 63 - 31) / 16 + 1; if (cnt > NCMP) cnt = NCMP;
                const int ntc = (cnt + 63) >> 6;
                const half_t* kcb = KCH + (size_t)b * 256 * 64; const half_t* vcb = VCT + (size_t)b * 64 * 256;
                float l = 0.f;
#pragma unroll
                for (int r = 0; r < 16; ++r) { T0[r] = 0.f; T1[r] = 0.f; }
                for (int c = 0; c < ntc; ++c) {
                    __syncthreads();
                    NS_ISSUE_R(kr, vr, kcb + (size_t)c * 64 * 64, 128, vcb + c * 64, 512); NS_WRITE_R(kr, vr, 0);
                    __syncthreads();
                    f32x16 S0, S1; init_tab(S0, S1, TXh, t - 31 - 1024 * c, hb, 16, 511, true);
                    qk64(S0, S1, q, lds, qi, hb);
                    l += exp_sum64(S0, S1);
                    LAS float* ip = impH + (h * 64 + row) * 65 + 16 * c + 2 * hb;
#pragma unroll
                    for (int g = 0; g < 4; ++g) {
                        const int mo = 4 * (g >> 1) + (g & 1);
                        { const float v1 = 16.f * S0[4 * g + 3], v0 = 32.f * ((S0[4 * g] + S0[4 * g + 1]) + S0[4 * g + 2]) + v1;
                          __hip_atomic_fetch_add(ip + mo, v0, __ATOMIC_RELAXED, __HIP_MEMORY_SCOPE_WORKGROUP); if (16 * c + 2 * hb + mo + 1 < 64) __hip_atomic_fetch_add(ip + mo + 1, v1, __ATOMIC_RELAXED, __HIP_MEMORY_SCOPE_WORKGROUP); }
                        { const float v1 = 16.f * S1[4 * g + 3], v0 = 32.f * ((S1[4 * g] + S1[4 * g + 1]) + S1[4 * g + 2]) + v1;
                          __hip_atomic_fetch_add(ip + 8 + mo, v0, __ATOMIC_RELAXED, __HIP_MEMORY_SCOPE_WORKGROUP); if (16 * c + 2 * hb + 8 + mo + 1 < 64) __hip_atomic_fetch_add(ip + 8 + mo + 1, v1, __ATOMIC_RELAXED, __HIP_MEMORY_SCOPE_WORKGROUP); }
                    }
                    pv64m(S0, S1, true, lds + NS_VT, T0, T1, qi, hb);
                }
                l += __shfl_xor(l, 32);
                const float il = l > 0.f ? __builtin_amdgcn_rcpf(l) : 0.f;
                if (hb == 0) stl[row * 4 + h] = il;
                const float g0 = sigmoidf_((float)gz[0 * 4 + h] + gb[0 * 4 + h]) * il;
#pragma unroll
                for (int r = 0; r < 16; ++r) { T0[r] *= g0; T1[r] *= g0; }
            }
            __syncthreads();
            for (int rpQ = 0; rpQ < REP_NSELECT; ++rpQ)
            for (int rr = 0; rr < 8; ++rr) {
                const int rw = wave * 8 + rr;
                float v = ((impH[(0 * 64 + rw) * 65 + lane] * stl[rw * 4 + 0] + impH[(1 * 64 + rw) * 65 + lane] * stl[rw * 4 + 1]) + impH[(2 * 64 + rw) * 65 + lane] * stl[rw * 4 + 2]) + impH[(3 * 64 + rw) * 65 + lane] * stl[rw * 4 + 3];
                if (lane > cur) v = -INFINITY; else if (lane == 0 || lane == cur || lane == cur - 1) v = 1e30f;
                int rank = 0;
#pragma unroll
                for (int o = 0; o < 64; ++o) { const float w = __builtin_bit_cast(float, __builtin_amdgcn_readlane(__builtin_bit_cast(int, v), o)); rank += (w > v || (w == v && o < lane)) ? 1 : 0; }
                const unsigned long long msk = __ballot(rank < 16);
                if (lane == 0) { selm[rw * 2] = (unsigned)msk; selm[rw * 2 + 1] = (unsigned)(msk >> 32); }
            }
            __syncthreads();
            if (wave == 0) {
                unsigned lo = selm[lane * 2], hi = selm[lane * 2 + 1];
#pragma unroll
                for (int o = 1; o < 64; o <<= 1) { lo |= __shfl_xor(lo, o); hi |= __shfl_xor(hi, o); }
                if (lane == 0) { misc[0] = lo; misc[1] = hi; }
            }
            __syncthreads();
            const unsigned long long mymask = (unsigned long long)selm[row * 2] | ((unsigned long long)selm[row * 2 + 1] << 32);
            unsigned long long um = (unsigned long long)(unsigned)__builtin_amdgcn_readfirstlane((int)misc[0]) | ((unsigned long long)(unsigned)__builtin_amdgcn_readfirstlane((int)misc[1]) << 32);
            um &= (cur >= 63) ? ~0ull : ((1ull << (cur + 1)) - 1ull);
            const unsigned long long um_all = um;
            for (int rpS = 0; rpS < REP_NSEL; ++rpS) {
                um = um_all; if (rpS) __syncthreads();
                f32x16 O0, O1;
#pragma unroll
                for (int r = 0; r < 16; ++r) { O0[r] = 0.f; O1[r] = 0.f; }
                float l = 0.f;
                int jc = __builtin_ctzll(um); um &= um - 1;
                int jn = -1; if (um) { jn = __builtin_ctzll(um); um &= um - 1; }
                int it = 0;
#define SEL_K(j_) (Z + (tokb + 64 * (j_)) * NZP + ZC_KS)
#define SEL_V(j_) (VST + (size_t)(b * 64 + (j_)) * 64 * 64)
                NS_ISSUE_R(kr, vr, SEL_K(jc), NZP * 2, SEL_V(jc), 128); NS_WRITE_R(kr, vr, 0);
                { const int je = jn >= 0 ? jn : jc; NS_ISSUE_R(kr, vr, SEL_K(je), NZP * 2, SEL_V(je), 128); }
                __syncthreads();
#define SEL_BODY(KX, VX, KY, VY) do { \
                    int jnn = -1; if (um) { jnn = __builtin_ctzll(um); um &= um - 1; } \
                    { const int je = jnn >= 0 ? jnn : jc; NS_ISSUE_R(KY, VY, SEL_K(je), NZP * 2, SEL_V(je), 128); } \
                    { const bool sel = (mymask >> jc) & 1ull; \
                      if (__any(sel)) { f32x16 S0, S1; const LAS unsigned char* st_ = lds + (it & 1) * NS_STAGE; \
                          if (jc >= cur - 2) { init_tab(S0, S1, TXh, t - 64 * jc, hb, 1, 511, sel); qk64(S0, S1, q, st_, qi, hb); } else qk64z(S0, S1, q, st_, qi, hb); \
                          const float ps_ = exp_sum64(S0, S1); l += sel ? ps_ : 0.f; \
                          pv64m(S0, S1, sel, st_ + NS_VT, O0, O1, qi, hb); } } \
                    if (jn >= 0) NS_WRITE_R(KX, VX, ((it + 1) & 1) * NS_STAGE); \
                    __syncthreads(); jc = jn; jn = jnn; ++it; } while (0)
                for (;;) { SEL_BODY(kr, vr, krB, vrB); if (jc < 0) break; SEL_BODY(krB, vrB, kr, vr); if (jc < 0) break; }
#undef SEL_BODY
#undef SEL_K
#undef SEL_V
                l += __shfl_xor(l, 32);
                const float g1 = sigmoidf_((float)gz[1 * 4 + h] + gb[1 * 4 + h]) * __builtin_amdgcn_rcpf(l);
                if (rpS == REP_NSEL - 1) {
#pragma unroll
                for (int r = 0; r < 16; ++r) { T0[r] += g1 * O0[r]; T1[r] += g1 * O1[r]; } }
            }
            __syncthreads();
            for (int rpW = 0; rpW < REP_NWIN; ++rpW) {
                if (rpW) __syncthreads();
                f32x16 O0, O1;
#pragma unroll
                for (int r = 0; r < 16; ++r) { O0[r] = 0.f; O1[r] = 0.f; }
                float l = 0.f;
                const int jlo = cur >= 8 ? cur - 8 : 0;
#define WIN_K(j_) (Z + (tokb + 64 * (j_)) * NZP + ZC_KW)
#define WIN_V(j_) (VWT + (size_t)(b * 64 + (j_)) * 64 * 64)
                NS_ISSUE_R(kr, vr, WIN_K(jlo), NZP * 2, WIN_V(jlo), 128); NS_WRITE_R(kr, vr, 0);
                { const int je = jlo + 1 <= cur ? jlo + 1 : cur; NS_ISSUE_R(kr, vr, WIN_K(je), NZP * 2, WIN_V(je), 128); }
                __syncthreads();
                int j = jlo;
#define WIN_BODY(KX, VX, KY, VY) do { \
                    { const int je = j + 2 <= cur ? j + 2 : cur; NS_ISSUE_R(KY, VY, WIN_K(je), NZP * 2, WIN_V(je), 128); } \
                    { f32x16 S0, S1; const LAS unsigned char* st_ = lds + ((j - jlo) & 1) * NS_STAGE; \
                      if (j >= cur - 2 || j == cur - 8) { init_tab(S0, S1, TXh, t - 64 * j, hb, 1, 512, true); qk64(S0, S1, q, st_, qi, hb); } else qk64z(S0, S1, q, st_, qi, hb); \
                      l += exp_sum64(S0, S1); \
                      pv64m(S0, S1, true, st_ + NS_VT, O0, O1, qi, hb); } \
                    if (j + 1 <= cur) NS_WRITE_R(KX, VX, (((j - jlo) + 1) & 1) * NS_STAGE); \
                    __syncthreads(); ++j; } while (0)
                for (;;) { WIN_BODY(kr, vr, krB, vrB); if (j > cur) break; WIN_BODY(krB, vrB, kr, vr); if (j > cur) break; }
#undef WIN_BODY
#undef WIN_K
#undef WIN_V
                l += __shfl_xor(l, 32);
                const float g2 = sigmoidf_((float)gz[2 * 4 + h] + gb[2 * 4 + h]) * __builtin_amdgcn_rcpf(l);
                if (rpW == REP_NWIN - 1) {
#pragma unroll
                for (int r = 0; r < 16; ++r) { T0[r] += g2 * O0[r]; T1[r] += g2 * O1[r]; } }
            }
#undef NS_ISSUE_R
#undef NS_WRITE_R
            {
                float ss = 0.f;
#pragma unroll
                for (int r = 0; r < 16; ++r) ss += T0[r] * T0[r] + T1[r] * T1[r];
                ss += __shfl_xor(ss, 32);
                if (hb == 0) ex[row * 4 + h] = ss;
                __syncthreads();
                const float rs = rsqrtf((ex[row * 4] + ex[row * 4 + 1] + ex[row * 4 + 2] + ex[row * 4 + 3]) * (1.f / 256.f) + EPS);
                const float* gn = P.out_norm + (L * 4 + 3) * 256 + h * 64;
                half_t* op = MIXED + (tokb + t) * D + 768 + h * 64;
#pragma unroll
                for (int g = 0; g < 4; ++g) {
                    const int d0 = 8 * g + 4 * hb; const f32x4 g0 = *(const f32x4*)(gn + d0), g1 = *(const f32x4*)(gn + 32 + d0);
                    u32x2 o0, o1;
                    o0.x = pack_h2(T0[4 * g] * rs * g0.x, T0[4 * g + 1] * rs * g0.y); o0.y = pack_h2(T0[4 * g + 2] * rs * g0.z, T0[4 * g + 3] * rs * g0.w);
                    o1.x = pack_h2(T1[4 * g] * rs * g1.x, T1[4 * g + 1] * rs * g1.y); o1.y = pack_h2(T1[4 * g + 2] * rs * g1.z, T1[4 * g + 3] * rs * g1.w);
                    *(u32x2*)(op + d0) = o0; *(u32x2*)(op + 32 + d0) = o1;
                }
            }
            __syncthreads();
        }
        else
        for (;;) {
            const int ui = q_next(ctl + CW_Q + ((L * 4 + 0) * 8 + (bid & 7)) * 64, MISC + 20); if (ui >= 64) break;
            int tid = threadIdx.x; asm volatile("" : "+v"(tid)); const int lane = tid & 63, hb = lane >> 5, qi = lane & 31;
            const int h = wave & 3, rh = wave >> 2;
            const int b = bid & 7, qt = 63 - ui, t0 = qt * 64, t = t0 + 32 * rh + qi, cur = qt, row = 32 * rh + qi;
            const size_t tokb = (size_t)b * SEQ;
            constexpr int NS_VT = 9216, NS_STAGE = 18432, NS_TR = 36864, NS_IMP = 38976, NS_SELM = NS_IMP + 4 * 64 * 65 * 4, NS_EX = NS_SELM + 512, NS_MISC = NS_EX + 1024;
            static_assert(NS_MISC + 256 <= RING_BYTES, "NSA LDS map");
            LAS float* TR = (LAS float*)(lds + NS_TR); LAS float* impH = (LAS float*)(lds + NS_IMP); LAS unsigned* selm = (LAS unsigned*)(lds + NS_SELM);
            LAS float* ex = (LAS float*)(lds + NS_EX); LAS unsigned* misc = (LAS unsigned*)(lds + NS_MISC);
            for (int e = tid; e < 4 * 129; e += NTHR) { const int hh = e / 129, d = e % 129; TR[hh * 132 + d] = P.rel_bias[(d < 128 ? (int)c_bucket[d] : 31) * 4 + hh] * LOG2E; }
            for (int e = tid; e < 4 * 64 * 65; e += NTHR) impH[e] = 0.f;
            const LAS float* TRh = TR + h * 132;
            h8 q[4];
#pragma unroll
            for (int kk = 0; kk < 4; ++kk) q[kk] = *(const h8*)(Z + (tokb + t) * NZP + ZC_NSA_Q + 64 * h + 16 * kk + 8 * hb);
            const float* gb = P.nsa_gate_bias + L * 12;
            const half_t* gz = Z + (tokb + t) * NZP + ZC_NSA_G;
            f32x16 T0, T1;
            u32x4 kr, vr, krB, vrB;
#define NS_ISSUE_R(KR, VR, kbase_, kstride_, vbase_, vstride_) do { KR = *(const u32x4*)((const char*)(kbase_) + (size_t)(tid >> 3) * (kstride_) + (tid & 7) * 16); \
                VR = *(const u32x4*)((const char*)(vbase_) + (size_t)(tid >> 3) * (vstride_) + (tid & 7) * 16); } while (0)
#define NS_WRITE_R(KR, VR, sb_) do { *(LAS u32x4*)(lds + (sb_) + (tid >> 3) * 144 + (tid & 7) * 16) = KR; *(LAS u32x4*)(lds + (sb_) + NS_VT + (tid >> 3) * 144 + (tid & 7) * 16) = VR; } while (0)
#define NS_ISSUE(kbase_, kstride_, vbase_, vstride_) do { kr = *(const u32x4*)((const char*)(kbase_) + (size_t)(tid >> 3) * (kstride_) + (tid & 7) * 16); \
                vr = *(const u32x4*)((const char*)(vbase_) + (size_t)(tid >> 3) * (vstride_) + (tid & 7) * 16); } while (0)
#define NS_WRITE(sb_) do { *(LAS u32x4*)(lds + (sb_) + (tid >> 3) * 144 + (tid & 7) * 16) = kr; *(LAS u32x4*)(lds + (sb_) + NS_VT + (tid >> 3) * 144 + (tid & 7) * 16) = vr; } while (0)
            {
                int cnt = (t0 + 63 - 31) / 16 + 1; if (cnt > NCMP) cnt = NCMP;
                const int ntc = (cnt + 63) >> 6;
                const half_t* kcb = KCH + (size_t)b * 256 * 64; const half_t* vcb = VCT + (size_t)b * 64 * 256;
                float m = -1e30f, l = 0.f;
                for (int c = 0; c < ntc; ++c) {
                    __syncthreads();
                    NS_ISSUE(kcb + (size_t)c * 64 * 64, 128, vcb + c * 64, 512); NS_WRITE(0);
                    __syncthreads();
                    f32x16 S0, S1; init_near(S0, S1, TRh, t - 31 - 1024 * c, hb, 16, 1 << 30);
                    qk64(S0, S1, q, lds, qi, hb);
                    const float mn = fmaxf(m, rowmax64(S0, S1)), alpha = __builtin_amdgcn_exp2f(m - mn);
                    m = mn; float ps = 0.f;
#pragma unroll
                    for (int r = 0; r < 16; ++r) ps += __builtin_amdgcn_exp2f(S0[r] - mn) + __builtin_amdgcn_exp2f(S1[r] - mn);
                    l = l * alpha + ps;
                }
                l += __shfl_xor(l, 32);
                const float il = l > 0.f ? __builtin_amdgcn_rcpf(l) : 0.f;
#pragma unroll
                for (int r = 0; r < 16; ++r) { T0[r] = 0.f; T1[r] = 0.f; }
                for (int c = 0; c < ntc; ++c) {
                    __syncthreads();
                    NS_ISSUE(kcb + (size_t)c * 64 * 64, 128, vcb + c * 64, 512); NS_WRITE(0);
                    __syncthreads();
                    f32x16 S0, S1; init_near(S0, S1, TRh, t - 31 - 1024 * c, hb, 16, 1 << 30);
                    qk64(S0, S1, q, lds, qi, hb);
#pragma unroll
                    for (int r = 0; r < 16; ++r) { S0[r] = __builtin_amdgcn_exp2f(S0[r] - m) * il; S1[r] = __builtin_amdgcn_exp2f(S1[r] - m) * il; }
                    LAS float* ip = impH + (h * 64 + row) * 65 + 16 * c + 2 * hb;
#pragma unroll
                    for (int g = 0; g < 4; ++g) {
                        const int mo = 4 * (g >> 1) + (g & 1);
                        { const float v1 = 16.f * S0[4 * g + 3], v0 = 32.f * ((S0[4 * g] + S0[4 * g + 1]) + S0[4 * g + 2]) + v1;
                          __hip_atomic_fetch_add(ip + mo, v0, __ATOMIC_RELAXED, __HIP_MEMORY_SCOPE_WORKGROUP); if (16 * c + 2 * hb + mo + 1 < 64) __hip_atomic_fetch_add(ip + mo + 1, v1, __ATOMIC_RELAXED, __HIP_MEMORY_SCOPE_WORKGROUP); }
                        { const float v1 = 16.f * S1[4 * g + 3], v0 = 32.f * ((S1[4 * g] + S1[4 * g + 1]) + S1[4 * g + 2]) + v1;
                          __hip_atomic_fetch_add(ip + 8 + mo, v0, __ATOMIC_RELAXED, __HIP_MEMORY_SCOPE_WORKGROUP); if (16 * c + 2 * hb + 8 + mo + 1 < 64) __hip_atomic_fetch_add(ip + 8 + mo + 1, v1, __ATOMIC_RELAXED, __HIP_MEMORY_SCOPE_WORKGROUP); }
                    }
                    pv64(S0, S1, lds + NS_VT, T0, T1, qi, hb);
                }
                const float g0 = sigmoidf_((float)gz[0 * 4 + h] + gb[0 * 4 + h]);
#pragma unroll
                for (int r = 0; r < 16; ++r) { T0[r] *= g0; T1[r] *= g0; }
            }
            __syncthreads();
            for (int rr = 0; rr < 8; ++rr) {
                const int rw = wave * 8 + rr;
                float v = ((impH[(0 * 64 + rw) * 65 + lane] + impH[(1 * 64 + rw) * 65 + lane]) + impH[(2 * 64 + rw) * 65 + lane]) + impH[(3 * 64 + rw) * 65 + lane];
                if (lane > cur) v = -INFINITY; else if (lane == 0 || lane == cur || lane == cur - 1) v = 1e30f;
                int rank = 0;
#pragma unroll
                for (int o = 0; o < 64; ++o) { const float w = __builtin_bit_cast(float, __builtin_amdgcn_readlane(__builtin_bit_cast(int, v), o)); rank += (w > v || (w == v && o < lane)) ? 1 : 0; }
                const unsigned long long msk = __ballot(rank < 16);
                if (lane == 0) { selm[rw * 2] = (unsigned)msk; selm[rw * 2 + 1] = (unsigned)(msk >> 32); }
            }
            __syncthreads();
            if (wave == 0) {
                unsigned lo = selm[lane * 2], hi = selm[lane * 2 + 1];
#pragma unroll
                for (int o = 1; o < 64; o <<= 1) { lo |= __shfl_xor(lo, o); hi |= __shfl_xor(hi, o); }
                if (lane == 0) { misc[0] = lo; misc[1] = hi; }
            }
            __syncthreads();
            const unsigned long long mymask = (unsigned long long)selm[row * 2] | ((unsigned long long)selm[row * 2 + 1] << 32);
            unsigned long long um = (unsigned long long)__builtin_amdgcn_readfirstlane((int)misc[0]) | ((unsigned long long)(unsigned)__builtin_amdgcn_readfirstlane((int)misc[1]) << 32);
            um &= (cur >= 63) ? ~0ull : ((1ull << (cur + 1)) - 1ull);
            const float cfar = TRh[128];
            {
                f32x16 O0, O1;
#pragma unroll
                for (int r = 0; r < 16; ++r) { O0[r] = 0.f; O1[r] = 0.f; }
                float m = -1e30f, l = 0.f;
                int jc = __builtin_ctzll(um); um &= um - 1;
                int jn = -1; if (um) { jn = __builtin_ctzll(um); um &= um - 1; }
                int it = 0;
#define SEL_K(j_) (Z + (tokb + 64 * (j_)) * NZP + ZC_KS)
#define SEL_V(j_) (VST + (size_t)(b * 64 + (j_)) * 64 * 64)
                NS_ISSUE_R(kr, vr, SEL_K(jc), NZP * 2, SEL_V(jc), 128); NS_WRITE_R(kr, vr, 0);
                { const int je = jn >= 0 ? jn : jc; NS_ISSUE_R(kr, vr, SEL_K(je), NZP * 2, SEL_V(je), 128); }
                __syncthreads();
#define SEL_BODY(KX, VX, KY, VY) do { \
                    int jnn = -1; if (um) { jnn = __builtin_ctzll(um); um &= um - 1; } \
                    { const int je = jnn >= 0 ? jnn : jc; NS_ISSUE_R(KY, VY, SEL_K(je), NZP * 2, SEL_V(je), 128); } \
                    { const bool sel = (mymask >> jc) & 1ull; \
                      if (__any(sel)) nsa_tile(jc >= cur - 2, t - 64 * jc, sel ? (1 << 30) : 0, sel ? cfar : -INFINITY, TRh, q, lds + (it & 1) * NS_STAGE, m, l, O0, O1, qi, hb); } \
                    if (jn >= 0) NS_WRITE_R(KX, VX, ((it + 1) & 1) * NS_STAGE); \
                    __syncthreads(); jc = jn; jn = jnn; ++it; } while (0)
                for (;;) { SEL_BODY(kr, vr, krB, vrB); if (jc < 0) break; SEL_BODY(krB, vrB, kr, vr); if (jc < 0) break; }
#undef SEL_BODY
#undef SEL_K
#undef SEL_V
                l += __shfl_xor(l, 32);
                const float g1 = sigmoidf_((float)gz[1 * 4 + h] + gb[1 * 4 + h]) * __builtin_amdgcn_rcpf(l);
#pragma unroll
                for (int r = 0; r < 16; ++r) { T0[r] += g1 * O0[r]; T1[r] += g1 * O1[r]; }
            }
            __syncthreads();
            {
                f32x16 O0, O1;
#pragma unroll
                for (int r = 0; r < 16; ++r) { O0[r] = 0.f; O1[r] = 0.f; }
                float m = -1e30f, l = 0.f;
                const int jlo = cur >= 8 ? cur - 8 : 0;
#define WIN_K(j_) (Z + (tokb + 64 * (j_)) * NZP + ZC_KW)
#define WIN_V(j_) (VWT + (size_t)(b * 64 + (j_)) * 64 * 64)
                NS_ISSUE_R(kr, vr, WIN_K(jlo), NZP * 2, WIN_V(jlo), 128); NS_WRITE_R(kr, vr, 0);
                { const int je = jlo + 1 <= cur ? jlo + 1 : cur; NS_ISSUE_R(kr, vr, WIN_K(je), NZP * 2, WIN_V(je), 128); }
                __syncthreads();
                int j = jlo;
#define WIN_BODY(KX, VX, KY, VY) do { \
                    { const int je = j + 2 <= cur ? j + 2 : cur; NS_ISSUE_R(KY, VY, WIN_K(je), NZP * 2, WIN_V(je), 128); } \
                    nsa_tile(j >= cur - 2 || j == cur - 8, t - 64 * j, 512, cfar, TRh, q, lds + ((j - jlo) & 1) * NS_STAGE, m, l, O0, O1, qi, hb); \
                    if (j + 1 <= cur) NS_WRITE_R(KX, VX, (((j - jlo) + 1) & 1) * NS_STAGE); \
                    __syncthreads(); ++j; } while (0)
                for (;;) { WIN_BODY(kr, vr, krB, vrB); if (j > cur) break; WIN_BODY(krB, vrB, kr, vr); if (j > cur) break; }
#undef WIN_BODY
#undef WIN_K
#undef WIN_V
                l += __shfl_xor(l, 32);
                const float g2 = sigmoidf_((float)gz[2 * 4 + h] + gb[2 * 4 + h]) * __builtin_amdgcn_rcpf(l);
#pragma unroll
                for (int r = 0; r < 16; ++r) { T0[r] += g2 * O0[r]; T1[r] += g2 * O1[r]; }
            }
#undef NS_ISSUE
#undef NS_WRITE
#undef NS_ISSUE_R
#undef NS_WRITE_R
            {
                float ss = 0.f;
#pragma unroll
                for (int r = 0; r < 16; ++r) ss += T0[r] * T0[r] + T1[r] * T1[r];
                ss += __shfl_xor(ss, 32);
                if (hb == 0) ex[row * 4 + h] = ss;
                __syncthreads();
                const float rs = rsqrtf((ex[row * 4] + ex[row * 4 + 1] + ex[row * 4 + 2] + ex[row * 4 + 3]) * (1.f / 256.f) + EPS);
                const float* gn = P.out_norm + (L * 4 + 3) * 256 + h * 64;
                half_t* op = MIXED + (tokb + t) * D + 768 + h * 64;
#pragma unroll
                for (int g = 0; g < 4; ++g) {
                    const int d0 = 8 * g + 4 * hb; const f32x4 g0 = *(const f32x4*)(gn + d0), g1 = *(const f32x4*)(gn + 32 + d0);
                    u32x2 o0, o1;
                    o0.x = pack_h2(T0[4 * g] * rs * g0.x, T0[4 * g + 1] * rs * g0.y); o0.y = pack_h2(T0[4 * g + 2] * rs * g0.z, T0[4 * g + 3] * rs * g0.w);
                    o1.x = pack_h2(T1[4 * g] * rs * g1.x, T1[4 * g + 1] * rs * g1.y); o1.y = pack_h2(T1[4 * g + 2] * rs * g1.z, T1[4 * g + 3] * rs * g1.w);
                    *(u32x2*)(op + d0) = o0; *(u32x2*)(op + 32 + d0) = o1;
                }
            }
            __syncthreads();
        }
#endif
#ifndef SKIP_FOX
        for (;;) {
            const int ui = q_next(ctl + CW_Q + ((L * 4 + 1) * 8 + (bid & 7)) * 64, MISC + 20); if (ui >= 64) break;
            int tid = threadIdx.x; asm volatile("" : "+v"(tid)); const int lane = tid & 63, hb = lane >> 5, qi = lane & 31;
            const int h = wave & 3, rh = wave >> 2;
            const int b = bid & 7, qt = 63 - ui, t0 = qt * 64, t = t0 + 32 * rh + qi;
            const size_t tokb = (size_t)b * SEQ;
            const float* cf = CFOX + (size_t)b * 4 * SEQ;
            constexpr int FX_VT = 18432, FX_CB = 38912, FX_STAGE = 39424, FX_EX = 2 * FX_STAGE, FX_MISC = FX_EX + 1024;
            LAS unsigned* misc = (LAS unsigned*)(lds + FX_MISC);
            if (wave == 0) {
                float gq = fabsf(P.fox_qk_norm[(L * 2 + 0) * 64 + lane]), gk = fabsf(P.fox_qk_norm[(L * 2 + 1) * 64 + lane]);
#pragma unroll
                for (int o = 1; o < 64; o <<= 1) { gq = fmaxf(gq, __shfl_xor(gq, o)); gk = fmaxf(gk, __shfl_xor(gk, o)); }
                const float bound = -(30.f + 16.f * gq * gk);
                const float sb2 = 8.f * gq * gk * LOG2E;
                if (lane == 0) { misc[1] = sb2 <= 15.8f ? 1u : 0u; misc[2] = __builtin_bit_cast(unsigned, 15.8f - sb2); }
                bool c0 = false, c1 = false;
#pragma unroll
                for (int hh = 0; hh < 4; ++hh) { const float cref = cf[hh * SEQ + t0];
                    const int e0 = 32 * lane + 31, e1 = 32 * (lane + 64) + 31;
                    c0 = c0 || (e0 >= t0) || (cref - cf[hh * SEQ + (e0 < SEQ ? e0 : SEQ - 1)] > bound);
                    c1 = c1 || (e1 >= t0) || (cref - cf[hh * SEQ + (e1 < SEQ ? e1 : SEQ - 1)] > bound); }
                const unsigned long long b0 = __ballot(c0), b1 = __ballot(c1);
                if (lane == 0) misc[0] = b0 ? (unsigned)__builtin_ctzll(b0) : 64u + (unsigned)__builtin_ctzll(b1);
            }
            __syncthreads();
            const int kt_lo = __builtin_amdgcn_readfirstlane((int)misc[0]), kt_hi = 2 * qt + 1;
            const bool fx_fast = __builtin_amdgcn_readfirstlane((int)misc[1]) != 0;
            const float fx_sh = __builtin_bit_cast(float, __builtin_amdgcn_readfirstlane((int)misc[2]));
            h8 q[4];
#pragma unroll
            for (int kk = 0; kk < 4; ++kk) q[kk] = *(const h8*)(Z + (tokb + t) * NZP + ZC_FOX_Q + 64 * h + 16 * kk + 8 * hb);
            f32x16 O0, O1;
#pragma unroll
            for (int r = 0; r < 16; ++r) { O0[r] = 0.f; O1[r] = 0.f; }
            float m = fx_fast ? -((cf[h * SEQ + t] - cf[h * SEQ + t0]) * LOG2E + fx_sh) : -1e30f, l = 0.f;
            u32x4 krA[2], vrA[2], krB[2], vrB[2]; float cbA = 0.f, cbB = 0.f;
            const float cref = cf[((tid >> 5) & 3) * SEQ + t0];
#define FX_ISSUE(KR, VR, CB, kt_) do { _Pragma("unroll") for (int i_ = 0; i_ < 2; ++i_) { const int p_ = tid + 512 * i_; \
                KR[i_] = *(const u32x4*)(Z + (tokb + 32 * (kt_) + (p_ >> 5)) * NZP + ZC_FOX_K + 8 * (p_ & 31)); \
                VR[i_] = *(const u32x4*)(FOXVT + ((size_t)(b * 128 + (kt_)) * 256 + (p_ >> 2)) * 32 + 8 * (p_ & 3)); } \
                CB = cf[((tid >> 5) & 3) * SEQ + 32 * (kt_) + (tid & 31)]; } while (0)
#define FX_WRITE(KR, VR, CB, sb_) do { _Pragma("unroll") for (int i_ = 0; i_ < 2; ++i_) { const int p_ = tid + 512 * i_; \
                *(LAS u32x4*)(lds + (sb_) + ((p_ & 31) >> 3) * 4608 + (p_ >> 5) * 144 + (p_ & 7) * 16) = KR[i_]; \
                *(LAS u32x4*)(lds + (sb_) + FX_VT + ((p_ >> 2) >> 6) * 5120 + ((p_ >> 2) & 63) * 80 + (p_ & 3) * 16) = VR[i_]; } \
                if (tid < 128) *(LAS float*)(lds + (sb_) + FX_CB + tid * 4) = (cref - CB) * LOG2E; } while (0)
            FX_ISSUE(krA, vrA, cbA, kt_lo); FX_WRITE(krA, vrA, cbA, (kt_lo & 1) * FX_STAGE);
            FX_ISSUE(krA, vrA, cbA, (kt_lo + 1 <= kt_hi ? kt_lo + 1 : kt_hi));
            __syncthreads();
            int kt = kt_lo;
#define FX_BODY(KX, VX, CX, KY, VY, CY) do { \
                FX_ISSUE(KY, VY, CY, (kt + 2 <= kt_hi ? kt + 2 : kt_hi)); \
                if (32 * kt <= t0 + 32 * rh + 31) { if (fx_fast) fox_tile<true>(lds + (kt & 1) * FX_STAGE, h, q, qi, hb, 32 * kt + 31 > t0 + 32 * rh, 32 * kt, t, m, l, O0, O1); \
                    else fox_tile<false>(lds + (kt & 1) * FX_STAGE, h, q, qi, hb, 32 * kt + 31 > t0 + 32 * rh, 32 * kt, t, m, l, O0, O1); } \
                if (kt + 1 <= kt_hi) FX_WRITE(KX, VX, CX, ((kt + 1) & 1) * FX_STAGE); \
                __syncthreads(); ++kt; } while (0)
            for (;;) { FX_BODY(krA, vrA, cbA, krB, vrB, cbB); if (kt > kt_hi) break; FX_BODY(krB, vrB, cbB, krA, vrA, cbA); if (kt > kt_hi) break; }
#undef FX_BODY
#undef FX_ISSUE
#undef FX_WRITE
            {
                l += __shfl_xor(l, 32);
                const float inv = __builtin_amdgcn_rcpf(l); float ss = 0.f;
#pragma unroll
                for (int r = 0; r < 16; ++r) { O0[r] *= inv; O1[r] *= inv; ss += O0[r] * O0[r] + O1[r] * O1[r]; }
                ss += __shfl_xor(ss, 32);
                LAS float* ex = (LAS float*)(lds + FX_EX);
                const int ridx = 32 * rh + qi;
                if (hb == 0) ex[ridx * 4 + h] = ss;
                __syncthreads();
                const float rs = rsqrtf((ex[ridx * 4] + ex[ridx * 4 + 1] + ex[ridx * 4 + 2] + ex[ridx * 4 + 3]) * (1.f / 256.f) + EPS);
                const float* gn = P.out_norm + (L * 4 + 2) * 256 + h * 64;
                half_t* op = MIXED + (tokb + t) * D + 512 + h * 64;
#pragma unroll
                for (int g = 0; g < 4; ++g) {
                    const int d0 = 8 * g + 4 * hb; const f32x4 g0 = *(const f32x4*)(gn + d0), g1 = *(const f32x4*)(gn + 32 + d0);
                    u32x2 o0, o1;
                    o0.x = pack_h2(O0[4 * g] * rs * g0.x, O0[4 * g + 1] * rs * g0.y); o0.y = pack_h2(O0[4 * g + 2] * rs * g0.z, O0[4 * g + 3] * rs * g0.w);
                    o1.x = pack_h2(O1[4 * g] * rs * g1.x, O1[4 * g + 1] * rs * g1.y); o1.y = pack_h2(O1[4 * g + 2] * rs * g1.z, O1[4 * g + 3] * rs * g1.w);
                    *(u32x2*)(op + d0) = o0; *(u32x2*)(op + 32 + d0) = o1;
                }
            }
            __syncthreads();
        }
#endif
#ifndef SKIP_LRU
        for (;;) {
            const int gI = q_next(ctl + CW_Q + ((L * 4 + 2) * 8 + (bid & 7)) * 64, MISC + 20); if (gI >= 64) break;
            float hc = 0.f;
            for (int k = 0; k < 2; ++k) lru_final(P, L, ((bid & 7) << 7) + 2 * gI + k, lds, Z, LRUAGG, LRUA, LRUB, MIXED, wave, hc, k == 0);
        }
#endif
        }
        xcd_barrier(bar);

#ifndef SKIP_G4
        {
            SECTION_ENV();
            pg8::Gemm g{MIXED, WOUT_T + (size_t)L * D * D, T, D, D}; pg8::StaticOrder S; S.init(T, D, G, bid);
            EpiRes E{L == 0 ? P.x : nullptr, nullptr, XH, SSQA};
            for (int rp = 0; rp < REP_G4N; ++rp) { EpiNull EN; pg8::gemm_phase<EpiNull, pg8::StaticOrder>(lds, g, S, EN); }
            pg8::gemm_phase<EpiRes, pg8::StaticOrder>(lds, g, S, E);
        }
#endif
        xcd_barrier(bar);
#ifndef SKIP_G5
        {
            SECTION_ENV();
            pg8::Gemm g{XH, WGU_T + (size_t)L * 2 * DFF * D, T, 2 * DFF, D}; pg8::StaticOrder S; S.init(T, 2 * DFF, G, bid);
            EpiSwiglu E{HB, SSQA};
            for (int rp = 0; rp < REP_G5; ++rp) pg8::gemm_phase<EpiSwiglu, pg8::StaticOrder>(lds, g, S, E);
        }
#endif
        xcd_barrier(bar);
#ifndef SKIP_G6
        {
            SECTION_ENV();
            pg8::Gemm g{HB, WDN_T + (size_t)L * D * DFF, T, D, DFF}; pg8::StaticOrder S; S.init(T, D, G, bid);
            EpiRes E{nullptr, L == 0 ? nullptr : P.out, XH, L == 0 ? SSQB : nullptr};
            for (int rp = 0; rp < REP_G6N; ++rp) { EpiNull EN; pg8::gemm_phase<EpiNull, pg8::StaticOrder>(lds, g, S, EN); }
            pg8::gemm_phase<EpiRes, pg8::StaticOrder>(lds, g, S, E);
        }
#endif
        if (L == 0) xcd_barrier(bar);
    }
}

extern "C" void kernel_launch(void* const* d_in, const int* in_sizes, int n_in, void* d_out, int out_size, void* d_ws, size_t ws_size, hipStream_t stream) {
    static int grid = 0;
    if (grid == 0) {
        if (n_in != 22 || ws_size < WS_END) { fprintf(stderr, "kernel_launch: unexpected n_in %d or ws_size %zu (< %zu)\n", n_in, ws_size, (size_t)WS_END); grid = -1; return; }
        int dev = 0, cus = 0, per_cu = 0;
        if (hipGetDevice(&dev) != hipSuccess || hipDeviceGetAttribute(&cus, hipDeviceAttributeMultiprocessorCount, dev) != hipSuccess) { grid = -1; return; }
        if (hipFuncSetAttribute((const void*)hymba_fwd, hipFuncAttributeMaxDynamicSharedMemorySize, LDS_BYTES) != hipSuccess) { fprintf(stderr, "kernel_launch: hipFuncSetAttribute failed\n"); grid = -1; return; }
        if (hipOccupancyMaxActiveBlocksPerMultiprocessor(&per_cu, (const void*)hymba_fwd, NTHR, LDS_BYTES) != hipSuccess || per_cu < 1) { fprintf(stderr, "kernel_launch: occupancy query says %d\n", per_cu); }
        (void)hipGetLastError();
        grid = cus;
    }
    if (grid < 0) return;
    (void)hipMemsetAsync((char*)d_ws + WS_CTL, 0, CTL_ZERO_BYTES, stream);
    Params p{};
    p.x = (const float*)d_in[0]; p.norm_mix = (const float*)d_in[1]; p.w_in = (const float*)d_in[2]; p.lru_conv_w = (const float*)d_in[3]; p.lru_conv_b = (const float*)d_in[4];
    p.lru_w_gates = (const float*)d_in[5]; p.lru_b_gates = (const float*)d_in[6]; p.lru_lambda = (const float*)d_in[7]; p.sc_conv_w = (const float*)d_in[8];
    p.fox_f_bias = (const float*)d_in[9]; p.fox_qk_norm = (const float*)d_in[10]; p.nsa_qk_norm = (const float*)d_in[11]; p.nsa_cmp_pos = (const float*)d_in[12];
    p.nsa_cmp_w1 = (const float*)d_in[13]; p.nsa_cmp_w2 = (const float*)d_in[14]; p.nsa_gate_bias = (const float*)d_in[15]; p.rel_bias = (const float*)d_in[16];
    p.out_norm = (const float*)d_in[17]; p.w_out = (const float*)d_in[18]; p.norm_ffn = (const float*)d_in[19]; p.w_gate_up = (const float*)d_in[20]; p.w_down = (const float*)d_in[21];
    p.out = (float*)d_out; p.ws = (unsigned char*)d_ws;
    hipLaunchKernelGGL(hymba_fwd, dim3(grid), dim3(NTHR), LDS_BYTES, stream, p);
}
```

```cpp
#include <hip/hip_runtime.h>
#include <stdint.h>
#include <stdio.h>

#define LAS __attribute__((address_space(3)))
typedef _Float16 half_t;
typedef _Float16 h8 __attribute__((ext_vector_type(8)));
typedef _Float16 h4 __attribute__((ext_vector_type(4)));
typedef _Float16 h2 __attribute__((ext_vector_type(2)));
typedef float f32x4 __attribute__((ext_vector_type(4)));
typedef unsigned u32x4 __attribute__((ext_vector_type(4)));
typedef unsigned u32x2 __attribute__((ext_vector_type(2)));
typedef float f32x16 __attribute__((ext_vector_type(16)));
#define MFMA32(a, b, c) __builtin_amdgcn_mfma_f32_32x32x16_f16(a, b, c, 0, 0, 0)
constexpr float LOG2E = 1.4426950408889634f, QSCALE = 0.125f * 1.4426950408889634f;
__device__ __forceinline__ int pi16(int r) { return (r & ~0xC) | ((r & 4) << 1) | ((r & 8) >> 1); }

constexpr int BATCH = 8, SEQ = 4096, T = BATCH * SEQ, D = 1024, NZP = 2816, DFF = 2816, NCMP = 255;
constexpr int NIN_SRC = 2704;
constexpr int ZC_LRU_X = 0, ZC_LRU_G = 256, ZC_SC_B = 512, ZC_SC_C = 768, ZC_SC_X = 1024, ZC_FOX_Q = 1280, ZC_FOX_K = 1536, ZC_FOX_V = 1792,
              ZC_NSA_Q = 2048, ZC_KC = 2304, ZC_VC = 2368, ZC_KS = 2432, ZC_VS = 2496, ZC_KW = 2560, ZC_VW = 2624, ZC_FOX_F = 2688, ZC_NSA_G = 2692;
constexpr float EPS = 1e-6f;
constexpr int NWAVES = 8, NTHR = 512;
#ifndef REP_G1
#define REP_G1 1
#endif
#ifndef REP_P0
#define REP_P0 1
#endif
#ifndef G1_WGM
#define G1_WGM 4
#endif
#ifndef G4_WGM
#define G4_WGM 8
#endif
#ifndef G6_WGM
#define G6_WGM 8
#endif
#ifndef G5_WGM
#define G5_WGM 4
#endif
#ifndef REP_G4N
#define REP_G4N 0
#endif
#ifndef REP_G6N
#define REP_G6N 0
#endif
#ifndef NORM_DRY
#define NORM_DRY 0
#endif
#ifndef REP_NSEL
#define REP_NSEL 1
#endif
#ifndef REP_NWIN
#define REP_NWIN 1
#endif
#ifndef REP_NSELECT
#define REP_NSELECT 1
#endif
#ifndef REP_G5
#define REP_G5 1
#endif
#ifndef REP_CUM
#define REP_CUM 1
#endif
#ifndef REP_VT
#define REP_VT 1
#endif
#ifndef REP_P2LRU
#define REP_P2LRU 1
#endif
#ifndef REP_P2CMP
#define REP_P2CMP 1
#endif
#ifndef REP_FOX
#define REP_FOX 1
#endif
#ifndef REP_NSA
#define REP_NSA 1
#endif
#ifndef REP_LRU
#define REP_LRU 1
#endif

constexpr size_t MiB = 1u << 20;
constexpr size_t WS_CTL = 0, CTL_ZERO_BYTES = 64 * 1024;
constexpr size_t WS_SSQA = 2 * MiB, WS_SSQB = 4 * MiB, WS_CFOX = 6 * MiB, WS_KVC = 7 * MiB, WS_LRUAGG = 9 * MiB, WS_CB = 11 * MiB;
constexpr size_t WS_WIN = 12 * MiB, WS_WOUT = 24 * MiB, WS_WGU = 28 * MiB, WS_WDN = 50 * MiB;
constexpr size_t WS_XH = 62 * MiB, WS_MIXED = 126 * MiB, WS_Z = 190 * MiB, WS_YD = 366 * MiB, WS_FOXVT = 398 * MiB, WS_VST = 414 * MiB, WS_VWT = 418 * MiB, WS_KCH = 422 * MiB, WS_VCT = 423 * MiB, WS_W1T = 424 * MiB, WS_WGT = 426 * MiB, WS_LRUA = 427 * MiB, WS_LRUB = 459 * MiB, WS_END = 491 * MiB;
static_assert(WS_WIN + 2 * (size_t)NZP * D * 2 <= WS_WOUT && WS_WOUT + 2 * (size_t)D * D * 2 <= WS_WGU && WS_WGU + 2 * (size_t)2 * DFF * D * 2 <= WS_WDN &&
              WS_WDN + 2 * (size_t)D * DFF * 2 <= WS_XH && WS_XH + (size_t)T * D * 2 <= WS_MIXED && WS_MIXED + (size_t)T * D * 2 <= WS_Z &&
              WS_Z + (size_t)T * NZP * 2 <= WS_YD && WS_YD + (size_t)T * 256 * 4 <= WS_FOXVT && WS_FOXVT + (size_t)T * 256 * 2 <= WS_VST, "ws map");
constexpr int CW_BAR = 1024;

constexpr int RING_BYTES = 131072, MISC_OFF = RING_BYTES, LDS_BYTES = 147456;

__device__ __constant__ unsigned char c_bucket[128] = {
 0,1,2,3,4,5,6,7,8,9,10,11,12,13,14,15,
 16,16,16,17,17,18,18,18,19,19,19,20,20,20,20,21,
 21,21,21,22,22,22,22,22,23,23,23,23,23,23,24,24,
 24,24,24,24,25,25,25,25,25,25,25,26,26,26,26,26,
 26,26,26,27,27,27,27,27,27,27,27,27,27,28,28,28,
 28,28,28,28,28,28,28,29,29,29,29,29,29,29,29,29,
 29,29,29,30,30,30,30,30,30,30,30,30,30,30,30,30,
 30,31,31,31,31,31,31,31,31,31,31,31,31,31,31,31};
__device__ __forceinline__ int rel_bucket(int d) { return d >= 128 ? 31 : (int)c_bucket[d < 0 ? 0 : d]; }

__device__ __forceinline__ float sigmoidf_(float x) { return __builtin_amdgcn_rcpf(1.f + __builtin_amdgcn_exp2f(-1.4426950408889634f * x)); }
__device__ __forceinline__ float gelu_tanh(float x) { return x * __builtin_amdgcn_rcpf(1.f + __builtin_amdgcn_exp2f(-2.f * 1.4426950408889634f * 0.7978845608028654f * (x + 0.044715f * x * x * x))); }
__device__ __forceinline__ float log_sigmoid(float x) { const float e = __builtin_amdgcn_exp2f(-1.4426950408889634f * fabsf(x)); return fminf(x, 0.f) - 0.6931471805599453f * __builtin_amdgcn_logf(1.f + e); }
__device__ __forceinline__ u32x4 pack_h8(f32x4 a, f32x4 b) {
    h8 h; h[0] = (half_t)a.x; h[1] = (half_t)a.y; h[2] = (half_t)a.z; h[3] = (half_t)a.w; h[4] = (half_t)b.x; h[5] = (half_t)b.y; h[6] = (half_t)b.z; h[7] = (half_t)b.w;
    return __builtin_bit_cast(u32x4, h);
}
__device__ __forceinline__ unsigned pack_h2(float a, float b) { h2 h; h[0] = (half_t)a; h[1] = (half_t)b; return __builtin_bit_cast(unsigned, h); }
#define LDS_WAIT() asm volatile("s_waitcnt lgkmcnt(0)" ::: "memory")

#define XB_TMO      128
#define XB_XCNT(j)  (256  + 64 * (j))
#define XB_XSUB(j)  (1280 + 64 * (j))
#define XB_XGEN(j)  (2304 + 64 * (j))
#define XB_TOP      3328
#define XB_TOPGEN   3392
#define XCD_BAR_WORDS 3456
#define XB_SPIN_CAP (1u << 20)
__device__ __forceinline__ unsigned xb_ld(unsigned* p)              { return __hip_atomic_load(p, __ATOMIC_RELAXED, __HIP_MEMORY_SCOPE_AGENT); }
__device__ __forceinline__ unsigned xb_add(unsigned* p, unsigned v) { return __hip_atomic_fetch_add(p, v, __ATOMIC_RELAXED, __HIP_MEMORY_SCOPE_AGENT); }
__device__ __forceinline__ unsigned xb_xcc_id() { return (unsigned)__builtin_amdgcn_s_getreg((3 << 11) | 20) & 0xFu; }
#define XB_SPIN(cond, bar) do { unsigned _sp = 0; while (cond) { __builtin_amdgcn_s_sleep(1); \
    if ((++_sp & 255u) == 0u) { if (xb_ld(&(bar)[XB_TMO])) break; if (_sp > XB_SPIN_CAP) { atomicAdd(&(bar)[XB_TMO], 1u); break; } } } } while (0)
struct XcdBarrier { unsigned* bar; unsigned x; volatile LAS unsigned* st; };
__device__ __forceinline__ XcdBarrier xcd_barrier_post(unsigned* bar, volatile LAS unsigned* st) {
    XcdBarrier b; b.bar = bar; b.x = xb_xcc_id(); b.st = st;
    if (threadIdx.x == 0) (void)xb_add(&bar[XB_XCNT(b.x)], 1u);
    return b;
}
__device__ __forceinline__ void xcd_barrier_complete(unsigned* bar, unsigned x, unsigned& nloc, unsigned& nx) {
    const unsigned G = gridDim.x * gridDim.y * gridDim.z;
    unsigned sum, cnt, mine, sp = 0u;
    for (;;) {
        sum = 0u; cnt = 0u; mine = 0u;
#pragma unroll
        for (unsigned j = 0; j < 16; ++j) { const unsigned c = xb_ld(&bar[XB_XCNT(j)]); sum += c; cnt += (c > 0u) ? 1u : 0u; mine = (j == x) ? c : mine; }
        if (sum == G) break;
        __builtin_amdgcn_s_sleep(1);
        if ((++sp & 255u) == 0u) { if (xb_ld(&bar[XB_TMO])) break; if (sp > XB_SPIN_CAP) { atomicAdd(&bar[XB_TMO], 1u); break; } }
    }
    nloc = mine > 0u ? mine : 1u; nx = cnt > 0u ? cnt : 1u;
}
__device__ __forceinline__ void xcd_barrier(const XcdBarrier& b) {
    asm volatile("s_waitcnt vmcnt(0)" ::: "memory");
    __syncthreads();
    if (threadIdx.x == 0) {
        unsigned* bar = b.bar;
        unsigned bx = b.x; asm volatile("" : "+s"(bx));
        __builtin_amdgcn_s_waitcnt(0);
        unsigned nloc = b.st[0], nx = b.st[1];
        if (nloc == 0u) { xcd_barrier_complete(bar, bx, nloc, nx); b.st[0] = nloc; b.st[1] = nx; }
        const unsigned old = xb_add(&bar[XB_XSUB(bx)], 1u);
        const unsigned gen = old / nloc;
        if (old + 1u == (gen + 1u) * nloc) {
            __builtin_amdgcn_fence(__ATOMIC_RELEASE, "agent");
            asm volatile("s_waitcnt vmcnt(0)" ::: "memory");
            const unsigned og = xb_add(&bar[XB_TOP], 1u);
            const unsigned tg = og / nx;
            if (og + 1u == (tg + 1u) * nx) xb_add(&bar[XB_TOPGEN], 1u);
            else XB_SPIN(xb_ld(&bar[XB_TOPGEN]) == tg, bar);
            __builtin_amdgcn_fence(__ATOMIC_ACQUIRE, "agent");
            xb_add(&bar[XB_XGEN(bx)], 1u);
            asm volatile("s_waitcnt vmcnt(0)" ::: "memory");
        } else {
            XB_SPIN(xb_ld(&bar[XB_XGEN(bx)]) == gen, bar);
            __builtin_amdgcn_fence(__ATOMIC_ACQUIRE, "agent");
            asm volatile("s_waitcnt vmcnt(0)" ::: "memory");
        }
    }
    __syncthreads();
}

namespace pg8 {
constexpr int BM = 256, BK = 64, HALF = 128, HTB = HALF * BK * 2, STAGE_BYTES = 8 * HTB, NXCD = 8, WGM = 8;
__host__ __device__ __forceinline__ int lds_byte(int r, int c) { const int st = (r >> 4) * 2 + (c >> 5), rr = r & 15, cc = c & 31, ob = rr * 64 + cc * 2; return st * 1024 + (ob ^ (((ob >> 9) & 1) << 5)); }
__host__ __device__ __forceinline__ void stage_rc(int b, int& R, int& C) { const int st = b / 1024, sb = b % 1024, swz = sb ^ (((sb >> 9) & 1) << 5); R = (st >> 1) * 16 + swz / 64; C = (st & 1) * 32 + (swz % 64) / 2; }
__host__ __device__ __forceinline__ int perm32(int rho) { const int n = rho >> 4, i = rho & 15; return 8 * (i >> 2) + 4 * n + (i & 3); }
struct Unit { int pm, pn; };
struct Gemm { const half_t* A; const half_t* Bt; int M, N, K; };
struct StaticOrder {
    int nM, nN, nwg, G, c, wgm;
    __host__ __device__ void init(int M, int N, int G_, int c_, int wgm_ = WGM) { nM = M / BM; nN = N / BM; nwg = nM * nN; G = G_; c = c_; wgm = wgm_; }
    __host__ __device__ bool next(int i, Unit& u) const {
        const long L = (long)i * G + c; if (L >= nwg) return false;
        int wgid = (int)L; { const int q = nwg / NXCD, r = nwg % NXCD, xcd = wgid % NXCD, off = wgid / NXCD; wgid = (xcd < r ? xcd * (q + 1) : r * (q + 1) + (xcd - r) * q) + off; }
        const int nig = wgm * nN, gid = wgid / nig, fm = gid * wgm, gsz = (nM - fm) < wgm ? (nM - fm) : wgm;
        u.pm = fm + ((wgid % nig) % gsz); u.pn = (wgid % nig) / gsz; return true;
    }
    __device__ __forceinline__ void a_ready(const Unit&) const {}
    __device__ __forceinline__ void done(const Unit&) const {}
};

template <class Epi, class Sched>
__device__ __forceinline__ void gemm_phase(LAS unsigned char* lds, const Gemm g, const Sched& S, const Epi& E) {
    int tid = threadIdx.x; asm volatile("" : "+v"(tid));
    const int wid = __builtin_amdgcn_readfirstlane(tid >> 6), lane = tid & 63, wr = wid >> 2, wc = wid & 3, fr = lane & 15, fq = lane >> 4;
    const int K = g.K, nt = K / BK;
    unsigned voffA[2], voffB[2];
#pragma unroll
    for (int i = 0; i < 2; ++i) { int R, C; stage_rc(tid * 16 + i * 8192, R, C); const int Rb = Epi::brow(R);
        voffA[i] = (unsigned)(R * K + C) * 2u; voffB[i] = (unsigned)(Rb * K + C) * 2u; }
    const size_t kstep = (size_t)(BK * 2);
    const size_t hstep = (size_t)HALF * K * 2;
    const size_t hstepB = (size_t)Epi::BHALF_ROWS * K * 2;
    const size_t tstep = 2 * hstep;
    const unsigned ldsw = (unsigned)wid * 1024u;
    const int aoff = lds_byte(wr * 64 + fr, fq * 8), boff = lds_byte(wc * 32 + fr, fq * 8);
#define PG8_SA(b, h) (((b) * 2 + (h)) * HTB)
#define PG8_SB(b, h) ((4 + (b) * 2 + (h)) * HTB)
#define PG8_STAGE(bufoff, gbase, voff) do { _Pragma("unroll") for (int _i = 0; _i < 2; ++_i) \
        __builtin_amdgcn_global_load_lds((const unsigned*)((const char*)(gbase) + (voff)[_i]), (LAS unsigned*)(lds + (bufoff) + ldsw + _i * 8192), 16, 0, 0); } while (0)
#define PG8_LDA(dst, b, h) do { _Pragma("unroll") for (int m = 0; m < 4; ++m) _Pragma("unroll") for (int k = 0; k < 2; ++k) dst[m][k] = *(const LAS h8*)(lds + PG8_SA(b, h) + aoff + m * 2048 + k * 1024); } while (0)
#define PG8_LDB(dst, b, h) do { _Pragma("unroll") for (int n = 0; n < 2; ++n) _Pragma("unroll") for (int k = 0; k < 2; ++k) dst[n][k] = *(const LAS h8*)(lds + PG8_SB(b, h) + boff + n * 2048 + k * 1024); } while (0)
#define PG8_MMA(ai, bj, At, Bt) do { __builtin_amdgcn_s_setprio(1); _Pragma("unroll") for (int m = 0; m < 4; ++m) _Pragma("unroll") for (int n = 0; n < 2; ++n) _Pragma("unroll") for (int k = 0; k < 2; ++k) \
        acc[ai][bj][m][n] = __builtin_amdgcn_mfma_f32_16x16x32_f16(Bt[n][k], At[m][k], acc[ai][bj][m][n], 0, 0, 0); __builtin_amdgcn_s_setprio(0); } while (0)
#define PG8_WAIT_V(n) asm volatile("s_waitcnt vmcnt(" #n ")" ::: "memory")
#define PG8_WAIT_L(n) asm volatile("s_waitcnt lgkmcnt(" #n ")" ::: "memory")
#define PG8_BAR __builtin_amdgcn_s_barrier()
#define PG8_SCHED __builtin_amdgcn_sched_barrier(0)
    Unit cur, nxt; int ui = 0;
    if (!S.next(0, cur)) return;
    f32x4 acc[2][2][4][2];
#pragma unroll
    for (int a = 0; a < 2; ++a)
#pragma unroll
        for (int b = 0; b < 2; ++b)
#pragma unroll
            for (int m = 0; m < 4; ++m)
#pragma unroll
                for (int n = 0; n < 2; ++n) acc[a][b][m][n] = (f32x4){0.f, 0.f, 0.f, 0.f};
    h8 At[4][2], B0[2][2], B1[2][2];
    const char* cA = (const char*)g.A + (size_t)cur.pm * tstep; const char* cB = (const char*)g.Bt + (size_t)cur.pn * tstep;
    S.a_ready(cur);
    PG8_STAGE(PG8_SB(0, 0), cB, voffB); PG8_STAGE(PG8_SA(0, 0), cA, voffA); PG8_STAGE(PG8_SB(0, 1), cB + hstepB, voffB); PG8_STAGE(PG8_SA(0, 1), cA + hstep, voffA);
    if (wr == 1) PG8_BAR;
    PG8_WAIT_V(4); PG8_BAR;
    PG8_STAGE(PG8_SB(1, 0), cB + kstep, voffB); PG8_STAGE(PG8_SA(1, 0), cA + kstep, voffA); PG8_STAGE(PG8_SB(1, 1), cB + hstepB + kstep, voffB);
    PG8_WAIT_V(6); PG8_BAR;
    for (;;) {
        const bool has_next = S.next(ui + 1, nxt);
        const char* nA = has_next ? (const char*)g.A + (size_t)nxt.pm * tstep : cA; const char* nB = has_next ? (const char*)g.Bt + (size_t)nxt.pn * tstep : cB;
        for (int t = 0; t < nt; t += 2) {
            const bool last = (t == nt - 2);
            const char* a1 = cA + (size_t)(t + 1) * kstep;
            const char* a2 = last ? nA : cA + (size_t)(t + 2) * kstep; const char* b2 = last ? nB : cB + (size_t)(t + 2) * kstep;
            const char* a3 = a2 + kstep; const char* b3 = b2 + kstep;
            if (last && has_next) S.a_ready(nxt);
            PG8_LDB(B0, 0, 0); PG8_SCHED; PG8_LDA(At, 0, 0); PG8_STAGE(PG8_SA(1, 1), a1 + hstep, voffA);
            PG8_WAIT_L(8); PG8_BAR; PG8_WAIT_L(0); PG8_MMA(0, 0, At, B0); PG8_BAR; PG8_SCHED;
            PG8_LDB(B1, 0, 1); PG8_STAGE(PG8_SB(0, 0), b2, voffB);
            PG8_BAR; PG8_WAIT_L(0); PG8_MMA(0, 1, At, B1); PG8_BAR;
            PG8_LDA(At, 0, 1); PG8_STAGE(PG8_SA(0, 0), a2, voffA);
            PG8_BAR; PG8_WAIT_L(0); PG8_MMA(1, 0, At, B0); PG8_BAR; PG8_SCHED;
            PG8_STAGE(PG8_SB(0, 1), b2 + hstepB, voffB);
            PG8_WAIT_V(6); PG8_BAR; PG8_MMA(1, 1, At, B1); PG8_BAR;
            PG8_LDB(B0, 1, 0); PG8_SCHED; PG8_LDA(At, 1, 0); PG8_STAGE(PG8_SA(0, 1), a2 + hstep, voffA);
            PG8_WAIT_L(8); PG8_BAR; PG8_WAIT_L(0); PG8_MMA(0, 0, At, B0); PG8_BAR; PG8_SCHED;
            PG8_LDB(B1, 1, 1); PG8_STAGE(PG8_SB(1, 0), b3, voffB);
            PG8_BAR; PG8_WAIT_L(0); PG8_MMA(0, 1, At, B1); PG8_BAR;
            PG8_LDA(At, 1, 1); PG8_STAGE(PG8_SA(1, 0), a3, voffA);
            PG8_BAR; PG8_WAIT_L(0); PG8_MMA(1, 0, At, B0); PG8_BAR; PG8_SCHED;
            PG8_STAGE(PG8_SB(1, 1), b3 + hstepB, voffB);
            PG8_WAIT_V(6); PG8_BAR; PG8_MMA(1, 1, At, B1); PG8_BAR;
        }
        { int te = threadIdx.x; asm volatile("" : "+v"(te));
          E(acc, cur, wr, wc, te & 15, (te & 63) >> 4); } S.done(cur);
        if (!has_next) break;
#pragma unroll
        for (int a = 0; a < 2; ++a)
#pragma unroll
            for (int b = 0; b < 2; ++b)
#pragma unroll
                for (int m = 0; m < 4; ++m)
#pragma unroll
                    for (int n = 0; n < 2; ++n) acc[a][b][m][n] = (f32x4){0.f, 0.f, 0.f, 0.f};
        cur = nxt; cA = nA; cB = nB; ++ui;
    }
    PG8_WAIT_V(0);
    if (wr == 0) PG8_BAR;
    PG8_BAR;
#undef PG8_SA
#undef PG8_SB
#undef PG8_STAGE
#undef PG8_LDA
#undef PG8_LDB
#undef PG8_MMA
#undef PG8_WAIT_V
#undef PG8_WAIT_L
#undef PG8_BAR
#undef PG8_SCHED
}
}

__device__ __forceinline__ float row_rstd(const float* ssq, int row) {
    const f32x4* p = (const f32x4*)(ssq + (size_t)row * 16);
    const f32x4 a = p[0], b = p[1], c = p[2], d = p[3];
    const float s = (((a.x + a.y) + (a.z + a.w)) + ((b.x + b.y) + (b.z + b.w))) + (((c.x + c.y) + (c.z + c.w)) + ((d.x + d.y) + (d.z + d.w)));
    return rsqrtf(s * (1.f / 1024.f) + EPS);
}
__device__ __forceinline__ void rows_rstd8(const float* ssq, int row0, int fq, float (&r)[8]) {
    f32x4 p[8];
#pragma unroll
    for (int i = 0; i < 8; ++i) p[i] = *(const f32x4*)(ssq + (size_t)(row0 + (i >> 2) * 128 + (i & 3) * 16) * 16 + 4 * fq);
#pragma unroll
    for (int i = 0; i < 8; ++i) { float s = (p[i].x + p[i].y) + (p[i].z + p[i].w); s += __shfl_xor(s, 16); s += __shfl_xor(s, 32); r[i] = rsqrtf(s * (1.f / 1024.f) + EPS); }
}
struct EpiZ {
    static constexpr bool PERM = true;
    static constexpr int BHALF_ROWS = 32;
    static __host__ __device__ __forceinline__ int brow(int R) { return 64 * ((R >> 5) & 3) + pg8::perm32(R & 31); }
    half_t* Z; const float* ssq; const float* fqn; const float* nqn;
    __device__ __forceinline__ void operator()(const f32x4 (&acc)[2][2][4][2], const pg8::Unit& u, int wr, int wc, int fr, int fq) const {
        const int row0 = u.pm * 256 + wr * 64 + fr, col0 = u.pn * 256 + wc * 64 + 8 * fq;
        float rr[8]; rows_rstd8(ssq, row0, fq, rr);
        const int cg = u.pn * 4 + wc;
        const float* gp = nullptr; float scl = 1.f;
        if (cg >= ZC_FOX_Q / 64 && cg < ZC_FOX_Q / 64 + 4) { gp = fqn; scl = QSCALE; }
        else if (cg >= ZC_FOX_K / 64 && cg < ZC_FOX_K / 64 + 4) gp = fqn + 64;
        else if (cg >= ZC_NSA_Q / 64 && cg < ZC_NSA_Q / 64 + 4) { gp = nqn; scl = QSCALE; }
        else if (cg == ZC_KS / 64) gp = nqn + 128;
        else if (cg == ZC_KW / 64) gp = nqn + 192;
        if (gp) {
            f32x4 gn[2][2];
#pragma unroll
            for (int bj = 0; bj < 2; ++bj)
#pragma unroll
                for (int n = 0; n < 2; ++n) gn[bj][n] = *(const f32x4*)(gp + bj * 32 + 8 * fq + 4 * n) * scl;
#pragma unroll
            for (int ai = 0; ai < 2; ++ai)
#pragma unroll
                for (int m = 0; m < 4; ++m) { const int row = row0 + ai * 128 + m * 16; const float r = rr[ai * 4 + m]; half_t* rp = Z + (size_t)row * NZP + col0;
                    f32x4 v[2][2]; float s = 0.f;
#pragma unroll
                    for (int bj = 0; bj < 2; ++bj)
#pragma unroll
                        for (int n = 0; n < 2; ++n) { v[bj][n] = acc[ai][bj][m][n] * r; s += (v[bj][n].x * v[bj][n].x + v[bj][n].y * v[bj][n].y) + (v[bj][n].z * v[bj][n].z + v[bj][n].w * v[bj][n].w); }
                    s += __shfl_xor(s, 16); s += __shfl_xor(s, 32);
                    const float rs = rsqrtf(s * (1.f / 64.f) + EPS);
#pragma unroll
                    for (int bj = 0; bj < 2; ++bj) *(u32x4*)(rp + bj * 32) = pack_h8(v[bj][0] * rs * gn[bj][0], v[bj][1] * rs * gn[bj][1]); }
        } else {
#pragma unroll
            for (int ai = 0; ai < 2; ++ai)
#pragma unroll
                for (int m = 0; m < 4; ++m) { const int row = row0 + ai * 128 + m * 16; const float r = rr[ai * 4 + m]; half_t* rp = Z + (size_t)row * NZP + col0;
#pragma unroll
                    for (int bj = 0; bj < 2; ++bj) *(u32x4*)(rp + bj * 32) = pack_h8(acc[ai][bj][m][0] * r, acc[ai][bj][m][1] * r); }
        }
    }
};
struct EpiRes {
    static constexpr bool PERM = true;
    static constexpr int BHALF_ROWS = 32;
    static __host__ __device__ __forceinline__ int brow(int R) { return 64 * ((R >> 5) & 3) + pg8::perm32(R & 31); }
    float* out;
    half_t* XH; float* ssq;
    __device__ __forceinline__ void operator()(const f32x4 (&acc)[2][2][4][2], const pg8::Unit& u, int wr, int wc, int fr, int fq) const {
        const int row0 = u.pm * 256 + wr * 64 + fr, col0 = u.pn * 256 + wc * 64 + 8 * fq;
        h8 xh[2][4][2];
#pragma unroll
        for (int ai = 0; ai < 2; ++ai)
#pragma unroll
            for (int m = 0; m < 4; ++m)
#pragma unroll
                for (int bj = 0; bj < 2; ++bj) xh[ai][m][bj] = *(const h8*)(XH + (size_t)(row0 + ai * 128 + m * 16) * D + col0 + bj * 32);
#pragma unroll
        for (int ai = 0; ai < 2; ++ai) {
#pragma unroll
            for (int m = 0; m < 4; ++m) { const int row = row0 + ai * 128 + m * 16; float s = 0.f;
#pragma unroll
                for (int bj = 0; bj < 2; ++bj) { const size_t o = (size_t)row * D + col0 + bj * 32; const h8 x8 = xh[ai][m][bj];
                    const f32x4 v0 = (f32x4){(float)x8[0], (float)x8[1], (float)x8[2], (float)x8[3]} + acc[ai][bj][m][0], v1 = (f32x4){(float)x8[4], (float)x8[5], (float)x8[6], (float)x8[7]} + acc[ai][bj][m][1];
                    if (out) { *(f32x4*)(out + o) = v0; *(f32x4*)(out + o + 4) = v1; }
                    else *(u32x4*)(XH + o) = pack_h8(v0, v1);
                    s += (v0.x * v0.x + v0.y * v0.y) + (v0.z * v0.z + v0.w * v0.w) + (v1.x * v1.x + v1.y * v1.y) + (v1.z * v1.z + v1.w * v1.w); }
                s += __shfl_xor(s, 16); s += __shfl_xor(s, 32);
                if (fq == 0 && ssq) ssq[(size_t)row * 16 + u.pn * 4 + wc] = s; }
        }
    }
};
struct EpiSwiglu {
    static constexpr bool PERM = true;
    static constexpr int BHALF_ROWS = 128;
    static __host__ __device__ __forceinline__ int brow(int R) { return (R & ~31) + pg8::perm32(R & 31); }
    half_t* H; const float* ssq;
    __device__ __forceinline__ void operator()(const f32x4 (&acc)[2][2][4][2], const pg8::Unit& u, int wr, int wc, int fr, int fq) const {
        const int row0 = u.pm * 256 + wr * 64 + fr, col0 = u.pn * 128 + wc * 32 + 8 * fq;
        float rr[8]; rows_rstd8(ssq, row0, fq, rr);
#pragma unroll
        for (int ai = 0; ai < 2; ++ai)
#pragma unroll
            for (int m = 0; m < 4; ++m) { const int row = row0 + ai * 128 + m * 16; const float r = rr[ai * 4 + m];
                f32x4 o[2];
#pragma unroll
                for (int n = 0; n < 2; ++n) { const f32x4 g = acc[ai][0][m][n] * r, uu = acc[ai][1][m][n] * r;
                    o[n].x = g.x * sigmoidf_(g.x) * uu.x; o[n].y = g.y * sigmoidf_(g.y) * uu.y; o[n].z = g.z * sigmoidf_(g.z) * uu.z; o[n].w = g.w * sigmoidf_(g.w) * uu.w; }
                *(u32x4*)(H + (size_t)row * DFF + col0) = pack_h8(o[0], o[1]); }
    }
};

struct EpiNull {
    static constexpr bool PERM = true;
    static constexpr int BHALF_ROWS = 128;
    static __host__ __device__ __forceinline__ int brow(int R) { return (R & ~31) + pg8::perm32(R & 31); }
    __device__ __forceinline__ void operator()(const f32x4 (&acc)[2][2][4][2], const pg8::Unit&, int, int, int, int) const {
#pragma unroll
        for (int ai = 0; ai < 2; ++ai)
#pragma unroll
            for (int bj = 0; bj < 2; ++bj)
#pragma unroll
                for (int m = 0; m < 4; ++m)
#pragma unroll
                    for (int n = 0; n < 2; ++n) asm volatile("" :: "v"(acc[ai][bj][m][n]));
    }
};
struct Params {
    const float* x; const float* norm_mix; const float* w_in; const float* lru_conv_w; const float* lru_conv_b; const float* lru_w_gates; const float* lru_b_gates;
    const float* lru_lambda; const float* sc_conv_w; const float* fox_f_bias; const float* fox_qk_norm; const float* nsa_qk_norm; const float* nsa_cmp_pos;
    const float* nsa_cmp_w1; const float* nsa_cmp_w2; const float* nsa_gate_bias; const float* rel_bias; const float* out_norm; const float* w_out;
    const float* norm_ffn; const float* w_gate_up; const float* w_down; float* out; unsigned char* ws;
};

template <int MODE> __device__ __forceinline__ int src_col(int n) {
    if (MODE == 1) { if (n < 2048) return n; if (n < 2688) return n + 4; if (n < 2692) return 2048 + (n - 2688); if (n < 2704) return n; return -1; }
    if (MODE == 2) { const int pn = n >> 8, w = n & 255; return w < 128 ? pn * 128 + w : DFF + pn * 128 + (w - 128); }
    return n;
}
template <int MODE> __device__ __forceinline__ void p0_item(const float* W, int K, int Nsrc, const float* gain, half_t* WT, int item, int nbn, LAS unsigned* scr, int lane) {
    const int kb = item / nbn, nb = item % nbn, k0 = 64 * kb, n0 = 64 * nb;
    const int sc = src_col<MODE>(n0 + lane);
    float v[64];
    const float* wp = W + (size_t)k0 * Nsrc + (sc >= 0 ? sc : 0);
#pragma unroll
    for (int kk = 0; kk < 64; ++kk) v[kk] = wp[(size_t)kk * Nsrc];
    const int gl = __builtin_bit_cast(int, gain ? gain[k0 + lane] : 1.f);
#pragma unroll
    for (int kk = 0; kk < 64; kk += 2) {
        float v0 = sc >= 0 ? v[kk] : 0.f, v1 = sc >= 0 ? v[kk + 1] : 0.f;
        v0 *= __builtin_bit_cast(float, __builtin_amdgcn_readlane(gl, kk)); v1 *= __builtin_bit_cast(float, __builtin_amdgcn_readlane(gl, kk + 1));
        scr[lane * 33 + (kk >> 1)] = pack_h2(v0, v1);
    }
    LDS_WAIT(); asm volatile("" ::: "memory");
    const int c = lane & 7;
#pragma unroll
    for (int j = 0; j < 8; ++j) { const int nn = (lane >> 3) + 8 * j; const LAS unsigned* s = scr + nn * 33 + 4 * c;
        u32x4 o; o.x = s[0]; o.y = s[1]; o.z = s[2]; o.w = s[3];
        *(u32x4*)(WT + (size_t)(n0 + nn) * K + k0 + 8 * c) = o; }
    LDS_WAIT(); asm volatile("" ::: "memory");
}
__device__ __forceinline__ float wave_sum(float v) {
#pragma unroll
    for (int o = 1; o < 64; o <<= 1) v += __shfl_xor(v, o);
    return v;
}

__device__ __forceinline__ void attn_step_h(const float (&q)[64], float (&acc)[64], float& m, float& l, const half_t* kp, const half_t* vp, float bias, bool valid) {
    float sc = 0.f;
#pragma unroll
    for (int hh = 0; hh < 2; ++hh) {
#pragma unroll
        for (int j = 4 * hh; j < 4 * hh + 4; ++j) { const h8 kv = *(const h8*)(kp + 8 * j);
#pragma unroll
            for (int e = 0; e < 8; ++e) sc = fmaf(q[8 * j + e], (float)kv[e], sc); }
        __builtin_amdgcn_sched_barrier(0);
    }
    sc += bias;
    const float mn = valid ? fmaxf(m, sc) : m;
    const float alpha = __expf(m - mn), p = valid ? __expf(sc - mn) : 0.f;
    m = mn; l = l * alpha + p;
#pragma unroll
    for (int hh = 0; hh < 2; ++hh) {
#pragma unroll
        for (int j = 4 * hh; j < 4 * hh + 4; ++j) { const h8 vv = *(const h8*)(vp + 8 * j);
#pragma unroll
            for (int e = 0; e < 8; ++e) acc[8 * j + e] = fmaf(acc[8 * j + e], alpha, p * (float)vv[e]); }
        __builtin_amdgcn_sched_barrier(0);
    }
}
__device__ __forceinline__ float dot_f32(const float (&q)[64], const float* kp) {
    float sc = 0.f;
#pragma unroll
    for (int j = 0; j < 16; ++j) { const f32x4 kv = *(const f32x4*)(kp + 4 * j); sc = fmaf(q[4 * j], kv.x, sc); sc = fmaf(q[4 * j + 1], kv.y, sc); sc = fmaf(q[4 * j + 2], kv.z, sc); sc = fmaf(q[4 * j + 3], kv.w, sc); }
    return sc;
}
__device__ __forceinline__ void load_q(float (&q)[64], const half_t* qp, float scale) {
#pragma unroll
    for (int j = 0; j < 8; ++j) { const h8 v = *(const h8*)(qp + 8 * j);
#pragma unroll
        for (int e = 0; e < 8; ++e) q[8 * j + e] = (float)v[e] * scale; }
}

__device__ __forceinline__ void lru_gate_r(const float* wcol, float bias, const LAS float* xrow, LAS float* yout) {
    float w[64];
#pragma unroll
    for (int k = 0; k < 64; ++k) w[k] = wcol[(size_t)k * 64];
    for (int i = 0; i < 32; ++i) {
        const LAS float* xr = xrow + i * 256; float r = bias;
#pragma unroll
        for (int k = 0; k < 64; k += 4) { const f32x4 xv = *(const LAS f32x4*)(xr + k);
            r = fmaf(xv.x, w[k], r); r = fmaf(xv.y, w[k + 1], r); r = fmaf(xv.z, w[k + 2], r); r = fmaf(xv.w, w[k + 3], r); }
        yout[i * 256] = 1.f / (1.f + expf(-r));
    }
}

__device__ __forceinline__ void ld_frags(h8 (&f)[8], const LAS unsigned char* base) {
#pragma unroll
    for (int i = 0; i < 4; ++i) { f[2 * i] = *(const LAS h8*)(base + 32 * i); f[2 * i + 1] = *(const LAS h8*)(base + 32 * 144 + 32 * i); }
}
__device__ __forceinline__ void qk64(f32x16& S0, f32x16& S1, const h8 (&q)[4], const LAS unsigned char* Ks, int qi, int hb) {
    h8 ka[8]; ld_frags(ka, Ks + pi16(qi) * 144 + 16 * hb);
    __builtin_amdgcn_sched_barrier(0);
#pragma unroll
    for (int kk = 0; kk < 4; ++kk) { S0 = MFMA32(ka[2 * kk], q[kk], S0); S1 = MFMA32(ka[2 * kk + 1], q[kk], S1); }
}
__device__ __forceinline__ void pv64(const f32x16& P0, const f32x16& P1, const LAS unsigned char* Vs, f32x16& O0, f32x16& O1, int qi, int hb) {
    h8 va[8]; ld_frags(va, Vs + qi * 144 + 16 * hb);
    h8 pf[4];
#pragma unroll
    for (int e = 0; e < 8; ++e) { pf[0][e] = (half_t)P0[e]; pf[1][e] = (half_t)P0[8 + e]; pf[2][e] = (half_t)P1[e]; pf[3][e] = (half_t)P1[8 + e]; }
    __builtin_amdgcn_sched_barrier(0);
#pragma unroll
    for (int s = 0; s < 4; ++s) { O0 = MFMA32(va[2 * s], pf[s], O0); O1 = MFMA32(va[2 * s + 1], pf[s], O1); }
}
__device__ __forceinline__ float rowmax64(const f32x16& S0, const f32x16& S1) {
    float mx = fmaxf(S0[0], S1[0]);
#pragma unroll
    for (int r = 1; r < 16; ++r) mx = fmaxf(mx, fmaxf(S0[r], S1[r]));
    return fmaxf(mx, __shfl_xor(mx, 32));
}
__device__ __forceinline__ void softmax64(f32x16& S0, f32x16& S1, float& m, float& l, f32x16& O0, f32x16& O1) {
    const float mn = fmaxf(m, rowmax64(S0, S1)), alpha = __builtin_amdgcn_exp2f(m - mn);
    m = mn; float ps = 0.f;
#pragma unroll
    for (int r = 0; r < 16; ++r) { S0[r] = __builtin_amdgcn_exp2f(S0[r] - mn); S1[r] = __builtin_amdgcn_exp2f(S1[r] - mn); ps += S0[r] + S1[r]; }
    l = l * alpha + ps;
    if (__any(alpha != 1.f)) {
#pragma unroll
        for (int r = 0; r < 16; ++r) { O0[r] *= alpha; O1[r] *= alpha; }
    }
}
__device__ __forceinline__ void init_near(f32x16& S0, f32x16& S1, const LAS float* TRh, int dq, int hb, int step, int wlim) {
#pragma unroll
    for (int r = 0; r < 16; ++r) {
        const int k0 = 16 * (r >> 3) + 8 * hb + 4 * ((r >> 2) & 1) + (r & 3);
        const int d0 = dq - step * k0, d1 = dq - step * (k0 + 32);
        const float b0 = TRh[d0 < 0 ? 0 : (d0 > 128 ? 128 : d0)], b1 = TRh[d1 < 0 ? 0 : (d1 > 128 ? 128 : d1)];
        S0[r] = (d0 >= 0 && d0 < wlim) ? b0 : -INFINITY; S1[r] = (d1 >= 0 && d1 < wlim) ? b1 : -INFINITY;
    }
}
__device__ __forceinline__ void init_const(f32x16& S0, f32x16& S1, float c) {
#pragma unroll
    for (int r = 0; r < 16; ++r) { S0[r] = c; S1[r] = c; }
}

__device__ __forceinline__ void init_tab(f32x16& S0, f32x16& S1, const LAS float* TXh, int dq, int hb, int step, int dmax, bool sel) {
#pragma unroll
    for (int r = 0; r < 16; ++r) {
        const int k0 = 16 * (r >> 3) + 8 * hb + 4 * ((r >> 2) & 1) + (r & 3);
        int i0 = dq - step * k0, i1 = dq - step * (k0 + 32);
        i0 = i0 < -1 ? -1 : (i0 > dmax ? dmax : i0); i1 = i1 < -1 ? -1 : (i1 > dmax ? dmax : i1);
        S0[r] = TXh[sel ? i0 + 1 : 0]; S1[r] = TXh[sel ? i1 + 1 : 0];
    }
}
__device__ __forceinline__ void qk64z(f32x16& S0, f32x16& S1, const h8 (&q)[4], const LAS unsigned char* Ks, int qi, int hb) {
    h8 ka[8]; ld_frags(ka, Ks + pi16(qi) * 144 + 16 * hb);
    __builtin_amdgcn_sched_barrier(0);
    const f32x16 z = {0.f, 0.f, 0.f, 0.f, 0.f, 0.f, 0.f, 0.f, 0.f, 0.f, 0.f, 0.f, 0.f, 0.f, 0.f, 0.f};
    S0 = MFMA32(ka[0], q[0], z); S1 = MFMA32(ka[1], q[0], z);
#pragma unroll
    for (int kk = 1; kk < 4; ++kk) { S0 = MFMA32(ka[2 * kk], q[kk], S0); S1 = MFMA32(ka[2 * kk + 1], q[kk], S1); }
}
__device__ __forceinline__ float exp_sum64(f32x16& S0, f32x16& S1) {
    float ps = 0.f;
#pragma unroll
    for (int r = 0; r < 16; ++r) { S0[r] = __builtin_amdgcn_exp2f(S0[r]); S1[r] = __builtin_amdgcn_exp2f(S1[r]); ps += S0[r] + S1[r]; }
    return ps;
}
__device__ __forceinline__ void pv64m(const f32x16& P0, const f32x16& P1, bool sel, const LAS unsigned char* Vs, f32x16& O0, f32x16& O1, int qi, int hb) {
    h8 va[8]; ld_frags(va, Vs + qi * 144 + 16 * hb);
    h8 pf[4];
#pragma unroll
    for (int e = 0; e < 8; ++e) { pf[0][e] = (half_t)P0[e]; pf[1][e] = (half_t)P0[8 + e]; pf[2][e] = (half_t)P1[e]; pf[3][e] = (half_t)P1[8 + e]; }
    const h8 hz = {0, 0, 0, 0, 0, 0, 0, 0};
#pragma unroll
    for (int s = 0; s < 4; ++s) pf[s] = sel ? pf[s] : hz;
    __builtin_amdgcn_sched_barrier(0);
#pragma unroll
    for (int s = 0; s < 4; ++s) { O0 = MFMA32(va[2 * s], pf[s], O0); O1 = MFMA32(va[2 * s + 1], pf[s], O1); }
}

__device__ __forceinline__ void pv64mv(const f32x16& P0, const f32x16& P1, bool sel, const h8 (&va)[8], f32x16& O0, f32x16& O1) {
    h8 pf[4];
#pragma unroll
    for (int e = 0; e < 8; ++e) { pf[0][e] = (half_t)P0[e]; pf[1][e] = (half_t)P0[8 + e]; pf[2][e] = (half_t)P1[e]; pf[3][e] = (half_t)P1[8 + e]; }
    const h8 hz = {0, 0, 0, 0, 0, 0, 0, 0};
#pragma unroll
    for (int s = 0; s < 4; ++s) pf[s] = sel ? pf[s] : hz;
    __builtin_amdgcn_sched_barrier(0);
#pragma unroll
    for (int s = 0; s < 4; ++s) { O0 = MFMA32(va[2 * s], pf[s], O0); O1 = MFMA32(va[2 * s + 1], pf[s], O1); }
}

typedef short v4i16_t __attribute__((ext_vector_type(4)));
__device__ __forceinline__ h4 vtr4(const LAS unsigned char* p) { return __builtin_bit_cast(h4, __builtin_amdgcn_ds_read_tr16_b64_v4i16((LAS v4i16_t*)p)); }
constexpr int VRS = 192, FVRS = 576;
__device__ __forceinline__ void ld_vtr(h8 (&va)[8], const LAS unsigned char* vimg, int lane) {
    const LAS unsigned char* b0 = vimg + (8 * (lane >> 5) + ((lane & 15) >> 2)) * VRS + (16 * ((lane >> 4) & 1) + 4 * (lane & 3)) * 2;
#pragma unroll
    for (int s_ = 0; s_ < 4; ++s_)
#pragma unroll
        for (int db = 0; db < 2; ++db) { const h4 lo = vtr4(b0 + s_ * 16 * VRS + db * 64), hi = vtr4(b0 + s_ * 16 * VRS + 4 * VRS + db * 64);
            h8 v; v[0] = lo[0]; v[1] = lo[1]; v[2] = lo[2]; v[3] = lo[3]; v[4] = hi[0]; v[5] = hi[1]; v[6] = hi[2]; v[7] = hi[3]; va[2 * s_ + db] = v; }
}

__device__ __forceinline__ u32x4 swap_pair(u32x2 a, u32x2 b) {
    const auto x = __builtin_amdgcn_permlane32_swap(a.x, b.x, false, false);
    const auto y = __builtin_amdgcn_permlane32_swap(a.y, b.y, false, false);
    return (u32x4){x[0], y[0], x[1], y[1]};
}

template <bool FAST>
__device__ __forceinline__ void fox_tile(const LAS unsigned char* sbp, int h, const h8 (&q)[4], int qi, int hb, bool diag, int kbase, int t, float& m, float& l, f32x16& O0, f32x16& O1) {
    const LAS unsigned char* Kh = sbp + h * 4608; const LAS unsigned char* Vh = sbp + 18432 + h * 5120;
    const LAS float* cbh = (const LAS float*)(sbp + 38912) + h * 32;
    f32x16 S;
#pragma unroll
    for (int g = 0; g < 4; ++g) { const f32x4 c4 = *(const LAS f32x4*)(cbh + 16 * (g >> 1) + 8 * hb + 4 * (g & 1)); S[4 * g] = c4.x; S[4 * g + 1] = c4.y; S[4 * g + 2] = c4.z; S[4 * g + 3] = c4.w; }
    h8 ka[4], va[4];
#pragma unroll
    for (int kk = 0; kk < 4; ++kk) ka[kk] = *(const LAS h8*)(Kh + pi16(qi) * 144 + (16 * kk + 8 * hb) * 2);
    va[0] = *(const LAS h8*)(Vh + qi * 80 + (8 * hb) * 2); va[1] = *(const LAS h8*)(Vh + qi * 80 + (16 + 8 * hb) * 2);
    va[2] = *(const LAS h8*)(Vh + (32 + qi) * 80 + (8 * hb) * 2); va[3] = *(const LAS h8*)(Vh + (32 + qi) * 80 + (16 + 8 * hb) * 2);
    __builtin_amdgcn_sched_barrier(0);
#pragma unroll
    for (int kk = 0; kk < 4; ++kk) S = MFMA32(ka[kk], q[kk], S);
    if (diag) {
#pragma unroll
        for (int r = 0; r < 16; ++r) { const int key = kbase + 16 * (r >> 3) + 8 * hb + 4 * ((r >> 2) & 1) + (r & 3); if (key > t) S[r] = -INFINITY; }
    }
    float mn = m, alpha = 1.f;
    if (!FAST) {
        float mx = S[0];
#pragma unroll
        for (int r = 1; r < 16; ++r) mx = fmaxf(mx, S[r]);
        mx = fmaxf(mx, __shfl_xor(mx, 32));
        mn = fmaxf(m, mx); alpha = __builtin_amdgcn_exp2f(m - mn);
        m = mn;
    }
    float ps = 0.f;
#pragma unroll
    for (int r = 0; r < 16; ++r) { S[r] = __builtin_amdgcn_exp2f(S[r] - mn); ps += S[r]; }
    l = l * alpha + ps;
    if (!FAST && __any(alpha != 1.f)) {
#pragma unroll
        for (int r = 0; r < 16; ++r) { O0[r] *= alpha; O1[r] *= alpha; }
    }
    h8 pf0, pf1;
#pragma unroll
    for (int e = 0; e < 8; ++e) { pf0[e] = (half_t)S[e]; pf1[e] = (half_t)S[8 + e]; }
    O0 = MFMA32(va[0], pf0, O0); O1 = MFMA32(va[2], pf0, O1); O0 = MFMA32(va[1], pf1, O0); O1 = MFMA32(va[3], pf1, O1);
}
template <bool FAST>
__device__ __forceinline__ void fox_tile2(const LAS unsigned char* sbp, int h, const h8 (&qA)[4], const h8 (&qB)[4], int qi, int hb, int kbase, int tA, bool diagA, bool diagB,
                                          float& mA, float& lA, f32x16& OA0, f32x16& OA1, float& mB, float& lB, f32x16& OB0, f32x16& OB1) {
    const LAS unsigned char* Kh = sbp + h * 4608; const LAS unsigned char* Vh = sbp + 18432 + h * 128;
    const LAS float* cbh = (const LAS float*)(sbp + 38912) + h * 32;
    h8 ka[4], va[4];
#pragma unroll
    for (int kk = 0; kk < 4; ++kk) ka[kk] = *(const LAS h8*)(Kh + pi16(qi) * 144 + (16 * kk + 8 * hb) * 2);
    {
        const LAS unsigned char* b0 = Vh + (8 * hb + ((qi & 15) >> 2)) * FVRS + (16 * ((qi >> 4) & 1) + 4 * (qi & 3)) * 2;
#pragma unroll
        for (int db = 0; db < 2; ++db)
#pragma unroll
            for (int s_ = 0; s_ < 2; ++s_) { const h4 lo = vtr4(b0 + s_ * 16 * FVRS + db * 64), hi = vtr4(b0 + s_ * 16 * FVRS + 4 * FVRS + db * 64);
                h8 v; v[0] = lo[0]; v[1] = lo[1]; v[2] = lo[2]; v[3] = lo[3]; v[4] = hi[0]; v[5] = hi[1]; v[6] = hi[2]; v[7] = hi[3]; va[2 * db + s_] = v; }
    }
    f32x16 SA, SB;
#pragma unroll
    for (int g = 0; g < 4; ++g) { const f32x4 c4 = *(const LAS f32x4*)(cbh + 16 * (g >> 1) + 8 * hb + 4 * (g & 1));
        SA[4 * g] = c4.x; SA[4 * g + 1] = c4.y; SA[4 * g + 2] = c4.z; SA[4 * g + 3] = c4.w; SB[4 * g] = c4.x; SB[4 * g + 1] = c4.y; SB[4 * g + 2] = c4.z; SB[4 * g + 3] = c4.w; }
#pragma unroll
    for (int kk = 0; kk < 4; ++kk) { SA = MFMA32(ka[kk], qA[kk], SA); SB = MFMA32(ka[kk], qB[kk], SB); }
    if (diagA) {
#pragma unroll
        for (int r = 0; r < 16; ++r) { const int key = kbase + 16 * (r >> 3) + 8 * hb + 4 * ((r >> 2) & 1) + (r & 3); if (key > tA) SA[r] = -INFINITY; }
    }
    if (diagB) {
#pragma unroll
        for (int r = 0; r < 16; ++r) { const int key = kbase + 16 * (r >> 3) + 8 * hb + 4 * ((r >> 2) & 1) + (r & 3); if (key > tA + 32) SB[r] = -INFINITY; }
    }
    float mnA = mA, mnB = mB, alA = 1.f, alB = 1.f;
    if (!FAST) {
        float xa = SA[0], xb = SB[0];
#pragma unroll
        for (int r = 1; r < 16; ++r) { xa = fmaxf(xa, SA[r]); xb = fmaxf(xb, SB[r]); }
        xa = fmaxf(xa, __shfl_xor(xa, 32)); xb = fmaxf(xb, __shfl_xor(xb, 32));
        mnA = fmaxf(mA, xa); alA = __builtin_amdgcn_exp2f(mA - mnA); mA = mnA;
        mnB = fmaxf(mB, xb); alB = __builtin_amdgcn_exp2f(mB - mnB); mB = mnB;
    }
    float pa = 0.f, pb = 0.f;
#pragma unroll
    for (int r = 0; r < 16; ++r) { SA[r] = __builtin_amdgcn_exp2f(SA[r] - mnA); SB[r] = __builtin_amdgcn_exp2f(SB[r] - mnB); pa += SA[r]; pb += SB[r]; }
    lA = lA * alA + pa; lB = lB * alB + pb;
    if (!FAST && __any(alA != 1.f || alB != 1.f)) {
#pragma unroll
        for (int r = 0; r < 16; ++r) { OA0[r] *= alA; OA1[r] *= alA; OB0[r] *= alB; OB1[r] *= alB; }
    }
    h8 fa0, fa1, fb0, fb1;
#pragma unroll
    for (int e = 0; e < 8; ++e) { fa0[e] = (half_t)SA[e]; fa1[e] = (half_t)SA[8 + e]; fb0[e] = (half_t)SB[e]; fb1[e] = (half_t)SB[8 + e]; }
    OA0 = MFMA32(va[0], fa0, OA0); OB0 = MFMA32(va[0], fb0, OB0); OA1 = MFMA32(va[2], fa0, OA1); OB1 = MFMA32(va[2], fb0, OB1);
    OA0 = MFMA32(va[1], fa1, OA0); OB0 = MFMA32(va[1], fb1, OB0); OA1 = MFMA32(va[3], fa1, OA1); OB1 = MFMA32(va[3], fb1, OB1);
}
__device__ __forceinline__ void nsa_tile(bool near, int dq, int wlim, float cinit, const LAS float* TRh, const h8 (&q)[4], const LAS unsigned char* stage, float& m, float& l, f32x16& O0, f32x16& O1, int qi, int hb) {
    f32x16 S0, S1;
    if (near) init_near(S0, S1, TRh, dq, hb, 1, wlim); else init_const(S0, S1, cinit);
    qk64(S0, S1, q, stage, qi, hb);
    softmax64(S0, S1, m, l, O0, O1);
    pv64(S0, S1, stage + 9216, O0, O1, qi, hb);
}

#define MFMA16(a, b, c) __builtin_amdgcn_mfma_f32_16x16x32_f16(a, b, c, 0, 0, 0)
template <bool FINAL>
__device__ __forceinline__ void lru_unit(const Params& P, int L, int ui, LAS unsigned char* lds, const half_t* Z, const half_t* WGT, const float* LSPp, float* LRUAGG, float* LRUA, float* LRUB, half_t* MIXED, int wave, float& hcarry, bool first) {
    int tid = threadIdx.x; asm volatile("" : "+v"(tid)); const int lane = tid & 63;
    const int b = ui >> 7, sub = ui & 127, t0 = sub * 32; const size_t tokb = (size_t)b * SEQ;
    LAS float* xcF = (LAS float*)lds;
    LAS float* Aa = (LAS float*)(lds + 32768);
    LAS half_t* xcH = (LAS half_t*)(lds + 65536);
    LAS float* Sc = (LAS float*)(lds + 82944);
    {
        const int c = tid & 255, q2 = tid >> 8, ta = t0 + 16 * q2;
        const float w0 = P.lru_conv_w[(L * 4 + 0) * 256 + c], w1 = P.lru_conv_w[(L * 4 + 1) * 256 + c], w2 = P.lru_conv_w[(L * 4 + 2) * 256 + c], w3 = P.lru_conv_w[(L * 4 + 3) * 256 + c], cb = P.lru_conv_b[L * 256 + c];
        const half_t* zp = Z + (tokb + ta) * NZP + ZC_LRU_X + c;
        float x0 = ta >= 3 ? (float)zp[-3 * NZP] : 0.f, x1 = ta >= 2 ? (float)zp[-2 * NZP] : 0.f, x2 = ta >= 1 ? (float)zp[-1 * NZP] : 0.f;
#pragma unroll
        for (int i = 0; i < 16; ++i) { const float x3 = (float)zp[(size_t)i * NZP]; const float v = cb + w0 * x0 + w1 * x1 + w2 * x2 + w3 * x3;
            xcF[(16 * q2 + i) * 256 + c] = v; xcH[(16 * q2 + i) * 264 + c] = (half_t)v; x0 = x1; x1 = x2; x2 = x3; }
    }
    __syncthreads();
    {
        const int blk = wave & 3, th = wave >> 2, r16 = lane & 15, kq = lane >> 4;
        const h8 a0 = *(const LAS h8*)(xcH + (16 * th + r16) * 264 + blk * 64 + 8 * kq), a1 = *(const LAS h8*)(xcH + (16 * th + r16) * 264 + blk * 64 + 32 + 8 * kq);
#pragma unroll
        for (int cbk = 0; cbk < 4; ++cbk) {
            const half_t* wr = WGT + ((size_t)((L * 2 + 0) * 4 + blk) * 64 + 16 * cbk + r16) * 64 + 8 * kq; const half_t* wi = wr + 4 * 64 * 64;
            f32x4 ar = {0.f, 0.f, 0.f, 0.f}, ai = {0.f, 0.f, 0.f, 0.f};
            ar = MFMA16(a0, *(const h8*)wr, ar); ar = MFMA16(a1, *(const h8*)(wr + 32), ar);
            ai = MFMA16(a0, *(const h8*)wi, ai); ai = MFMA16(a1, *(const h8*)(wi + 32), ai);
            const int c = blk * 64 + 16 * cbk + r16;
            const float br = P.lru_b_gates[(L * 2 + 0) * 256 + c], bi = P.lru_b_gates[(L * 2 + 1) * 256 + c];
            const float lsp = LSPp[L * 256 + c];
#pragma unroll
            for (int rg = 0; rg < 4; ++rg) { const int tl = 16 * th + 4 * kq + rg;
                const float r = __builtin_amdgcn_rcpf(1.f + __builtin_amdgcn_exp2f(-LOG2E * (ar[rg] + br))), ii = __builtin_amdgcn_rcpf(1.f + __builtin_amdgcn_exp2f(-LOG2E * (ai[rg] + bi)));
                const float xc = xcF[tl * 256 + c];
                const float a = __builtin_amdgcn_exp2f(lsp * r), bb = __builtin_amdgcn_sqrtf(fmaxf(1.f - a * a, 0.f)) * (ii * xc);
                Aa[tl * 256 + c] = a; xcF[tl * 256 + c] = bb; }
        }
    }
    __syncthreads();
    if (tid < 256) {
        const int c = tid;
        if (!FINAL) {
            float h = 0.f, Ap = 1.f;
#pragma unroll 8
            for (int i = 0; i < 32; ++i) { const unsigned pk = pack_h2(Aa[i * 256 + c], xcF[i * 256 + c]); const h2 ab = __builtin_bit_cast(h2, pk);
                const float a = (float)ab[0], bb = (float)ab[1]; h = fmaf(a, h, bb); Ap *= a;
                ((unsigned*)LRUA)[(tokb + t0 + i) * 256 + c] = pk; }
            float* ag = LRUAGG + (((size_t)b * 128 + sub) * 256 + c) * 2; ag[0] = Ap; ag[1] = h;
        } else {
            float h = hcarry;
            if (first) { h = 0.f; const float* ag = LRUAGG + ((size_t)b * 128 * 256 + c) * 2;
              for (int s0 = 0; s0 < sub; s0 += 16) {
                  typedef float f32x2 __attribute__((ext_vector_type(2)));
                  f32x2 pr[16];
#pragma unroll
                  for (int k = 0; k < 16; ++k) pr[k] = (s0 + k < sub) ? *(const f32x2*)(ag + (size_t)(s0 + k) * 512) : (f32x2){1.f, 0.f};
#pragma unroll
                  for (int k = 0; k < 16; ++k) h = fmaf(pr[k].x, h, pr[k].y); } }
            const half_t* gp = Z + (tokb + t0) * NZP + ZC_LRU_G + c;
#pragma unroll 8
            for (int i = 0; i < 32; ++i) { const float a = Aa[i * 256 + c], bb = xcF[i * 256 + c]; h = fmaf(a, h, bb);
                const float gx = (float)gp[(size_t)i * NZP];
                Aa[i * 256 + c] = h * gx * __builtin_amdgcn_rcpf(1.f + __builtin_amdgcn_exp2f(-2.f * LOG2E * 0.7978845608028654f * (gx + 0.044715f * gx * gx * gx))); }
            hcarry = h;
        }
    } else if (FINAL) {
        const int c = tid - 256;
        const float w0 = P.sc_conv_w[(L * 3 + 0) * 256 + c], w1 = P.sc_conv_w[(L * 3 + 1) * 256 + c], w2 = P.sc_conv_w[(L * 3 + 2) * 256 + c];
        const half_t* zp = Z + (tokb + t0) * NZP + c;
        float u0 = t0 >= 2 ? (float)zp[-2 * NZP + ZC_SC_C] * (float)zp[-2 * NZP + ZC_SC_X] : 0.f, u1 = t0 >= 1 ? (float)zp[-1 * NZP + ZC_SC_C] * (float)zp[-1 * NZP + ZC_SC_X] : 0.f;
#pragma unroll 8
        for (int i = 0; i < 32; ++i) { const half_t* zr = zp + (size_t)i * NZP; const float u2 = (float)zr[ZC_SC_C] * (float)zr[ZC_SC_X];
            Sc[i * 256 + c] = (float)zr[ZC_SC_B] * (w0 * u0 + w1 * u1 + w2 * u2); u0 = u1; u1 = u2; }
    }
    __syncthreads();
    if (FINAL) {
        const f32x4 ga = *(const f32x4*)(P.out_norm + (L * 4 + 0) * 256 + 4 * lane), gbv = *(const f32x4*)(P.out_norm + (L * 4 + 1) * 256 + 4 * lane);
#pragma unroll
        for (int i = 0; i < 4; ++i) { const int tl = wave * 4 + i; half_t* op = MIXED + (tokb + t0 + tl) * D + 4 * lane;
            { const f32x4 v = *(const LAS f32x4*)(Aa + tl * 256 + 4 * lane); const float rs = rsqrtf(wave_sum((v.x * v.x + v.y * v.y) + (v.z * v.z + v.w * v.w)) * (1.f / 256.f) + EPS);
              u32x2 o; o.x = pack_h2(v.x * rs * ga.x, v.y * rs * ga.y); o.y = pack_h2(v.z * rs * ga.z, v.w * rs * ga.w); *(u32x2*)op = o; }
            { const f32x4 v = *(const LAS f32x4*)(Sc + tl * 256 + 4 * lane); const float rs = rsqrtf(wave_sum((v.x * v.x + v.y * v.y) + (v.z * v.z + v.w * v.w)) * (1.f / 256.f) + EPS);
              u32x2 o; o.x = pack_h2(v.x * rs * gbv.x, v.y * rs * gbv.y); o.y = pack_h2(v.z * rs * gbv.z, v.w * rs * gbv.w); *(u32x2*)(op + 256) = o; }
        }
        __syncthreads();
    }
}

__device__ __forceinline__ void lru_agg2(const Params& P, int L, int ui, LAS unsigned char* lds, const half_t* Z, const half_t* WGT, const float* LSPp, float* LRUAGG, float* LRUA, int wave) {
    int tid = threadIdx.x; asm volatile("" : "+v"(tid)); const int lane = tid & 63;
    const int b = ui >> 6, sub2 = ui & 63, t0 = sub2 * 64; const size_t tokb = (size_t)b * SEQ;
    LAS half_t* xcH = (LAS half_t*)lds;
    LAS unsigned* PK = (LAS unsigned*)(lds + 33792);
    {
        const int c = tid & 255, q2 = tid >> 8, ta = t0 + 32 * q2;
        const float w0 = P.lru_conv_w[(L * 4 + 0) * 256 + c], w1 = P.lru_conv_w[(L * 4 + 1) * 256 + c], w2 = P.lru_conv_w[(L * 4 + 2) * 256 + c], w3 = P.lru_conv_w[(L * 4 + 3) * 256 + c], cb = P.lru_conv_b[L * 256 + c];
        const half_t* zp = Z + (tokb + ta) * NZP + ZC_LRU_X + c;
        half_t xv[35];
#pragma unroll
        for (int i = 0; i < 3; ++i) xv[i] = ta > 0 ? zp[(i - 3) * NZP] : (half_t)0.f;
#pragma unroll
        for (int i = 0; i < 32; ++i) xv[3 + i] = zp[(size_t)i * NZP];
#pragma unroll
        for (int i = 0; i < 32; ++i) xcH[(32 * q2 + i) * 264 + c] = (half_t)(cb + w0 * (float)xv[i] + w1 * (float)xv[i + 1] + w2 * (float)xv[i + 2] + w3 * (float)xv[i + 3]);
    }
    __syncthreads();
    {
        const int blk = wave & 3, th = wave >> 2, r16 = lane & 15, kq = lane >> 4;
        h8 a0[2], a1[2];
#pragma unroll
        for (int k = 0; k < 2; ++k) { const LAS half_t* ap = xcH + (16 * (th + 2 * k) + r16) * 264 + blk * 64 + 8 * kq; a0[k] = *(const LAS h8*)ap; a1[k] = *(const LAS h8*)(ap + 32); }
#pragma unroll
        for (int cbk = 0; cbk < 4; ++cbk) {
            const half_t* wr = WGT + ((size_t)((L * 2 + 0) * 4 + blk) * 64 + 16 * cbk + r16) * 64 + 8 * kq; const half_t* wi = wr + 4 * 64 * 64;
            const h8 wr0 = *(const h8*)wr, wr1 = *(const h8*)(wr + 32), wi0 = *(const h8*)wi, wi1 = *(const h8*)(wi + 32);
            const int c = blk * 64 + 16 * cbk + r16;
            const float br = P.lru_b_gates[(L * 2 + 0) * 256 + c], bi = P.lru_b_gates[(L * 2 + 1) * 256 + c];
            const float lsp = LSPp[L * 256 + c];
#pragma unroll
            for (int k = 0; k < 2; ++k) {
                f32x4 ar = {0.f, 0.f, 0.f, 0.f}, ai = {0.f, 0.f, 0.f, 0.f};
                ar = MFMA16(a0[k], wr0, ar); ar = MFMA16(a1[k], wr1, ar);
                ai = MFMA16(a0[k], wi0, ai); ai = MFMA16(a1[k], wi1, ai);
#pragma unroll
                for (int rg = 0; rg < 4; ++rg) { const int tl = 16 * (th + 2 * k) + 4 * kq + rg;
                    const float r = __builtin_amdgcn_rcpf(1.f + __builtin_amdgcn_exp2f(-LOG2E * (ar[rg] + br))), ii = __builtin_amdgcn_rcpf(1.f + __builtin_amdgcn_exp2f(-LOG2E * (ai[rg] + bi)));
                    const float xc = (float)xcH[tl * 264 + c];
                    const float a = __builtin_amdgcn_exp2f(lsp * r), bb = __builtin_amdgcn_sqrtf(fmaxf(1.f - a * a, 0.f)) * (ii * xc);
                    PK[tl * 256 + c] = pack_h2(a, bb); }
            }
        }
    }
    __syncthreads();
    {
        u32x4* dst = (u32x4*)((unsigned*)LRUA + (tokb + t0) * 256);
#pragma unroll
        for (int i = 0; i < 8; ++i) dst[tid + 512 * i] = *(const LAS u32x4*)(PK + 4 * (tid + 512 * i));
        const int c = tid & 255, hf = tid >> 8;
        float h = 0.f, Ap = 1.f;
#pragma unroll 8
        for (int i = 0; i < 32; ++i) { const h2 ab = __builtin_bit_cast(h2, PK[(32 * hf + i) * 256 + c]); const float a = (float)ab[0]; h = fmaf(a, h, (float)ab[1]); Ap *= a; }
        float* ag = LRUAGG + (((size_t)b * 128 + sub2 * 2 + hf) * 256 + c) * 2; ag[0] = Ap; ag[1] = h;
    }
}

constexpr int W_I_IN = 16 * 44, W_I_OUT = 16 * 16, W_I_GU = 16 * 88, W_I_DN = 44 * 16, W_PER_L = W_I_IN + W_I_OUT + W_I_GU + W_I_DN;
#define P0_WEIGHT_ITEM(Lx_, r_) do { const int Lw_ = (Lx_); int rw_ = (r_); \
        if (rw_ < W_I_IN) { p0_item<1>(P.w_in + (size_t)Lw_ * D * NIN_SRC, D, NIN_SRC, P.norm_mix + Lw_ * D, WIN_T + (size_t)Lw_ * NZP * D, rw_, 44, scr, lane); break; } rw_ -= W_I_IN; \
        if (rw_ < W_I_OUT) { p0_item<0>(P.w_out + (size_t)Lw_ * D * D, D, D, nullptr, WOUT_T + (size_t)Lw_ * D * D, rw_, 16, scr, lane); break; } rw_ -= W_I_OUT; \
        if (rw_ < W_I_GU) { p0_item<2>(P.w_gate_up + (size_t)Lw_ * D * 2 * DFF, D, 2 * DFF, P.norm_ffn + Lw_ * D, WGU_T + (size_t)Lw_ * 2 * DFF * D, rw_, 88, scr, lane); break; } rw_ -= W_I_GU; \
        p0_item<0>(P.w_down + (size_t)Lw_ * DFF * D, DFF, D, nullptr, WDN_T + (size_t)Lw_ * D * DFF, rw_, 16, scr, lane); } while (0)

__device__ __forceinline__ void lru_final(const Params& P, int L, int ui, LAS unsigned char* lds, const half_t* Z, const float* LRUAGG, const float* LRUA, const float* LRUB, half_t* MIXED, int wave, float& hcarry, bool first) {
    int tid = threadIdx.x; asm volatile("" : "+v"(tid)); const int lane = tid & 63;
    const int b = ui >> 7, sub = ui & 127, t0 = sub * 32; const size_t tokb = (size_t)b * SEQ;
    LAS float* Aa = (LAS float*)lds;
    LAS float* Sc = (LAS float*)(lds + 32768);
    if (tid < 256) {
        const int c = tid;
        unsigned abv[32]; half_t gv[32];
        const unsigned* ap = (const unsigned*)LRUA + (tokb + t0) * 256 + c; const half_t* gp = Z + (tokb + t0) * NZP + ZC_LRU_G + c;
#pragma unroll
        for (int i = 0; i < 32; ++i) { abv[i] = ap[i * 256]; gv[i] = gp[(size_t)i * NZP]; }
        float h = hcarry;
        if (first) { h = 0.f; const float* ag = LRUAGG + ((size_t)b * 128 * 256 + c) * 2;
          for (int s0 = 0; s0 < sub; s0 += 16) {
              typedef float f32x2 __attribute__((ext_vector_type(2)));
              f32x2 pr[16];
#pragma unroll
              for (int k = 0; k < 16; ++k) pr[k] = (s0 + k < sub) ? *(const f32x2*)(ag + (size_t)(s0 + k) * 512) : (f32x2){1.f, 0.f};
#pragma unroll
              for (int k = 0; k < 16; ++k) h = fmaf(pr[k].x, h, pr[k].y); } }
#pragma unroll
        for (int i = 0; i < 32; ++i) { const h2 ab = __builtin_bit_cast(h2, abv[i]); h = fmaf((float)ab[0], h, (float)ab[1]); const float gx = (float)gv[i];
            Aa[i * 256 + c] = h * gx * __builtin_amdgcn_rcpf(1.f + __builtin_amdgcn_exp2f(-2.f * LOG2E * 0.7978845608028654f * (gx + 0.044715f * gx * gx * gx))); }
        hcarry = h;
    } else {
        const int t2 = tid - 256, cl = t2 & 31, tk = t2 >> 5;
        const float* wp = P.sc_conv_w + (L * 3) * 256 + 8 * cl; const float* gp2 = P.out_norm + (L * 4 + 1) * 256 + 8 * cl;
        f32x4 wv[3][2], gv2[2];
#pragma unroll
        for (int k = 0; k < 3; ++k) { wv[k][0] = *(const f32x4*)(wp + k * 256); wv[k][1] = *(const f32x4*)(wp + k * 256 + 4); }
        gv2[0] = *(const f32x4*)gp2; gv2[1] = *(const f32x4*)(gp2 + 4);
        h8 ld[4][7];
#pragma unroll
        for (int ps = 0; ps < 4; ++ps) { const int t = t0 + 8 * ps + tk; const half_t* zr = Z + (tokb + t) * NZP + 8 * cl;
            const half_t* z1 = t >= 1 ? zr - NZP : zr; const half_t* z2 = t >= 2 ? zr - 2 * NZP : zr;
            ld[ps][0] = *(const h8*)(zr + ZC_SC_B); ld[ps][1] = *(const h8*)(zr + ZC_SC_C); ld[ps][2] = *(const h8*)(zr + ZC_SC_X);
            ld[ps][3] = *(const h8*)(z1 + ZC_SC_C); ld[ps][4] = *(const h8*)(z1 + ZC_SC_X); ld[ps][5] = *(const h8*)(z2 + ZC_SC_C); ld[ps][6] = *(const h8*)(z2 + ZC_SC_X); }
#pragma unroll
        for (int ps = 0; ps < 4; ++ps) { const int t = t0 + 8 * ps + tk;
            const float m1 = t >= 1 ? 1.f : 0.f, m2 = t >= 2 ? 1.f : 0.f;
            float y[8]; float ss = 0.f;
#pragma unroll
            for (int e = 0; e < 8; ++e) { const float u2 = (float)ld[ps][1][e] * (float)ld[ps][2][e], u1 = (float)ld[ps][3][e] * (float)ld[ps][4][e] * m1, u0 = (float)ld[ps][5][e] * (float)ld[ps][6][e] * m2;
                y[e] = (float)ld[ps][0][e] * (wv[0][e >> 2][e & 3] * u0 + wv[1][e >> 2][e & 3] * u1 + wv[2][e >> 2][e & 3] * u2); ss += y[e] * y[e]; }
            ss += __shfl_xor(ss, 1); ss += __shfl_xor(ss, 2); ss += __shfl_xor(ss, 4); ss += __shfl_xor(ss, 8); ss += __shfl_xor(ss, 16);
            const float rs = rsqrtf(ss * (1.f / 256.f) + EPS);
            *(u32x4*)(MIXED + (tokb + t) * D + 256 + 8 * cl) = pack_h8((f32x4){y[0] * rs * gv2[0].x, y[1] * rs * gv2[0].y, y[2] * rs * gv2[0].z, y[3] * rs * gv2[0].w},
                                                                      (f32x4){y[4] * rs * gv2[1].x, y[5] * rs * gv2[1].y, y[6] * rs * gv2[1].z, y[7] * rs * gv2[1].w}); }
    }
    __syncthreads();
    {
        const f32x4 ga = *(const f32x4*)(P.out_norm + (L * 4 + 0) * 256 + 4 * lane);
#pragma unroll
        for (int i = 0; i < 4; ++i) { const int tl = wave * 4 + i; half_t* op = MIXED + (tokb + t0 + tl) * D + 4 * lane;
            const f32x4 v = *(const LAS f32x4*)(Aa + tl * 256 + 4 * lane); const float rs = rsqrtf(wave_sum((v.x * v.x + v.y * v.y) + (v.z * v.z + v.w * v.w)) * (1.f / 256.f) + EPS);
            u32x2 o; o.x = pack_h2(v.x * rs * ga.x, v.y * rs * ga.y); o.y = pack_h2(v.z * rs * ga.z, v.w * rs * ga.w); *(u32x2*)op = o; }
    }
    __syncthreads();
}

constexpr int CW_Q = 8192;
__device__ __forceinline__ int q_next(unsigned* ctr, volatile LAS unsigned* slot) {
    __syncthreads();
    if (threadIdx.x == 0) *slot = __hip_atomic_fetch_add(ctr, 1u, __ATOMIC_RELAXED, __HIP_MEMORY_SCOPE_AGENT);
    __syncthreads();
    return __builtin_amdgcn_readfirstlane((int)*slot);
}
struct QPull {
    unsigned* ctr; volatile LAS unsigned* slot; unsigned nx; int ui;
    __device__ __forceinline__ QPull(unsigned* c, volatile LAS unsigned* s) : ctr(c), slot(s), nx(0u), ui(0) { issue(); publish(); }
    __device__ __forceinline__ void issue() { if (threadIdx.x == 0) nx = __hip_atomic_fetch_add(ctr, 1u, __ATOMIC_RELAXED, __HIP_MEMORY_SCOPE_AGENT); }
    __device__ __forceinline__ void publish() { __syncthreads(); if (threadIdx.x == 0) *slot = nx; __syncthreads(); ui = __builtin_amdgcn_readfirstlane((int)*slot); }
};
__device__ __forceinline__ unsigned long long ld_uptr(const LAS unsigned long long* pb, int i) {
    const unsigned long long v = pb[i];
    return ((unsigned long long)(unsigned)__builtin_amdgcn_readfirstlane((int)(v >> 32)) << 32) | (unsigned)__builtin_amdgcn_readfirstlane((int)(unsigned)v);
}
#define SECTION_ENV() \
    asm volatile("" ::: "memory"); \
    int bid = blockIdx.x; asm volatile("" : "+s"(bid));     \
    Params P; { unsigned poff_ = MISC_OFF + 512; asm volatile("" : "+s"(poff_)); const LAS unsigned long long* pb_ = (const LAS unsigned long long*)(lds + poff_); P.x = (const float*)(const __attribute__((address_space(1))) float*)ld_uptr(pb_, 0); P.norm_mix = (const float*)(const __attribute__((address_space(1))) float*)ld_uptr(pb_, 1); P.w_in = (const float*)(const __attribute__((address_space(1))) float*)ld_uptr(pb_, 2); P.lru_conv_w = (const float*)(const __attribute__((address_space(1))) float*)ld_uptr(pb_, 3); P.lru_conv_b = (const float*)(const __attribute__((address_space(1))) float*)ld_uptr(pb_, 4); P.lru_w_gates = (const float*)(const __attribute__((address_space(1))) float*)ld_uptr(pb_, 5); P.lru_b_gates = (const float*)(const __attribute__((address_space(1))) float*)ld_uptr(pb_, 6); P.lru_lambda = (const float*)(const __attribute__((address_space(1))) float*)ld_uptr(pb_, 7); P.sc_conv_w = (const float*)(const __attribute__((address_space(1))) float*)ld_uptr(pb_, 8); P.fox_f_bias = (const float*)(const __attribute__((address_space(1))) float*)ld_uptr(pb_, 9); P.fox_qk_norm = (const float*)(const __attribute__((address_space(1))) float*)ld_uptr(pb_, 10); P.nsa_qk_norm = (const float*)(const __attribute__((address_space(1))) float*)ld_uptr(pb_, 11); P.nsa_cmp_pos = (const float*)(const __attribute__((address_space(1))) float*)ld_uptr(pb_, 12); P.nsa_cmp_w1 = (const float*)(const __attribute__((address_space(1))) float*)ld_uptr(pb_, 13); P.nsa_cmp_w2 = (const float*)(const __attribute__((address_space(1))) float*)ld_uptr(pb_, 14); P.nsa_gate_bias = (const float*)(const __attribute__((address_space(1))) float*)ld_uptr(pb_, 15); P.rel_bias = (const float*)(const __attribute__((address_space(1))) float*)ld_uptr(pb_, 16); P.out_norm = (const float*)(const __attribute__((address_space(1))) float*)ld_uptr(pb_, 17); P.w_out = (const float*)(const __attribute__((address_space(1))) float*)ld_uptr(pb_, 18); P.norm_ffn = (const float*)(const __attribute__((address_space(1))) float*)ld_uptr(pb_, 19); P.w_gate_up = (const float*)(const __attribute__((address_space(1))) float*)ld_uptr(pb_, 20); P.w_down = (const float*)(const __attribute__((address_space(1))) float*)ld_uptr(pb_, 21); P.out = (float*)(__attribute__((address_space(1))) float*)ld_uptr(pb_, 22); P.ws = (unsigned char*)(__attribute__((address_space(1))) unsigned char*)ld_uptr(pb_, 23); } \
    unsigned char* ws = P.ws; (void)ws; \
    float* SSQA = (float*)(ws + WS_SSQA); float* SSQB = (float*)(ws + WS_SSQB); float* CFOX = (float*)(ws + WS_CFOX); \
    float* LRUAGG = (float*)(ws + WS_LRUAGG); float* CB = (float*)(ws + WS_CB); \
    half_t* WIN_T = (half_t*)(ws + WS_WIN); half_t* WOUT_T = (half_t*)(ws + WS_WOUT); half_t* WGU_T = (half_t*)(ws + WS_WGU); half_t* WDN_T = (half_t*)(ws + WS_WDN); \
    half_t* FOXVT = (half_t*)(ws + WS_FOXVT); half_t* VST = (half_t*)(ws + WS_VST); half_t* VWT = (half_t*)(ws + WS_VWT); half_t* KCH = (half_t*)(ws + WS_KCH); half_t* VCT = (half_t*)(ws + WS_VCT); \
    half_t* W1T = (half_t*)(ws + WS_W1T); half_t* WGT = (half_t*)(ws + WS_WGT); float* LRUA = (float*)(ws + WS_LRUA); float* LRUB = (float*)(ws + WS_LRUB); (void)LRUA; (void)LRUB; \
    half_t* XH = (half_t*)(ws + WS_XH); half_t* MIXED = (half_t*)(ws + WS_MIXED); half_t* Z = (half_t*)(ws + WS_Z); half_t* HB = (half_t*)(ws + WS_Z); \
    (void)SSQA; (void)SSQB; (void)CFOX; (void)LRUAGG; (void)CB; (void)WIN_T; (void)WOUT_T; (void)WGU_T; (void)WDN_T; (void)FOXVT; (void)VST; (void)VWT; (void)KCH; (void)VCT; (void)W1T; (void)WGT; (void)XH; (void)MIXED; (void)Z; (void)HB

__global__ void __launch_bounds__(NTHR, 2) hymba_fwd(Params Pk) {
    extern __shared__ __attribute__((aligned(16))) unsigned char lds_raw[];
    LAS unsigned char* lds = (LAS unsigned char*)lds_raw;
    volatile LAS unsigned* MISC = (volatile LAS unsigned*)(lds + MISC_OFF);
    const int tid = threadIdx.x, lane = tid & 63, wave = __builtin_amdgcn_readfirstlane(tid >> 6);
    const int G = gridDim.x, bid = blockIdx.x;
    if (tid == 0) { LAS unsigned long long* pb = (LAS unsigned long long*)(lds + MISC_OFF + 512); pb[0] = (unsigned long long)Pk.x; pb[1] = (unsigned long long)Pk.norm_mix; pb[2] = (unsigned long long)Pk.w_in; pb[3] = (unsigned long long)Pk.lru_conv_w; pb[4] = (unsigned long long)Pk.lru_conv_b; pb[5] = (unsigned long long)Pk.lru_w_gates; pb[6] = (unsigned long long)Pk.lru_b_gates; pb[7] = (unsigned long long)Pk.lru_lambda; pb[8] = (unsigned long long)Pk.sc_conv_w; pb[9] = (unsigned long long)Pk.fox_f_bias; pb[10] = (unsigned long long)Pk.fox_qk_norm; pb[11] = (unsigned long long)Pk.nsa_qk_norm; pb[12] = (unsigned long long)Pk.nsa_cmp_pos; pb[13] = (unsigned long long)Pk.nsa_cmp_w1; pb[14] = (unsigned long long)Pk.nsa_cmp_w2; pb[15] = (unsigned long long)Pk.nsa_gate_bias; pb[16] = (unsigned long long)Pk.rel_bias; pb[17] = (unsigned long long)Pk.out_norm; pb[18] = (unsigned long long)Pk.w_out; pb[19] = (unsigned long long)Pk.norm_ffn; pb[20] = (unsigned long long)Pk.w_gate_up; pb[21] = (unsigned long long)Pk.w_down; pb[22] = (unsigned long long)Pk.out; pb[23] = (unsigned long long)Pk.ws; }
    unsigned* ctl = (unsigned*)(Pk.ws + WS_CTL);

    for (int u = tid; u < 64; u += NTHR) MISC[u] = 0u;
    __syncthreads();
    XcdBarrier bar = xcd_barrier_post(ctl + CW_BAR, MISC + 8);

    const int gw = bid * NWAVES + wave, NGW = G * NWAVES;

#ifndef SKIP_P0
    for (int rp0 = 0; rp0 < REP_P0; ++rp0) {
        SECTION_ENV();
        LAS unsigned* scr = (LAS unsigned*)(lds + wave * 8448);
        for (int r = gw; r < W_I_IN; r += NGW) P0_WEIGHT_ITEM(0, r);
        for (int it = gw; it < 4 * 64 + 16; it += NGW) {
            if (it < 256) { const int ln = it >> 6; p0_item<0>(P.nsa_cmp_w1 + (size_t)ln * 2048 * 128, 2048, 128, nullptr, W1T + (size_t)ln * 128 * 2048, it & 63, 2, scr, lane); }
            else { const int gi = it - 256; p0_item<0>(P.lru_w_gates + (size_t)gi * 64 * 64, 64, 64, nullptr, WGT + (size_t)gi * 64 * 64, 0, 1, scr, lane); }
        }
        for (int og = gw; og < 4 * 512; og += NGW) {
            const int o = og & 511, qr = og >> 9, m = o & 127, ln = o >> 7;
            const float* pp = P.nsa_cmp_pos + (size_t)ln * 2048 + qr * 512; const float* wp = P.nsa_cmp_w1 + ((size_t)ln * 2048 + qr * 512) * 128 + m;
            float s = 0.f;
#pragma unroll
            for (int i = 0; i < 8; ++i) s = fmaf(pp[lane + 64 * i], wp[(size_t)(lane + 64 * i) * 128], s);
            s = wave_sum(s);
            if (lane == 0) CB[qr * 512 + o] = s;
        }
        for (int o = bid * NTHR + tid; o < 512; o += G * NTHR) CB[2048 + o] = -8.0f * LOG2E * log1pf(expf(-P.lru_lambda[o]));
        for (int row0 = gw; row0 < T; row0 += 4 * NGW) {
            f32x4 v[4][4];
#pragma unroll
            for (int rr = 0; rr < 4; ++rr)
#pragma unroll
                for (int j = 0; j < 4; ++j) v[rr][j] = ((const f32x4*)(P.x + (size_t)(row0 + rr * NGW) * D) + lane)[64 * j];
#pragma unroll
            for (int rr = 0; rr < 4; ++rr) { const int row = row0 + rr * NGW; float s = 0.f;
#pragma unroll
                for (int j = 0; j < 4; ++j) { const f32x4 w = v[rr][j]; s += (w.x * w.x + w.y * w.y) + (w.z * w.z + w.w * w.w);
                    u32x2 o; o.x = pack_h2(w.x, w.y); o.y = pack_h2(w.z, w.w); *(u32x2*)(XH + (size_t)row * D + 4 * (lane + 64 * j)) = o; }
                s = wave_sum(s);
                if (lane < 16) SSQB[(size_t)row * 16 + lane] = lane == 0 ? s : 0.f; }
        }
    }
#endif
    xcd_barrier(bar);

    for (int L = 0; L < 2; ++L) {
#ifndef SKIP_G1
        {
            SECTION_ENV();
            pg8::Gemm g{XH, WIN_T + (size_t)L * NZP * D, T, NZP, D}; pg8::StaticOrder S; S.init(T, NZP, G, bid, G1_WGM);
            EpiZ E{Z, SSQB, P.fox_qk_norm + L * 128, P.nsa_qk_norm + L * 256};
            {
                int tidw = threadIdx.x; asm volatile("" : "+v"(tidw)); const int lane = tidw & 63;
                LAS unsigned* scr = (LAS unsigned*)(lds + wave * 8448);
                const int rem = S.nwg % G;
                if (rem == 0 || bid >= rem) {
                    const int sw = ((rem == 0 ? bid : bid - rem) * NWAVES + wave), nsw = (rem == 0 ? G : G - rem) * NWAVES;
                    const int nrest = W_PER_L - W_I_IN, n = L == 0 ? W_PER_L : nrest;
                    for (int it = sw; it < n; it += nsw) {
                        if (it < nrest) P0_WEIGHT_ITEM(L, W_I_IN + it); else P0_WEIGHT_ITEM(1, it - nrest);
                    }
                    __syncthreads();
                }
            }
            for (int rp = 0; rp < REP_G1; ++rp) pg8::gemm_phase<EpiZ, pg8::StaticOrder>(lds, g, S, E);
        }
#endif
        xcd_barrier(bar);

        {
            SECTION_ENV();
            if (wave == 0) {
                int tidf = threadIdx.x; asm volatile("" : "+v"(tidf));
                float gq = fabsf(P.nsa_qk_norm[(L * 4 + 0) * 64 + tidf]), gk = fmaxf(fmaxf(fabsf(P.nsa_qk_norm[(L * 4 + 1) * 64 + tidf]), fabsf(P.nsa_qk_norm[(L * 4 + 2) * 64 + tidf])), fabsf(P.nsa_qk_norm[(L * 4 + 3) * 64 + tidf]));
                float rb = fmaxf(fabsf(P.rel_bias[tidf]), fabsf(P.rel_bias[64 + tidf]));
#pragma unroll
                for (int o = 1; o < 64; o <<= 1) { gq = fmaxf(gq, __shfl_xor(gq, o)); gk = fmaxf(gk, __shfl_xor(gk, o)); rb = fmaxf(rb, __shfl_xor(rb, o)); }
                if (tidf == 0) MISC[16] = ((8.f * gq * gk + 2.f * rb) * LOG2E <= 15.8f) ? 1u : 0u;
            }
            __syncthreads();
            const bool nsa_fast_p2 = __builtin_amdgcn_readfirstlane((int)MISC[16]) != 0;
#ifndef SKIP_P2AB
            for (int rp = 0; rp < REP_CUM; ++rp)
            if (wave == 1)
            for (int task = 0; task < 32; ++task) if ((task * 8 + (task >> 2)) % G == bid) {
                int tid = threadIdx.x; asm volatile("" : "+v"(tid)); const int lane = tid & 63;
                const int b = task >> 2, h = task & 3;
                const float fb = P.fox_f_bias[L * 4 + h];
                const half_t* zp = Z + ((size_t)b * SEQ + 64 * lane) * NZP + ZC_FOX_F + h;
                float vals[64];
#pragma unroll
                for (int j = 0; j < 64; ++j) vals[j] = (float)zp[(size_t)j * NZP];
                float run = 0.f;
#pragma unroll
                for (int j = 0; j < 64; ++j) { run += log_sigmoid(vals[j] + fb); vals[j] = run; }
                float incl = run;
#pragma unroll
                for (int o = 1; o < 64; o <<= 1) { const float n = __shfl_up(incl, o); if (lane >= o) incl += n; }
                const float excl = incl - run;
                float* cp = CFOX + ((size_t)b * 4 + h) * SEQ + 64 * lane;
#pragma unroll
                for (int j = 0; j < 64; j += 4) *(f32x4*)(cp + j) = (f32x4){vals[j] + excl, vals[j + 1] + excl, vals[j + 2] + excl, vals[j + 3] + excl};
            }
#endif
            if (!nsa_fast_p2)
            for (int rp = 0; rp < REP_VT; ++rp)
            for (int ui = bid; ui < 256; ui += G) {
                int tid = threadIdx.x; asm volatile("" : "+v"(tid));
                const int b = ui >> 5, c2 = ui & 31; const size_t tokb = (size_t)b * SEQ + c2 * 128;
                LAS half_t* tb2 = (LAS half_t*)lds;
                h8 ld1[4];
#pragma unroll
                for (int i = 0; i < 4; ++i) { const int p = tid + 512 * i, tk = p >> 4, c8 = p & 15; ld1[i] = *(const h8*)(Z + (tokb + tk) * NZP + (c8 < 8 ? ZC_VS + 8 * c8 : ZC_VW + 8 * (c8 - 8))); }
#pragma unroll
                for (int i = 0; i < 4; ++i) { const int p = tid + 512 * i, tk = p >> 4, c8 = p & 15; *(LAS h8*)(tb2 + tk * 136 + 8 * c8) = ld1[i]; }
                __syncthreads();
#pragma unroll
                for (int i = 0; i < 4; ++i) { const int p = tid + 512 * i, ch2 = p >> 10, which = (p >> 9) & 1, d = (p >> 3) & 63, ch = p & 7; h8 o;
#pragma unroll
                    for (int e = 0; e < 8; ++e) o[e] = tb2[(64 * ch2 + 8 * ch + e) * 136 + 64 * which + d];
                    *(h8*)((which ? VWT : VST) + ((size_t)(b * 64 + c2 * 2 + ch2) * 64 + d) * 64 + 8 * ch) = o; }
                __syncthreads();
            }
#ifndef SKIP_P2CMP
            for (int rp = 0; rp < REP_P2CMP; ++rp)
            for (int ui = bid; ui < 256; ui += G) {
                int tid = threadIdx.x; asm volatile("" : "+v"(tid)); const int lane = tid & 63, r16 = lane & 15, kq = lane >> 4;
                const int net = ui >> 7, b = (ui >> 4) & 7, n0 = (ui & 15) * 16;
                const size_t tokb = (size_t)b * SEQ;
                LAS half_t* zt = (LAS half_t*)lds;
                LAS float* w2s = (LAS float*)(lds + 39424);
                LAS float* hidb = (LAS float*)(lds + 39424 + 32768);
                {
                    const half_t* zsrc = Z + (tokb + 16 * n0) * NZP + (net ? ZC_VC : ZC_KC);
                    h8 zl[5]; f32x4 wl[4];
#pragma unroll
                    for (int i = 0; i < 5; ++i) { const int e = tid + NTHR * i, tk = (e >> 3) < 272 ? (e >> 3) : 271, c8 = e & 7; const int tt = 16 * n0 + tk; const int tcl = tt > SEQ - 1 ? SEQ - 1 - 16 * n0 : tk;
                        zl[i] = *(const h8*)(zsrc + (size_t)tcl * NZP + 8 * c8); }
                    const float* w2g = P.nsa_cmp_w2 + (size_t)(L * 2 + net) * 128 * 64;
#pragma unroll
                    for (int i = 0; i < 4; ++i) wl[i] = *(const f32x4*)(w2g + 4 * (tid + NTHR * i));
#pragma unroll
                    for (int i = 0; i < 5; ++i) { const int e = tid + NTHR * i, tk = e >> 3, c8 = e & 7; if (tk < 272) *(LAS h8*)(zt + tk * 72 + 8 * c8) = zl[i]; }
#pragma unroll
                    for (int i = 0; i < 4; ++i) *(LAS f32x4*)(w2s + 4 * (tid + NTHR * i)) = wl[i];
                }
                const half_t* w1t = W1T + ((size_t)((L * 2 + net) * 128 + 16 * wave + r16)) * 2048 + 8 * kq;
                h8 bf[16];
#pragma unroll
                for (int s = 0; s < 16; ++s) bf[s] = *(const h8*)(w1t + 32 * s);
                __syncthreads();
                {
                    f32x4 c0 = {0.f, 0.f, 0.f, 0.f}, c1 = {0.f, 0.f, 0.f, 0.f};
                    const LAS half_t* za = zt + (16 * r16) * 72 + 8 * kq;
#pragma unroll
                    for (int qd = 0; qd < 4; ++qd) {
                        h8 bn[16];
                        if (qd < 3) {
#pragma unroll
                            for (int s = 0; s < 16; ++s) bn[s] = *(const h8*)(w1t + 32 * (16 * (qd + 1) + s));
                        }
#pragma unroll
                        for (int s = 0; s < 16; s += 2) { const int sg = 16 * qd + s;
                            c0 = MFMA16(*(const LAS h8*)(za + (sg >> 1) * 72), bf[s], c0);
                            c1 = MFMA16(*(const LAS h8*)(za + (sg >> 1) * 72 + 32), bf[s + 1], c1); }
                        if (qd < 3) {
#pragma unroll
                            for (int s = 0; s < 16; ++s) bf[s] = bn[s];
                        }
                    }
                    const int m = 16 * wave + r16; const int cbi = (L * 2 + net) * 128 + m; const float cbm = ((CB[cbi] + CB[512 + cbi]) + CB[1024 + cbi]) + CB[1536 + cbi];
#pragma unroll
                    for (int rg = 0; rg < 4; ++rg) hidb[(4 * kq + rg) * 132 + m] = gelu_tanh((c0[rg] + c1[rg]) + cbm);
                }
                __syncthreads();
                {
                    const int d = lane;
                    float o0 = 0.f, o1 = 0.f; const LAS float* hp = hidb + (2 * wave) * 132;
#pragma unroll 8
                    for (int m = 0; m < 128; m += 4) { const f32x4 h0 = *(const LAS f32x4*)(hp + m), h1 = *(const LAS f32x4*)(hp + 132 + m);
                        const float w0 = w2s[m * 64 + d], w1 = w2s[(m + 1) * 64 + d], w2_ = w2s[(m + 2) * 64 + d], w3 = w2s[(m + 3) * 64 + d];
                        o0 = fmaf(h0.x, w0, o0); o0 = fmaf(h0.y, w1, o0); o0 = fmaf(h0.z, w2_, o0); o0 = fmaf(h0.w, w3, o0);
                        o1 = fmaf(h1.x, w0, o1); o1 = fmaf(h1.y, w1, o1); o1 = fmaf(h1.z, w2_, o1); o1 = fmaf(h1.w, w3, o1); }
                    float ov[2] = {o0, o1};
#pragma unroll
                    for (int i = 0; i < 2; ++i) { float o = ov[i]; const int n = n0 + 2 * wave + i;
                        if (net == 0) { const float ss = wave_sum(o * o); o = o * rsqrtf(ss * (1.f / 64.f) + EPS) * P.nsa_qk_norm[(L * 4 + 1) * 64 + d]; }
                        if (n >= NCMP) o = 0.f;
                        if (net == 0) KCH[((size_t)b * 256 + n) * 64 + d] = (half_t)o; else VCT[((size_t)b * 64 + d) * 256 + n] = (half_t)o; }
                }
                __syncthreads();
            }
#endif
#ifndef SKIP_P2LRU
            for (int rp = 0; rp < REP_P2LRU; ++rp)
            for (QPull qp_(ctl + CW_Q + ((L * 4 + 3) * 8 + rp) * 64, MISC + 20); qp_.ui < 512; qp_.publish()) { qp_.issue(); const int ui = qp_.ui;
                lru_agg2(P, L, ui, lds, Z, WGT, CB + 2048, LRUAGG, LRUA, wave); }
#endif
        }
        xcd_barrier(bar);

        {
        SECTION_ENV();
#ifndef SKIP_NSA
        {
            int tidt = threadIdx.x; asm volatile("" : "+v"(tidt)); LAS float* TRXp = (LAS float*)(lds + MISC_OFF + 1024);
            for (int e = tidt; e < 4 * 520; e += NTHR) { const int hh = e / 520, i = e % 520, d = i - 1;
                TRXp[e] = (i == 0 || i > 512) ? -INFINITY : (P.rel_bias[(d < 128 ? (int)c_bucket[d] : 31) * 4 + hh] - P.rel_bias[31 * 4 + hh]) * LOG2E; }
        }
        __syncthreads();
        const bool nsa_fast = __builtin_amdgcn_readfirstlane((int)MISC[16]) != 0;
        if (nsa_fast)
        for (QPull qp_(ctl + CW_Q + ((L * 4 + 0) * 8 + (bid & 7)) * 64, MISC + 20); qp_.ui < 64; qp_.publish()) {
            qp_.issue(); const int ui = qp_.ui;
            int tid = threadIdx.x; asm volatile("" : "+v"(tid)); const int lane = tid & 63, hb = lane >> 5, qi = lane & 31;
            const int h = wave & 3, rh = wave >> 2;
            const int b = bid & 7, qt = 63 - ui, t0 = qt * 64, t = t0 + 32 * rh + qi, cur = qt, row = 32 * rh + qi;
            const size_t tokb = (size_t)b * SEQ;
            constexpr int NS_VT = 9216, NS_STAGE = 18432, NF_TRX = 36864, NF_IMP = NF_TRX + 4 * 520 * 4, NF_SELM = NF_IMP + 4 * 64 * 65 * 4, NF_EX = NF_SELM + 512, NF_STL = NF_EX + 1024, NF_MISC = NF_STL + 1024;
            static_assert(4 * (9216 + 64 * 192) <= NF_SELM && NF_MISC + 256 <= RING_BYTES && MISC_OFF + 1024 + 4 * 520 * 4 <= LDS_BYTES, "NSA fast LDS map");
            LAS float* TRX = (LAS float*)(lds + MISC_OFF + 1024); LAS float* impH = (LAS float*)(lds + NF_IMP); LAS unsigned* selm = (LAS unsigned*)(lds + NF_SELM);
            LAS float* ex = (LAS float*)(lds + NF_EX); LAS float* stl = (LAS float*)(lds + NF_STL); LAS unsigned* misc = (LAS unsigned*)(lds + NF_MISC);
            for (int e = tid; e < 4 * 64 * 65; e += NTHR) impH[e] = 0.f;
            const LAS float* TXh = TRX + h * 520;
            h8 q[4];
#pragma unroll
            for (int kk = 0; kk < 4; ++kk) q[kk] = *(const h8*)(Z + (tokb + t) * NZP + ZC_NSA_Q + 64 * h + 16 * kk + 8 * hb);
            float gs0, gs1, gs2;
            { const float* gb = P.nsa_gate_bias + L * 12; const half_t* gz = Z + (tokb + t) * NZP + ZC_NSA_G;
              gs0 = sigmoidf_((float)gz[0 * 4 + h] + gb[0 * 4 + h]); gs1 = sigmoidf_((float)gz[1 * 4 + h] + gb[1 * 4 + h]); gs2 = sigmoidf_((float)gz[2 * 4 + h] + gb[2 * 4 + h]); }
            f32x16 T0, T1;
            u32x4 kr, vr, krB, vrB;
#define NS_ISSUE_R(KR, VR, kbase_, kstride_, vbase_, vstride_) do { KR = *(const u32x4*)((const char*)(kbase_) + (size_t)(tid >> 3) * (kstride_) + (tid & 7) * 16); \
                VR = *(const u32x4*)((const char*)(vbase_) + (size_t)(tid >> 3) * (vstride_) + (tid & 7) * 16); } while (0)
#define NS_WRITE_R(KR, VR, sb_) do { *(LAS u32x4*)(lds + (sb_) + (tid >> 3) * 144 + (tid & 7) * 16) = KR; *(LAS u32x4*)(lds + (sb_) + NS_VT + (tid >> 3) * 144 + (tid & 7) * 16) = VR; } while (0)
            {
                int cnt = (t0 + 63 - 31) / 16 + 1; if (cnt > NCMP) cnt = NCMP;
                const int ntc = (cnt + 63) >> 6;
                const half_t* kcb = KCH + (size_t)b * 256 * 64; const half_t* vcb = VCT + (size_t)b * 64 * 256;
                float l = 0.f;
#pragma unroll
                for (int r = 0; r < 16; ++r) { T0[r] = 0.f; T1[r] = 0.f; }
                for (int c = 0; c < ntc; ++c) {
                    __syncthreads();
                    NS_ISSUE_R(kr, vr, kcb + (size_t)c * 64 * 64, 128, vcb + c * 64, 512); NS_WRITE_R(kr, vr, 0);
                    __syncthreads();
                    f32x16 S0, S1; init_tab(S0, S1, TXh, t - 31 - 1024 * c, hb, 16, 511, true);
                    qk64(S0, S1, q, lds, qi, hb);
                    l += exp_sum64(S0, S1);
                    LAS float* ip = impH + (h * 64 + row) * 65 + 16 * c + 2 * hb;
#pragma unroll
                    for (int g = 0; g < 4; ++g) {
                        const int mo = 4 * (g >> 1) + (g & 1);
                        { const float v1 = 16.f * S0[4 * g + 3], v0 = 32.f * ((S0[4 * g] + S0[4 * g + 1]) + S0[4 * g + 2]) + v1;
                          __hip_atomic_fetch_add(ip + mo, v0, __ATOMIC_RELAXED, __HIP_MEMORY_SCOPE_WORKGROUP); if (16 * c + 2 * hb + mo + 1 < 64) __hip_atomic_fetch_add(ip + mo + 1, v1, __ATOMIC_RELAXED, __HIP_MEMORY_SCOPE_WORKGROUP); }
                        { const float v1 = 16.f * S1[4 * g + 3], v0 = 32.f * ((S1[4 * g] + S1[4 * g + 1]) + S1[4 * g + 2]) + v1;
                          __hip_atomic_fetch_add(ip + 8 + mo, v0, __ATOMIC_RELAXED, __HIP_MEMORY_SCOPE_WORKGROUP); if (16 * c + 2 * hb + 8 + mo + 1 < 64) __hip_atomic_fetch_add(ip + 8 + mo + 1, v1, __ATOMIC_RELAXED, __HIP_MEMORY_SCOPE_WORKGROUP); }
                    }
                    pv64m(S0, S1, true, lds + NS_VT, T0, T1, qi, hb);
                }
                l += __shfl_xor(l, 32);
                const float il = l > 0.f ? __builtin_amdgcn_rcpf(l) : 0.f;
                if (hb == 0) stl[row * 4 + h] = il;
                const float g0 = gs0 * il;
#pragma unroll
                for (int r = 0; r < 16; ++r) { T0[r] *= g0; T1[r] *= g0; }
            }
            __syncthreads();
            for (int rpQ = 0; rpQ < REP_NSELECT; ++rpQ)
#pragma unroll 4
            for (int rr = 0; rr < 8; ++rr) {
                const int rw = wave * 8 + rr;
                float v = ((impH[(0 * 64 + rw) * 65 + lane] * stl[rw * 4 + 0] + impH[(1 * 64 + rw) * 65 + lane] * stl[rw * 4 + 1]) + impH[(2 * 64 + rw) * 65 + lane] * stl[rw * 4 + 2]) + impH[(3 * 64 + rw) * 65 + lane] * stl[rw * 4 + 3];
                if (lane == 0 || lane == cur || lane == cur - 1) v = 1e30f;
                const unsigned key = lane > cur ? 0u : __builtin_bit_cast(unsigned, v) + 1u;
                unsigned Tk = 0u;
#pragma unroll
                for (int bit = 30; bit >= 0; --bit) { const unsigned cand = Tk | (1u << bit); if (__builtin_popcountll(__ballot(key >= cand)) >= 16) Tk = cand; }
                const unsigned long long gtm = __ballot(key > Tk), eqm = __ballot(key == Tk);
                const int need = 16 - __builtin_popcountll(gtm);
                const int eqb = __builtin_popcountll(eqm & ((1ull << lane) - 1ull));
                const unsigned long long msk = __ballot(key > Tk || (key == Tk && eqb < need));
                if (lane == 0) { selm[rw * 2] = (unsigned)msk; selm[rw * 2 + 1] = (unsigned)(msk >> 32); }
            }
            __syncthreads();
            if (wave == 0) {
                unsigned lo = selm[lane * 2], hi = selm[lane * 2 + 1];
#pragma unroll
                for (int o = 1; o < 64; o <<= 1) { lo |= __shfl_xor(lo, o); hi |= __shfl_xor(hi, o); }
                if (lane == 0) { misc[0] = lo; misc[1] = hi; }
            }
            __syncthreads();
            const unsigned long long mymask = (unsigned long long)selm[row * 2] | ((unsigned long long)selm[row * 2 + 1] << 32);
            unsigned long long um = (unsigned long long)(unsigned)__builtin_amdgcn_readfirstlane((int)misc[0]) | ((unsigned long long)(unsigned)__builtin_amdgcn_readfirstlane((int)misc[1]) << 32);
            um &= (cur >= 63) ? ~0ull : ((1ull << (cur + 1)) - 1ull);
            constexpr int NSTT = 9216 + 64 * VRS;
#define NS_WRITE_RT(KR, VR, sb_) do { *(LAS u32x4*)(lds + (sb_) + (tid >> 3) * 144 + (tid & 7) * 16) = KR; *(LAS u32x4*)(lds + (sb_) + 9216 + (tid >> 3) * VRS + (tid & 7) * 16) = VR; } while (0)
            const unsigned long long um_all = um;
            for (int rpS = 0; rpS < REP_NSEL; ++rpS) {
                um = um_all; if (rpS) __syncthreads();
                f32x16 O0, O1;
#pragma unroll
                for (int r = 0; r < 16; ++r) { O0[r] = 0.f; O1[r] = 0.f; }
                float l = 0.f;
                int ja = __builtin_ctzll(um); um &= um - 1;
                int jb = -1; if (um) { jb = __builtin_ctzll(um); um &= um - 1; }
                int sb_ = 0;
#define SEL_K(j_) (Z + (tokb + 64 * (j_)) * NZP + ZC_KS)
#define SEL_V(j_) (Z + (tokb + 64 * (j_)) * NZP + ZC_VS)
#define SEL_TILE(j_, stp_) do { const bool sel = (mymask >> (j_)) & 1ull; \
                      if (__any(sel)) { f32x16 S0, S1; const LAS unsigned char* st_ = (stp_); \
                          if ((j_) >= cur - 2) { init_tab(S0, S1, TXh, t - 64 * (j_), hb, 1, 511, sel); qk64(S0, S1, q, st_, qi, hb); } else qk64z(S0, S1, q, st_, qi, hb); \
                          h8 va_[8]; ld_vtr(va_, st_ + 9216, lane); \
                          const float ps_ = exp_sum64(S0, S1); l += sel ? ps_ : 0.f; \
                          pv64mv(S0, S1, sel, va_, O0, O1); } } while (0)
                NS_ISSUE_R(kr, vr, SEL_K(ja), NZP * 2, SEL_V(ja), NZP * 2);
                { const int je = jb >= 0 ? jb : ja; NS_ISSUE_R(krB, vrB, SEL_K(je), NZP * 2, SEL_V(je), NZP * 2); }
                NS_WRITE_RT(kr, vr, 0); NS_WRITE_RT(krB, vrB, NSTT);
                __syncthreads();
                for (;;) {
                    int jc2 = -1, jd2 = -1; if (um) { jc2 = __builtin_ctzll(um); um &= um - 1; } if (um) { jd2 = __builtin_ctzll(um); um &= um - 1; }
                    { const int je = jc2 >= 0 ? jc2 : ja; NS_ISSUE_R(kr, vr, SEL_K(je), NZP * 2, SEL_V(je), NZP * 2); }
                    { const int je = jd2 >= 0 ? jd2 : ja; NS_ISSUE_R(krB, vrB, SEL_K(je), NZP * 2, SEL_V(je), NZP * 2); }
                    SEL_TILE(ja, lds + sb_);
                    if (jb >= 0) SEL_TILE(jb, lds + sb_ + NSTT);
                    if (jc2 >= 0) { NS_WRITE_RT(kr, vr, (sb_ ^ (2 * NSTT))); if (jd2 >= 0) NS_WRITE_RT(krB, vrB, (sb_ ^ (2 * NSTT)) + NSTT); }
                    __syncthreads(); ja = jc2; jb = jd2; sb_ ^= 2 * NSTT;
                    if (ja < 0) break;
                }
#undef SEL_TILE
#undef SEL_K
#undef SEL_V
                l += __shfl_xor(l, 32);
                const float g1 = gs1 * __builtin_amdgcn_rcpf(l);
                if (rpS == REP_NSEL - 1) {
#pragma unroll
                for (int r = 0; r < 16; ++r) { T0[r] += g1 * O0[r]; T1[r] += g1 * O1[r]; } }
            }
            __syncthreads();
            for (int rpW = 0; rpW < REP_NWIN; ++rpW) {
                if (rpW) __syncthreads();
                f32x16 O0, O1;
#pragma unroll
                for (int r = 0; r < 16; ++r) { O0[r] = 0.f; O1[r] = 0.f; }
                float l = 0.f;
                const int jlo = cur >= 8 ? cur - 8 : 0;
                int sb_ = 0;
#define WIN_K(j_) (Z + (tokb + 64 * (j_)) * NZP + ZC_KW)
#define WIN_V(j_) (Z + (tokb + 64 * (j_)) * NZP + ZC_VW)
#define WIN_TILE(j_, stp_) do { f32x16 S0, S1; const LAS unsigned char* st_ = (stp_); \
                      if ((j_) >= cur - 2 || (j_) == cur - 8) { init_tab(S0, S1, TXh, t - 64 * (j_), hb, 1, 512, true); qk64(S0, S1, q, st_, qi, hb); } else qk64z(S0, S1, q, st_, qi, hb); \
                      h8 va_[8]; ld_vtr(va_, st_ + 9216, lane); \
                      l += exp_sum64(S0, S1); \
                      pv64mv(S0, S1, true, va_, O0, O1); } while (0)
                NS_ISSUE_R(kr, vr, WIN_K(jlo), NZP * 2, WIN_V(jlo), NZP * 2);
                { const int je = jlo + 1 <= cur ? jlo + 1 : cur; NS_ISSUE_R(krB, vrB, WIN_K(je), NZP * 2, WIN_V(je), NZP * 2); }
                NS_WRITE_RT(kr, vr, 0); NS_WRITE_RT(krB, vrB, NSTT);
                __syncthreads();
                for (int j = jlo; j <= cur; j += 2) {
                    { const int je = j + 2 <= cur ? j + 2 : cur; NS_ISSUE_R(kr, vr, WIN_K(je), NZP * 2, WIN_V(je), NZP * 2); }
                    { const int je = j + 3 <= cur ? j + 3 : cur; NS_ISSUE_R(krB, vrB, WIN_K(je), NZP * 2, WIN_V(je), NZP * 2); }
                    WIN_TILE(j, lds + sb_);
                    if (j + 1 <= cur) WIN_TILE(j + 1, lds + sb_ + NSTT);
                    if (j + 2 <= cur) { NS_WRITE_RT(kr, vr, (sb_ ^ (2 * NSTT))); if (j + 3 <= cur) NS_WRITE_RT(krB, vrB, (sb_ ^ (2 * NSTT)) + NSTT); }
                    __syncthreads(); sb_ ^= 2 * NSTT;
                }
#undef WIN_TILE
#undef WIN_K
#undef WIN_V
                l += __shfl_xor(l, 32);
                const float g2 = gs2 * __builtin_amdgcn_rcpf(l);
                if (rpW == REP_NWIN - 1) {
#pragma unroll
                for (int r = 0; r < 16; ++r) { T0[r] += g2 * O0[r]; T1[r] += g2 * O1[r]; } }
            }
#undef NS_ISSUE_R
#undef NS_WRITE_R
#undef NS_WRITE_RT
            {
                float ss = 0.f;
#pragma unroll
                for (int r = 0; r < 16; ++r) ss += T0[r] * T0[r] + T1[r] * T1[r];
                ss += __shfl_xor(ss, 32);
                if (hb == 0) ex[row * 4 + h] = ss;
                __syncthreads();
                const float rs = rsqrtf((ex[row * 4] + ex[row * 4 + 1] + ex[row * 4 + 2] + ex[row * 4 + 3]) * (1.f / 256.f) + EPS);
                const float* gn = P.out_norm + (L * 4 + 3) * 256 + h * 64;
                half_t* op = MIXED + (tokb + t) * D + 768 + h * 64;
                u32x2 p0[4], p1[4];
#pragma unroll
                for (int g = 0; g < 4; ++g) {
                    const int d0 = 8 * g + 4 * hb; const f32x4 g0 = *(const f32x4*)(gn + d0), g1 = *(const f32x4*)(gn + 32 + d0);
                    p0[g].x = pack_h2(T0[4 * g] * rs * g0.x, T0[4 * g + 1] * rs * g0.y); p0[g].y = pack_h2(T0[4 * g + 2] * rs * g0.z, T0[4 * g + 3] * rs * g0.w);
                    p1[g].x = pack_h2(T1[4 * g] * rs * g1.x, T1[4 * g + 1] * rs * g1.y); p1[g].y = pack_h2(T1[4 * g + 2] * rs * g1.z, T1[4 * g + 3] * rs * g1.w);
                }
#pragma unroll
                for (int k = 0; k < 2; ++k) { *(u32x4*)(op + 8 * (2 * k + hb)) = swap_pair(p0[2 * k], p0[2 * k + 1]); *(u32x4*)(op + 32 + 8 * (2 * k + hb)) = swap_pair(p1[2 * k], p1[2 * k + 1]); }
            }
            __syncthreads();
        }
        else
        for (QPull qp_(ctl + CW_Q + ((L * 4 + 0) * 8 + (bid & 7)) * 64, MISC + 20); qp_.ui < 64; qp_.publish()) {
            qp_.issue(); const int ui = qp_.ui;
            int tid = threadIdx.x; asm volatile("" : "+v"(tid)); const int lane = tid & 63, hb = lane >> 5, qi = lane & 31;
            const int h = wave & 3, rh = wave >> 2;
            const int b = bid & 7, qt = 63 - ui, t0 = qt * 64, t = t0 + 32 * rh + qi, cur = qt, row = 32 * rh + qi;
            const size_t tokb = (size_t)b * SEQ;
            constexpr int NS_VT = 9216, NS_STAGE = 18432, NS_TR = 36864, NS_IMP = 38976, NS_SELM = NS_IMP + 4 * 64 * 65 * 4, NS_EX = NS_SELM + 512, NS_MISC = NS_EX + 1024;
            static_assert(NS_MISC + 256 <= RING_BYTES, "NSA LDS map");
            LAS float* TR = (LAS float*)(lds + NS_TR); LAS float* impH = (LAS float*)(lds + NS_IMP); LAS unsigned* selm = (LAS unsigned*)(lds + NS_SELM);
            LAS float* ex = (LAS float*)(lds + NS_EX); LAS unsigned* misc = (LAS unsigned*)(lds + NS_MISC);
            for (int e = tid; e < 4 * 129; e += NTHR) { const int hh = e / 129, d = e % 129; TR[hh * 132 + d] = P.rel_bias[(d < 128 ? (int)c_bucket[d] : 31) * 4 + hh] * LOG2E; }
            for (int e = tid; e < 4 * 64 * 65; e += NTHR) impH[e] = 0.f;
            const LAS float* TRh = TR + h * 132;
            h8 q[4];
#pragma unroll
            for (int kk = 0; kk < 4; ++kk) q[kk] = *(const h8*)(Z + (tokb + t) * NZP + ZC_NSA_Q + 64 * h + 16 * kk + 8 * hb);
            const float* gb = P.nsa_gate_bias + L * 12;
            const half_t* gz = Z + (tokb + t) * NZP + ZC_NSA_G;
            f32x16 T0, T1;
            u32x4 kr, vr, krB, vrB;
#define NS_ISSUE_R(KR, VR, kbase_, kstride_, vbase_, vstride_) do { KR = *(const u32x4*)((const char*)(kbase_) + (size_t)(tid >> 3) * (kstride_) + (tid & 7) * 16); \
                VR = *(const u32x4*)((const char*)(vbase_) + (size_t)(tid >> 3) * (vstride_) + (tid & 7) * 16); } while (0)
#define NS_WRITE_R(KR, VR, sb_) do { *(LAS u32x4*)(lds + (sb_) + (tid >> 3) * 144 + (tid & 7) * 16) = KR; *(LAS u32x4*)(lds + (sb_) + NS_VT + (tid >> 3) * 144 + (tid & 7) * 16) = VR; } while (0)
#define NS_ISSUE(kbase_, kstride_, vbase_, vstride_) do { kr = *(const u32x4*)((const char*)(kbase_) + (size_t)(tid >> 3) * (kstride_) + (tid & 7) * 16); \
                vr = *(const u32x4*)((const char*)(vbase_) + (size_t)(tid >> 3) * (vstride_) + (tid & 7) * 16); } while (0)
#define NS_WRITE(sb_) do { *(LAS u32x4*)(lds + (sb_) + (tid >> 3) * 144 + (tid & 7) * 16) = kr; *(LAS u32x4*)(lds + (sb_) + NS_VT + (tid >> 3) * 144 + (tid & 7) * 16) = vr; } while (0)
            {
                int cnt = (t0 + 63 - 31) / 16 + 1; if (cnt > NCMP) cnt = NCMP;
                const int ntc = (cnt + 63) >> 6;
                const half_t* kcb = KCH + (size_t)b * 256 * 64; const half_t* vcb = VCT + (size_t)b * 64 * 256;
                float m = -1e30f, l = 0.f;
                for (int c = 0; c < ntc; ++c) {
                    __syncthreads();
                    NS_ISSUE(kcb + (size_t)c * 64 * 64, 128, vcb + c * 64, 512); NS_WRITE(0);
                    __syncthreads();
                    f32x16 S0, S1; init_near(S0, S1, TRh, t - 31 - 1024 * c, hb, 16, 1 << 30);
                    qk64(S0, S1, q, lds, qi, hb);
                    const float mn = fmaxf(m, rowmax64(S0, S1)), alpha = __builtin_amdgcn_exp2f(m - mn);
                    m = mn; float ps = 0.f;
#pragma unroll
                    for (int r = 0; r < 16; ++r) ps += __builtin_amdgcn_exp2f(S0[r] - mn) + __builtin_amdgcn_exp2f(S1[r] - mn);
                    l = l * alpha + ps;
                }
                l += __shfl_xor(l, 32);
                const float il = l > 0.f ? __builtin_amdgcn_rcpf(l) : 0.f;
#pragma unroll
                for (int r = 0; r < 16; ++r) { T0[r] = 0.f; T1[r] = 0.f; }
                for (int c = 0; c < ntc; ++c) {
                    __syncthreads();
                    NS_ISSUE(kcb + (size_t)c * 64 * 64, 128, vcb + c * 64, 512); NS_WRITE(0);
                    __syncthreads();
                    f32x16 S0, S1; init_near(S0, S1, TRh, t - 31 - 1024 * c, hb, 16, 1 << 30);
                    qk64(S0, S1, q, lds, qi, hb);
#pragma unroll
                    for (int r = 0; r < 16; ++r) { S0[r] = __builtin_amdgcn_exp2f(S0[r] - m) * il; S1[r] = __builtin_amdgcn_exp2f(S1[r] - m) * il; }
                    LAS float* ip = impH + (h * 64 + row) * 65 + 16 * c + 2 * hb;
#pragma unroll
                    for (int g = 0; g < 4; ++g) {
                        const int mo = 4 * (g >> 1) + (g & 1);
                        { const float v1 = 16.f * S0[4 * g + 3], v0 = 32.f * ((S0[4 * g] + S0[4 * g + 1]) + S0[4 * g + 2]) + v1;
                          __hip_atomic_fetch_add(ip + mo, v0, __ATOMIC_RELAXED, __HIP_MEMORY_SCOPE_WORKGROUP); if (16 * c + 2 * hb + mo + 1 < 64) __hip_atomic_fetch_add(ip + mo + 1, v1, __ATOMIC_RELAXED, __HIP_MEMORY_SCOPE_WORKGROUP); }
                        { const float v1 = 16.f * S1[4 * g + 3], v0 = 32.f * ((S1[4 * g] + S1[4 * g + 1]) + S1[4 * g + 2]) + v1;
                          __hip_atomic_fetch_add(ip + 8 + mo, v0, __ATOMIC_RELAXED, __HIP_MEMORY_SCOPE_WORKGROUP); if (16 * c + 2 * hb + 8 + mo + 1 < 64) __hip_atomic_fetch_add(ip + 8 + mo + 1, v1, __ATOMIC_RELAXED, __HIP_MEMORY_SCOPE_WORKGROUP); }
                    }
                    pv64(S0, S1, lds + NS_VT, T0, T1, qi, hb);
                }
                const float g0 = sigmoidf_((float)gz[0 * 4 + h] + gb[0 * 4 + h]);
#pragma unroll
                for (int r = 0; r < 16; ++r) { T0[r] *= g0; T1[r] *= g0; }
            }
            __syncthreads();
#pragma unroll 4
            for (int rr = 0; rr < 8; ++rr) {
                const int rw = wave * 8 + rr;
                float v = ((impH[(0 * 64 + rw) * 65 + lane] + impH[(1 * 64 + rw) * 65 + lane]) + impH[(2 * 64 + rw) * 65 + lane]) + impH[(3 * 64 + rw) * 65 + lane];
                if (lane == 0 || lane == cur || lane == cur - 1) v = 1e30f;
                const unsigned key = lane > cur ? 0u : __builtin_bit_cast(unsigned, v) + 1u;
                unsigned Tk = 0u;
#pragma unroll
                for (int bit = 30; bit >= 0; --bit) { const unsigned cand = Tk | (1u << bit); if (__builtin_popcountll(__ballot(key >= cand)) >= 16) Tk = cand; }
                const unsigned long long gtm = __ballot(key > Tk), eqm = __ballot(key == Tk);
                const int need = 16 - __builtin_popcountll(gtm);
                const int eqb = __builtin_popcountll(eqm & ((1ull << lane) - 1ull));
                const unsigned long long msk = __ballot(key > Tk || (key == Tk && eqb < need));
                if (lane == 0) { selm[rw * 2] = (unsigned)msk; selm[rw * 2 + 1] = (unsigned)(msk >> 32); }
            }
            __syncthreads();
            if (wave == 0) {
                unsigned lo = selm[lane * 2], hi = selm[lane * 2 + 1];
#pragma unroll
                for (int o = 1; o < 64; o <<= 1) { lo |= __shfl_xor(lo, o); hi |= __shfl_xor(hi, o); }
                if (lane == 0) { misc[0] = lo; misc[1] = hi; }
            }
            __syncthreads();
            const unsigned long long mymask = (unsigned long long)selm[row * 2] | ((unsigned long long)selm[row * 2 + 1] << 32);
            unsigned long long um = (unsigned long long)__builtin_amdgcn_readfirstlane((int)misc[0]) | ((unsigned long long)(unsigned)__builtin_amdgcn_readfirstlane((int)misc[1]) << 32);
            um &= (cur >= 63) ? ~0ull : ((1ull << (cur + 1)) - 1ull);
            const float cfar = TRh[128];
            {
                f32x16 O0, O1;
#pragma unroll
                for (int r = 0; r < 16; ++r) { O0[r] = 0.f; O1[r] = 0.f; }
                float m = -1e30f, l = 0.f;
                int jc = __builtin_ctzll(um); um &= um - 1;
                int jn = -1; if (um) { jn = __builtin_ctzll(um); um &= um - 1; }
                int it = 0;
#define SEL_K(j_) (Z + (tokb + 64 * (j_)) * NZP + ZC_KS)
#define SEL_V(j_) (VST + (size_t)(b * 64 + (j_)) * 64 * 64)
                NS_ISSUE_R(kr, vr, SEL_K(jc), NZP * 2, SEL_V(jc), 128); NS_WRITE_R(kr, vr, 0);
                { const int je = jn >= 0 ? jn : jc; NS_ISSUE_R(kr, vr, SEL_K(je), NZP * 2, SEL_V(je), 128); }
                __syncthreads();
#define SEL_BODY(KX, VX, KY, VY) do { \
                    int jnn = -1; if (um) { jnn = __builtin_ctzll(um); um &= um - 1; } \
                    { const int je = jnn >= 0 ? jnn : jc; NS_ISSUE_R(KY, VY, SEL_K(je), NZP * 2, SEL_V(je), 128); } \
                    { const bool sel = (mymask >> jc) & 1ull; \
                      if (__any(sel)) nsa_tile(jc >= cur - 2, t - 64 * jc, sel ? (1 << 30) : 0, sel ? cfar : -INFINITY, TRh, q, lds + (it & 1) * NS_STAGE, m, l, O0, O1, qi, hb); } \
                    if (jn >= 0) NS_WRITE_R(KX, VX, ((it + 1) & 1) * NS_STAGE); \
                    __syncthreads(); jc = jn; jn = jnn; ++it; } while (0)
                for (;;) { SEL_BODY(kr, vr, krB, vrB); if (jc < 0) break; SEL_BODY(krB, vrB, kr, vr); if (jc < 0) break; }
#undef SEL_BODY
#undef SEL_K
#undef SEL_V
                l += __shfl_xor(l, 32);
                const float g1 = sigmoidf_((float)gz[1 * 4 + h] + gb[1 * 4 + h]) * __builtin_amdgcn_rcpf(l);
#pragma unroll
                for (int r = 0; r < 16; ++r) { T0[r] += g1 * O0[r]; T1[r] += g1 * O1[r]; }
            }
            __syncthreads();
            {
                f32x16 O0, O1;
#pragma unroll
                for (int r = 0; r < 16; ++r) { O0[r] = 0.f; O1[r] = 0.f; }
                float m = -1e30f, l = 0.f;
                const int jlo = cur >= 8 ? cur - 8 : 0;
#define WIN_K(j_) (Z + (tokb + 64 * (j_)) * NZP + ZC_KW)
#define WIN_V(j_) (VWT + (size_t)(b * 64 + (j_)) * 64 * 64)
                NS_ISSUE_R(kr, vr, WIN_K(jlo), NZP * 2, WIN_V(jlo), 128); NS_WRITE_R(kr, vr, 0);
                { const int je = jlo + 1 <= cur ? jlo + 1 : cur; NS_ISSUE_R(kr, vr, WIN_K(je), NZP * 2, WIN_V(je), 128); }
                __syncthreads();
                int j = jlo;
#define WIN_BODY(KX, VX, KY, VY) do { \
                    { const int je = j + 2 <= cur ? j + 2 : cur; NS_ISSUE_R(KY, VY, WIN_K(je), NZP * 2, WIN_V(je), 128); } \
                    nsa_tile(j >= cur - 2 || j == cur - 8, t - 64 * j, 512, cfar, TRh, q, lds + ((j - jlo) & 1) * NS_STAGE, m, l, O0, O1, qi, hb); \
                    if (j + 1 <= cur) NS_WRITE_R(KX, VX, (((j - jlo) + 1) & 1) * NS_STAGE); \
                    __syncthreads(); ++j; } while (0)
                for (;;) { WIN_BODY(kr, vr, krB, vrB); if (j > cur) break; WIN_BODY(krB, vrB, kr, vr); if (j > cur) break; }
#undef WIN_BODY
#undef WIN_K
#undef WIN_V
                l += __shfl_xor(l, 32);
                const float g2 = sigmoidf_((float)gz[2 * 4 + h] + gb[2 * 4 + h]) * __builtin_amdgcn_rcpf(l);
#pragma unroll
                for (int r = 0; r < 16; ++r) { T0[r] += g2 * O0[r]; T1[r] += g2 * O1[r]; }
            }
#undef NS_ISSUE
#undef NS_WRITE
#undef NS_ISSUE_R
#undef NS_WRITE_R
            {
                float ss = 0.f;
#pragma unroll
                for (int r = 0; r < 16; ++r) ss += T0[r] * T0[r] + T1[r] * T1[r];
                ss += __shfl_xor(ss, 32);
                if (hb == 0) ex[row * 4 + h] = ss;
                __syncthreads();
                const float rs = rsqrtf((ex[row * 4] + ex[row * 4 + 1] + ex[row * 4 + 2] + ex[row * 4 + 3]) * (1.f / 256.f) + EPS);
                const float* gn = P.out_norm + (L * 4 + 3) * 256 + h * 64;
                half_t* op = MIXED + (tokb + t) * D + 768 + h * 64;
#pragma unroll
                for (int g = 0; g < 4; ++g) {
                    const int d0 = 8 * g + 4 * hb; const f32x4 g0 = *(const f32x4*)(gn + d0), g1 = *(const f32x4*)(gn + 32 + d0);
                    u32x2 o0, o1;
                    o0.x = pack_h2(T0[4 * g] * rs * g0.x, T0[4 * g + 1] * rs * g0.y); o0.y = pack_h2(T0[4 * g + 2] * rs * g0.z, T0[4 * g + 3] * rs * g0.w);
                    o1.x = pack_h2(T1[4 * g] * rs * g1.x, T1[4 * g + 1] * rs * g1.y); o1.y = pack_h2(T1[4 * g + 2] * rs * g1.z, T1[4 * g + 3] * rs * g1.w);
                    *(u32x2*)(op + d0) = o0; *(u32x2*)(op + 32 + d0) = o1;
                }
            }
            __syncthreads();
        }
#endif
#ifndef SKIP_FOX
        for (QPull qp_(ctl + CW_Q + ((L * 4 + 1) * 8 + (bid & 7)) * 64, MISC + 20); qp_.ui < 32; qp_.publish()) {
            qp_.issue(); const int ui = qp_.ui;
            int tid = threadIdx.x; asm volatile("" : "+v"(tid)); const int lane = tid & 63, hb = lane >> 5, qi = lane & 31;
            const int h = wave & 3, rh = wave >> 2;
            const int b = bid & 7, qt = 31 - ui, t0 = qt * 128, tA = t0 + 64 * rh + qi;
            const size_t tokb = (size_t)b * SEQ;
            const float* cf = CFOX + (size_t)b * 4 * SEQ;
            constexpr int FX_VT = 18432, FX_CB = 38912, FX_STAGE = 39424, FX_EX = 2 * FX_STAGE, FX_MISC = FX_EX + 2048;
            LAS unsigned* misc = (LAS unsigned*)(lds + FX_MISC);
            if (wave == 0) {
                float gq = fabsf(P.fox_qk_norm[(L * 2 + 0) * 64 + lane]), gk = fabsf(P.fox_qk_norm[(L * 2 + 1) * 64 + lane]);
#pragma unroll
                for (int o = 1; o < 64; o <<= 1) { gq = fmaxf(gq, __shfl_xor(gq, o)); gk = fmaxf(gk, __shfl_xor(gk, o)); }
                const float bound = -(30.f + 16.f * gq * gk);
                const float sb2 = 8.f * gq * gk * LOG2E;
                if (lane == 0) { misc[1] = sb2 <= 15.8f ? 1u : 0u; misc[2] = __builtin_bit_cast(unsigned, 15.8f - sb2); }
                bool c0 = false, c1 = false;
#pragma unroll
                for (int hh = 0; hh < 4; ++hh) { const float cref = cf[hh * SEQ + t0];
                    const int e0 = 32 * lane + 31, e1 = 32 * (lane + 64) + 31;
                    c0 = c0 || (e0 >= t0) || (cref - cf[hh * SEQ + (e0 < SEQ ? e0 : SEQ - 1)] > bound);
                    c1 = c1 || (e1 >= t0) || (cref - cf[hh * SEQ + (e1 < SEQ ? e1 : SEQ - 1)] > bound); }
                const unsigned long long b0 = __ballot(c0), b1 = __ballot(c1);
                if (lane == 0) misc[0] = b0 ? (unsigned)__builtin_ctzll(b0) : 64u + (unsigned)__builtin_ctzll(b1);
            }
            __syncthreads();
            const int kt_lo = __builtin_amdgcn_readfirstlane((int)misc[0]), kt_hi = 4 * qt + 3;
            const bool fx_fast = __builtin_amdgcn_readfirstlane((int)misc[1]) != 0;
            const float fx_sh = __builtin_bit_cast(float, __builtin_amdgcn_readfirstlane((int)misc[2]));
            h8 qA[4], qB[4];
#pragma unroll
            for (int kk = 0; kk < 4; ++kk) { qA[kk] = *(const h8*)(Z + (tokb + tA) * NZP + ZC_FOX_Q + 64 * h + 16 * kk + 8 * hb); qB[kk] = *(const h8*)(Z + (tokb + tA + 32) * NZP + ZC_FOX_Q + 64 * h + 16 * kk + 8 * hb); }
            f32x16 OA0, OA1, OB0, OB1;
#pragma unroll
            for (int r = 0; r < 16; ++r) { OA0[r] = 0.f; OA1[r] = 0.f; OB0[r] = 0.f; OB1[r] = 0.f; }
            float mA = fx_fast ? -((cf[h * SEQ + tA] - cf[h * SEQ + t0]) * LOG2E + fx_sh) : -1e30f, lA = 0.f;
            float mB = fx_fast ? -((cf[h * SEQ + tA + 32] - cf[h * SEQ + t0]) * LOG2E + fx_sh) : -1e30f, lB = 0.f;
            u32x4 krA[2], vrA[2]; float cbA = 0.f;
            const float cref = cf[((tid >> 5) & 3) * SEQ + t0];
#define FX_ISSUE(KR, VR, CB, kt_) do { _Pragma("unroll") for (int i_ = 0; i_ < 2; ++i_) { const int p_ = tid + 512 * i_; \
                KR[i_] = *(const u32x4*)(Z + (tokb + 32 * (kt_) + (p_ >> 5)) * NZP + ZC_FOX_K + 8 * (p_ & 31)); \
                VR[i_] = *(const u32x4*)(Z + (tokb + 32 * (kt_) + (p_ >> 5)) * NZP + ZC_FOX_V + 8 * (p_ & 31)); } \
                CB = cf[((tid >> 5) & 3) * SEQ + 32 * (kt_) + (tid & 31)]; } while (0)
#define FX_WRITE(KR, VR, CB, sb_) do { _Pragma("unroll") for (int i_ = 0; i_ < 2; ++i_) { const int p_ = tid + 512 * i_; \
                *(LAS u32x4*)(lds + (sb_) + ((p_ & 31) >> 3) * 4608 + (p_ >> 5) * 144 + (p_ & 7) * 16) = KR[i_]; \
                *(LAS u32x4*)(lds + (sb_) + FX_VT + (p_ >> 5) * FVRS + (p_ & 31) * 16) = VR[i_]; } \
                if (tid < 128) *(LAS float*)(lds + (sb_) + FX_CB + tid * 4) = (cref - CB) * LOG2E; } while (0)
            FX_ISSUE(krA, vrA, cbA, kt_lo); FX_WRITE(krA, vrA, cbA, (kt_lo & 1) * FX_STAGE);
            __syncthreads();
            const int rA0 = t0 + 64 * rh;
#define FX_LOOP(FASTF) for (int kt = kt_lo; kt <= kt_hi; ++kt) { \
                FX_ISSUE(krA, vrA, cbA, (kt + 1 <= kt_hi ? kt + 1 : kt_hi)); \
                if (32 * kt <= rA0 + 63) fox_tile2<FASTF>(lds + (kt & 1) * FX_STAGE, h, qA, qB, qi, hb, 32 * kt, tA, 32 * kt + 31 > rA0, 32 * kt + 31 > rA0 + 32, mA, lA, OA0, OA1, mB, lB, OB0, OB1); \
                if (kt + 1 <= kt_hi) FX_WRITE(krA, vrA, cbA, ((kt + 1) & 1) * FX_STAGE); \
                __syncthreads(); }
            if (fx_fast) { FX_LOOP(true) } else { FX_LOOP(false) }
#undef FX_LOOP
#undef FX_ISSUE
#undef FX_WRITE
            {
                lA += __shfl_xor(lA, 32); lB += __shfl_xor(lB, 32);
                const float invA = __builtin_amdgcn_rcpf(lA), invB = __builtin_amdgcn_rcpf(lB); float ssA = 0.f, ssB = 0.f;
#pragma unroll
                for (int r = 0; r < 16; ++r) { OA0[r] *= invA; OA1[r] *= invA; ssA += OA0[r] * OA0[r] + OA1[r] * OA1[r]; OB0[r] *= invB; OB1[r] *= invB; ssB += OB0[r] * OB0[r] + OB1[r] * OB1[r]; }
                ssA += __shfl_xor(ssA, 32); ssB += __shfl_xor(ssB, 32);
                LAS float* ex = (LAS float*)(lds + FX_EX);
                const int ridx = 64 * rh + qi;
                if (hb == 0) { ex[ridx * 4 + h] = ssA; ex[(ridx + 32) * 4 + h] = ssB; }
                __syncthreads();
                const float* gn = P.out_norm + (L * 4 + 2) * 256 + h * 64;
#pragma unroll
                for (int rb = 0; rb < 2; ++rb) {
                    const int rx = ridx + 32 * rb;
                    const float rs = rsqrtf((ex[rx * 4] + ex[rx * 4 + 1] + ex[rx * 4 + 2] + ex[rx * 4 + 3]) * (1.f / 256.f) + EPS);
                    half_t* op = MIXED + (tokb + tA + 32 * rb) * D + 512 + h * 64;
                    const f32x16& O0 = rb ? OB0 : OA0; const f32x16& O1 = rb ? OB1 : OA1;
                    u32x2 p0[4], p1[4];
#pragma unroll
                    for (int g = 0; g < 4; ++g) {
                        const int d0 = 8 * g + 4 * hb; const f32x4 g0 = *(const f32x4*)(gn + d0), g1 = *(const f32x4*)(gn + 32 + d0);
                        p0[g].x = pack_h2(O0[4 * g] * rs * g0.x, O0[4 * g + 1] * rs * g0.y); p0[g].y = pack_h2(O0[4 * g + 2] * rs * g0.z, O0[4 * g + 3] * rs * g0.w);
                        p1[g].x = pack_h2(O1[4 * g] * rs * g1.x, O1[4 * g + 1] * rs * g1.y); p1[g].y = pack_h2(O1[4 * g + 2] * rs * g1.z, O1[4 * g + 3] * rs * g1.w);
                    }
#pragma unroll
                    for (int k = 0; k < 2; ++k) { *(u32x4*)(op + 8 * (2 * k + hb)) = swap_pair(p0[2 * k], p0[2 * k + 1]); *(u32x4*)(op + 32 + 8 * (2 * k + hb)) = swap_pair(p1[2 * k], p1[2 * k + 1]); }
                }
            }
            __syncthreads();
        }
#endif
#ifndef SKIP_LRU
        for (int rpl = 0; rpl < REP_LRU; ++rpl)
        for (QPull qp_(ctl + CW_Q + (rpl * 64 + (L * 4 + 2) * 8 + (bid & 7)) * 64, MISC + 20); qp_.ui < 64; qp_.publish()) {
            qp_.issue(); const int gI = qp_.ui;
            float hc = 0.f;
            for (int k = 0; k < 2; ++k) lru_final(P, L, ((bid & 7) << 7) + 2 * (63 - gI) + k, lds, Z, LRUAGG, LRUA, LRUB, MIXED, wave, hc, k == 0);
        }
#endif
        }
        xcd_barrier(bar);

#ifndef SKIP_G4
        {
            SECTION_ENV();
            pg8::Gemm g{MIXED, WOUT_T + (size_t)L * D * D, T, D, D}; pg8::StaticOrder S; S.init(T, D, G, bid, G4_WGM);
            EpiRes E{nullptr, XH, SSQA};
            for (int rp = 0; rp < REP_G4N; ++rp) { EpiNull EN; pg8::gemm_phase<EpiNull, pg8::StaticOrder>(lds, g, S, EN); }
            pg8::gemm_phase<EpiRes, pg8::StaticOrder>(lds, g, S, E);
        }
#endif
        xcd_barrier(bar);
#ifndef SKIP_G5
        {
            SECTION_ENV();
            pg8::Gemm g{XH, WGU_T + (size_t)L * 2 * DFF * D, T, 2 * DFF, D}; pg8::StaticOrder S; S.init(T, 2 * DFF, G, bid, G5_WGM);
            EpiSwiglu E{HB, SSQA};
            for (int rp = 0; rp < REP_G5; ++rp) pg8::gemm_phase<EpiSwiglu, pg8::StaticOrder>(lds, g, S, E);
        }
#endif
        xcd_barrier(bar);
#ifndef SKIP_G6
        {
            SECTION_ENV();
            pg8::Gemm g{HB, WDN_T + (size_t)L * D * DFF, T, D, DFF}; pg8::StaticOrder S; S.init(T, D, G, bid, G6_WGM);
            EpiRes E{L == 0 ? nullptr : P.out, XH, L == 0 ? SSQB : nullptr};
            for (int rp = 0; rp < REP_G6N; ++rp) { EpiNull EN; pg8::gemm_phase<EpiNull, pg8::StaticOrder>(lds, g, S, EN); }
            pg8::gemm_phase<EpiRes, pg8::StaticOrder>(lds, g, S, E);
        }
#endif
        if (L == 0) xcd_barrier(bar);
    }
}

extern "C" void kernel_launch(void* const* d_in, const int* in_sizes, int n_in, void* d_out, int out_size, void* d_ws, size_t ws_size, hipStream_t stream) {
    static int grid = 0;
    if (grid == 0) {
        if (n_in != 22 || ws_size < WS_END) { fprintf(stderr, "kernel_launch: unexpected n_in %d or ws_size %zu (< %zu)\n", n_in, ws_size, (size_t)WS_END); grid = -1; return; }
        int dev = 0, cus = 0, per_cu = 0;
        if (hipGetDevice(&dev) != hipSuccess || hipDeviceGetAttribute(&cus, hipDeviceAttributeMultiprocessorCount, dev) != hipSuccess) { grid = -1; return; }
        if (hipFuncSetAttribute((const void*)hymba_fwd, hipFuncAttributeMaxDynamicSharedMemorySize, LDS_BYTES) != hipSuccess) { fprintf(stderr, "kernel_launch: hipFuncSetAttribute failed\n"); grid = -1; return; }
        if (hipOccupancyMaxActiveBlocksPerMultiprocessor(&per_cu, (const void*)hymba_fwd, NTHR, LDS_BYTES) != hipSuccess || per_cu < 1) { fprintf(stderr, "kernel_launch: occupancy query says %d\n", per_cu); }
        (void)hipGetLastError();
        grid = cus;
    }
    if (grid < 0) return;
    (void)hipMemsetAsync((char*)d_ws + WS_CTL, 0, CTL_ZERO_BYTES, stream);
    Params p{};
    p.x = (const float*)d_in[0]; p.norm_mix = (const float*)d_in[1]; p.w_in = (const float*)d_in[2]; p.lru_conv_w = (const float*)d_in[3]; p.lru_conv_b = (const float*)d_in[4];
    p.lru_w_gates = (const float*)d_in[5]; p.lru_b_gates = (const float*)d_in[6]; p.lru_lambda = (const float*)d_in[7]; p.sc_conv_w = (const float*)d_in[8];
    p.fox_f_bias = (const float*)d_in[9]; p.fox_qk_norm = (const float*)d_in[10]; p.nsa_qk_norm = (const float*)d_in[11]; p.nsa_cmp_pos = (const float*)d_in[12];
    p.nsa_cmp_w1 = (const float*)d_in[13]; p.nsa_cmp_w2 = (const float*)d_in[14]; p.nsa_gate_bias = (const float*)d_in[15]; p.rel_bias = (const float*)d_in[16];
    p.out_norm = (const float*)d_in[17]; p.w_out = (const float*)d_in[18]; p.norm_ffn = (const float*)d_in[19]; p.w_gate_up = (const float*)d_in[20]; p.w_down = (const float*)d_in[21];
    p.out = (float*)d_out; p.ws = (unsigned char*)d_ws;
    hipLaunchKernelGGL(hymba_fwd, dim3(grid), dim3(NTHR), LDS_BYTES, stream, p);
}
```
